# Optimizing an MI355X kernel written in HIP

```python
import jax
import jax.numpy as jnp
from jax import lax
import numpy as np

D_MODEL = 1024
BATCH = 8
SEQ = 4096
DEPTH = 2

GRID_W = 64
CTX_LEN = 256
HEAD_DIM = 64
D_MIX = D_MODEL
RWKV_W = 3 * D_MIX // 8
HGRN_W = D_MIX // 4
ATTN_W = D_MIX - RWKV_W - HGRN_W
RWKV_HEADS = RWKV_W // HEAD_DIM
HGRN_HEADS = HGRN_W // HEAD_DIM
ATTN_Q_HEADS = ATTN_W // HEAD_DIM
ATTN_KV_HEADS = 2
ATTN_GROUP = ATTN_Q_HEADS // ATTN_KV_HEADS
ATTN_KV_W = ATTN_KV_HEADS * HEAD_DIM
DECAY_LORA = 64
ICLR_LORA = 64
VRES_LORA = 32
GN_EPS = 64e-5
NORM_EPS = 1e-6
HGRN_CHUNK = 32
ATTN_WINDOW = 128
ATTN_BLOCK = 128
ROPE_THETA = 10000.0
RWKV_SPLITS = (RWKV_W, RWKV_W, RWKV_W, DECAY_LORA, DECAY_LORA, ICLR_LORA, ICLR_LORA, RWKV_W)
HGRN_SPLITS = (HGRN_W, HGRN_W, HGRN_W, HGRN_W, HGRN_W)
ATTN_SPLITS = (ATTN_W, ATTN_KV_W, ATTN_KV_W, ATTN_W)
RWKV_COLS = sum(RWKV_SPLITS)
HGRN_COLS = sum(HGRN_SPLITS)
ATTN_COLS = sum(ATTN_SPLITS)
IN_COLS = RWKV_COLS + HGRN_COLS + ATTN_COLS
F32 = jnp.float32

kernel_name = 'hybrid_rwkv7_hgrn2_swa_diffusion_trunk'


def rms_norm(x, w):
    xf = x.astype(F32)
    y = xf * lax.rsqrt(jnp.mean(xf * xf, axis=-1, keepdims=True) + NORM_EPS)
    return (y * w.astype(F32)).astype(x.dtype)


def _split(p, sizes):
    cuts, acc = [], 0
    for s in sizes[:-1]:
        acc += s
        cuts.append(acc)
    return jnp.split(p, cuts, axis=-1)


def _heads(t, n):
    return t.reshape(t.shape[:-1] + (n, t.shape[-1] // n))


def _dirs_shared(t):
    return jnp.stack([t, jnp.flip(t, axis=1)])


def _dirs_own(t):
    return jnp.stack([t[0], jnp.flip(t[1], axis=1)])


def centred_shift(p, mu_prev, mu_next):
    prev = jnp.pad(p, ((0, 0), (1, 0), (0, 0)))[:, :-1]
    nxt = jnp.pad(p, ((0, 0), (0, 1), (0, 0)))[:, 1:]
    return p + mu_prev * (prev - p) + mu_next * (nxt - p)


def rope_1d(x, pos):
    half = x.shape[-1] // 2
    inv = ROPE_THETA ** (-jnp.arange(half, dtype=F32) / half)
    ang = pos.astype(F32)[:, None] * inv[None, :]
    cos = jnp.cos(ang)[None, :, None, :]
    sin = jnp.sin(ang)[None, :, None, :]
    x1, x2 = x[..., :half], x[..., half:]
    return jnp.concatenate([x1 * cos - x2 * sin, x1 * sin + x2 * cos], axis=-1)


def axial_rope(x, row, col):
    half = x.shape[-1] // 2
    return jnp.concatenate([rope_1d(x[..., :half], row), rope_1d(x[..., half:], col)], axis=-1)


def rwkv_features(pa, h, v_first, mu_prev, mu_next, w0, w2, a0, a2, k_k, k_a, vres):
    pa = centred_shift(pa.astype(F32), mu_prev, mu_next)
    r, k, v, wd_f, wd_b, ad_f, ad_b, g = _split(pa, RWKV_SPLITS)
    wd = jnp.stack([wd_f, wd_b])
    ad = jnp.stack([ad_f, ad_b])
    w_log = -jax.nn.softplus(-(w0[:, None, None, :] + jnp.einsum('zbtr,zrc->zbtc', jnp.tanh(wd), w2))) - 0.5
    decay = jnp.exp(-jnp.exp(w_log))
    a = jax.nn.sigmoid(a0[:, None, None, :] + jnp.einsum('zbtr,zrc->zbtc', ad, a2))
    if vres is not None:
        vw1, vw2, vb = vres
        v = v + (v_first - v) * jax.nn.sigmoid(vb + (h.astype(F32) @ vw1) @ vw2)
    B, T, _ = k.shape
    kk = _heads(k * k_k, RWKV_HEADS)
    kk = (kk / jnp.maximum(jnp.linalg.norm(kk, axis=-1, keepdims=True), 1e-12)).reshape(B, T, RWKV_W)
    k_dir = k * (1.0 + (a - 1.0) * k_a)
    b_dir = kk * a
    return (r, decay, k_dir, v, kk, b_dir, g, k)


def rwkv_mix(feats, s0, with_output):
    r, decay, k_dir, v, kk, b_dir = feats[:6]
    seqs = (_dirs_shared(r), _dirs_own(decay), _dirs_own(k_dir), _dirs_shared(v), _dirs_shared(kk), _dirs_own(b_dir))
    xs = tuple(jnp.transpose(_heads(t, RWKV_HEADS), (2, 0, 1, 3, 4)) for t in seqs)

    def step(state, inp):
        r_t, w_t, k_t, v_t, kk_t, b_t = inp
        sa = jnp.einsum('zbhvk,zbhk->zbhv', state, -kk_t)
        state = state * w_t[..., None, :] + sa[..., :, None] * b_t[..., None, :] + v_t[..., :, None] * k_t[..., None, :]
        y = jnp.einsum('zbhvk,zbhk->zbhv', state, r_t) if with_output else None
        return state, y

    state, ys = lax.scan(step, s0, xs)
    if not with_output:
        return state, None
    y = ys[:, 0] + jnp.flip(ys[:, 1], axis=0)
    return state, jnp.transpose(y, (1, 0, 2, 3))


def rwkv_readout(y, feats, r_k, gn_w, gn_b):
    r, v, g, k = feats[0], feats[3], feats[6], feats[7]
    B, T, _ = r.shape
    yc = y - jnp.mean(y, axis=-1, keepdims=True)
    yn = yc * lax.rsqrt(jnp.mean(yc * yc, axis=-1, keepdims=True) + GN_EPS)
    yn = yn.reshape(B, T, RWKV_W) * gn_w + gn_b
    bonus = jnp.sum(_heads(r, RWKV_HEADS) * _heads(k, RWKV_HEADS) * r_k, axis=-1, keepdims=True) * _heads(v, RWKV_HEADS)
    return (yn + bonus.reshape(B, T, RWKV_W)) * jax.nn.silu(g)


def hgrn_features(pb, lb):
    q, f_fwd, f_bwd, i, g = _split(pb.astype(F32), HGRN_SPLITS)
    lbb = lb[:, None, None, :]
    forget = lbb + (1.0 - lbb) * jax.nn.sigmoid(jnp.stack([f_fwd, f_bwd]))
    return (q, jnp.log(forget), 1.0 - forget, i, g)


def hgrn_mix(feats, s0, with_output):
    q, log_f, key, i = feats[:4]
    B, T, _ = q.shape

    def chunks(t):
        z, b, n, _ = t.shape
        return jnp.transpose(t.reshape(z, b, n // HGRN_CHUNK, HGRN_CHUNK, HGRN_HEADS, HEAD_DIM), (2, 0, 1, 4, 3, 5))

    xs = (chunks(_dirs_shared(q)), chunks(_dirs_own(key)), chunks(_dirs_shared(i)), chunks(_dirs_own(log_f)))
    lower_tri = jnp.tril(jnp.ones((HGRN_CHUNK, HGRN_CHUNK), dtype=bool))

    def step(state, inp):
        q_c, k_c, v_c, g_c = inp
        b = jnp.cumsum(g_c, axis=-2)
        b_last = b[..., -1, :]
        new_state = state * jnp.exp(b_last)[..., :, None] + jnp.einsum('zbhsk,zbhsv->zbhkv', k_c * jnp.exp(b_last[..., None, :] - b), v_c)
        if not with_output:
            return new_state, None
        o_inter = jnp.einsum('zbhtk,zbhkv->zbhtv', q_c * jnp.exp(b), state)
        diff = jnp.where(lower_tri[:, :, None], b[..., :, None, :] - b[..., None, :, :], -jnp.inf)
        att = jnp.sum(q_c[..., :, None, :] * k_c[..., None, :, :] * jnp.exp(diff), axis=-1)
        return new_state, o_inter + jnp.einsum('zbhts,zbhsv->zbhtv', att, v_c)

    state, outs = lax.scan(step, s0, xs)
    if not with_output:
        return state, None
    o = jnp.transpose(outs, (1, 2, 0, 4, 3, 5)).reshape(2, B, T, HGRN_HEADS, HEAD_DIM)
    return state, o[0] + jnp.flip(o[1], axis=1)


def hgrn_readout(o, g, norm_w):
    B, T, _ = g.shape
    on = o * lax.rsqrt(jnp.mean(o * o, axis=-1, keepdims=True) + NORM_EPS)
    return on.reshape(B, T, HGRN_W) * norm_w * jax.nn.silu(g)


def banded_attention(q, k, v, kc, vc, sink):
    B, T = q.shape[:2]
    nb = T // ATTN_BLOCK
    qb = q.reshape(B, nb, ATTN_BLOCK, ATTN_KV_HEADS, ATTN_GROUP, HEAD_DIM)

    def band(t):
        tb = t.reshape(B, nb, ATTN_BLOCK, ATTN_KV_HEADS, HEAD_DIM)
        tp = jnp.pad(tb, ((0, 0), (1, 1), (0, 0), (0, 0), (0, 0)))
        return jnp.concatenate([tp[:, :-2], tp[:, 1:-1], tp[:, 2:]], axis=2)

    kband, vband = band(k), band(v)
    blk = jnp.arange(nb)[:, None]
    q_pos = blk * ATTN_BLOCK + jnp.arange(ATTN_BLOCK)[None, :]
    k_pos = (blk - 1) * ATTN_BLOCK + jnp.arange(3 * ATTN_BLOCK)[None, :]
    kp = k_pos[:, None, :]
    valid = (kp >= 0) & (kp < T) & (jnp.abs(kp - q_pos[:, :, None]) <= ATTN_WINDOW)
    scale = HEAD_DIM ** -0.5
    s_loc = jnp.einsum('bnqhgd,bnkhd->bnhgqk', qb, kband) * scale
    s_loc = jnp.where(valid[None, :, None, None], s_loc, -jnp.inf)
    s_ctx = jnp.einsum('bnqhgd,bchd->bnhgqc', qb, kc) * scale
    s_sink = jnp.broadcast_to(sink.reshape(ATTN_KV_HEADS, ATTN_GROUP)[None, None, :, :, None, None], s_loc.shape[:-1] + (1,))
    probs = jax.nn.softmax(jnp.concatenate([s_loc, s_ctx, s_sink], axis=-1).astype(F32), axis=-1)
    nk, nc = 3 * ATTN_BLOCK, kc.shape[1]
    o = jnp.einsum('bnhgqk,bnkhd->bnqhgd', probs[..., :nk], vband) + jnp.einsum('bnhgqc,bchd->bnqhgd', probs[..., nk:nk + nc], vc)
    return o.reshape(B, T, ATTN_W)


def context_attention(qc, kc, vc, sink):
    B, C = qc.shape[:2]
    qg = qc.reshape(B, C, ATTN_KV_HEADS, ATTN_GROUP, HEAD_DIM)
    s = jnp.einsum('bqhgd,bkhd->bhgqk', qg, kc) * HEAD_DIM ** -0.5
    s_sink = jnp.broadcast_to(sink.reshape(ATTN_KV_HEADS, ATTN_GROUP)[None, :, :, None, None], s.shape[:-1] + (1,))
    probs = jax.nn.softmax(jnp.concatenate([s, s_sink], axis=-1).astype(F32), axis=-1)
    o = jnp.einsum('bhgqk,bkhd->bqhgd', probs[..., :C], vc)
    return o.reshape(B, C, ATTN_W)


def setup_inputs(seed: int = 0) -> dict:
    key = jax.random.key(seed)
    ks = jax.random.split(key, 27)
    L, D = DEPTH, D_MODEL

    def nrm(k, shape, s):
        return s * jax.random.normal(k, shape, F32)

    return {
        'x': nrm(ks[0], (BATCH, SEQ, D), 1.0),
        'c': nrm(ks[1], (BATCH, D), 1.0),
        'ctx': nrm(ks[2], (BATCH, CTX_LEN, D), 1.0),
        'c_ctx': nrm(ks[3], (D,), 1.0),
        'mod_w': nrm(ks[4], (L, D, 3 * D), 0.5 * D ** -0.5),
        'mod_b': nrm(ks[5], (L, 3 * D), 0.02),
        'norm_w': 1.0 + nrm(ks[6], (L, D), 0.02),
        'w_in': nrm(ks[7], (L, D, IN_COLS), D ** -0.5),
        'w_out': nrm(ks[8], (L, D_MIX, D), D_MIX ** -0.5),
        'rwkv_mu_prev': jax.random.uniform(ks[9], (L, RWKV_COLS), F32, 0.0, 0.5),
        'rwkv_mu_next': jax.random.uniform(ks[10], (L, RWKV_COLS), F32, 0.0, 0.5),
        'rwkv_w0': nrm(ks[11], (L, 2, RWKV_W), 0.5),
        'rwkv_w2': nrm(ks[12], (L, 2, DECAY_LORA, RWKV_W), 0.5 * DECAY_LORA ** -0.5),
        'rwkv_a0': nrm(ks[13], (L, 2, RWKV_W), 0.5),
        'rwkv_a2': nrm(ks[14], (L, 2, ICLR_LORA, RWKV_W), 0.5 * ICLR_LORA ** -0.5),
        'rwkv_k_k': 0.85 + nrm(ks[15], (L, RWKV_W), 0.05),
        'rwkv_k_a': 1.0 + nrm(ks[16], (L, RWKV_W), 0.05),
        'rwkv_r_k': nrm(ks[17], (L, RWKV_HEADS, HEAD_DIM), 0.1),
        'rwkv_gn_w': 1.0 + nrm(ks[18], (L, RWKV_W), 0.02),
        'rwkv_gn_b': nrm(ks[19], (L, RWKV_W), 0.02),
        'rwkv_vres_w1': nrm(ks[20], (L - 1, D, VRES_LORA), D ** -0.5),
        'rwkv_vres_w2': nrm(ks[21], (L - 1, VRES_LORA, RWKV_W), VRES_LORA ** -0.5),
        'rwkv_vres_b': nrm(ks[22], (L - 1, RWKV_W), 0.02),
        'hgrn_lb_logits': nrm(ks[23], (2, L, HGRN_W), 0.5),
        'hgrn_norm_w': 1.0 + nrm(ks[24], (L, HGRN_W), 0.02),
        'attn_sink': nrm(ks[25], (L, ATTN_Q_HEADS), 0.5),
        'final_norm_w': 1.0 + nrm(ks[26], (D,), 0.02),
    }


def reference(x, c, ctx, c_ctx, mod_w, mod_b, norm_w, w_in, w_out,
              rwkv_mu_prev, rwkv_mu_next, rwkv_w0, rwkv_w2, rwkv_a0, rwkv_a2,
              rwkv_k_k, rwkv_k_a, rwkv_r_k, rwkv_gn_w, rwkv_gn_b,
              rwkv_vres_w1, rwkv_vres_w2, rwkv_vres_b,
              hgrn_lb_logits, hgrn_norm_w, attn_sink, final_norm_w):
    B, T, _ = x.shape
    rows = T // GRID_W
    row = jnp.broadcast_to(jnp.arange(rows)[:, None], (rows, GRID_W)).reshape(-1)
    col = jnp.broadcast_to(jnp.arange(GRID_W)[None, :], (rows, GRID_W)).reshape(-1)
    lb_p = jax.nn.softmax(hgrn_lb_logits.astype(F32), axis=1)
    lower_bounds = jnp.cumsum(lb_p, axis=1) - lb_p[:, :1]
    silu_c = jax.nn.silu(c)
    silu_cc = jax.nn.silu(c_ctx)
    xc = ctx
    v_first = None
    vc_first = None
    for l in range(DEPTH):
        last = l == DEPTH - 1
        mod = silu_c @ mod_w[l] + mod_b[l]
        mod_c = silu_cc @ mod_w[l] + mod_b[l]
        shift, scale, gate = jnp.split(mod[:, None, :], 3, axis=-1)
        shift_c, scale_c, gate_c = jnp.split(mod_c, 3, axis=-1)
        h = rms_norm(x, norm_w[l]) * (1.0 + scale) + shift
        hc = rms_norm(xc, norm_w[l]) * (1.0 + scale_c) + shift_c
        pa, pb, pt = _split(h @ w_in[l], (RWKV_COLS, HGRN_COLS, ATTN_COLS))
        pa_c, pb_c, pt_c = _split(hc @ w_in[l], (RWKV_COLS, HGRN_COLS, ATTN_COLS))

        vres = None if l == 0 else (rwkv_vres_w1[l - 1], rwkv_vres_w2[l - 1], rwkv_vres_b[l - 1])
        rw = (rwkv_mu_prev[l], rwkv_mu_next[l], rwkv_w0[l], rwkv_w2[l], rwkv_a0[l], rwkv_a2[l], rwkv_k_k[l], rwkv_k_a[l])
        fa_c = rwkv_features(pa_c, hc, vc_first, *rw, vres)
        fa = rwkv_features(pa, h, v_first, *rw, vres)
        if l == 0:
            vc_first, v_first = fa_c[3], fa[3]
        s0 = jnp.zeros((2, B, RWKV_HEADS, HEAD_DIM, HEAD_DIM), F32)
        sa_c, ya_c = rwkv_mix(fa_c, s0, not last)
        _, ya = rwkv_mix(fa, sa_c, True)
        ya = rwkv_readout(ya, fa, rwkv_r_k[l], rwkv_gn_w[l], rwkv_gn_b[l])

        fb_c = hgrn_features(pb_c, lower_bounds[:, l])
        fb = hgrn_features(pb, lower_bounds[:, l])
        h0 = jnp.zeros((2, B, HGRN_HEADS, HEAD_DIM, HEAD_DIM), F32)
        sb_c, ob_c = hgrn_mix(fb_c, h0, not last)
        _, ob = hgrn_mix(fb, sb_c, True)
        yb = hgrn_readout(ob, fb[4], hgrn_norm_w[l])

        qa, ka, va, ga = _split(pt.astype(F32), ATTN_SPLITS)
        qa_c, ka_c, va_c, ga_c = _split(pt_c.astype(F32), ATTN_SPLITS)
        q = axial_rope(_heads(qa, ATTN_Q_HEADS), row, col)
        k = axial_rope(_heads(ka, ATTN_KV_HEADS), row, col)
        v = _heads(va, ATTN_KV_HEADS)
        k_c = _heads(ka_c, ATTN_KV_HEADS)
        v_c = _heads(va_c, ATTN_KV_HEADS)
        sink = attn_sink[l].astype(F32)
        yt = banded_attention(q, k, v, k_c, v_c, sink) * jax.nn.silu(ga)

        y = jnp.concatenate([ya, yb, yt], axis=-1).astype(x.dtype) @ w_out[l]
        if not last:
            ya_c = rwkv_readout(ya_c, fa_c, rwkv_r_k[l], rwkv_gn_w[l], rwkv_gn_b[l])
            yb_c = hgrn_readout(ob_c, fb_c[4], hgrn_norm_w[l])
            yt_c = context_attention(_heads(qa_c, ATTN_Q_HEADS), k_c, v_c, sink) * jax.nn.silu(ga_c)
            y_c = jnp.concatenate([ya_c, yb_c, yt_c], axis=-1).astype(xc.dtype) @ w_out[l]
            xc = xc + gate_c * y_c
        x = x + gate * y
    return rms_norm(x, final_norm_w)
```

```cpp
#include <hip/hip_runtime.h>
#include <hip/hip_cooperative_groups.h>
#include <cstdio>
#include <cstdint>
namespace cg = cooperative_groups;

typedef _Float16 h16;
typedef _Float16 half8 __attribute__((ext_vector_type(8)));
typedef _Float16 half4 __attribute__((ext_vector_type(4)));
typedef float f32x16 __attribute__((ext_vector_type(16)));
typedef float f32x4 __attribute__((ext_vector_type(4)));
typedef float f32x2 __attribute__((ext_vector_type(2)));
typedef unsigned u32x4 __attribute__((ext_vector_type(4)));

constexpr int NLAT = 32768, NTOK = 34816;
constexpr int PC = 4096;
constexpr int NPAD = 4224;
constexpr int VTS = 4352;
constexpr int SMEM_BYTES = 36864;

#ifndef SINGLE_LAUNCH
#define SINGLE_LAUNCH 1
#endif

struct Params {
  const float *x, *c, *ctx, *c_ctx, *mod_w, *mod_b, *norm_w, *w_in, *w_out;
  const float *mu_prev, *mu_next, *w0, *w2, *a0, *a2, *k_k, *k_a, *r_k, *gn_w, *gn_b;
  const float *vw1, *vw2, *vb, *lb_logits, *hg_norm_w, *sink, *final_w;
  float* out;
  h16 *win_t, *wout_t;
  float* mod;
  h16 *hy, *P, *F, *VB;
  float* Z;
  h16* VT;
  float* xc1;
  float* rope;
};

__device__ __forceinline__ float wave_sum(float v) {
#pragma unroll
  for (int o = 32; o > 0; o >>= 1) v += __shfl_xor(v, o);
  return v;
}
__device__ __forceinline__ float sigmoidf_(float x) { return 1.f / (1.f + __expf(-x)); }
__device__ __forceinline__ float siluf_(float x) { return x / (1.f + __expf(-x)); }
template <int CTRL> __device__ __forceinline__ float dpp_mov(float x) {
  return __int_as_float(__builtin_amdgcn_update_dpp(0, __float_as_int(x), CTRL, 0xf, 0xf, true));
}
__device__ __forceinline__ float red8(float x) {
  x += dpp_mov<0xB1>(x);
  x += dpp_mov<0x4E>(x);
  x += dpp_mov<0x141>(x);
  return x;
}

__device__ void phase_prep(const Params& p, int bid, int nb, char* smem) {
  const int tid = threadIdx.x;
  float* sf = (float*)smem;
  constexpr int N_WIN = 2048, N_WOUT = 512, N_MOD = 24, N_PADI = 1024;
  constexpr int total = N_WIN + N_WOUT + N_MOD + N_PADI + 1;
  for (int it = bid; it < total; it += nb) {
    if (it < N_WIN + N_WOUT) {
      const float* src; h16* dst; int ncols, kt, ntile;
      if (it < N_WIN) { int l = it >> 10, r = it & 1023; kt = r >> 6; ntile = r & 63; src = p.w_in + (size_t)l * 1024 * 4096; dst = p.win_t + (size_t)l * NPAD * 1024; ncols = 4096; }
      else { int j = it - N_WIN; int l = j >> 8, r = j & 255; kt = r >> 4; ntile = r & 15; src = p.w_out + (size_t)l * 1024 * 1024; dst = p.wout_t + (size_t)l * 1024 * 1024; ncols = 1024; }
      for (int i = tid; i < 4096; i += 256) { int kk = i >> 6, nn = i & 63; sf[kk * 65 + nn] = src[(size_t)(kt * 64 + kk) * ncols + ntile * 64 + nn]; }
      __syncthreads();
      for (int i = tid; i < 4096; i += 256) { int nn = i >> 6, kk = i & 63; dst[(size_t)(ntile * 64 + nn) * 1024 + kt * 64 + kk] = (h16)sf[kk * 65 + nn]; }
      __syncthreads();
    } else if (it < N_WIN + N_WOUT + N_MOD) {
      int j = it - N_WIN - N_WOUT; int l = j / 12; int col = (j % 12) * 256 + tid;
      for (int i = tid; i < 9 * 1024; i += 256) { int r = i >> 10, k = i & 1023; float v = r < 8 ? p.c[r * 1024 + k] : p.c_ctx[k]; sf[i] = siluf_(v); }
      __syncthreads();
      float acc[9];
#pragma unroll
      for (int r = 0; r < 9; ++r) acc[r] = 0.f;
      const float* mw = p.mod_w + (size_t)l * 1024 * 3072 + col;
      for (int k = 0; k < 1024; k += 4) {
        float w0 = mw[(size_t)k * 3072], w1 = mw[(size_t)(k + 1) * 3072], w2 = mw[(size_t)(k + 2) * 3072], w3 = mw[(size_t)(k + 3) * 3072];
#pragma unroll
        for (int r = 0; r < 9; ++r) { f32x4 s = *(const f32x4*)&sf[r * 1024 + k]; acc[r] += s[0] * w0 + s[1] * w1 + s[2] * w2 + s[3] * w3; }
      }
      float bb = p.mod_b[l * 3072 + col];
#pragma unroll
      for (int r = 0; r < 9; ++r) p.mod[(size_t)(l * 9 + r) * 3072 + col] = acc[r] + bb;
      __syncthreads();
    } else if (it < N_WIN + N_WOUT + N_MOD + N_PADI) {
      int j = it - (N_WIN + N_WOUT + N_MOD); int idx = j * 256 + tid;
      int l = idx >> 17; int rem = idx & 131071; int m = rem >> 10, k = rem & 1023;
      float v = (l == 1 && m < 32) ? p.vw1[k * 32 + m] : 0.f;
      p.win_t[(size_t)l * NPAD * 1024 + (size_t)(4096 + m) * 1024 + k] = (h16)v;
    } else {
      if (tid < 16) {
        double inv = 1.0; for (int i = 0; i < tid; ++i) inv *= 0.5623413251903491;
        double x2 = inv * inv, ts = inv, tc = 1.0, s1 = inv, c1 = 1.0;
        for (int n = 1; n <= 10; ++n) { tc *= -x2 / ((2.0 * n - 1.0) * (2.0 * n)); c1 += tc; ts *= -x2 / ((2.0 * n) * (2.0 * n + 1.0)); s1 += ts; }
        double cc = 1.0, ss = 0.0;
        for (int pos = 0; pos < 64; ++pos) {
          p.rope[(pos * 16 + tid) * 2] = (float)cc; p.rope[(pos * 16 + tid) * 2 + 1] = (float)ss;
          double nc = cc * c1 - ss * s1, ns = ss * c1 + cc * s1; cc = nc; ss = ns;
        }
      }
    }
  }
}

__device__ void phase_norm(const Params& p, int l, int bid, int nb) {
  const int tid = threadIdx.x, lane = tid & 63, w = tid >> 6;
  for (int row = bid * 4 + w; row < NTOK; row += nb * 4) {
    const float* src = (l == 0) ? (row < NLAT ? p.x + (size_t)row * 1024 : p.ctx + (size_t)(row - NLAT) * 1024)
                                : (row < NLAT ? p.out + (size_t)row * 1024 : p.xc1 + (size_t)(row - NLAT) * 1024);
    const int mr = row < NLAT ? (row >> 12) : 8;
    const float* md = p.mod + (size_t)(l * 9 + mr) * 3072;
    const float* nw = p.norm_w + l * 1024;
    f32x4 v[4]; float ss = 0.f;
#pragma unroll
    for (int i = 0; i < 4; ++i) { v[i] = *(const f32x4*)(src + i * 256 + lane * 4); ss += v[i][0] * v[i][0] + v[i][1] * v[i][1] + v[i][2] * v[i][2] + v[i][3] * v[i][3]; }
    ss = wave_sum(ss);
    const float rs = rsqrtf(ss * (1.f / 1024.f) + 1e-6f);
#pragma unroll
    for (int i = 0; i < 4; ++i) {
      const int col = i * 256 + lane * 4;
      f32x4 nwv = *(const f32x4*)(nw + col), sc = *(const f32x4*)(md + 1024 + col), sh = *(const f32x4*)(md + col);
      half4 o;
#pragma unroll
      for (int j = 0; j < 4; ++j) o[j] = (h16)(v[i][j] * rs * nwv[j] * (1.f + sc[j]) + sh[j]);
      *(half4*)(p.hy + (size_t)row * 1024 + col) = o;
    }
  }
}

template <int MODE>
__device__ void phase_gemm(const Params& p, int l, int bid, int nb, char* smem) {
  const h16* A = p.hy;
  const h16* Bt = MODE == 0 ? p.win_t + (size_t)l * NPAD * 1024 : p.wout_t + (size_t)l * 1024 * 1024;
  const int ntn = MODE == 0 ? (l == 1 ? 33 : 32) : 8;
  const int ntm = (MODE == 1 && l == 1) ? 256 : 272;
  const int tid = threadIdx.x, lane = tid & 63, w = tid >> 6, wr = w >> 1, wc = w & 1, lq = lane & 31, hh = lane >> 5;
  h16* As = (h16*)smem; h16* Bs = As + 128 * 72;
  for (int tile = bid; tile < ntm * ntn; tile += nb) {
    const int tm = tile / ntn, tn = tile % ntn;
    const h16* Ag = A + (size_t)tm * 128 * 1024; const h16* Bg = Bt + (size_t)tn * 128 * 1024;
    f32x16 acc[2][2];
#pragma unroll
    for (int i = 0; i < 2; ++i)
#pragma unroll
      for (int j = 0; j < 2; ++j)
#pragma unroll
        for (int r = 0; r < 16; ++r) acc[i][j][r] = 0.f;
    u32x4 ra[4], rb[4];
#pragma unroll
    for (int i = 0; i < 4; ++i) { int id = tid + i * 256; int row = id >> 3, ch = id & 7; ra[i] = *(const u32x4*)(Ag + (size_t)row * 1024 + ch * 8); rb[i] = *(const u32x4*)(Bg + (size_t)row * 1024 + ch * 8); }
    for (int kt = 0; kt < 16; ++kt) {
      __syncthreads();
#pragma unroll
      for (int i = 0; i < 4; ++i) { int id = tid + i * 256; int row = id >> 3, ch = id & 7; *(u32x4*)(As + row * 72 + ch * 8) = ra[i]; *(u32x4*)(Bs + row * 72 + ch * 8) = rb[i]; }
      __syncthreads();
      if (kt + 1 < 16) {
#pragma unroll
        for (int i = 0; i < 4; ++i) { int id = tid + i * 256; int row = id >> 3, ch = id & 7; ra[i] = *(const u32x4*)(Ag + (size_t)row * 1024 + (kt + 1) * 64 + ch * 8); rb[i] = *(const u32x4*)(Bg + (size_t)row * 1024 + (kt + 1) * 64 + ch * 8); }
      }
#pragma unroll
      for (int s = 0; s < 4; ++s) {
        half8 a[2], b[2];
#pragma unroll
        for (int i = 0; i < 2; ++i) { a[i] = *(const half8*)(As + (64 * wr + 32 * i + lq) * 72 + 16 * s + 8 * hh); b[i] = *(const half8*)(Bs + (64 * wc + 32 * i + lq) * 72 + 16 * s + 8 * hh); }
#pragma unroll
        for (int i = 0; i < 2; ++i)
#pragma unroll
          for (int j = 0; j < 2; ++j) acc[i][j] = __builtin_amdgcn_mfma_f32_32x32x16_f16(a[i], b[j], acc[i][j], 0, 0, 0);
      }
    }
#pragma unroll
    for (int i = 0; i < 2; ++i)
#pragma unroll
      for (int j = 0; j < 2; ++j)
#pragma unroll
        for (int r = 0; r < 16; ++r) {
          const int row = tm * 128 + 64 * wr + 32 * i + (r & 3) + 8 * (r >> 2) + 4 * hh;
          const int col = tn * 128 + 64 * wc + 32 * j + lq;
          const float v = acc[i][j][r];
          if (MODE == 0) {
            if (tn < 32) p.P[(size_t)row * PC + col] = (h16)v;
            else if (col - 4096 < 32) p.Z[(size_t)row * 32 + (col - 4096)] = v;
          } else {
            const int mr = row < NLAT ? (row >> 12) : 8;
            const float g = p.mod[(size_t)(l * 9 + mr) * 3072 + 2048 + col];
            if (l == 0) {
              if (row < NLAT) p.out[(size_t)row * 1024 + col] = p.x[(size_t)row * 1024 + col] + g * v;
              else p.xc1[(size_t)(row - NLAT) * 1024 + col] = p.ctx[(size_t)(row - NLAT) * 1024 + col] + g * v;
            } else {
              p.out[(size_t)row * 1024 + col] = p.out[(size_t)row * 1024 + col] + g * v;
            }
          }
        }
  }
}

__device__ void phase_feat(const Params& p, int l, int bid, int nb, char* smem) {
  const int tid = threadIdx.x;
  float* in = (float*)smem;
  float* zt = in + 32 * 256;
  for (int item = bid; item < 1088; item += nb) {
    int b, t0, Tn, rowbase; bool isctx;
    if (item < 1024) { b = item >> 7; t0 = (item & 127) * 32; Tn = 4096; rowbase = b * 4096; isctx = false; }
    else { int j = item - 1024; b = j >> 3; t0 = (j & 7) * 32; Tn = 256; rowbase = NLAT + b * 256; isctx = true; }
    {
      const int col = 1152 + tid;
      const float mp = p.mu_prev[l * 1792 + col], mn = p.mu_next[l * 1792 + col];
      const h16* base = p.P + (size_t)rowbase * PC + col;
      float prev = (t0 > 0) ? (float)base[(size_t)(t0 - 1) * PC] : 0.f;
      float cur = (float)base[(size_t)t0 * PC];
#pragma unroll 1
      for (int tt = 0; tt < 32; ++tt) {
        const int t = t0 + tt;
        float nxt = (t + 1 < Tn) ? (float)base[(size_t)(t + 1) * PC] : 0.f;
        float s = cur + mp * (prev - cur) + mn * (nxt - cur);
        if (tid < 128) s = tanhf(s);
        in[tt * 256 + tid] = s;
        prev = cur; cur = nxt;
      }
      if (l == 1) {
#pragma unroll
        for (int i = 0; i < 4; ++i) { int id = tid + i * 256; zt[id] = p.Z[(size_t)(rowbase + t0) * 32 + id]; }
      }
    }
    __syncthreads();
    for (int c = tid; c < 384; c += 256) {
      const int col = 768 + c;
      const float mp = p.mu_prev[l * 1792 + col], mn = p.mu_next[l * 1792 + col];
      const h16* base = p.P + (size_t)rowbase * PC + col;
      float prev = (t0 > 0) ? (float)base[(size_t)(t0 - 1) * PC] : 0.f;
      float cur = (float)base[(size_t)t0 * PC];
      if (l == 0) {
#pragma unroll 1
        for (int tt = 0; tt < 32; ++tt) {
          const int t = t0 + tt;
          float nxt = (t + 1 < Tn) ? (float)base[(size_t)(t + 1) * PC] : 0.f;
          p.VB[(size_t)(rowbase + t) * 384 + c] = (h16)(cur + mp * (prev - cur) + mn * (nxt - cur));
          prev = cur; cur = nxt;
        }
      } else {
        float vw[32];
#pragma unroll
        for (int m = 0; m < 32; ++m) vw[m] = p.vw2[m * 384 + c];
        const float vbv = p.vb[c];
#pragma unroll 1
        for (int tt = 0; tt < 32; ++tt) {
          const int t = t0 + tt;
          float nxt = (t + 1 < Tn) ? (float)base[(size_t)(t + 1) * PC] : 0.f;
          float s = cur + mp * (prev - cur) + mn * (nxt - cur);
          h16* dst = p.VB + (size_t)(rowbase + t) * 384 + c;
          float a = vbv;
#pragma unroll
          for (int m = 0; m < 32; m += 4) { const f32x4 z = *(const f32x4*)&zt[tt * 32 + m]; a += z[0] * vw[m] + z[1] * vw[m + 1] + z[2] * vw[m + 2] + z[3] * vw[m + 3]; }
          const float vf = (float)*dst;
          *dst = (h16)(s + (vf - s) * sigmoidf_(a));
          prev = cur; cur = nxt;
        }
      }
    }
#pragma unroll 1
    for (int oc = tid; oc < 1536; oc += 256) {
      const int slot = oc / 384, c = oc % 384, dir = slot & 1, kind = slot >> 1;
      const float* wm = (kind == 0 ? p.w2 : p.a2) + (size_t)((l * 2 + dir) * 64) * 384 + c;
      const float bias = (kind == 0 ? p.w0 : p.a0)[(l * 2 + dir) * 384 + c];
      const int io = (kind == 0 ? 0 : 128) + dir * 64;
      float acc[32];
#pragma unroll
      for (int tt = 0; tt < 32; ++tt) acc[tt] = bias;
#pragma unroll 1
      for (int r = 0; r < 64; r += 4) {
        const float w0 = wm[(size_t)r * 384], w1 = wm[(size_t)(r + 1) * 384], w2 = wm[(size_t)(r + 2) * 384], w3 = wm[(size_t)(r + 3) * 384];
#pragma unroll
        for (int tt = 0; tt < 32; ++tt) { f32x4 iv = *(const f32x4*)&in[tt * 256 + io + r]; acc[tt] += iv[0] * w0 + iv[1] * w1 + iv[2] * w2 + iv[3] * w3; }
      }
      const float mul = kind == 0 ? 0.6065306597126334f : 1.f;
#pragma unroll
      for (int tt = 0; tt < 32; ++tt) p.F[(size_t)(rowbase + t0 + tt) * 1536 + slot * 384 + c] = (h16)(mul * sigmoidf_(acc[tt]));
    }
    {
      const int head = tid >> 5, pr = tid & 31, half = pr >> 4, i = pr & 15;
      const int colbase = head < 6 ? 3072 + head * 64 : 3456 + (head - 6) * 64;
      const int d1 = half * 32 + i;
      const float qs = head < 6 ? 0.125f : 1.f;
#pragma unroll 1
      for (int tt = 0; tt < 32; ++tt) {
        const int t = t0 + tt;
        h16* pp = p.P + (size_t)(rowbase + t) * PC + colbase + d1;
        float x1 = (float)pp[0], x2 = (float)pp[16];
        float cs = 1.f, sn = 0.f;
        if (!isctx) { const int pos = half == 0 ? (t >> 6) : (t & 63); cs = p.rope[(pos * 16 + i) * 2]; sn = p.rope[(pos * 16 + i) * 2 + 1]; }
        pp[0] = (h16)((x1 * cs - x2 * sn) * qs);
        pp[16] = (h16)((x1 * sn + x2 * cs) * qs);
      }
    }
    if (tid < 128) {
      const int g = tid >> 6, d = tid & 63;
      const h16* base = p.P + (size_t)(rowbase + t0) * PC + 3584 + tid;
      h16* dst = p.VT + (size_t)((b * 2 + g) * 64 + d) * VTS + (isctx ? 4096 + t0 : t0);
#pragma unroll
      for (int q = 0; q < 4; ++q) {
        half8 v;
#pragma unroll
        for (int j = 0; j < 8; ++j) v[j] = base[(size_t)(q * 8 + j) * PC];
        *(half8*)(dst + q * 8) = v;
      }
    }
    __syncthreads();
  }
}

__device__ void rwkv_chain(const Params& p, int l, int chain, char* smem) {
  const int tid = threadIdx.x, lane = tid & 63, w = tid >> 6;
  const int dir = chain / 48, b = (chain % 48) / 6, h = chain % 6;
  float* op = (float*)smem;
  float* ybuf = op + 16 * 384;
  const int hc = h * 64 + lane;
  const float mpr = p.mu_prev[l * 1792 + hc], mnr = p.mu_next[l * 1792 + hc];
  const float mpk = p.mu_prev[l * 1792 + 384 + hc], mnk = p.mu_next[l * 1792 + 384 + hc];
  const float kkw = p.k_k[l * 384 + hc], kaw = p.k_a[l * 384 + hc];
  const int vp = tid >> 3, kq = tid & 7;
  f32x2 S0[4], S1[4];
#pragma unroll
  for (int j = 0; j < 4; ++j) { S0[j] = (f32x2){0.f, 0.f}; S1[j] = (f32x2){0.f, 0.f}; }
  for (int seg = 0; seg < 2; ++seg) {
    const int Tn = seg == 0 ? 256 : 4096;
    const int rowbase = seg == 0 ? NLAT + b * 256 : b * 4096;
    const bool wout = seg == 1 || l == 0;
    for (int c0 = 0; c0 < Tn; c0 += 16) {
#pragma unroll
      for (int i = 0; i < 4; ++i) {
        const int step = w * 4 + i;
        const int t = dir == 0 ? c0 + step : Tn - 1 - (c0 + step);
        const size_t row = (size_t)rowbase + t;
        const h16* pr = p.P + row * PC;
        const float r0 = (float)pr[hc], k0 = (float)pr[384 + hc];
        const float rm = t > 0 ? (float)pr[hc - PC] : 0.f, km = t > 0 ? (float)pr[384 + hc - PC] : 0.f;
        const float rp = t + 1 < Tn ? (float)pr[hc + PC] : 0.f, kp = t + 1 < Tn ? (float)pr[384 + hc + PC] : 0.f;
        const float rs = r0 + mpr * (rm - r0) + mnr * (rp - r0);
        const float ks = k0 + mpk * (km - k0) + mnk * (kp - k0);
        const float vv = (float)p.VB[row * 384 + hc];
        const float e = (float)p.F[row * 1536 + dir * 384 + hc];
        const float al = (float)p.F[row * 1536 + (2 + dir) * 384 + hc];
        const float kkr = ks * kkw;
        const float n2 = wave_sum(kkr * kkr);
        const float kk = kkr / fmaxf(sqrtf(n2), 1e-12f);
        float* o = op + step * 384 + lane;
        o[0] = __expf(-e); o[64] = -kk; o[128] = kk * al; o[192] = ks * (1.f + (al - 1.f) * kaw); o[256] = rs; o[320] = vv;
      }
      __syncthreads();
#pragma unroll 2
      for (int step = 0; step < 16; ++step) {
        const float* o = op + step * 384 + 8 * kq;
        const f32x4 wA = *(const f32x4*)(o), wB = *(const f32x4*)(o + 4);
        const f32x4 aA = *(const f32x4*)(o + 64), aB = *(const f32x4*)(o + 68);
        const f32x4 bA = *(const f32x4*)(o + 128), bB = *(const f32x4*)(o + 132);
        const f32x4 kA = *(const f32x4*)(o + 192), kB = *(const f32x4*)(o + 196);
        const f32x4 rA = *(const f32x4*)(o + 256), rB = *(const f32x4*)(o + 260);
        const f32x2 vv = *(const f32x2*)(op + step * 384 + 320 + 2 * vp);
        const f32x2 w2[4] = {{wA[0], wA[1]}, {wA[2], wA[3]}, {wB[0], wB[1]}, {wB[2], wB[3]}};
        const f32x2 a2[4] = {{aA[0], aA[1]}, {aA[2], aA[3]}, {aB[0], aB[1]}, {aB[2], aB[3]}};
        const f32x2 b2[4] = {{bA[0], bA[1]}, {bA[2], bA[3]}, {bB[0], bB[1]}, {bB[2], bB[3]}};
        const f32x2 k2[4] = {{kA[0], kA[1]}, {kA[2], kA[3]}, {kB[0], kB[1]}, {kB[2], kB[3]}};
        const f32x2 r2[4] = {{rA[0], rA[1]}, {rA[2], rA[3]}, {rB[0], rB[1]}, {rB[2], rB[3]}};
        f32x2 d0 = S0[0] * a2[0], d1 = S1[0] * a2[0];
#pragma unroll
        for (int j = 1; j < 4; ++j) { d0 += S0[j] * a2[j]; d1 += S1[j] * a2[j]; }
        const float sa0 = red8(d0[0] + d0[1]), sa1 = red8(d1[0] + d1[1]);
        const f32x2 sa0v = {sa0, sa0}, sa1v = {sa1, sa1}, v0v = {vv[0], vv[0]}, v1v = {vv[1], vv[1]};
#pragma unroll
        for (int j = 0; j < 4; ++j) {
          S0[j] = S0[j] * w2[j] + sa0v * b2[j] + v0v * k2[j];
          S1[j] = S1[j] * w2[j] + sa1v * b2[j] + v1v * k2[j];
        }
        f32x2 y0 = S0[0] * r2[0], y1 = S1[0] * r2[0];
#pragma unroll
        for (int j = 1; j < 4; ++j) { y0 += S0[j] * r2[j]; y1 += S1[j] * r2[j]; }
        const float yy0 = red8(y0[0] + y0[1]), yy1 = red8(y1[0] + y1[1]);
        if (kq == 0) *(f32x2*)(ybuf + step * 64 + 2 * vp) = (f32x2){yy0, yy1};
      }
      __syncthreads();
      if (wout) {
#pragma unroll
        for (int i = 0; i < 4; ++i) {
          const int idx = tid + i * 256; const int step = idx >> 6, ch = idx & 63;
          const int t = dir == 0 ? c0 + step : Tn - 1 - (c0 + step);
          p.F[(size_t)(rowbase + t) * 1536 + dir * 384 + h * 64 + ch] = (h16)ybuf[idx];
        }
      }
    }
  }
}

__device__ void hgrn_chain(const Params& p, int l, int chain, char* smem) {
  const int tid = threadIdx.x, lane = tid & 63, w = tid >> 6;
  const int dir = chain / 32, b = (chain % 32) / 4, h = chain % 4;
  float* op = (float*)smem;
  float* ybuf = op + 16 * 192;
  const int hc = h * 64 + lane;
  float lb = 0.f;
  if (l == 1) lb = sigmoidf_(p.lb_logits[(dir * 2 + 1) * 256 + hc] - p.lb_logits[(dir * 2 + 0) * 256 + hc]);
  const int fcol = 1792 + 256 * (1 + dir) + hc;
  const int vp = tid >> 3, kq = tid & 7;
  f32x2 S[8];
#pragma unroll
  for (int j = 0; j < 8; ++j) S[j] = (f32x2){0.f, 0.f};
  for (int seg = 0; seg < 2; ++seg) {
    const int Tn = seg == 0 ? 256 : 4096;
    const int rowbase = seg == 0 ? NLAT + b * 256 : b * 4096;
    const bool wout = seg == 1 || l == 0;
    for (int c0 = 0; c0 < Tn; c0 += 16) {
#pragma unroll
      for (int i = 0; i < 4; ++i) {
        const int step = w * 4 + i;
        const int t = dir == 0 ? c0 + step : Tn - 1 - (c0 + step);
        const h16* pr = p.P + ((size_t)rowbase + t) * PC;
        const float fr = (float)pr[fcol];
        float* o = op + step * 192 + lane;
        o[0] = lb + (1.f - lb) * sigmoidf_(fr); o[64] = (float)pr[1792 + hc]; o[128] = (float)pr[1792 + 768 + hc];
      }
      __syncthreads();
#pragma unroll 2
      for (int step = 0; step < 16; ++step) {
        const float* o = op + step * 192 + 8 * kq;
        const f32x4 fA = *(const f32x4*)(o), fB = *(const f32x4*)(o + 4);
        const f32x4 qA = *(const f32x4*)(o + 64), qB = *(const f32x4*)(o + 68);
        const f32x2 iv = *(const f32x2*)(op + step * 192 + 128 + 2 * vp);
        const float f[8] = {fA[0], fA[1], fA[2], fA[3], fB[0], fB[1], fB[2], fB[3]};
        const float q[8] = {qA[0], qA[1], qA[2], qA[3], qB[0], qB[1], qB[2], qB[3]};
        f32x2 acc = {0.f, 0.f};
#pragma unroll
        for (int j = 0; j < 8; ++j) {
          const f32x2 fv = {f[j], f[j]}, gv = {1.f - f[j], 1.f - f[j]}, qv = {q[j], q[j]};
          S[j] = S[j] * fv + gv * iv;
          acc += S[j] * qv;
        }
        const float o0 = red8(acc[0]), o1 = red8(acc[1]);
        if (kq == 0) *(f32x2*)(ybuf + step * 64 + 2 * vp) = (f32x2){o0, o1};
      }
      __syncthreads();
      if (wout) {
#pragma unroll
        for (int i = 0; i < 4; ++i) {
          const int idx = tid + i * 256; const int step = idx >> 6, ch = idx & 63;
          const int t = dir == 0 ? c0 + step : Tn - 1 - (c0 + step);
          p.P[(size_t)(rowbase + t) * PC + 1792 + 256 * (1 + dir) + h * 64 + ch] = (h16)ybuf[idx];
        }
      }
    }
  }
}

__device__ void attn_unit(const Params& p, int l, int u) {
  const int tid = threadIdx.x, lane = tid & 63, w = tid >> 6, lq = lane & 31, hh = lane >> 5;
  int b, head, qrow_base, qpos0; bool isctx;
  if (u < 1536) { b = u / 192; int rem = u % 192; int blk = rem / 6; head = rem % 6; qpos0 = blk * 128 + w * 32; qrow_base = b * 4096; isctx = false; }
  else { int j = u - 1536; b = j / 12; int rem = j % 12; int qb = rem / 6; head = rem % 6; qpos0 = qb * 128 + w * 32; qrow_base = NLAT + b * 256; isctx = true; }
  const int g = head / 3;
  const size_t qrow = (size_t)qrow_base + qpos0 + lq;
  half8 qf[4];
#pragma unroll
  for (int s = 0; s < 4; ++s) qf[s] = *(const half8*)(p.P + qrow * PC + 3072 + head * 64 + 16 * s + 8 * hh);
  const float sinkv = p.sink[l * 6 + head];
  float m = sinkv, lsum = hh == 0 ? 1.f : 0.f;
  f32x16 O[2];
#pragma unroll
  for (int r = 0; r < 16; ++r) { O[0][r] = 0.f; O[1][r] = 0.f; }
  const h16* vt = p.VT + (size_t)((b * 2 + g) * 64) * VTS;
  int nband = 0, kstart = 0;
  if (!isctx) { kstart = max(0, qpos0 - 128); const int kend = min(4096, qpos0 + 160); nband = (kend - kstart) >> 5; }
  const int ntiles = nband + 8;
  for (int ti = 0; ti < ntiles; ++ti) {
    const bool band = ti < nband;
    const int kt = band ? kstart + ti * 32 : (ti - nband) * 32;
    const size_t krow = band ? (size_t)b * 4096 + kt + lq : (size_t)NLAT + b * 256 + kt + lq;
    const int vidx = band ? kt : 4096 + kt;
    const h16* kp = p.P + krow * PC + 3456 + g * 64 + 8 * hh;
    f32x16 sacc;
#pragma unroll
    for (int r = 0; r < 16; ++r) sacc[r] = 0.f;
#pragma unroll
    for (int s = 0; s < 4; ++s) { half8 kf = *(const half8*)(kp + 16 * s); sacc = __builtin_amdgcn_mfma_f32_32x32x16_f16(kf, qf[s], sacc, 0, 0, 0); }
    float mx = -INFINITY;
#pragma unroll
    for (int r = 0; r < 16; ++r) {
      float sv = sacc[r];
      if (band) { const int dlt = kt + (r & 3) + 8 * (r >> 2) + 4 * hh - (qpos0 + lq); if (dlt > 128 || dlt < -128) sv = -INFINITY; }
      sacc[r] = sv; mx = fmaxf(mx, sv);
    }
    mx = fmaxf(mx, __shfl_xor(mx, 32));
    const float mn = fmaxf(m, mx); const float corr = __expf(m - mn); m = mn;
    float ps = 0.f; half8 pb[2];
#pragma unroll
    for (int r = 0; r < 16; ++r) { const float pv = __expf(sacc[r] - mn); ps += pv; pb[r >> 3][r & 7] = (h16)pv; }
    lsum = lsum * corr + ps;
#pragma unroll
    for (int r = 0; r < 16; ++r) { O[0][r] *= corr; O[1][r] *= corr; }
#pragma unroll
    for (int s2 = 0; s2 < 2; ++s2)
#pragma unroll
      for (int dt = 0; dt < 2; ++dt) {
        const h16* vp = vt + (size_t)(dt * 32 + lq) * VTS + vidx + 16 * s2 + 4 * hh;
        const half4 lo = *(const half4*)vp, hi = *(const half4*)(vp + 8);
        const half8 vf = {lo[0], lo[1], lo[2], lo[3], hi[0], hi[1], hi[2], hi[3]};
        O[dt] = __builtin_amdgcn_mfma_f32_32x32x16_f16(vf, pb[s2], O[dt], 0, 0, 0);
      }
  }
  lsum += __shfl_xor(lsum, 32);
  const float inv = 1.f / lsum;
#pragma unroll
  for (int dt = 0; dt < 2; ++dt)
#pragma unroll
    for (int g4 = 0; g4 < 4; ++g4) {
      const int d0 = dt * 32 + 8 * g4 + 4 * hh;
      const half4 ga = *(const half4*)(p.P + qrow * PC + 3712 + head * 64 + d0);
      half4 o;
#pragma unroll
      for (int j = 0; j < 4; ++j) { const float gv = (float)ga[j]; o[j] = (h16)(O[dt][g4 * 4 + j] * inv * siluf_(gv)); }
      *(half4*)(p.hy + qrow * 1024 + 640 + head * 64 + d0) = o;
    }
}

__device__ void phase_mix(const Params& p, int l, int bid, int nb, char* smem) {
  const int nunits = l == 0 ? 1536 + 96 : 1536;
  if (nb >= 320) {
    if (bid < 96) rwkv_chain(p, l, bid, smem);
    else if (bid < 160) hgrn_chain(p, l, bid - 96, smem);
    else for (int u = bid - 160; u < nunits; u += nb - 160) attn_unit(p, l, u);
  } else {
    for (int it = bid; it < 160 + nunits; it += nb) {
      if (it < 96) rwkv_chain(p, l, it, smem);
      else if (it < 160) hgrn_chain(p, l, it - 96, smem);
      else attn_unit(p, l, it - 160);
      __syncthreads();
    }
  }
}

__device__ void phase_readout(const Params& p, int l, int bid, int nb) {
  const int tid = threadIdx.x, lane = tid & 63, w = tid >> 6;
  const int nrows = l == 1 ? NLAT : NTOK;
  for (int row = bid * 4 + w; row < nrows; row += nb * 4) {
    int t, Tn;
    if (row < NLAT) { t = row & 4095; Tn = 4096; } else { t = (row - NLAT) & 255; Tn = 256; }
    const h16* pr = p.P + (size_t)row * PC;
    const h16* fr = p.F + (size_t)row * 1536;
    h16* yo = p.hy + (size_t)row * 1024;
    const bool hp = t > 0, hn = t + 1 < Tn;
#pragma unroll 1
    for (int h = 0; h < 6; ++h) {
      const int c = h * 64 + lane;
      const float y = (float)fr[c] + (float)fr[384 + c];
      const float mean = wave_sum(y) * (1.f / 64.f);
      const float yc = y - mean;
      const float var = wave_sum(yc * yc) * (1.f / 64.f);
      const float yn = yc * rsqrtf(var + 64e-5f) * p.gn_w[l * 384 + c] + p.gn_b[l * 384 + c];
      float sh[3];
#pragma unroll
      for (int q = 0; q < 3; ++q) {
        const int col = (q == 0 ? 0 : (q == 1 ? 384 : 1408)) + c;
        const float mp = p.mu_prev[l * 1792 + col], mn = p.mu_next[l * 1792 + col];
        const float cur = (float)pr[col];
        const float prv = hp ? (float)pr[col - PC] : 0.f, nxt = hn ? (float)pr[col + PC] : 0.f;
        sh[q] = cur + mp * (prv - cur) + mn * (nxt - cur);
      }
      const float v = (float)p.VB[(size_t)row * 384 + c];
      const float bonus = wave_sum(sh[0] * sh[1] * p.r_k[l * 384 + c]) * v;
      yo[c] = (h16)((yn + bonus) * siluf_(sh[2]));
    }
#pragma unroll 1
    for (int h = 0; h < 4; ++h) {
      const int c = h * 64 + lane;
      const float o = (float)pr[2048 + c] + (float)pr[2304 + c];
      const float ms = wave_sum(o * o) * (1.f / 64.f);
      const float on = o * rsqrtf(ms + 1e-6f);
      yo[384 + c] = (h16)(on * p.hg_norm_w[l * 256 + c] * siluf_((float)pr[2816 + c]));
    }
  }
}

__device__ void phase_final(const Params& p, int bid, int nb) {
  const int tid = threadIdx.x, lane = tid & 63, w = tid >> 6;
  for (int row = bid * 4 + w; row < NLAT; row += nb * 4) {
    float* src = p.out + (size_t)row * 1024;
    f32x4 v[4]; float ss = 0.f;
#pragma unroll
    for (int i = 0; i < 4; ++i) { v[i] = *(const f32x4*)(src + i * 256 + lane * 4); ss += v[i][0] * v[i][0] + v[i][1] * v[i][1] + v[i][2] * v[i][2] + v[i][3] * v[i][3]; }
    ss = wave_sum(ss);
    const float rs = rsqrtf(ss * (1.f / 1024.f) + 1e-6f);
#pragma unroll
    for (int i = 0; i < 4; ++i) {
      const int col = i * 256 + lane * 4;
      const f32x4 nwv = *(const f32x4*)(p.final_w + col);
      f32x4 o;
#pragma unroll
      for (int j = 0; j < 4; ++j) o[j] = v[i][j] * rs * nwv[j];
      *(f32x4*)(src + col) = o;
    }
  }
}

__global__ void __launch_bounds__(256) mega(Params p, int ph_lo, int ph_hi, int coop) {
  __shared__ __attribute__((aligned(16))) char smem[SMEM_BYTES];
  const int bid = blockIdx.x, nb = gridDim.x;
  for (int ph = ph_lo; ph < ph_hi; ++ph) {
    if (ph == 0) phase_prep(p, bid, nb, smem);
    else if (ph == 13) phase_final(p, bid, nb);
    else {
      const int l = (ph - 1) / 6, s = (ph - 1) % 6;
      if (s == 0) phase_norm(p, l, bid, nb);
      else if (s == 1) phase_gemm<0>(p, l, bid, nb, smem);
      else if (s == 2) phase_feat(p, l, bid, nb, smem);
      else if (s == 3) phase_mix(p, l, bid, nb, smem);
      else if (s == 4) phase_readout(p, l, bid, nb);
      else phase_gemm<1>(p, l, bid, nb, smem);
    }
    if (coop && ph + 1 < ph_hi) cg::this_grid().sync();
  }
}

extern "C" void kernel_launch(void* const* d_in, const int* in_sizes, int n_in, void* d_out, int out_size, void* d_ws, size_t ws_size, hipStream_t stream) {
  static int grid_blocks = 0;
  if (!grid_blocks) {
    int dev = 0, cus = 0, per_cu = 0;
    hipGetDevice(&dev);
    hipDeviceGetAttribute(&cus, hipDeviceAttributeMultiprocessorCount, dev);
    hipOccupancyMaxActiveBlocksPerMultiprocessor(&per_cu, mega, 256, 0);
    if (per_cu < 1) per_cu = 1;
    grid_blocks = cus * per_cu;
  }
  Params p{};
  const float* const* in = (const float* const*)d_in;
  p.x = in[0]; p.c = in[1]; p.ctx = in[2]; p.c_ctx = in[3]; p.mod_w = in[4]; p.mod_b = in[5]; p.norm_w = in[6]; p.w_in = in[7]; p.w_out = in[8];
  p.mu_prev = in[9]; p.mu_next = in[10]; p.w0 = in[11]; p.w2 = in[12]; p.a0 = in[13]; p.a2 = in[14]; p.k_k = in[15]; p.k_a = in[16]; p.r_k = in[17];
  p.gn_w = in[18]; p.gn_b = in[19]; p.vw1 = in[20]; p.vw2 = in[21]; p.vb = in[22]; p.lb_logits = in[23]; p.hg_norm_w = in[24]; p.sink = in[25]; p.final_w = in[26];
  p.out = (float*)d_out;
  char* ws = (char*)d_ws; size_t off = 0;
  auto take = [&](size_t bytes) { char* r = ws + off; off += (bytes + 255) & ~(size_t)255; return r; };
  p.win_t = (h16*)take((size_t)2 * NPAD * 1024 * 2);
  p.wout_t = (h16*)take((size_t)2 * 1024 * 1024 * 2);
  p.mod = (float*)take((size_t)2 * 9 * 3072 * 4);
  p.rope = (float*)take((size_t)64 * 16 * 2 * 4);
  p.hy = (h16*)take((size_t)NTOK * 1024 * 2);
  p.P = (h16*)take((size_t)NTOK * PC * 2);
  p.F = (h16*)take((size_t)NTOK * 1536 * 2);
  p.VB = (h16*)take((size_t)NTOK * 384 * 2);
  p.Z = (float*)take((size_t)NTOK * 32 * 4);
  p.VT = (h16*)take((size_t)16 * 64 * VTS * 2);
  p.xc1 = (float*)take((size_t)2048 * 1024 * 4);
  if (off > ws_size) fprintf(stderr, "workspace too small: need %zu have %zu\n", off, ws_size);
#if SINGLE_LAUNCH
  int lo = 0, hi = 14, coop = 1;
  void* args[] = {&p, &lo, &hi, &coop};
  hipError_t e = hipLaunchCooperativeKernel((void*)mega, dim3(grid_blocks), dim3(256), args, 0, stream);
  if (e != hipSuccess) fprintf(stderr, "cooperative launch failed: %s (grid %d)\n", hipGetErrorString(e), grid_blocks);
#else
  for (int ph = 0; ph < 14; ++ph) mega<<<grid_blocks, 256, 0, stream>>>(p, ph, ph + 1, 0);
#endif
}
```

```cpp
#include <hip/hip_runtime.h>
#include <hip/hip_cooperative_groups.h>
#include <cstdio>
#include <cstdint>
namespace cg = cooperative_groups;

typedef _Float16 h16;
typedef _Float16 half8 __attribute__((ext_vector_type(8)));
typedef _Float16 half4 __attribute__((ext_vector_type(4)));
typedef float f32x16 __attribute__((ext_vector_type(16)));
typedef float f32x4 __attribute__((ext_vector_type(4)));
typedef float f32x2 __attribute__((ext_vector_type(2)));
typedef unsigned u32x4 __attribute__((ext_vector_type(4)));

constexpr int NLAT = 32768, NTOK = 34816;
constexpr int PC = 4096;
constexpr int NPAD = 4224;
constexpr int VTS = 4352;
constexpr int SMEM_BYTES = 36864;

#ifndef SINGLE_LAUNCH
#define SINGLE_LAUNCH 1
#endif

struct Params {
  const float *x, *c, *ctx, *c_ctx, *mod_w, *mod_b, *norm_w, *w_in, *w_out;
  const float *mu_prev, *mu_next, *w0, *w2, *a0, *a2, *k_k, *k_a, *r_k, *gn_w, *gn_b;
  const float *vw1, *vw2, *vb, *lb_logits, *hg_norm_w, *sink, *final_w;
  float* out;
  h16 *win_t, *wout_t;
  float* mod;
  h16 *hy, *P, *F, *VB;
  float* Z;
  h16* VT;
  float* xc1;
  float* rope;
};

__device__ __forceinline__ int tid_opaque() { int t = threadIdx.x; asm volatile("" : "+v"(t)); return t; }
__device__ __forceinline__ float wave_sum(float v) {
#pragma unroll
  for (int o = 32; o > 0; o >>= 1) v += __shfl_xor(v, o);
  return v;
}
__device__ __forceinline__ float sigmoidf_(float x) { return 1.f / (1.f + __expf(-x)); }
__device__ __forceinline__ float siluf_(float x) { return x / (1.f + __expf(-x)); }
template <int CTRL> __device__ __forceinline__ float dpp_mov(float x) {
  return __int_as_float(__builtin_amdgcn_update_dpp(0, __float_as_int(x), CTRL, 0xf, 0xf, true));
}
__device__ __forceinline__ float wave_sum_dpp(float x) {
  x += dpp_mov<0xB1>(x);
  x += dpp_mov<0x4E>(x);
  x += dpp_mov<0x141>(x);
  x += dpp_mov<0x140>(x);
  const int xi = __float_as_int(x);
  return __int_as_float(__builtin_amdgcn_readlane(xi, 0)) + __int_as_float(__builtin_amdgcn_readlane(xi, 16)) +
         __int_as_float(__builtin_amdgcn_readlane(xi, 32)) + __int_as_float(__builtin_amdgcn_readlane(xi, 48));
}
__device__ __forceinline__ float red8(float x) {
  x += dpp_mov<0xB1>(x);
  x += dpp_mov<0x4E>(x);
  x += dpp_mov<0x141>(x);
  return x;
}

__device__ void phase_prep(const Params& p, int bid, int nb, char* smem) {
  const int tid = tid_opaque();
  float* sf = (float*)smem;
  constexpr int N_WIN = 2048, N_WOUT = 512, N_MOD = 24, N_PADI = 1024;
  constexpr int total = N_WIN + N_WOUT + N_MOD + N_PADI + 1;
  for (int it = bid; it < total; it += nb) {
    if (it < N_WIN + N_WOUT) {
      const float* src; h16* dst; int ncols, kt, ntile;
      if (it < N_WIN) { int l = it >> 10, r = it & 1023; kt = r >> 6; ntile = r & 63; src = p.w_in + (size_t)l * 1024 * 4096; dst = p.win_t + (size_t)l * NPAD * 1024; ncols = 4096; }
      else { int j = it - N_WIN; int l = j >> 8, r = j & 255; kt = r >> 4; ntile = r & 15; src = p.w_out + (size_t)l * 1024 * 1024; dst = p.wout_t + (size_t)l * 1024 * 1024; ncols = 1024; }
      for (int i = tid; i < 4096; i += 256) { int kk = i >> 6, nn = i & 63; sf[kk * 65 + nn] = src[(size_t)(kt * 64 + kk) * ncols + ntile * 64 + nn]; }
      __syncthreads();
      for (int i = tid; i < 4096; i += 256) { int nn = i >> 6, kk = i & 63; dst[(size_t)(ntile * 64 + nn) * 1024 + kt * 64 + kk] = (h16)sf[kk * 65 + nn]; }
      __syncthreads();
    } else if (it < N_WIN + N_WOUT + N_MOD) {
      int j = it - N_WIN - N_WOUT; int l = j / 12; int col = (j % 12) * 256 + tid;
      for (int i = tid; i < 9 * 1024; i += 256) { int r = i >> 10, k = i & 1023; float v = r < 8 ? p.c[r * 1024 + k] : p.c_ctx[k]; sf[i] = siluf_(v); }
      __syncthreads();
      float acc[9];
#pragma unroll
      for (int r = 0; r < 9; ++r) acc[r] = 0.f;
      const float* mw = p.mod_w + (size_t)l * 1024 * 3072 + col;
      for (int k = 0; k < 1024; k += 4) {
        float w0 = mw[(size_t)k * 3072], w1 = mw[(size_t)(k + 1) * 3072], w2 = mw[(size_t)(k + 2) * 3072], w3 = mw[(size_t)(k + 3) * 3072];
#pragma unroll
        for (int r = 0; r < 9; ++r) { f32x4 s = *(const f32x4*)&sf[r * 1024 + k]; acc[r] += s[0] * w0 + s[1] * w1 + s[2] * w2 + s[3] * w3; }
      }
      float bb = p.mod_b[l * 3072 + col];
#pragma unroll
      for (int r = 0; r < 9; ++r) p.mod[(size_t)(l * 9 + r) * 3072 + col] = acc[r] + bb;
      __syncthreads();
    } else if (it < N_WIN + N_WOUT + N_MOD + N_PADI) {
      int j = it - (N_WIN + N_WOUT + N_MOD); int idx = j * 256 + tid;
      int l = idx >> 17; int rem = idx & 131071; int m = rem >> 10, k = rem & 1023;
      float v = (l == 1 && m < 32) ? p.vw1[k * 32 + m] : 0.f;
      p.win_t[(size_t)l * NPAD * 1024 + (size_t)(4096 + m) * 1024 + k] = (h16)v;
    } else {
      if (tid < 16) {
        double inv = 1.0; for (int i = 0; i < tid; ++i) inv *= 0.5623413251903491;
        double x2 = inv * inv, ts = inv, tc = 1.0, s1 = inv, c1 = 1.0;
        for (int n = 1; n <= 10; ++n) { tc *= -x2 / ((2.0 * n - 1.0) * (2.0 * n)); c1 += tc; ts *= -x2 / ((2.0 * n) * (2.0 * n + 1.0)); s1 += ts; }
        double cc = 1.0, ss = 0.0;
        for (int pos = 0; pos < 64; ++pos) {
          p.rope[(pos * 16 + tid) * 2] = (float)cc; p.rope[(pos * 16 + tid) * 2 + 1] = (float)ss;
          double nc = cc * c1 - ss * s1, ns = ss * c1 + cc * s1; cc = nc; ss = ns;
        }
      }
    }
  }
}

__device__ void phase_norm(const Params& p, int l, int bid, int nb) {
  const int tid = tid_opaque(), lane = tid & 63, w = tid >> 6;
  for (int row = bid * 4 + w; row < NTOK; row += nb * 4) {
    const float* src = (l == 0) ? (row < NLAT ? p.x + (size_t)row * 1024 : p.ctx + (size_t)(row - NLAT) * 1024)
                                : (row < NLAT ? p.out + (size_t)row * 1024 : p.xc1 + (size_t)(row - NLAT) * 1024);
    const int mr = row < NLAT ? (row >> 12) : 8;
    const float* md = p.mod + (size_t)(l * 9 + mr) * 3072;
    const float* nw = p.norm_w + l * 1024;
    f32x4 v[4]; float ss = 0.f;
#pragma unroll
    for (int i = 0; i < 4; ++i) { v[i] = *(const f32x4*)(src + i * 256 + lane * 4); ss += v[i][0] * v[i][0] + v[i][1] * v[i][1] + v[i][2] * v[i][2] + v[i][3] * v[i][3]; }
    ss = wave_sum_dpp(ss);
    const float rs = rsqrtf(ss * (1.f / 1024.f) + 1e-6f);
#pragma unroll
    for (int i = 0; i < 4; ++i) {
      const int col = i * 256 + lane * 4;
      f32x4 nwv = *(const f32x4*)(nw + col), sc = *(const f32x4*)(md + 1024 + col), sh = *(const f32x4*)(md + col);
      half4 o;
#pragma unroll
      for (int j = 0; j < 4; ++j) o[j] = (h16)(v[i][j] * rs * nwv[j] * (1.f + sc[j]) + sh[j]);
      *(half4*)(p.hy + (size_t)row * 1024 + col) = o;
    }
  }
}

template <int MODE>
__device__ void phase_gemm(const Params& p, int l, int bid, int nb, char* smem) {
  const h16* A = p.hy;
  const h16* Bt = MODE == 0 ? p.win_t + (size_t)l * NPAD * 1024 : p.wout_t + (size_t)l * 1024 * 1024;
  const int ntn = MODE == 0 ? (l == 1 ? 33 : 32) : 8;
  const int ntm = (MODE == 1 && l == 1) ? 256 : 272;
  const int tid = tid_opaque(), lane = tid & 63, w = tid >> 6, wr = w >> 1, wc = w & 1, lq = lane & 31, hh = lane >> 5;
  h16* As = (h16*)smem; h16* Bs = As + 128 * 72;
  const int ldrow = tid >> 3, ldch = (tid & 7) * 8;
  for (int tile = bid; tile < ntm * ntn; tile += nb) {
    const int tm = tile / ntn, tn = tile % ntn;
    const h16* Ag = A + (size_t)(tm * 128 + ldrow) * 1024 + ldch; const h16* Bg = Bt + (size_t)(tn * 128 + ldrow) * 1024 + ldch;
    f32x16 acc[2][2];
#pragma unroll
    for (int i = 0; i < 2; ++i)
#pragma unroll
      for (int j = 0; j < 2; ++j)
#pragma unroll
        for (int r = 0; r < 16; ++r) acc[i][j][r] = 0.f;
    u32x4 ra[4], rb[4];
#pragma unroll
    for (int i = 0; i < 4; ++i) { ra[i] = *(const u32x4*)(Ag + (size_t)i * 32 * 1024); rb[i] = *(const u32x4*)(Bg + (size_t)i * 32 * 1024); }
#pragma unroll 1
    for (int kt = 0; kt < 16; ++kt) {
      __syncthreads();
#pragma unroll
      for (int i = 0; i < 4; ++i) { *(u32x4*)(As + (ldrow + i * 32) * 72 + ldch) = ra[i]; *(u32x4*)(Bs + (ldrow + i * 32) * 72 + ldch) = rb[i]; }
      __syncthreads();
      if (kt + 1 < 16) {
#pragma unroll
        for (int i = 0; i < 4; ++i) { ra[i] = *(const u32x4*)(Ag + (size_t)i * 32 * 1024 + (kt + 1) * 64); rb[i] = *(const u32x4*)(Bg + (size_t)i * 32 * 1024 + (kt + 1) * 64); }
      }
#pragma unroll
      for (int s = 0; s < 4; ++s) {
        half8 a[2], b[2];
#pragma unroll
        for (int i = 0; i < 2; ++i) { a[i] = *(const half8*)(As + (64 * wr + 32 * i + lq) * 72 + 16 * s + 8 * hh); b[i] = *(const half8*)(Bs + (64 * wc + 32 * i + lq) * 72 + 16 * s + 8 * hh); }
#pragma unroll
        for (int i = 0; i < 2; ++i)
#pragma unroll
          for (int j = 0; j < 2; ++j) {
            if (MODE == 0) acc[i][j] = __builtin_amdgcn_mfma_f32_32x32x16_f16(b[j], a[i], acc[i][j], 0, 0, 0);
            else acc[i][j] = __builtin_amdgcn_mfma_f32_32x32x16_f16(a[i], b[j], acc[i][j], 0, 0, 0);
          }
      }
    }
    if (MODE == 0) {
      if (tn < 32) {
        __syncthreads();
        h16* Cs = (h16*)smem;
#pragma unroll
        for (int i = 0; i < 2; ++i)
#pragma unroll
          for (int j = 0; j < 2; ++j)
#pragma unroll
            for (int g = 0; g < 4; ++g) {
              half4 o;
#pragma unroll
              for (int q = 0; q < 4; ++q) o[q] = (h16)acc[i][j][4 * g + q];
              *(half4*)(Cs + (64 * wr + 32 * i + lq) * 136 + 64 * wc + 32 * j + 8 * g + 4 * hh) = o;
            }
        __syncthreads();
#pragma unroll
        for (int q = 0; q < 8; ++q) {
          const int id = tid + q * 256; const int row = id >> 4, ch = id & 15;
          *(u32x4*)(p.P + (size_t)(tm * 128 + row) * PC + tn * 128 + ch * 8) = *(const u32x4*)(Cs + row * 136 + ch * 8);
        }
      } else if (wc == 0) {
#pragma unroll
        for (int i = 0; i < 2; ++i)
#pragma unroll
          for (int r = 0; r < 16; ++r) p.Z[(size_t)(tm * 128 + 64 * wr + 32 * i + lq) * 32 + (r & 3) + 8 * (r >> 2) + 4 * hh] = acc[i][0][r];
      }
    } else {
#pragma unroll
      for (int i = 0; i < 2; ++i)
#pragma unroll
        for (int r = 0; r < 16; ++r) {
          const int row = tm * 128 + 64 * wr + 32 * i + (r & 3) + 8 * (r >> 2) + 4 * hh;
          const int mr = row < NLAT ? (row >> 12) : 8;
          const float* gp = p.mod + (size_t)(l * 9 + mr) * 3072 + 2048 + tn * 128 + 64 * wc + lq;
          const float* xo; float* dst;
          if (l == 0) { if (row < NLAT) { xo = p.x + (size_t)row * 1024; dst = p.out + (size_t)row * 1024; } else { xo = p.ctx + (size_t)(row - NLAT) * 1024; dst = p.xc1 + (size_t)(row - NLAT) * 1024; } }
          else { xo = p.out + (size_t)row * 1024; dst = p.out + (size_t)row * 1024; }
          const int col = tn * 128 + 64 * wc + lq;
#pragma unroll
          for (int j = 0; j < 2; ++j) dst[col + 32 * j] = xo[col + 32 * j] + gp[32 * j] * acc[i][j][r];
        }
    }
  }
}

#define LOAD_COL34(arr, base, t0, Tn) \
  _Pragma("unroll") for (int q_ = 0; q_ < 34; ++q_) { const int t_ = (t0) - 1 + q_; arr[q_] = (t_ >= 0 && t_ < (Tn)) ? (base)[(long)t_ * PC] : (h16)0.f; }

__device__ void phase_feat(const Params& p, int l, int bid, int nb, char* smem) {
  const int tid = tid_opaque();
  float* in = (float*)smem;
  float* zt = in + 32 * 256;
  for (int item = bid; item < 1088; item += nb) {
    int b, t0, Tn, rowbase; bool isctx;
    if (item < 1024) { b = item >> 7; t0 = (item & 127) * 32; Tn = 4096; rowbase = b * 4096; isctx = false; }
    else { int j = item - 1024; b = j >> 3; t0 = (j & 7) * 32; Tn = 256; rowbase = NLAT + b * 256; isctx = true; }
    {
      const int col = 1152 + tid;
      const float mp = p.mu_prev[l * 1792 + col], mn = p.mu_next[l * 1792 + col];
      const h16* base = p.P + (size_t)rowbase * PC + col;
      h16 xv[34];
      LOAD_COL34(xv, base, t0, Tn)
#pragma unroll
      for (int tt = 0; tt < 32; ++tt) {
        const float prev = (float)xv[tt], cur = (float)xv[tt + 1], nxt = (float)xv[tt + 2];
        float sv = cur + mp * (prev - cur) + mn * (nxt - cur);
        if (tid < 128) { const float e2 = __expf(2.f * sv); sv = 1.f - 2.f / (e2 + 1.f); }
        in[tt * 256 + tid] = sv;
      }
      if (l == 1) {
#pragma unroll
        for (int i = 0; i < 4; ++i) { int id = tid + i * 256; zt[id] = p.Z[(size_t)(rowbase + t0) * 32 + id]; }
      }
    }
    __syncthreads();
#pragma unroll 1
    for (int c = tid; c < 384; c += 256) {
      const int col = 768 + c;
      const float mp = p.mu_prev[l * 1792 + col], mn = p.mu_next[l * 1792 + col];
      const h16* base = p.P + (size_t)rowbase * PC + col;
      h16 xv[34];
      LOAD_COL34(xv, base, t0, Tn)
      h16* dst = p.VB + (size_t)(rowbase + t0) * 384 + c;
      if (l == 0) {
#pragma unroll
        for (int tt = 0; tt < 32; ++tt) {
          const float prev = (float)xv[tt], cur = (float)xv[tt + 1], nxt = (float)xv[tt + 2];
          dst[tt * 384] = (h16)(cur + mp * (prev - cur) + mn * (nxt - cur));
        }
      } else {
        const float vbv = p.vb[c];
#pragma unroll 1
        for (int hf = 0; hf < 2; ++hf) {
          h16 vfv[16]; float ga[16];
#pragma unroll
          for (int tt = 0; tt < 16; ++tt) { vfv[tt] = dst[(hf * 16 + tt) * 384]; ga[tt] = vbv; }
#pragma unroll 1
          for (int m = 0; m < 32; m += 4) {
            const float w0 = p.vw2[m * 384 + c], w1 = p.vw2[(m + 1) * 384 + c], w2 = p.vw2[(m + 2) * 384 + c], w3 = p.vw2[(m + 3) * 384 + c];
#pragma unroll
            for (int tt = 0; tt < 16; ++tt) { const f32x4 z = *(const f32x4*)&zt[(hf * 16 + tt) * 32 + m]; ga[tt] += z[0] * w0 + z[1] * w1 + z[2] * w2 + z[3] * w3; }
          }
#pragma unroll
          for (int tt = 0; tt < 16; ++tt) {
            const float prev = hf ? (float)xv[16 + tt] : (float)xv[tt], cur = hf ? (float)xv[17 + tt] : (float)xv[tt + 1], nxt = hf ? (float)xv[18 + tt] : (float)xv[tt + 2];
            const float sv = cur + mp * (prev - cur) + mn * (nxt - cur);
            dst[(hf * 16 + tt) * 384] = (h16)(sv + ((float)vfv[tt] - sv) * sigmoidf_(ga[tt]));
          }
        }
      }
    }
#pragma unroll 1
    for (int oc = tid; oc < 1536; oc += 256) {
      const int slot = oc / 384, c = oc % 384, dir = slot & 1, kind = slot >> 1;
      const float* wm = (kind == 0 ? p.w2 : p.a2) + (size_t)((l * 2 + dir) * 64) * 384 + c;
      const float bias = (kind == 0 ? p.w0 : p.a0)[(l * 2 + dir) * 384 + c];
      const int io = (kind == 0 ? 0 : 128) + dir * 64;
      float acc[32];
#pragma unroll
      for (int tt = 0; tt < 32; ++tt) acc[tt] = bias;
#pragma unroll 1
      for (int r = 0; r < 64; r += 4) {
        const float w0 = wm[(size_t)r * 384], w1 = wm[(size_t)(r + 1) * 384], w2 = wm[(size_t)(r + 2) * 384], w3 = wm[(size_t)(r + 3) * 384];
#pragma unroll
        for (int tt = 0; tt < 32; ++tt) { f32x4 iv = *(const f32x4*)&in[tt * 256 + io + r]; acc[tt] += iv[0] * w0 + iv[1] * w1 + iv[2] * w2 + iv[3] * w3; }
      }
      const float mul = kind == 0 ? 0.6065306597126334f : 1.f;
#pragma unroll
      for (int tt = 0; tt < 32; ++tt) p.F[(size_t)(rowbase + t0 + tt) * 1536 + slot * 384 + c] = (h16)(mul * sigmoidf_(acc[tt]));
    }
    {
      const int head = tid >> 5, pr = tid & 31, half = pr >> 4, i = pr & 15;
      const int colbase = head < 6 ? 3072 + head * 64 : 3456 + (head - 6) * 64;
      const int d1 = half * 32 + i;
      const float qs = head < 6 ? 0.125f : 1.f;
      h16* pp = p.P + (size_t)(rowbase + t0) * PC + colbase + d1;
#pragma unroll
      for (int tq = 0; tq < 32; tq += 8) {
        h16 x1[8], x2[8];
#pragma unroll
        for (int u = 0; u < 8; ++u) { x1[u] = pp[(size_t)(tq + u) * PC]; x2[u] = pp[(size_t)(tq + u) * PC + 16]; }
#pragma unroll
        for (int u = 0; u < 8; ++u) {
          const int t = t0 + tq + u;
          float cs = 1.f, sn = 0.f;
          if (!isctx) { const int pos = half == 0 ? (t >> 6) : (t & 63); const f32x2 r2 = *(const f32x2*)&p.rope[(pos * 16 + i) * 2]; cs = r2[0]; sn = r2[1]; }
          const float a = (float)x1[u], bq = (float)x2[u];
          pp[(size_t)(tq + u) * PC] = (h16)((a * cs - bq * sn) * qs);
          pp[(size_t)(tq + u) * PC + 16] = (h16)((a * sn + bq * cs) * qs);
        }
      }
    }
    if (tid < 128) {
      const int g = tid >> 6, d = tid & 63;
      const h16* base = p.P + (size_t)(rowbase + t0) * PC + 3584 + tid;
      h16* dst = p.VT + (size_t)((b * 2 + g) * 64 + d) * VTS + (isctx ? 4096 + t0 : t0);
      half8 v[4];
#pragma unroll
      for (int q = 0; q < 4; ++q)
#pragma unroll
        for (int j = 0; j < 8; ++j) v[q][j] = base[(size_t)(q * 8 + j) * PC];
#pragma unroll
      for (int q = 0; q < 4; ++q) *(half8*)(dst + q * 8) = v[q];
    }
    __syncthreads();
  }
}

struct RwkvOps { f32x4 wA, wB, bA, bB, kA, kB, rA, rB; f32x2 vv; };
__device__ __forceinline__ RwkvOps rwkv_load_ops(const float* op, int step, int kq, int vp) {
  const float* o = op + step * 384 + 8 * kq;
  RwkvOps r;
  r.wA = *(const f32x4*)(o); r.wB = *(const f32x4*)(o + 4);
  r.bA = *(const f32x4*)(o + 128); r.bB = *(const f32x4*)(o + 132);
  r.kA = *(const f32x4*)(o + 192); r.kB = *(const f32x4*)(o + 196);
  r.rA = *(const f32x4*)(o + 256); r.rB = *(const f32x4*)(o + 260);
  r.vv = *(const f32x2*)(op + step * 384 + 320 + 2 * vp);
  return r;
}

__device__ void rwkv_chain(const Params& p, int l, int chain, char* smem) {
  const int tid = tid_opaque(), lane = tid & 63, w = tid >> 6;
  const int dir = chain / 48, b = (chain % 48) / 6, h = chain % 6;
  float* op = (float*)smem;
  float* ybuf = op + 16 * 384;
  const int hc = h * 64 + lane;
  const float mpr = p.mu_prev[l * 1792 + hc], mnr = p.mu_next[l * 1792 + hc];
  const float mpk = p.mu_prev[l * 1792 + 384 + hc], mnk = p.mu_next[l * 1792 + 384 + hc];
  const float kkw = p.k_k[l * 384 + hc], kaw = p.k_a[l * 384 + hc];
  const int vp = tid >> 3, kq = tid & 7;
  f32x2 S0[4], S1[4];
#pragma unroll
  for (int j = 0; j < 4; ++j) { S0[j] = (f32x2){0.f, 0.f}; S1[j] = (f32x2){0.f, 0.f}; }
  __builtin_amdgcn_s_setprio(3);
  h16 pf[4][9];
#define RWKV_ISSUE(ci_) { const int seg_ = (ci_) >= 16; const int Tn_ = seg_ ? 4096 : 256; const int rb_ = seg_ ? b * 4096 : NLAT + b * 256; const int c0_ = (seg_ ? (ci_) - 16 : (ci_)) * 16; \
    _Pragma("unroll") for (int i = 0; i < 4; ++i) { const int step = w * 4 + i; const int t = dir == 0 ? c0_ + step : Tn_ - 1 - (c0_ + step); const size_t row = (size_t)rb_ + t; const h16* pr = p.P + row * PC; \
      pf[i][0] = t > 0 ? pr[hc - PC] : (h16)0.f; pf[i][1] = pr[hc]; pf[i][2] = t + 1 < Tn_ ? pr[hc + PC] : (h16)0.f; \
      pf[i][3] = t > 0 ? pr[384 + hc - PC] : (h16)0.f; pf[i][4] = pr[384 + hc]; pf[i][5] = t + 1 < Tn_ ? pr[384 + hc + PC] : (h16)0.f; \
      pf[i][6] = p.VB[row * 384 + hc]; pf[i][7] = p.F[row * 1536 + dir * 384 + hc]; pf[i][8] = p.F[row * 1536 + (2 + dir) * 384 + hc]; } }
  RWKV_ISSUE(0)
#pragma unroll 1
  for (int ci = 0; ci < 272; ++ci) {
    const int seg = ci >= 16; const int Tn = seg ? 4096 : 256; const int rowbase = seg ? b * 4096 : NLAT + b * 256; const int c0 = (seg ? ci - 16 : ci) * 16;
    const bool wout = seg == 1 || l == 0;
#pragma unroll
    for (int i = 0; i < 4; ++i) {
      const int step = w * 4 + i;
      const float rm = (float)pf[i][0], r0 = (float)pf[i][1], rp = (float)pf[i][2];
      const float km = (float)pf[i][3], k0 = (float)pf[i][4], kp = (float)pf[i][5];
      const float vv = (float)pf[i][6], e = (float)pf[i][7], al = (float)pf[i][8];
      const float rs = r0 + mpr * (rm - r0) + mnr * (rp - r0);
      const float ks = k0 + mpk * (km - k0) + mnk * (kp - k0);
      const float kkr = ks * kkw;
      const float n2 = wave_sum_dpp(kkr * kkr);
      const float kk = kkr / fmaxf(sqrtf(n2), 1e-12f);
      float* o = op + step * 384 + lane;
      o[0] = __expf(-e); o[64] = -kk; o[128] = kk * al; o[192] = ks * (1.f + (al - 1.f) * kaw); o[256] = rs; o[320] = vv;
    }
    __syncthreads();
    if (ci + 1 < 272) RWKV_ISSUE(ci + 1)
    f32x4 aA = *(const f32x4*)(op + 8 * kq + 64), aB = *(const f32x4*)(op + 8 * kq + 68);
#pragma unroll
    for (int step = 0; step < 16; ++step) {
      const RwkvOps cur = rwkv_load_ops(op, step, kq, vp);
      f32x4 naA = aA, naB = aB;
      if (step + 1 < 16) { naA = *(const f32x4*)(op + (step + 1) * 384 + 8 * kq + 64); naB = *(const f32x4*)(op + (step + 1) * 384 + 8 * kq + 68); }
      const f32x2 w2[4] = {{cur.wA[0], cur.wA[1]}, {cur.wA[2], cur.wA[3]}, {cur.wB[0], cur.wB[1]}, {cur.wB[2], cur.wB[3]}};
      const f32x2 a2[4] = {{aA[0], aA[1]}, {aA[2], aA[3]}, {aB[0], aB[1]}, {aB[2], aB[3]}};
      const f32x2 b2[4] = {{cur.bA[0], cur.bA[1]}, {cur.bA[2], cur.bA[3]}, {cur.bB[0], cur.bB[1]}, {cur.bB[2], cur.bB[3]}};
      const f32x2 k2[4] = {{cur.kA[0], cur.kA[1]}, {cur.kA[2], cur.kA[3]}, {cur.kB[0], cur.kB[1]}, {cur.kB[2], cur.kB[3]}};
      const f32x2 r2[4] = {{cur.rA[0], cur.rA[1]}, {cur.rA[2], cur.rA[3]}, {cur.rB[0], cur.rB[1]}, {cur.rB[2], cur.rB[3]}};
      f32x2 d0 = S0[0] * a2[0], d1 = S1[0] * a2[0];
#pragma unroll
      for (int j = 1; j < 4; ++j) { d0 += S0[j] * a2[j]; d1 += S1[j] * a2[j]; }
      const float sa0 = red8(d0[0] + d0[1]), sa1 = red8(d1[0] + d1[1]);
      const f32x2 sa0v = {sa0, sa0}, sa1v = {sa1, sa1}, v0v = {cur.vv[0], cur.vv[0]}, v1v = {cur.vv[1], cur.vv[1]};
#pragma unroll
      for (int j = 0; j < 4; ++j) {
        S0[j] = S0[j] * w2[j] + sa0v * b2[j] + v0v * k2[j];
        S1[j] = S1[j] * w2[j] + sa1v * b2[j] + v1v * k2[j];
      }
      f32x2 y0 = S0[0] * r2[0], y1 = S1[0] * r2[0];
#pragma unroll
      for (int j = 1; j < 4; ++j) { y0 += S0[j] * r2[j]; y1 += S1[j] * r2[j]; }
      const float yy0 = red8(y0[0] + y0[1]), yy1 = red8(y1[0] + y1[1]);
      if (kq == 0) *(f32x2*)(ybuf + step * 64 + 2 * vp) = (f32x2){yy0, yy1};
      aA = naA; aB = naB;
    }
    __syncthreads();
    if (wout) {
#pragma unroll
      for (int i = 0; i < 4; ++i) {
        const int idx = tid + i * 256; const int step = idx >> 6, ch = idx & 63;
        const int t = dir == 0 ? c0 + step : Tn - 1 - (c0 + step);
        p.F[(size_t)(rowbase + t) * 1536 + dir * 384 + h * 64 + ch] = (h16)ybuf[idx];
      }
    }
  }
  __builtin_amdgcn_s_setprio(0);
}

struct HgrnOps { f32x4 fA, fB, qA, qB; f32x2 iv; };
__device__ __forceinline__ HgrnOps hgrn_load_ops(const float* op, int step, int kq, int vp) {
  const float* o = op + step * 192 + 8 * kq;
  HgrnOps r;
  r.fA = *(const f32x4*)(o); r.fB = *(const f32x4*)(o + 4);
  r.qA = *(const f32x4*)(o + 64); r.qB = *(const f32x4*)(o + 68);
  r.iv = *(const f32x2*)(op + step * 192 + 128 + 2 * vp);
  return r;
}

__device__ void hgrn_chain(const Params& p, int l, int chain, char* smem) {
  const int tid = tid_opaque(), lane = tid & 63, w = tid >> 6;
  const int dir = chain / 32, b = (chain % 32) / 4, h = chain % 4;
  float* op = (float*)smem;
  float* ybuf = op + 16 * 192;
  const int hc = h * 64 + lane;
  float lb = 0.f;
  if (l == 1) lb = sigmoidf_(p.lb_logits[(dir * 2 + 1) * 256 + hc] - p.lb_logits[(dir * 2 + 0) * 256 + hc]);
  const int fcol = 1792 + 256 * (1 + dir) + hc;
  const int vp = tid >> 3, kq = tid & 7;
  f32x2 S[8];
#pragma unroll
  for (int j = 0; j < 8; ++j) S[j] = (f32x2){0.f, 0.f};
  __builtin_amdgcn_s_setprio(2);
  h16 pf[4][3];
#define HGRN_ISSUE(ci_) { const int seg_ = (ci_) >= 16; const int Tn_ = seg_ ? 4096 : 256; const int rb_ = seg_ ? b * 4096 : NLAT + b * 256; const int c0_ = (seg_ ? (ci_) - 16 : (ci_)) * 16; \
    _Pragma("unroll") for (int i = 0; i < 4; ++i) { const int step = w * 4 + i; const int t = dir == 0 ? c0_ + step : Tn_ - 1 - (c0_ + step); const h16* pr = p.P + ((size_t)rb_ + t) * PC; \
      pf[i][0] = pr[fcol]; pf[i][1] = pr[1792 + hc]; pf[i][2] = pr[1792 + 768 + hc]; } }
  HGRN_ISSUE(0)
#pragma unroll 1
  for (int ci = 0; ci < 272; ++ci) {
    const int seg = ci >= 16; const int Tn = seg ? 4096 : 256; const int rowbase = seg ? b * 4096 : NLAT + b * 256; const int c0 = (seg ? ci - 16 : ci) * 16;
    const bool wout = seg == 1 || l == 0;
#pragma unroll
    for (int i = 0; i < 4; ++i) {
      const int step = w * 4 + i;
      float* o = op + step * 192 + lane;
      o[0] = lb + (1.f - lb) * sigmoidf_((float)pf[i][0]); o[64] = (float)pf[i][1]; o[128] = (float)pf[i][2];
    }
    __syncthreads();
    if (ci + 1 < 272) HGRN_ISSUE(ci + 1)
    HgrnOps cur = hgrn_load_ops(op, 0, kq, vp);
#pragma unroll
    for (int step = 0; step < 16; ++step) {
      HgrnOps nxt;
      if (step + 1 < 16) nxt = hgrn_load_ops(op, step + 1, kq, vp);
      const float f[8] = {cur.fA[0], cur.fA[1], cur.fA[2], cur.fA[3], cur.fB[0], cur.fB[1], cur.fB[2], cur.fB[3]};
      const float q[8] = {cur.qA[0], cur.qA[1], cur.qA[2], cur.qA[3], cur.qB[0], cur.qB[1], cur.qB[2], cur.qB[3]};
      f32x2 acc = {0.f, 0.f};
#pragma unroll
      for (int j = 0; j < 8; ++j) {
        const f32x2 fv = {f[j], f[j]}, gv = {1.f - f[j], 1.f - f[j]}, qv = {q[j], q[j]};
        S[j] = S[j] * fv + gv * cur.iv;
        acc += S[j] * qv;
      }
      const float o0 = red8(acc[0]), o1 = red8(acc[1]);
      if (kq == 0) *(f32x2*)(ybuf + step * 64 + 2 * vp) = (f32x2){o0, o1};
      if (step + 1 < 16) cur = nxt;
    }
    __syncthreads();
    if (wout) {
#pragma unroll
      for (int i = 0; i < 4; ++i) {
        const int idx = tid + i * 256; const int step = idx >> 6, ch = idx & 63;
        const int t = dir == 0 ? c0 + step : Tn - 1 - (c0 + step);
        p.P[(size_t)(rowbase + t) * PC + 1792 + 256 * (1 + dir) + h * 64 + ch] = (h16)ybuf[idx];
      }
    }
  }
  __builtin_amdgcn_s_setprio(0);
}

__device__ void attn_unit(const Params& p, int l, int u) {
  const int tid = tid_opaque(), lane = tid & 63, w = tid >> 6, lq = lane & 31, hh = lane >> 5;
  int b, head, qrow_base, qpos0; bool isctx;
  if (u < 1536) { b = u / 192; int rem = u % 192; int blk = rem / 6; head = rem % 6; qpos0 = blk * 128 + w * 32; qrow_base = b * 4096; isctx = false; }
  else { int j = u - 1536; b = j / 12; int rem = j % 12; int qb = rem / 6; head = rem % 6; qpos0 = qb * 128 + w * 32; qrow_base = NLAT + b * 256; isctx = true; }
  const int g = head / 3;
  const size_t qrow = (size_t)qrow_base + qpos0 + lq;
  half8 qf[4];
#pragma unroll
  for (int s = 0; s < 4; ++s) qf[s] = *(const half8*)(p.P + qrow * PC + 3072 + head * 64 + 16 * s + 8 * hh);
  const float sinkv = p.sink[l * 6 + head];
  float m = sinkv, lsum = hh == 0 ? 1.f : 0.f;
  f32x16 O[2];
#pragma unroll
  for (int r = 0; r < 16; ++r) { O[0][r] = 0.f; O[1][r] = 0.f; }
  const h16* vt = p.VT + (size_t)((b * 2 + g) * 64) * VTS;
  int nband = 0, kstart = 0;
  if (!isctx) { kstart = max(0, qpos0 - 128); const int kend = min(4096, qpos0 + 160); nband = (kend - kstart) >> 5; }
  const int ntiles = nband + 8;
  for (int ti = 0; ti < ntiles; ++ti) {
    const bool band = ti < nband;
    const int kt = band ? kstart + ti * 32 : (ti - nband) * 32;
    const size_t krow = band ? (size_t)b * 4096 + kt + lq : (size_t)NLAT + b * 256 + kt + lq;
    const int vidx = band ? kt : 4096 + kt;
    const h16* kp = p.P + krow * PC + 3456 + g * 64 + 8 * hh;
    f32x16 sacc;
#pragma unroll
    for (int r = 0; r < 16; ++r) sacc[r] = 0.f;
#pragma unroll
    for (int s = 0; s < 4; ++s) { half8 kf = *(const half8*)(kp + 16 * s); sacc = __builtin_amdgcn_mfma_f32_32x32x16_f16(kf, qf[s], sacc, 0, 0, 0); }
    float mx = -INFINITY;
#pragma unroll
    for (int r = 0; r < 16; ++r) {
      float sv = sacc[r];
      if (band) { const int dlt = kt + (r & 3) + 8 * (r >> 2) + 4 * hh - (qpos0 + lq); if (dlt > 128 || dlt < -128) sv = -INFINITY; }
      sacc[r] = sv; mx = fmaxf(mx, sv);
    }
    mx = fmaxf(mx, __shfl_xor(mx, 32));
    const float mn = fmaxf(m, mx); const float corr = __expf(m - mn); m = mn;
    float ps = 0.f; half8 pb[2];
#pragma unroll
    for (int r = 0; r < 16; ++r) { const float pv = __expf(sacc[r] - mn); ps += pv; pb[r >> 3][r & 7] = (h16)pv; }
    lsum = lsum * corr + ps;
#pragma unroll
    for (int r = 0; r < 16; ++r) { O[0][r] *= corr; O[1][r] *= corr; }
#pragma unroll
    for (int s2 = 0; s2 < 2; ++s2)
#pragma unroll
      for (int dt = 0; dt < 2; ++dt) {
        const h16* vp = vt + (size_t)(dt * 32 + lq) * VTS + vidx + 16 * s2 + 4 * hh;
        const half4 lo = *(const half4*)vp, hi = *(const half4*)(vp + 8);
        const half8 vf = {lo[0], lo[1], lo[2], lo[3], hi[0], hi[1], hi[2], hi[3]};
        O[dt] = __builtin_amdgcn_mfma_f32_32x32x16_f16(vf, pb[s2], O[dt], 0, 0, 0);
      }
  }
  lsum += __shfl_xor(lsum, 32);
  const float inv = 1.f / lsum;
#pragma unroll
  for (int dt = 0; dt < 2; ++dt)
#pragma unroll
    for (int g4 = 0; g4 < 4; ++g4) {
      const int d0 = dt * 32 + 8 * g4 + 4 * hh;
      const half4 ga = *(const half4*)(p.P + qrow * PC + 3712 + head * 64 + d0);
      half4 o;
#pragma unroll
      for (int j = 0; j < 4; ++j) { const float gv = (float)ga[j]; o[j] = (h16)(O[dt][g4 * 4 + j] * inv * siluf_(gv)); }
      *(half4*)(p.hy + qrow * 1024 + 640 + head * 64 + d0) = o;
    }
}

__device__ void phase_mix(const Params& p, int l, int bid, int nb, char* smem) {
  const int nunits = l == 0 ? 1536 + 96 : 1536;
  if (nb >= 320) {
    if (bid < 96) rwkv_chain(p, l, bid, smem);
    else if (bid < 160) hgrn_chain(p, l, bid - 96, smem);
    else for (int u = bid - 160; u < nunits; u += nb - 160) attn_unit(p, l, u);
  } else {
    for (int it = bid; it < 160 + nunits; it += nb) {
      if (it < 96) rwkv_chain(p, l, it, smem);
      else if (it < 160) hgrn_chain(p, l, it - 96, smem);
      else attn_unit(p, l, it - 160);
      __syncthreads();
    }
  }
}

__device__ void phase_readout(const Params& p, int l, int bid, int nb) {
  const int tid = tid_opaque(), lane = tid & 63, w = tid >> 6;
  const int nrows = l == 1 ? NLAT : NTOK;
  for (int row = bid * 4 + w; row < nrows; row += nb * 4) {
    int t, Tn;
    if (row < NLAT) { t = row & 4095; Tn = 4096; } else { t = (row - NLAT) & 255; Tn = 256; }
    const h16* pr = p.P + (size_t)row * PC;
    const h16* fr = p.F + (size_t)row * 1536;
    h16* yo = p.hy + (size_t)row * 1024;
    const bool hp = t > 0, hn = t + 1 < Tn;
#pragma unroll 1
    for (int h = 0; h < 6; ++h) {
      const int c = h * 64 + lane;
      const float y = (float)fr[c] + (float)fr[384 + c];
      const float mean = wave_sum_dpp(y) * (1.f / 64.f);
      const float yc = y - mean;
      const float var = wave_sum_dpp(yc * yc) * (1.f / 64.f);
      const float yn = yc * rsqrtf(var + 64e-5f) * p.gn_w[l * 384 + c] + p.gn_b[l * 384 + c];
      float sh[3];
#pragma unroll
      for (int q = 0; q < 3; ++q) {
        const int col = (q == 0 ? 0 : (q == 1 ? 384 : 1408)) + c;
        const float mp = p.mu_prev[l * 1792 + col], mn = p.mu_next[l * 1792 + col];
        const float cur = (float)pr[col];
        const float prv = hp ? (float)pr[col - PC] : 0.f, nxt = hn ? (float)pr[col + PC] : 0.f;
        sh[q] = cur + mp * (prv - cur) + mn * (nxt - cur);
      }
      const float v = (float)p.VB[(size_t)row * 384 + c];
      const float bonus = wave_sum_dpp(sh[0] * sh[1] * p.r_k[l * 384 + c]) * v;
      yo[c] = (h16)((yn + bonus) * siluf_(sh[2]));
    }
#pragma unroll 1
    for (int h = 0; h < 4; ++h) {
      const int c = h * 64 + lane;
      const float o = (float)pr[2048 + c] + (float)pr[2304 + c];
      const float ms = wave_sum_dpp(o * o) * (1.f / 64.f);
      const float on = o * rsqrtf(ms + 1e-6f);
      yo[384 + c] = (h16)(on * p.hg_norm_w[l * 256 + c] * siluf_((float)pr[2816 + c]));
    }
  }
}

__device__ void phase_final(const Params& p, int bid, int nb) {
  const int tid = tid_opaque(), lane = tid & 63, w = tid >> 6;
  for (int row = bid * 4 + w; row < NLAT; row += nb * 4) {
    float* src = p.out + (size_t)row * 1024;
    f32x4 v[4]; float ss = 0.f;
#pragma unroll
    for (int i = 0; i < 4; ++i) { v[i] = *(const f32x4*)(src + i * 256 + lane * 4); ss += v[i][0] * v[i][0] + v[i][1] * v[i][1] + v[i][2] * v[i][2] + v[i][3] * v[i][3]; }
    ss = wave_sum_dpp(ss);
    const float rs = rsqrtf(ss * (1.f / 1024.f) + 1e-6f);
#pragma unroll
    for (int i = 0; i < 4; ++i) {
      const int col = i * 256 + lane * 4;
      const f32x4 nwv = *(const f32x4*)(p.final_w + col);
      f32x4 o;
#pragma unroll
      for (int j = 0; j < 4; ++j) o[j] = v[i][j] * rs * nwv[j];
      *(f32x4*)(src + col) = o;
    }
  }
}

__global__ void __launch_bounds__(256, 3) mega(Params p, int ph_lo, int ph_hi, int coop) {
  __shared__ __attribute__((aligned(16))) char smem[SMEM_BYTES];
  for (int ph = ph_lo; ph < ph_hi; ++ph) {
    int bid = blockIdx.x, nb = gridDim.x;
    asm volatile("" : "+s"(bid), "+s"(nb));
    if (ph == 0) phase_prep(p, bid, nb, smem);
    else if (ph == 13) phase_final(p, bid, nb);
    else {
      const int l = (ph - 1) / 6, s = (ph - 1) % 6;
      if (s == 0) phase_norm(p, l, bid, nb);
      else if (s == 1) phase_gemm<0>(p, l, bid, nb, smem);
      else if (s == 2) phase_feat(p, l, bid, nb, smem);
      else if (s == 3) phase_mix(p, l, bid, nb, smem);
      else if (s == 4) phase_readout(p, l, bid, nb);
      else phase_gemm<1>(p, l, bid, nb, smem);
    }
    if (coop && ph + 1 < ph_hi) cg::this_grid().sync();
  }
}

extern "C" void kernel_launch(void* const* d_in, const int* in_sizes, int n_in, void* d_out, int out_size, void* d_ws, size_t ws_size, hipStream_t stream) {
  static int grid_blocks = 0;
  if (!grid_blocks) {
    int dev = 0, cus = 0, per_cu = 0;
    hipGetDevice(&dev);
    hipDeviceGetAttribute(&cus, hipDeviceAttributeMultiprocessorCount, dev);
    hipOccupancyMaxActiveBlocksPerMultiprocessor(&per_cu, mega, 256, 0);
    if (per_cu < 1) per_cu = 1;
    grid_blocks = cus * per_cu;
  }
  Params p{};
  const float* const* in = (const float* const*)d_in;
  p.x = in[0]; p.c = in[1]; p.ctx = in[2]; p.c_ctx = in[3]; p.mod_w = in[4]; p.mod_b = in[5]; p.norm_w = in[6]; p.w_in = in[7]; p.w_out = in[8];
  p.mu_prev = in[9]; p.mu_next = in[10]; p.w0 = in[11]; p.w2 = in[12]; p.a0 = in[13]; p.a2 = in[14]; p.k_k = in[15]; p.k_a = in[16]; p.r_k = in[17];
  p.gn_w = in[18]; p.gn_b = in[19]; p.vw1 = in[20]; p.vw2 = in[21]; p.vb = in[22]; p.lb_logits = in[23]; p.hg_norm_w = in[24]; p.sink = in[25]; p.final_w = in[26];
  p.out = (float*)d_out;
  char* ws = (char*)d_ws; size_t off = 0;
  auto take = [&](size_t bytes) { char* r = ws + off; off += (bytes + 255) & ~(size_t)255; return r; };
  p.win_t = (h16*)take((size_t)2 * NPAD * 1024 * 2);
  p.wout_t = (h16*)take((size_t)2 * 1024 * 1024 * 2);
  p.mod = (float*)take((size_t)2 * 9 * 3072 * 4);
  p.rope = (float*)take((size_t)64 * 16 * 2 * 4);
  p.hy = (h16*)take((size_t)NTOK * 1024 * 2);
  p.P = (h16*)take((size_t)NTOK * PC * 2);
  p.F = (h16*)take((size_t)NTOK * 1536 * 2);
  p.VB = (h16*)take((size_t)NTOK * 384 * 2);
  p.Z = (float*)take((size_t)NTOK * 32 * 4);
  p.VT = (h16*)take((size_t)16 * 64 * VTS * 2);
  p.xc1 = (float*)take((size_t)2048 * 1024 * 4);
  if (off > ws_size) fprintf(stderr, "workspace too small: need %zu have %zu\n", off, ws_size);
#if SINGLE_LAUNCH
  int lo = 0, hi = 14, coop = 1;
  void* args[] = {&p, &lo, &hi, &coop};
  hipError_t e = hipLaunchCooperativeKernel((void*)mega, dim3(grid_blocks), dim3(256), args, 0, stream);
  if (e != hipSuccess) fprintf(stderr, "cooperative launch failed: %s (grid %d)\n", hipGetErrorString(e), grid_blocks);
#else
  for (int ph = 0; ph < 14; ++ph) mega<<<grid_blocks, 256, 0, stream>>>(p, ph, ph + 1, 0);
#endif
}
```

```cpp
#include <hip/hip_runtime.h>
#include <hip/hip_cooperative_groups.h>
#include <cstdio>
#include <cstdint>
namespace cg = cooperative_groups;

typedef _Float16 h16;
typedef _Float16 half8 __attribute__((ext_vector_type(8)));
typedef _Float16 half4 __attribute__((ext_vector_type(4)));
typedef float f32x16 __attribute__((ext_vector_type(16)));
typedef float f32x4 __attribute__((ext_vector_type(4)));
typedef float f32x2 __attribute__((ext_vector_type(2)));
typedef unsigned u32x4 __attribute__((ext_vector_type(4)));
typedef _Float16 half2v __attribute__((ext_vector_type(2)));

constexpr int NLAT = 32768, NTOK = 34816;
constexpr int PC = 4096;
constexpr int NPAD = 4224;
constexpr int VTS = 4352;
constexpr int SMEM_BYTES = 49152;

#ifndef EXTRA_SYNCS
#define EXTRA_SYNCS 0
#endif
#ifndef PROBE_MASK
#define PROBE_MASK 0
#endif
#ifndef SINGLE_LAUNCH
#define SINGLE_LAUNCH 1
#endif

struct Params {
  const float *x, *c, *ctx, *c_ctx, *mod_w, *mod_b, *norm_w, *w_in, *w_out;
  const float *mu_prev, *mu_next, *w0, *w2, *a0, *a2, *k_k, *k_a, *r_k, *gn_w, *gn_b;
  const float *vw1, *vw2, *vb, *lb_logits, *hg_norm_w, *sink, *final_w;
  float* out;
  h16 *win_t, *wout_t;
  float* mod;
  h16 *hy, *P, *F, *VB;
  float* Z;
  h16* VT;
  float* xc1;
  float* rope;
  unsigned* bar;
};

__device__ __forceinline__ int tid_opaque() { int t = threadIdx.x; asm volatile("" : "+v"(t)); return t; }
__device__ __forceinline__ float wave_sum(float v) {
#pragma unroll
  for (int o = 32; o > 0; o >>= 1) v += __shfl_xor(v, o);
  return v;
}
__device__ __forceinline__ float sigmoidf_(float x) { return 1.f / (1.f + __expf(-x)); }
__device__ __forceinline__ float siluf_(float x) { return x / (1.f + __expf(-x)); }
template <int CTRL> __device__ __forceinline__ float dpp_mov(float x) {
  return __int_as_float(__builtin_amdgcn_update_dpp(0, __float_as_int(x), CTRL, 0xf, 0xf, true));
}
__device__ __forceinline__ float wave_sum_dpp(float x) {
  x += dpp_mov<0xB1>(x);
  x += dpp_mov<0x4E>(x);
  x += dpp_mov<0x141>(x);
  x += dpp_mov<0x140>(x);
  const int xi = __float_as_int(x);
  return __int_as_float(__builtin_amdgcn_readlane(xi, 0)) + __int_as_float(__builtin_amdgcn_readlane(xi, 16)) +
         __int_as_float(__builtin_amdgcn_readlane(xi, 32)) + __int_as_float(__builtin_amdgcn_readlane(xi, 48));
}
__device__ __forceinline__ float red8(float x) {
  x += dpp_mov<0xB1>(x);
  x += dpp_mov<0x4E>(x);
  x += dpp_mov<0x141>(x);
  return x;
}

#define XB_TMO      128
#define XB_XCNT(j)  (256  + 64 * (j))
#define XB_XSUB(j)  (1280 + 64 * (j))
#define XB_XGEN(j)  (2304 + 64 * (j))
#define XB_TOP      3328
#define XB_TOPGEN   3392
#define XCD_BAR_WORDS 3456
#define XB_SPIN_CAP (1u << 18)
#define LAS __attribute__((address_space(3)))
__device__ __forceinline__ unsigned xb_ld(unsigned* p)              { return __hip_atomic_load(p, __ATOMIC_RELAXED, __HIP_MEMORY_SCOPE_AGENT); }
__device__ __forceinline__ unsigned xb_add(unsigned* p, unsigned v) { return __hip_atomic_fetch_add(p, v, __ATOMIC_RELAXED, __HIP_MEMORY_SCOPE_AGENT); }
__device__ __forceinline__ unsigned xb_xcc_id() { return (unsigned)__builtin_amdgcn_s_getreg((3 << 11) | 20) & 0xFu; }
#define XB_SPIN(cond, bar) do { unsigned _sp = 0; while (cond) { __builtin_amdgcn_s_sleep(1); \
    if ((++_sp & 255u) == 0u) { if (xb_ld(&(bar)[XB_TMO])) break; if (_sp > XB_SPIN_CAP) { atomicAdd(&(bar)[XB_TMO], 1u); break; } } } } while (0)
struct XcdBarrier { unsigned* bar; unsigned x; volatile LAS unsigned* st; };
__device__ __forceinline__ XcdBarrier xcd_barrier_post(unsigned* bar, volatile LAS unsigned* st) {
  XcdBarrier b; b.bar = bar; b.x = xb_xcc_id(); b.st = st;
  if (threadIdx.x == 0) (void)xb_add(&bar[XB_XCNT(b.x)], 1u);
  return b;
}
__device__ __forceinline__ void xcd_barrier_complete(unsigned* bar, unsigned x, unsigned& nloc, unsigned& nx) {
  const unsigned G = gridDim.x * gridDim.y * gridDim.z;
  unsigned sum, cnt, mine, sp = 0u;
  for (;;) {
    sum = 0u; cnt = 0u; mine = 0u;
#pragma unroll
    for (unsigned j = 0; j < 16; ++j) { const unsigned c = xb_ld(&bar[XB_XCNT(j)]); sum += c; cnt += (c > 0u) ? 1u : 0u; mine = (j == x) ? c : mine; }
    if (sum == G) break;
    __builtin_amdgcn_s_sleep(1);
    if ((++sp & 255u) == 0u) { if (xb_ld(&bar[XB_TMO])) break; if (sp > XB_SPIN_CAP) { atomicAdd(&bar[XB_TMO], 1u); break; } }
  }
  nloc = mine > 0u ? mine : 1u; nx = cnt > 0u ? cnt : 1u;
}
__device__ __forceinline__ void xcd_barrier(const XcdBarrier& b) {
  asm volatile("s_waitcnt vmcnt(0)" ::: "memory");
  __syncthreads();
  if (threadIdx.x == 0) {
    unsigned* bar = b.bar;
    __builtin_amdgcn_s_waitcnt(0);
    unsigned nloc = b.st[0], nx = b.st[1];
    if (nloc == 0u) { xcd_barrier_complete(bar, b.x, nloc, nx); b.st[0] = nloc; b.st[1] = nx; }
    const unsigned old = xb_add(&bar[XB_XSUB(b.x)], 1u);
    const unsigned gen = old / nloc;
    if (old + 1u == (gen + 1u) * nloc) {
      __builtin_amdgcn_fence(__ATOMIC_RELEASE, "agent");
      asm volatile("s_waitcnt vmcnt(0)" ::: "memory");
      const unsigned og = xb_add(&bar[XB_TOP], 1u);
      const unsigned tg = og / nx;
      if (og + 1u == (tg + 1u) * nx) xb_add(&bar[XB_TOPGEN], 1u);
      else XB_SPIN(xb_ld(&bar[XB_TOPGEN]) == tg, bar);
      __builtin_amdgcn_fence(__ATOMIC_ACQUIRE, "agent");
      xb_add(&bar[XB_XGEN(b.x)], 1u);
      asm volatile("s_waitcnt vmcnt(0)" ::: "memory");
    } else {
      XB_SPIN(xb_ld(&bar[XB_XGEN(b.x)]) == gen, bar);
      __builtin_amdgcn_fence(__ATOMIC_ACQUIRE, "agent");
      asm volatile("s_waitcnt vmcnt(0)" ::: "memory");
    }
  }
  __syncthreads();
}

__device__ __forceinline__ void phase_prep(const Params& p, int bid, int nb, char* smem) {
  const int tid = tid_opaque();
  float* sf = (float*)smem;
  constexpr int N_WIN = 2048, N_WOUT = 512, N_MOD = 192, N_PADI = 1024;
  constexpr int total = N_WIN + N_WOUT + N_MOD + N_PADI + 1;
  for (int it = bid; it < total; it += nb) {
    if (it < N_WIN + N_WOUT) {
      const float* src; h16* dst; int ncols, kt, ntile;
      if (it < N_WIN) { int l = it >> 10, r = it & 1023; kt = r >> 6; ntile = r & 63; src = p.w_in + (size_t)l * 1024 * 4096; dst = p.win_t + (size_t)l * NPAD * 1024; ncols = 4096; }
      else { int j = it - N_WIN; int l = j >> 8, r = j & 255; kt = r >> 4; ntile = r & 15; src = p.w_out + (size_t)l * 1024 * 1024; dst = p.wout_t + (size_t)l * 1024 * 1024; ncols = 1024; }
      for (int i = tid; i < 4096; i += 256) { int kk = i >> 6, nn = i & 63; sf[kk * 65 + nn] = src[(size_t)(kt * 64 + kk) * ncols + ntile * 64 + nn]; }
      __syncthreads();
      for (int i = tid; i < 4096; i += 256) { int nn = i >> 6, kk = i & 63; dst[(size_t)(ntile * 64 + nn) * 1024 + kt * 64 + kk] = (h16)sf[kk * 65 + nn]; }
      __syncthreads();
    } else if (it < N_WIN + N_WOUT + N_MOD) {
      const int j = it - N_WIN - N_WOUT; const int l = j / 96; const int cl = tid & 31, ks = tid >> 5; const int col = (j % 96) * 32 + cl;
      for (int i = tid; i < 9 * 1024; i += 256) { int r = i >> 10, k = i & 1023; float v = r < 8 ? p.c[r * 1024 + k] : p.c_ctx[k]; sf[i] = siluf_(v); }
      __syncthreads();
      float acc[9];
#pragma unroll
      for (int r = 0; r < 9; ++r) acc[r] = 0.f;
      const float* mw = p.mod_w + (size_t)l * 1024 * 3072 + (size_t)(ks * 128) * 3072 + col;
#pragma unroll 2
      for (int k = 0; k < 128; k += 4) {
        const float w0 = mw[(size_t)k * 3072], w1 = mw[(size_t)(k + 1) * 3072], w2 = mw[(size_t)(k + 2) * 3072], w3 = mw[(size_t)(k + 3) * 3072];
#pragma unroll
        for (int r = 0; r < 9; ++r) { const f32x4 sv = *(const f32x4*)&sf[r * 1024 + ks * 128 + k]; acc[r] += sv[0] * w0 + sv[1] * w1 + sv[2] * w2 + sv[3] * w3; }
      }
#pragma unroll
      for (int r = 0; r < 9; ++r) acc[r] += __shfl_xor(acc[r], 32);
      __syncthreads();
      if ((tid & 63) < 32) {
#pragma unroll
        for (int r = 0; r < 9; ++r) sf[((tid >> 6) * 9 + r) * 32 + cl] = acc[r];
      }
      __syncthreads();
      for (int i = tid; i < 288; i += 256) {
        const int r = i >> 5, c2 = i & 31;
        const float v = sf[(0 * 9 + r) * 32 + c2] + sf[(1 * 9 + r) * 32 + c2] + sf[(2 * 9 + r) * 32 + c2] + sf[(3 * 9 + r) * 32 + c2];
        const int cc = (j % 96) * 32 + c2;
        p.mod[(size_t)(l * 9 + r) * 3072 + cc] = v + p.mod_b[l * 3072 + cc];
      }
      __syncthreads();
    } else if (it < N_WIN + N_WOUT + N_MOD + N_PADI) {
      int j = it - (N_WIN + N_WOUT + N_MOD); int idx = j * 256 + tid;
      int l = idx >> 17; int rem = idx & 131071; int m = rem >> 10, k = rem & 1023;
      float v = (l == 1 && m < 32) ? p.vw1[k * 32 + m] : 0.f;
      p.win_t[(size_t)l * NPAD * 1024 + (size_t)(4096 + m) * 1024 + k] = (h16)v;
    } else {
      if (tid < 16) {
        double inv = 1.0; for (int i = 0; i < tid; ++i) inv *= 0.5623413251903491;
        double x2 = inv * inv, ts = inv, tc = 1.0, s1 = inv, c1 = 1.0;
        for (int n = 1; n <= 10; ++n) { tc *= -x2 / ((2.0 * n - 1.0) * (2.0 * n)); c1 += tc; ts *= -x2 / ((2.0 * n) * (2.0 * n + 1.0)); s1 += ts; }
        double cc = 1.0, ss = 0.0;
        for (int pos = 0; pos < 64; ++pos) {
          p.rope[(pos * 16 + tid) * 2] = (float)cc; p.rope[(pos * 16 + tid) * 2 + 1] = (float)ss;
          double nc = cc * c1 - ss * s1, ns = ss * c1 + cc * s1; cc = nc; ss = ns;
        }
      }
    }
  }
}

__device__ __forceinline__ void phase_norm(const Params& p, int l, int bid, int nb) {
  const int tid = tid_opaque(), lane = tid & 63, w = tid >> 6;
  for (int row = bid * 4 + w; row < NTOK; row += nb * 4) {
    const float* src = (l == 0) ? (row < NLAT ? p.x + (size_t)row * 1024 : p.ctx + (size_t)(row - NLAT) * 1024)
                                : (row < NLAT ? p.out + (size_t)row * 1024 : p.xc1 + (size_t)(row - NLAT) * 1024);
    const int mr = row < NLAT ? (row >> 12) : 8;
    const float* md = p.mod + (size_t)(l * 9 + mr) * 3072;
    const float* nw = p.norm_w + l * 1024;
    f32x4 v[4]; float ss = 0.f;
#pragma unroll
    for (int i = 0; i < 4; ++i) { v[i] = *(const f32x4*)(src + i * 256 + lane * 4); ss += v[i][0] * v[i][0] + v[i][1] * v[i][1] + v[i][2] * v[i][2] + v[i][3] * v[i][3]; }
    ss = wave_sum_dpp(ss);
    const float rs = rsqrtf(ss * (1.f / 1024.f) + 1e-6f);
#pragma unroll
    for (int i = 0; i < 4; ++i) {
      const int col = i * 256 + lane * 4;
      f32x4 nwv = *(const f32x4*)(nw + col), sc = *(const f32x4*)(md + 1024 + col), sh = *(const f32x4*)(md + col);
      half4 o;
#pragma unroll
      for (int j = 0; j < 4; ++j) o[j] = (h16)(v[i][j] * rs * nwv[j] * (1.f + sc[j]) + sh[j]);
      *(half4*)(p.hy + (size_t)row * 1024 + col) = o;
    }
  }
}

template <int MODE>
__device__ __forceinline__ void phase_gemm(const Params& p, int l, int bid, int nb, char* smem) {
  const h16* A = p.hy;
  const h16* Bt = MODE == 0 ? p.win_t + (size_t)l * NPAD * 1024 : p.wout_t + (size_t)l * 1024 * 1024;
  const int ntn = MODE == 0 ? (l == 1 ? 33 : 32) : 8;
  const int ntm = (MODE == 1 && l == 1) ? 256 : 272;
  const int tid = tid_opaque(), lane = tid & 63, w = tid >> 6, wr = w >> 1, wc = w & 1, lq = lane & 31, hh = lane >> 5;
  h16* As = (h16*)smem; h16* Bs = As + 128 * 72;
  const int ldrow = tid >> 3, ldch = (tid & 7) * 8;
  for (int tile = bid; tile < ntm * ntn; tile += nb) {
    const int tm = tile / ntn, tn = tile % ntn;
    const h16* Ag = A + (size_t)(tm * 128 + ldrow) * 1024 + ldch; const h16* Bg = Bt + (size_t)(tn * 128 + ldrow) * 1024 + ldch;
    f32x16 acc[2][2];
#pragma unroll
    for (int i = 0; i < 2; ++i)
#pragma unroll
      for (int j = 0; j < 2; ++j)
#pragma unroll
        for (int r = 0; r < 16; ++r) acc[i][j][r] = 0.f;
    u32x4 ra[4], rb[4];
#pragma unroll
    for (int i = 0; i < 4; ++i) { ra[i] = *(const u32x4*)(Ag + (size_t)i * 32 * 1024); rb[i] = *(const u32x4*)(Bg + (size_t)i * 32 * 1024); }
#pragma unroll 1
    for (int kt = 0; kt < 16; ++kt) {
      __syncthreads();
#pragma unroll
      for (int i = 0; i < 4; ++i) { *(u32x4*)(As + (ldrow + i * 32) * 72 + ldch) = ra[i]; *(u32x4*)(Bs + (ldrow + i * 32) * 72 + ldch) = rb[i]; }
      __syncthreads();
      if (kt + 1 < 16) {
#pragma unroll
        for (int i = 0; i < 4; ++i) { ra[i] = *(const u32x4*)(Ag + (size_t)i * 32 * 1024 + (kt + 1) * 64); rb[i] = *(const u32x4*)(Bg + (size_t)i * 32 * 1024 + (kt + 1) * 64); }
      }
#pragma unroll
      for (int s = 0; s < 4; ++s) {
        half8 a[2], b[2];
#pragma unroll
        for (int i = 0; i < 2; ++i) { a[i] = *(const half8*)(As + (64 * wr + 32 * i + lq) * 72 + 16 * s + 8 * hh); b[i] = *(const half8*)(Bs + (64 * wc + 32 * i + lq) * 72 + 16 * s + 8 * hh); }
#pragma unroll
        for (int i = 0; i < 2; ++i)
#pragma unroll
          for (int j = 0; j < 2; ++j) {
            if (MODE == 0) acc[i][j] = __builtin_amdgcn_mfma_f32_32x32x16_f16(b[j], a[i], acc[i][j], 0, 0, 0);
            else acc[i][j] = __builtin_amdgcn_mfma_f32_32x32x16_f16(a[i], b[j], acc[i][j], 0, 0, 0);
          }
      }
    }
    if (MODE == 0) {
      if (tn < 32) {
        __syncthreads();
        h16* Cs = (h16*)smem;
#pragma unroll
        for (int i = 0; i < 2; ++i)
#pragma unroll
          for (int j = 0; j < 2; ++j)
#pragma unroll
            for (int g = 0; g < 4; ++g) {
              half4 o;
#pragma unroll
              for (int q = 0; q < 4; ++q) o[q] = (h16)acc[i][j][4 * g + q];
              *(half4*)(Cs + (64 * wr + 32 * i + lq) * 136 + 64 * wc + 32 * j + 8 * g + 4 * hh) = o;
            }
        __syncthreads();
#pragma unroll
        for (int q = 0; q < 8; ++q) {
          const int id = tid + q * 256; const int row = id >> 4, ch = id & 15;
          *(u32x4*)(p.P + (size_t)(tm * 128 + row) * PC + tn * 128 + ch * 8) = *(const u32x4*)(Cs + row * 136 + ch * 8);
        }
      } else if (wc == 0) {
#pragma unroll
        for (int i = 0; i < 2; ++i)
#pragma unroll
          for (int r = 0; r < 16; ++r) p.Z[(size_t)(tm * 128 + 64 * wr + 32 * i + lq) * 32 + (r & 3) + 8 * (r >> 2) + 4 * hh] = acc[i][0][r];
      }
    } else {
#pragma unroll
      for (int i = 0; i < 2; ++i)
#pragma unroll
        for (int r = 0; r < 16; ++r) {
          const int row = tm * 128 + 64 * wr + 32 * i + (r & 3) + 8 * (r >> 2) + 4 * hh;
          const int mr = row < NLAT ? (row >> 12) : 8;
          const float* gp = p.mod + (size_t)(l * 9 + mr) * 3072 + 2048 + tn * 128 + 64 * wc + lq;
          const float* xo; float* dst;
          if (l == 0) { if (row < NLAT) { xo = p.x + (size_t)row * 1024; dst = p.out + (size_t)row * 1024; } else { xo = p.ctx + (size_t)(row - NLAT) * 1024; dst = p.xc1 + (size_t)(row - NLAT) * 1024; } }
          else { xo = p.out + (size_t)row * 1024; dst = p.out + (size_t)row * 1024; }
          const int col = tn * 128 + 64 * wc + lq;
#pragma unroll
          for (int j = 0; j < 2; ++j) dst[col + 32 * j] = xo[col + 32 * j] + gp[32 * j] * acc[i][j][r];
        }
    }
  }
}

#define LOAD_COL34(arr, base, t0, Tn) \
  _Pragma("unroll") for (int q_ = 0; q_ < 34; ++q_) { const int t_ = (t0) - 1 + q_; arr[q_] = (t_ >= 0 && t_ < (Tn)) ? (base)[(long)t_ * PC] : (h16)0.f; }

__device__ __forceinline__ void phase_feat(const Params& p, int l, int bid, int nb, char* smem) {
  const int tid = tid_opaque();
  float* in = (float*)smem;
  float* zt = in + 32 * 256;
  for (int item = bid; item < 1088; item += nb) {
    int b, t0, Tn, rowbase; bool isctx;
    if (item < 1024) { b = item >> 7; t0 = (item & 127) * 32; Tn = 4096; rowbase = b * 4096; isctx = false; }
    else { int j = item - 1024; b = j >> 3; t0 = (j & 7) * 32; Tn = 256; rowbase = NLAT + b * 256; isctx = true; }
    {
      const int col = 1152 + tid;
      const float mp = p.mu_prev[l * 1792 + col], mn = p.mu_next[l * 1792 + col];
      const h16* base = p.P + (size_t)rowbase * PC + col;
      h16 xv[34];
      LOAD_COL34(xv, base, t0, Tn)
#pragma unroll
      for (int tt = 0; tt < 32; ++tt) {
        const float prev = (float)xv[tt], cur = (float)xv[tt + 1], nxt = (float)xv[tt + 2];
        float sv = cur + mp * (prev - cur) + mn * (nxt - cur);
        if (tid < 128) { const float e2 = __expf(2.f * sv); sv = 1.f - 2.f / (e2 + 1.f); }
        in[tt * 256 + tid] = sv;
      }
      if (l == 1) {
#pragma unroll
        for (int i = 0; i < 4; ++i) { int id = tid + i * 256; zt[id] = p.Z[(size_t)(rowbase + t0) * 32 + id]; }
      }
    }
    __syncthreads();
#pragma unroll 1
    for (int c = tid; c < 384; c += 256) {
      const int col = 768 + c;
      const float mp = p.mu_prev[l * 1792 + col], mn = p.mu_next[l * 1792 + col];
      const h16* base = p.P + (size_t)rowbase * PC + col;
      h16 xv[34];
      LOAD_COL34(xv, base, t0, Tn)
      h16* dst = p.VB + (size_t)(rowbase + t0) * 384 + c;
      if (l == 0) {
#pragma unroll
        for (int tt = 0; tt < 32; ++tt) {
          const float prev = (float)xv[tt], cur = (float)xv[tt + 1], nxt = (float)xv[tt + 2];
          dst[tt * 384] = (h16)(cur + mp * (prev - cur) + mn * (nxt - cur));
        }
      } else {
        const float vbv = p.vb[c];
#pragma unroll 1
        for (int hf = 0; hf < 2; ++hf) {
          h16 vfv[16]; float ga[16];
#pragma unroll
          for (int tt = 0; tt < 16; ++tt) { vfv[tt] = dst[(hf * 16 + tt) * 384]; ga[tt] = vbv; }
#pragma unroll 1
          for (int m = 0; m < 32; m += 4) {
            const float w0 = p.vw2[m * 384 + c], w1 = p.vw2[(m + 1) * 384 + c], w2 = p.vw2[(m + 2) * 384 + c], w3 = p.vw2[(m + 3) * 384 + c];
#pragma unroll
            for (int tt = 0; tt < 16; ++tt) { const f32x4 z = *(const f32x4*)&zt[(hf * 16 + tt) * 32 + m]; ga[tt] += z[0] * w0 + z[1] * w1 + z[2] * w2 + z[3] * w3; }
          }
#pragma unroll
          for (int tt = 0; tt < 16; ++tt) {
            const float prev = hf ? (float)xv[16 + tt] : (float)xv[tt], cur = hf ? (float)xv[17 + tt] : (float)xv[tt + 1], nxt = hf ? (float)xv[18 + tt] : (float)xv[tt + 2];
            const float sv = cur + mp * (prev - cur) + mn * (nxt - cur);
            dst[(hf * 16 + tt) * 384] = (h16)(sv + ((float)vfv[tt] - sv) * sigmoidf_(ga[tt]));
          }
        }
      }
    }
#pragma unroll 1
    for (int oc = tid; oc < 1536; oc += 256) {
      const int slot = oc / 384, c = oc % 384, dir = slot & 1, kind = slot >> 1;
      const float* wm = (kind == 0 ? p.w2 : p.a2) + (size_t)((l * 2 + dir) * 64) * 384 + c;
      const float bias = (kind == 0 ? p.w0 : p.a0)[(l * 2 + dir) * 384 + c];
      const int io = (kind == 0 ? 0 : 128) + dir * 64;
      float acc[32];
#pragma unroll
      for (int tt = 0; tt < 32; ++tt) acc[tt] = bias;
#pragma unroll 1
      for (int r = 0; r < 64; r += 4) {
        const float w0 = wm[(size_t)r * 384], w1 = wm[(size_t)(r + 1) * 384], w2 = wm[(size_t)(r + 2) * 384], w3 = wm[(size_t)(r + 3) * 384];
#pragma unroll
        for (int tt = 0; tt < 32; ++tt) { f32x4 iv = *(const f32x4*)&in[tt * 256 + io + r]; acc[tt] += iv[0] * w0 + iv[1] * w1 + iv[2] * w2 + iv[3] * w3; }
      }
      const float mul = kind == 0 ? 0.6065306597126334f : 1.f;
#pragma unroll
      for (int tt = 0; tt < 32; ++tt) p.F[(size_t)(rowbase + t0 + tt) * 1536 + slot * 384 + c] = (h16)(mul * sigmoidf_(acc[tt]));
    }
    {
      const int head = tid >> 5, pr = tid & 31, half = pr >> 4, i = pr & 15;
      const int colbase = head < 6 ? 3072 + head * 64 : 3456 + (head - 6) * 64;
      const int d1 = half * 32 + i;
      const float qs = head < 6 ? 0.125f : 1.f;
      h16* pp = p.P + (size_t)(rowbase + t0) * PC + colbase + d1;
#pragma unroll
      for (int tq = 0; tq < 32; tq += 8) {
        h16 x1[8], x2[8];
#pragma unroll
        for (int u = 0; u < 8; ++u) { x1[u] = pp[(size_t)(tq + u) * PC]; x2[u] = pp[(size_t)(tq + u) * PC + 16]; }
#pragma unroll
        for (int u = 0; u < 8; ++u) {
          const int t = t0 + tq + u;
          float cs = 1.f, sn = 0.f;
          if (!isctx) { const int pos = half == 0 ? (t >> 6) : (t & 63); const f32x2 r2 = *(const f32x2*)&p.rope[(pos * 16 + i) * 2]; cs = r2[0]; sn = r2[1]; }
          const float a = (float)x1[u], bq = (float)x2[u];
          pp[(size_t)(tq + u) * PC] = (h16)((a * cs - bq * sn) * qs);
          pp[(size_t)(tq + u) * PC + 16] = (h16)((a * sn + bq * cs) * qs);
        }
      }
    }
    if (tid < 128) {
      const int g = tid >> 6, d = tid & 63;
      const h16* base = p.P + (size_t)(rowbase + t0) * PC + 3584 + tid;
      h16* dst = p.VT + (size_t)((b * 2 + g) * 64 + d) * VTS + (isctx ? 4096 + t0 : t0);
      half8 v[4];
#pragma unroll
      for (int q = 0; q < 4; ++q)
#pragma unroll
        for (int j = 0; j < 8; ++j) v[q][j] = base[(size_t)(q * 8 + j) * PC];
#pragma unroll
      for (int q = 0; q < 4; ++q) *(half8*)(dst + q * 8) = v[q];
    }
    __syncthreads();
  }
}

struct RwkvOps { f32x4 wA, wB, bA, bB, kA, kB, rA, rB; f32x2 vv; };
constexpr int RREC = 352;
__device__ __forceinline__ RwkvOps rwkv_load_ops(const float* op, int step, int kq, int vp) {
  const float* o = op + step * RREC + 8 * kq;
  RwkvOps r;
  r.wA = *(const f32x4*)(o); r.wB = *(const f32x4*)(o + 4);
  r.bA = *(const f32x4*)(o + 128); r.bB = *(const f32x4*)(o + 132);
  r.kA = *(const f32x4*)(o + 192); r.kB = *(const f32x4*)(o + 196);
  r.rA = *(const f32x4*)(o + 256); r.rB = *(const f32x4*)(o + 260);
  r.vv = *(const f32x2*)(op + step * RREC + 320 + 2 * vp);
  return r;
}

__device__ __forceinline__ void rwkv_chain(const Params& p, int l, int item, char* smem) {
  const int tid = tid_opaque(), lane = tid & 63, w = tid >> 6;
  const int chain = item >> 1, vh = item & 1;
  const int dir = chain / 48, b = (chain % 48) / 6, h = chain % 6;
  float* opb = (float*)smem;
  float* ybuf = opb + 2 * 16 * RREC;
  constexpr int NCH = 272;
  if (w < 2) {
    const int vp = tid >> 3, kq = tid & 7;
    f32x2 S0[4], S1[4];
#pragma unroll
    for (int j = 0; j < 4; ++j) { S0[j] = (f32x2){0.f, 0.f}; S1[j] = (f32x2){0.f, 0.f}; }
    __builtin_amdgcn_s_setprio(3);
    __syncthreads();
#pragma unroll 1
    for (int ci = 0; ci < NCH; ++ci) {
      const float* op = opb + (ci & 1) * 16 * RREC;
      float* yb = ybuf + (ci & 1) * 512;
      f32x4 aA = *(const f32x4*)(op + 8 * kq + 64), aB = *(const f32x4*)(op + 8 * kq + 68);
#pragma unroll
      for (int step = 0; step < 16; ++step) {
        const RwkvOps cur = rwkv_load_ops(op, step, kq, vp);
        f32x4 naA = aA, naB = aB;
        if (step + 1 < 16) { naA = *(const f32x4*)(op + (step + 1) * RREC + 8 * kq + 64); naB = *(const f32x4*)(op + (step + 1) * RREC + 8 * kq + 68); }
        const f32x2 w2[4] = {{cur.wA[0], cur.wA[1]}, {cur.wA[2], cur.wA[3]}, {cur.wB[0], cur.wB[1]}, {cur.wB[2], cur.wB[3]}};
        const f32x2 a2[4] = {{aA[0], aA[1]}, {aA[2], aA[3]}, {aB[0], aB[1]}, {aB[2], aB[3]}};
        const f32x2 b2[4] = {{cur.bA[0], cur.bA[1]}, {cur.bA[2], cur.bA[3]}, {cur.bB[0], cur.bB[1]}, {cur.bB[2], cur.bB[3]}};
        const f32x2 k2[4] = {{cur.kA[0], cur.kA[1]}, {cur.kA[2], cur.kA[3]}, {cur.kB[0], cur.kB[1]}, {cur.kB[2], cur.kB[3]}};
        const f32x2 r2[4] = {{cur.rA[0], cur.rA[1]}, {cur.rA[2], cur.rA[3]}, {cur.rB[0], cur.rB[1]}, {cur.rB[2], cur.rB[3]}};
        f32x2 d0 = S0[0] * a2[0], d1 = S1[0] * a2[0];
#pragma unroll
        for (int j = 1; j < 4; ++j) { d0 += S0[j] * a2[j]; d1 += S1[j] * a2[j]; }
        const float sa0 = red8(d0[0] + d0[1]), sa1 = red8(d1[0] + d1[1]);
        const f32x2 sa0v = {sa0, sa0}, sa1v = {sa1, sa1}, v0v = {cur.vv[0], cur.vv[0]}, v1v = {cur.vv[1], cur.vv[1]};
#pragma unroll
        for (int j = 0; j < 4; ++j) {
          S0[j] = S0[j] * w2[j] + sa0v * b2[j] + v0v * k2[j];
          S1[j] = S1[j] * w2[j] + sa1v * b2[j] + v1v * k2[j];
        }
        f32x2 y0 = S0[0] * r2[0], y1 = S1[0] * r2[0];
#pragma unroll
        for (int j = 1; j < 4; ++j) { y0 += S0[j] * r2[j]; y1 += S1[j] * r2[j]; }
        const float yy0 = red8(y0[0] + y0[1]), yy1 = red8(y1[0] + y1[1]);
        if (kq == 0) *(f32x2*)(yb + step * 32 + 2 * vp) = (f32x2){yy0, yy1};
        aA = naA; aB = naB;
      }
      __syncthreads();
    }
    __builtin_amdgcn_s_setprio(0);
  } else {
    const int lw = w - 2, lt = tid - 128;
    const int hc = h * 64 + lane;
    const float mpr = p.mu_prev[l * 1792 + hc], mnr = p.mu_next[l * 1792 + hc];
    const float mpk = p.mu_prev[l * 1792 + 384 + hc], mnk = p.mu_next[l * 1792 + 384 + hc];
    const float kkw = p.k_k[l * 384 + hc], kaw = p.k_a[l * 384 + hc];
    half2v pf[8][5];
#define RWKV_ISSUE(ci_) { const int seg_ = (ci_) >= 16; const int Tn_ = seg_ ? 4096 : 256; const int rb_ = seg_ ? b * 4096 : NLAT + b * 256; const int c0_ = (seg_ ? (ci_) - 16 : (ci_)) * 16; \
    _Pragma("unroll") for (int i = 0; i < 8; ++i) { const int step = lw * 8 + i; const int t = dir == 0 ? c0_ + step : Tn_ - 1 - (c0_ + step); const size_t row = (size_t)rb_ + t; const h16* pr = p.P + row * PC; \
      pf[i][0][0] = t > 0 ? pr[hc - PC] : (h16)0.f; pf[i][0][1] = pr[hc]; pf[i][1][0] = t + 1 < Tn_ ? pr[hc + PC] : (h16)0.f; \
      pf[i][1][1] = t > 0 ? pr[384 + hc - PC] : (h16)0.f; pf[i][2][0] = pr[384 + hc]; pf[i][2][1] = t + 1 < Tn_ ? pr[384 + hc + PC] : (h16)0.f; \
      pf[i][3][0] = p.VB[row * 384 + hc]; pf[i][3][1] = p.F[row * 1536 + dir * 384 + hc]; pf[i][4][0] = p.F[row * 1536 + (2 + dir) * 384 + hc]; pf[i][4][1] = (h16)0.f; } }
#define RWKV_STAGE(ci_) { float* op_ = opb + ((ci_) & 1) * 16 * RREC; \
    _Pragma("unroll") for (int i = 0; i < 8; ++i) { const int step = lw * 8 + i; \
      const float rm = (float)pf[i][0][0], r0 = (float)pf[i][0][1], rp = (float)pf[i][1][0]; \
      const float km = (float)pf[i][1][1], k0 = (float)pf[i][2][0], kp = (float)pf[i][2][1]; \
      const float vv = (float)pf[i][3][0], e = (float)pf[i][3][1], al = (float)pf[i][4][0]; \
      const float rs = r0 + mpr * (rm - r0) + mnr * (rp - r0); \
      const float ks = k0 + mpk * (km - k0) + mnk * (kp - k0); \
      const float kkr = ks * kkw; \
      const float n2 = wave_sum_dpp(kkr * kkr); \
      const float kk = kkr / fmaxf(sqrtf(n2), 1e-12f); \
      float* o = op_ + step * RREC + lane; \
      o[0] = __expf(-e); o[64] = -kk; o[128] = kk * al; o[192] = ks * (1.f + (al - 1.f) * kaw); o[256] = rs; \
      if ((lane >> 5) == vh) op_[step * RREC + 320 + (lane & 31)] = vv; } }
    RWKV_ISSUE(0)
    RWKV_STAGE(0)
    RWKV_ISSUE(1)
    __syncthreads();
#pragma unroll 1
    for (int ci = 0; ci < NCH; ++ci) {
      if (ci + 1 < NCH) { RWKV_STAGE(ci + 1) }
      if (ci + 2 < NCH) { RWKV_ISSUE(ci + 2) }
      if (ci >= 1) {
        const int cj = ci - 1;
        const int seg = cj >= 16; const int Tn = seg ? 4096 : 256; const int rowbase = seg ? b * 4096 : NLAT + b * 256; const int c0 = (seg ? cj - 16 : cj) * 16;
        if (seg == 1 || l == 0) {
          const float* yb = ybuf + (cj & 1) * 512;
#pragma unroll
          for (int i = 0; i < 4; ++i) {
            const int idx = lt + i * 128; const int step = idx >> 5, ch = idx & 31;
            const int t = dir == 0 ? c0 + step : Tn - 1 - (c0 + step);
            if (dir == 0) p.P[(size_t)(rowbase + t) * PC + 768 + h * 64 + 32 * vh + ch] = (h16)yb[idx];
            else p.hy[(size_t)(rowbase + t) * 1024 + h * 64 + 32 * vh + ch] = (h16)yb[idx];
          }
        }
      }
      __syncthreads();
    }
    {
      const int cj = NCH - 1;
      const int Tn = 4096; const int rowbase = b * 4096; const int c0 = (cj - 16) * 16;
      const float* yb = ybuf + (cj & 1) * 512;
#pragma unroll
      for (int i = 0; i < 4; ++i) {
        const int idx = lt + i * 128; const int step = idx >> 5, ch = idx & 31;
        const int t = dir == 0 ? c0 + step : Tn - 1 - (c0 + step);
        if (dir == 0) p.P[(size_t)(rowbase + t) * PC + 768 + h * 64 + 32 * vh + ch] = (h16)yb[idx];
        else p.hy[(size_t)(rowbase + t) * 1024 + h * 64 + 32 * vh + ch] = (h16)yb[idx];
      }
    }
  }
}

struct HgrnOps { f32x4 fA, fB, qA, qB; f32x2 iv; };
__device__ __forceinline__ HgrnOps hgrn_load_ops(const float* op, int step, int kq, int vp) {
  const float* o = op + step * 192 + 8 * kq;
  HgrnOps r;
  r.fA = *(const f32x4*)(o); r.fB = *(const f32x4*)(o + 4);
  r.qA = *(const f32x4*)(o + 64); r.qB = *(const f32x4*)(o + 68);
  r.iv = *(const f32x2*)(op + step * 192 + 128 + 2 * vp);
  return r;
}

__device__ __forceinline__ void hgrn_chain(const Params& p, int l, int chain, char* smem) {
  const int tid = tid_opaque(), lane = tid & 63, w = tid >> 6;
  const int dir = chain / 32, b = (chain % 32) / 4, h = chain % 4;
  float* op = (float*)smem;
  float* ybuf = op + 16 * 192;
  const int hc = h * 64 + lane;
  float lb = 0.f;
  if (l == 1) lb = sigmoidf_(p.lb_logits[(dir * 2 + 1) * 256 + hc] - p.lb_logits[(dir * 2 + 0) * 256 + hc]);
  const int fcol = 1792 + 256 * (1 + dir) + hc;
  const int vp = tid >> 3, kq = tid & 7;
  f32x2 S[8];
#pragma unroll
  for (int j = 0; j < 8; ++j) S[j] = (f32x2){0.f, 0.f};
  __builtin_amdgcn_s_setprio(2);
  h16 pf[4][3];
#define HGRN_ISSUE(ci_) { const int seg_ = (ci_) >= 16; const int Tn_ = seg_ ? 4096 : 256; const int rb_ = seg_ ? b * 4096 : NLAT + b * 256; const int c0_ = (seg_ ? (ci_) - 16 : (ci_)) * 16; \
    _Pragma("unroll") for (int i = 0; i < 4; ++i) { const int step = w * 4 + i; const int t = dir == 0 ? c0_ + step : Tn_ - 1 - (c0_ + step); const h16* pr = p.P + ((size_t)rb_ + t) * PC; \
      pf[i][0] = pr[fcol]; pf[i][1] = pr[1792 + hc]; pf[i][2] = pr[1792 + 768 + hc]; } }
  HGRN_ISSUE(0)
#pragma unroll 1
  for (int ci = 0; ci < 272; ++ci) {
    const int seg = ci >= 16; const int Tn = seg ? 4096 : 256; const int rowbase = seg ? b * 4096 : NLAT + b * 256; const int c0 = (seg ? ci - 16 : ci) * 16;
    const bool wout = seg == 1 || l == 0;
#pragma unroll
    for (int i = 0; i < 4; ++i) {
      const int step = w * 4 + i;
      float* o = op + step * 192 + lane;
      o[0] = lb + (1.f - lb) * sigmoidf_((float)pf[i][0]); o[64] = (float)pf[i][1]; o[128] = (float)pf[i][2];
    }
    __syncthreads();
    if (ci + 1 < 272) HGRN_ISSUE(ci + 1)
    HgrnOps cur = hgrn_load_ops(op, 0, kq, vp);
#pragma unroll
    for (int step = 0; step < 16; ++step) {
      HgrnOps nxt;
      if (step + 1 < 16) nxt = hgrn_load_ops(op, step + 1, kq, vp);
      const float f[8] = {cur.fA[0], cur.fA[1], cur.fA[2], cur.fA[3], cur.fB[0], cur.fB[1], cur.fB[2], cur.fB[3]};
      const float q[8] = {cur.qA[0], cur.qA[1], cur.qA[2], cur.qA[3], cur.qB[0], cur.qB[1], cur.qB[2], cur.qB[3]};
      f32x2 acc = {0.f, 0.f};
#pragma unroll
      for (int j = 0; j < 8; ++j) {
        const f32x2 fv = {f[j], f[j]}, gv = {1.f - f[j], 1.f - f[j]}, qv = {q[j], q[j]};
        S[j] = S[j] * fv + gv * cur.iv;
        acc += S[j] * qv;
      }
      const float o0 = red8(acc[0]), o1 = red8(acc[1]);
      if (kq == 0) *(f32x2*)(ybuf + step * 64 + 2 * vp) = (f32x2){o0, o1};
      if (step + 1 < 16) cur = nxt;
    }
    __syncthreads();
    if (wout) {
#pragma unroll
      for (int i = 0; i < 4; ++i) {
        const int idx = tid + i * 256; const int step = idx >> 6, ch = idx & 63;
        const int t = dir == 0 ? c0 + step : Tn - 1 - (c0 + step);
        if (dir == 0) p.P[(size_t)(rowbase + t) * PC + 1152 + h * 64 + ch] = (h16)ybuf[idx];
        else p.hy[(size_t)(rowbase + t) * 1024 + 384 + h * 64 + ch] = (h16)ybuf[idx];
      }
    }
  }
  __builtin_amdgcn_s_setprio(0);
}

__device__ __forceinline__ void attn_unit(const Params& p, int l, int u) {
  const int tid = tid_opaque(), lane = tid & 63, w = tid >> 6, lq = lane & 31, hh = lane >> 5;
  int b, head, qrow_base, qpos0; bool isctx;
  if (u < 1536) { b = u / 192; int rem = u % 192; int blk = rem / 6; head = rem % 6; qpos0 = blk * 128 + w * 32; qrow_base = b * 4096; isctx = false; }
  else { int j = u - 1536; b = j / 12; int rem = j % 12; int qb = rem / 6; head = rem % 6; qpos0 = qb * 128 + w * 32; qrow_base = NLAT + b * 256; isctx = true; }
  const int g = head / 3;
  const size_t qrow = (size_t)qrow_base + qpos0 + lq;
  half8 qf[4];
#pragma unroll
  for (int s = 0; s < 4; ++s) qf[s] = *(const half8*)(p.P + qrow * PC + 3072 + head * 64 + 16 * s + 8 * hh);
  const float sinkv = p.sink[l * 6 + head];
  float m = sinkv, lsum = hh == 0 ? 1.f : 0.f;
  f32x16 O[2];
#pragma unroll
  for (int r = 0; r < 16; ++r) { O[0][r] = 0.f; O[1][r] = 0.f; }
  const h16* vt = p.VT + (size_t)((b * 2 + g) * 64) * VTS;
  int nband = 0, kstart = 0;
  if (!isctx) { kstart = max(0, qpos0 - 128); const int kend = min(4096, qpos0 + 160); nband = (kend - kstart) >> 5; }
  const int ntiles = nband + 8;
  for (int ti = 0; ti < ntiles; ++ti) {
    const bool band = ti < nband;
    const int kt = band ? kstart + ti * 32 : (ti - nband) * 32;
    const size_t krow = band ? (size_t)b * 4096 + kt + lq : (size_t)NLAT + b * 256 + kt + lq;
    const int vidx = band ? kt : 4096 + kt;
    const h16* kp = p.P + krow * PC + 3456 + g * 64 + 8 * hh;
    f32x16 sacc;
#pragma unroll
    for (int r = 0; r < 16; ++r) sacc[r] = 0.f;
#pragma unroll
    for (int s = 0; s < 4; ++s) { half8 kf = *(const half8*)(kp + 16 * s); sacc = __builtin_amdgcn_mfma_f32_32x32x16_f16(kf, qf[s], sacc, 0, 0, 0); }
    float mx = -INFINITY;
#pragma unroll
    for (int r = 0; r < 16; ++r) {
      float sv = sacc[r];
      if (band) { const int dlt = kt + (r & 3) + 8 * (r >> 2) + 4 * hh - (qpos0 + lq); if (dlt > 128 || dlt < -128) sv = -INFINITY; }
      sacc[r] = sv; mx = fmaxf(mx, sv);
    }
    mx = fmaxf(mx, __shfl_xor(mx, 32));
    const float mn = fmaxf(m, mx); const float corr = __expf(m - mn); m = mn;
    float ps = 0.f; half8 pb[2];
#pragma unroll
    for (int r = 0; r < 16; ++r) { const float pv = __expf(sacc[r] - mn); ps += pv; pb[r >> 3][r & 7] = (h16)pv; }
    lsum = lsum * corr + ps;
#pragma unroll
    for (int r = 0; r < 16; ++r) { O[0][r] *= corr; O[1][r] *= corr; }
#pragma unroll
    for (int s2 = 0; s2 < 2; ++s2)
#pragma unroll
      for (int dt = 0; dt < 2; ++dt) {
        const h16* vp = vt + (size_t)(dt * 32 + lq) * VTS + vidx + 16 * s2 + 4 * hh;
        const half4 lo = *(const half4*)vp, hi = *(const half4*)(vp + 8);
        const half8 vf = {lo[0], lo[1], lo[2], lo[3], hi[0], hi[1], hi[2], hi[3]};
        O[dt] = __builtin_amdgcn_mfma_f32_32x32x16_f16(vf, pb[s2], O[dt], 0, 0, 0);
      }
  }
  lsum += __shfl_xor(lsum, 32);
  const float inv = 1.f / lsum;
#pragma unroll
  for (int dt = 0; dt < 2; ++dt)
#pragma unroll
    for (int g4 = 0; g4 < 4; ++g4) {
      const int d0 = dt * 32 + 8 * g4 + 4 * hh;
      const half4 ga = *(const half4*)(p.P + qrow * PC + 3712 + head * 64 + d0);
      half4 o;
#pragma unroll
      for (int j = 0; j < 4; ++j) { const float gv = (float)ga[j]; o[j] = (h16)(O[dt][g4 * 4 + j] * inv * siluf_(gv)); }
      *(half4*)(p.hy + qrow * 1024 + 640 + head * 64 + d0) = o;
    }
}

__device__ __forceinline__ void phase_mix(const Params& p, int l, int bid, int nb, char* smem) {
  const int nunits = l == 0 ? 1536 + 96 : 1536;
  if (nb >= 512) {
    if (bid < 192) rwkv_chain(p, l, bid, smem);
    else if (bid < 256) hgrn_chain(p, l, bid - 192, smem);
    else for (int u = bid - 256; u < nunits; u += nb - 256) attn_unit(p, l, u);
  } else {
    for (int it = bid; it < 256 + nunits; it += nb) {
      if (it < 192) rwkv_chain(p, l, it, smem);
      else if (it < 256) hgrn_chain(p, l, it - 192, smem);
      else attn_unit(p, l, it - 256);
      __syncthreads();
    }
  }
}

__device__ __forceinline__ void phase_readout(const Params& p, int l, int bid, int nb) {
  const int tid = tid_opaque(), lane = tid & 63, w = tid >> 6;
  const int nrows = l == 1 ? NLAT : NTOK;
  for (int row = bid * 4 + w; row < nrows; row += nb * 4) {
    int t, Tn;
    if (row < NLAT) { t = row & 4095; Tn = 4096; } else { t = (row - NLAT) & 255; Tn = 256; }
    const h16* pr = p.P + (size_t)row * PC;
    const h16* fr = p.F + (size_t)row * 1536;
    h16* yo = p.hy + (size_t)row * 1024;
    const bool hp = t > 0, hn = t + 1 < Tn;
#pragma unroll
    for (int h = 0; h < 6; ++h) {
      const int c = h * 64 + lane;
      const float y = (float)pr[768 + c] + (float)yo[c];
      const float mean = wave_sum_dpp(y) * (1.f / 64.f);
      const float yc = y - mean;
      const float var = wave_sum_dpp(yc * yc) * (1.f / 64.f);
      const float yn = yc * rsqrtf(var + 64e-5f) * p.gn_w[l * 384 + c] + p.gn_b[l * 384 + c];
      float sh[3];
#pragma unroll
      for (int q = 0; q < 3; ++q) {
        const int col = (q == 0 ? 0 : (q == 1 ? 384 : 1408)) + c;
        const float mp = p.mu_prev[l * 1792 + col], mn = p.mu_next[l * 1792 + col];
        const float cur = (float)pr[col];
        const float prv = hp ? (float)pr[col - PC] : 0.f, nxt = hn ? (float)pr[col + PC] : 0.f;
        sh[q] = cur + mp * (prv - cur) + mn * (nxt - cur);
      }
      const float v = (float)p.VB[(size_t)row * 384 + c];
      const float bonus = wave_sum_dpp(sh[0] * sh[1] * p.r_k[l * 384 + c]) * v;
      yo[c] = (h16)((yn + bonus) * siluf_(sh[2]));
    }
#pragma unroll
    for (int h = 0; h < 4; ++h) {
      const int c = h * 64 + lane;
      const float o = (float)pr[1152 + c] + (float)yo[384 + c];
      const float ms = wave_sum_dpp(o * o) * (1.f / 64.f);
      const float on = o * rsqrtf(ms + 1e-6f);
      yo[384 + c] = (h16)(on * p.hg_norm_w[l * 256 + c] * siluf_((float)pr[2816 + c]));
    }
  }
}

__device__ __forceinline__ void phase_final(const Params& p, int bid, int nb) {
  const int tid = tid_opaque(), lane = tid & 63, w = tid >> 6;
  for (int row = bid * 4 + w; row < NLAT; row += nb * 4) {
    float* src = p.out + (size_t)row * 1024;
    f32x4 v[4]; float ss = 0.f;
#pragma unroll
    for (int i = 0; i < 4; ++i) { v[i] = *(const f32x4*)(src + i * 256 + lane * 4); ss += v[i][0] * v[i][0] + v[i][1] * v[i][1] + v[i][2] * v[i][2] + v[i][3] * v[i][3]; }
    ss = wave_sum_dpp(ss);
    const float rs = rsqrtf(ss * (1.f / 1024.f) + 1e-6f);
#pragma unroll
    for (int i = 0; i < 4; ++i) {
      const int col = i * 256 + lane * 4;
      const f32x4 nwv = *(const f32x4*)(p.final_w + col);
      f32x4 o;
#pragma unroll
      for (int j = 0; j < 4; ++j) o[j] = v[i][j] * rs * nwv[j];
      *(f32x4*)(src + col) = o;
    }
  }
}

__global__ void __launch_bounds__(256, 3) mega(Params p, int ph_lo, int ph_hi, int coop) {
  __shared__ __attribute__((aligned(16))) char smem[SMEM_BYTES];
  __shared__ uint4 xb_words;
  XcdBarrier xb; xb.bar = p.bar; xb.x = 0; xb.st = (volatile LAS unsigned*)&xb_words;
  if (coop) { if (threadIdx.x == 0) xb_words = make_uint4(0u, 0u, 0u, 0u); __syncthreads(); xb = xcd_barrier_post(p.bar, (volatile LAS unsigned*)&xb_words); }
  if (coop) for (int i = 0; i < EXTRA_SYNCS; ++i) { xcd_barrier(xb); }
  if (coop == 2) cg::this_grid().sync();
  for (int ph = ph_lo; ph < ph_hi; ++ph) {
    for (int rep = 0; rep < (((PROBE_MASK >> ph) & 1) ? 2 : 1); ++rep) {
      int bid = blockIdx.x, nb = gridDim.x;
      asm volatile("" : "+s"(bid), "+s"(nb));
      if (ph == 0) phase_prep(p, bid, nb, smem);
      else if (ph == 13) phase_final(p, bid, nb);
      else {
        const int l = (ph - 1) / 6, s = (ph - 1) % 6;
        if (s == 0) phase_norm(p, l, bid, nb);
        else if (s == 1) phase_gemm<0>(p, l, bid, nb, smem);
        else if (s == 2) phase_feat(p, l, bid, nb, smem);
        else if (s == 3) phase_mix(p, l, bid, nb, smem);
        else if (s == 4) phase_readout(p, l, bid, nb);
        else phase_gemm<1>(p, l, bid, nb, smem);
      }
      if (PROBE_MASK && rep == 0 && ((PROBE_MASK >> ph) & 1)) { xcd_barrier(xb); }
    }
    if (coop && ph + 1 < ph_hi) { xcd_barrier(xb); }
  }
}

extern "C" void kernel_launch(void* const* d_in, const int* in_sizes, int n_in, void* d_out, int out_size, void* d_ws, size_t ws_size, hipStream_t stream) {
  static int grid_blocks = 0;
  if (!grid_blocks) {
    int dev = 0, cus = 0, per_cu = 0;
    hipGetDevice(&dev);
    hipDeviceGetAttribute(&cus, hipDeviceAttributeMultiprocessorCount, dev);
    hipOccupancyMaxActiveBlocksPerMultiprocessor(&per_cu, mega, 256, 0);
    if (per_cu < 1) per_cu = 1;
    grid_blocks = cus * per_cu;
  }
  Params p{};
  const float* const* in = (const float* const*)d_in;
  p.x = in[0]; p.c = in[1]; p.ctx = in[2]; p.c_ctx = in[3]; p.mod_w = in[4]; p.mod_b = in[5]; p.norm_w = in[6]; p.w_in = in[7]; p.w_out = in[8];
  p.mu_prev = in[9]; p.mu_next = in[10]; p.w0 = in[11]; p.w2 = in[12]; p.a0 = in[13]; p.a2 = in[14]; p.k_k = in[15]; p.k_a = in[16]; p.r_k = in[17];
  p.gn_w = in[18]; p.gn_b = in[19]; p.vw1 = in[20]; p.vw2 = in[21]; p.vb = in[22]; p.lb_logits = in[23]; p.hg_norm_w = in[24]; p.sink = in[25]; p.final_w = in[26];
  p.out = (float*)d_out;
  char* ws = (char*)d_ws; size_t off = 0;
  auto take = [&](size_t bytes) { char* r = ws + off; off += (bytes + 255) & ~(size_t)255; return r; };
  p.win_t = (h16*)take((size_t)2 * NPAD * 1024 * 2);
  p.wout_t = (h16*)take((size_t)2 * 1024 * 1024 * 2);
  p.mod = (float*)take((size_t)2 * 9 * 3072 * 4);
  p.rope = (float*)take((size_t)64 * 16 * 2 * 4);
  p.hy = (h16*)take((size_t)NTOK * 1024 * 2);
  p.P = (h16*)take((size_t)NTOK * PC * 2);
  p.F = (h16*)take((size_t)NTOK * 1536 * 2);
  p.VB = (h16*)take((size_t)NTOK * 384 * 2);
  p.Z = (float*)take((size_t)NTOK * 32 * 4);
  p.VT = (h16*)take((size_t)16 * 64 * VTS * 2);
  p.xc1 = (float*)take((size_t)2048 * 1024 * 4);
  p.bar = (unsigned*)take(16384);
  if (off > ws_size) fprintf(stderr, "workspace too small: need %zu have %zu\n", off, ws_size);
#if SINGLE_LAUNCH
  hipMemsetAsync(p.bar, 0, 16384, stream);
  int lo = 0, hi = 14, coop = 1;
  void* args[] = {&p, &lo, &hi, &coop};
  hipError_t e = hipLaunchCooperativeKernel((void*)mega, dim3(grid_blocks), dim3(256), args, 0, stream);
  if (e != hipSuccess) fprintf(stderr, "cooperative launch failed: %s (grid %d)\n", hipGetErrorString(e), grid_blocks);
#else
  for (int ph = 0; ph < 14; ++ph) mega<<<grid_blocks, 256, 0, stream>>>(p, ph, ph + 1, 0);
#endif
}
```

```cpp
#include <hip/hip_runtime.h>
#include <hip/hip_cooperative_groups.h>
#include <cstdio>
#include <cstdint>
namespace cg = cooperative_groups;

typedef _Float16 h16;
typedef _Float16 half8 __attribute__((ext_vector_type(8)));
typedef _Float16 half4 __attribute__((ext_vector_type(4)));
typedef float f32x16 __attribute__((ext_vector_type(16)));
typedef float f32x4 __attribute__((ext_vector_type(4)));
typedef float f32x2 __attribute__((ext_vector_type(2)));
typedef unsigned u32x4 __attribute__((ext_vector_type(4)));
typedef _Float16 half2v __attribute__((ext_vector_type(2)));

constexpr int NLAT = 32768, NTOK = 34816;
constexpr int PC = 4160;
constexpr int NPAD = 4224;
constexpr int VTS = 4352;
constexpr int SMEM_BYTES = 49152;

#ifndef EXTRA_SYNCS
#define EXTRA_SYNCS 0
#endif
#ifndef PROBE_SUB
#define PROBE_SUB 7
#endif
#ifndef PROBE_MASK
#define PROBE_MASK 0
#endif
#ifndef SINGLE_LAUNCH
#define SINGLE_LAUNCH 1
#endif

struct Params {
  const float *x, *c, *ctx, *c_ctx, *mod_w, *mod_b, *norm_w, *w_in, *w_out;
  const float *mu_prev, *mu_next, *w0, *w2, *a0, *a2, *k_k, *k_a, *r_k, *gn_w, *gn_b;
  const float *vw1, *vw2, *vb, *lb_logits, *hg_norm_w, *sink, *final_w;
  float* out;
  h16 *win_t, *wout_t;
  float* mod;
  h16 *hy, *P, *F, *VB;
  h16* VT;
  float* xc1;
  float* rope;
  unsigned* bar;
};

__device__ __forceinline__ int tid_opaque() { int t = threadIdx.x; asm volatile("" : "+v"(t)); return t; }
__device__ __forceinline__ float wave_sum(float v) {
#pragma unroll
  for (int o = 32; o > 0; o >>= 1) v += __shfl_xor(v, o);
  return v;
}
__device__ __forceinline__ float sigmoidf_(float x) { return 1.f / (1.f + __expf(-x)); }
__device__ __forceinline__ float siluf_(float x) { return x / (1.f + __expf(-x)); }
template <int CTRL> __device__ __forceinline__ float dpp_mov(float x) {
  return __int_as_float(__builtin_amdgcn_update_dpp(0, __float_as_int(x), CTRL, 0xf, 0xf, true));
}
__device__ __forceinline__ float wave_sum_dpp(float x) {
  x += dpp_mov<0xB1>(x);
  x += dpp_mov<0x4E>(x);
  x += dpp_mov<0x141>(x);
  x += dpp_mov<0x140>(x);
  const int xi = __float_as_int(x);
  return __int_as_float(__builtin_amdgcn_readlane(xi, 0)) + __int_as_float(__builtin_amdgcn_readlane(xi, 16)) +
         __int_as_float(__builtin_amdgcn_readlane(xi, 32)) + __int_as_float(__builtin_amdgcn_readlane(xi, 48));
}
__device__ __forceinline__ float red8(float x) {
  x += dpp_mov<0xB1>(x);
  x += dpp_mov<0x4E>(x);
  x += dpp_mov<0x141>(x);
  return x;
}

#define XB_TMO      128
#define XB_XCNT(j)  (256  + 64 * (j))
#define XB_XSUB(j)  (1280 + 64 * (j))
#define XB_XGEN(j)  (2304 + 64 * (j))
#define XB_TOP      3328
#define XB_TOPGEN   3392
#define XCD_BAR_WORDS 3456
#define XB_SPIN_CAP (1u << 18)
#define LAS __attribute__((address_space(3)))
__device__ __forceinline__ unsigned xb_ld(unsigned* p)              { return __hip_atomic_load(p, __ATOMIC_RELAXED, __HIP_MEMORY_SCOPE_AGENT); }
__device__ __forceinline__ unsigned xb_add(unsigned* p, unsigned v) { return __hip_atomic_fetch_add(p, v, __ATOMIC_RELAXED, __HIP_MEMORY_SCOPE_AGENT); }
__device__ __forceinline__ unsigned xb_xcc_id() { return (unsigned)__builtin_amdgcn_s_getreg((3 << 11) | 20) & 0xFu; }
#define XB_SPIN(cond, bar) do { unsigned _sp = 0; while (cond) { __builtin_amdgcn_s_sleep(1); \
    if ((++_sp & 255u) == 0u) { if (xb_ld(&(bar)[XB_TMO])) break; if (_sp > XB_SPIN_CAP) { atomicAdd(&(bar)[XB_TMO], 1u); break; } } } } while (0)
struct XcdBarrier { unsigned* bar; unsigned x; volatile LAS unsigned* st; };
__device__ __forceinline__ XcdBarrier xcd_barrier_post(unsigned* bar, volatile LAS unsigned* st) {
  XcdBarrier b; b.bar = bar; b.x = xb_xcc_id(); b.st = st;
  if (threadIdx.x == 0) (void)xb_add(&bar[XB_XCNT(b.x)], 1u);
  return b;
}
__device__ __forceinline__ void xcd_barrier_complete(unsigned* bar, unsigned x, unsigned& nloc, unsigned& nx) {
  const unsigned G = gridDim.x * gridDim.y * gridDim.z;
  unsigned sum, cnt, mine, sp = 0u;
  for (;;) {
    sum = 0u; cnt = 0u; mine = 0u;
#pragma unroll
    for (unsigned j = 0; j < 16; ++j) { const unsigned c = xb_ld(&bar[XB_XCNT(j)]); sum += c; cnt += (c > 0u) ? 1u : 0u; mine = (j == x) ? c : mine; }
    if (sum == G) break;
    __builtin_amdgcn_s_sleep(1);
    if ((++sp & 255u) == 0u) { if (xb_ld(&bar[XB_TMO])) break; if (sp > XB_SPIN_CAP) { atomicAdd(&bar[XB_TMO], 1u); break; } }
  }
  nloc = mine > 0u ? mine : 1u; nx = cnt > 0u ? cnt : 1u;
}
__device__ __forceinline__ void xcd_barrier(const XcdBarrier& b) {
  asm volatile("s_waitcnt vmcnt(0)" ::: "memory");
  __syncthreads();
  if (threadIdx.x == 0) {
    unsigned* bar = b.bar;
    __builtin_amdgcn_s_waitcnt(0);
    unsigned nloc = b.st[0], nx = b.st[1];
    if (nloc == 0u) { xcd_barrier_complete(bar, b.x, nloc, nx); b.st[0] = nloc; b.st[1] = nx; }
    const unsigned old = xb_add(&bar[XB_XSUB(b.x)], 1u);
    const unsigned gen = old / nloc;
    if (old + 1u == (gen + 1u) * nloc) {
      __builtin_amdgcn_fence(__ATOMIC_RELEASE, "agent");
      asm volatile("s_waitcnt vmcnt(0)" ::: "memory");
      const unsigned og = xb_add(&bar[XB_TOP], 1u);
      const unsigned tg = og / nx;
      if (og + 1u == (tg + 1u) * nx) xb_add(&bar[XB_TOPGEN], 1u);
      else XB_SPIN(xb_ld(&bar[XB_TOPGEN]) == tg, bar);
      __builtin_amdgcn_fence(__ATOMIC_ACQUIRE, "agent");
      xb_add(&bar[XB_XGEN(b.x)], 1u);
      asm volatile("s_waitcnt vmcnt(0)" ::: "memory");
    } else {
      XB_SPIN(xb_ld(&bar[XB_XGEN(b.x)]) == gen, bar);
      __builtin_amdgcn_fence(__ATOMIC_ACQUIRE, "agent");
      asm volatile("s_waitcnt vmcnt(0)" ::: "memory");
    }
  }
  __syncthreads();
}

__device__ __forceinline__ void phase_prep(const Params& p, int bid, int nb, char* smem) {
  const int tid = tid_opaque();
  float* sf = (float*)smem;
  constexpr int N_WIN = 2048, N_WOUT = 512, N_MOD = 192, N_PADI = 1024;
  constexpr int total = N_WIN + N_WOUT + N_MOD + N_PADI + 1;
  for (int it = bid; it < total; it += nb) {
    if (it < N_WIN + N_WOUT) {
      const float* src; h16* dst; int ncols, kt, ntile;
      if (it < N_WIN) { int l = it >> 10, r = it & 1023; kt = r >> 6; ntile = r & 63; src = p.w_in + (size_t)l * 1024 * 4096; dst = p.win_t + (size_t)l * NPAD * 1024; ncols = 4096; }
      else { int j = it - N_WIN; int l = j >> 8, r = j & 255; kt = r >> 4; ntile = r & 15; src = p.w_out + (size_t)l * 1024 * 1024; dst = p.wout_t + (size_t)l * 1024 * 1024; ncols = 1024; }
      for (int i = tid; i < 4096; i += 256) { int kk = i >> 6, nn = i & 63; sf[kk * 65 + nn] = src[(size_t)(kt * 64 + kk) * ncols + ntile * 64 + nn]; }
      __syncthreads();
      for (int i = tid; i < 4096; i += 256) { int nn = i >> 6, kk = i & 63; dst[(size_t)(ntile * 64 + nn) * 1024 + kt * 64 + kk] = (h16)sf[kk * 65 + nn]; }
      __syncthreads();
    } else if (it < N_WIN + N_WOUT + N_MOD) {
      const int j = it - N_WIN - N_WOUT; const int l = j / 96; const int cl = tid & 31, ks = tid >> 5; const int col = (j % 96) * 32 + cl;
      for (int i = tid; i < 9 * 1024; i += 256) { int r = i >> 10, k = i & 1023; float v = r < 8 ? p.c[r * 1024 + k] : p.c_ctx[k]; sf[i] = siluf_(v); }
      __syncthreads();
      float acc[9];
#pragma unroll
      for (int r = 0; r < 9; ++r) acc[r] = 0.f;
      const float* mw = p.mod_w + (size_t)l * 1024 * 3072 + (size_t)(ks * 128) * 3072 + col;
#pragma unroll 2
      for (int k = 0; k < 128; k += 4) {
        const float w0 = mw[(size_t)k * 3072], w1 = mw[(size_t)(k + 1) * 3072], w2 = mw[(size_t)(k + 2) * 3072], w3 = mw[(size_t)(k + 3) * 3072];
#pragma unroll
        for (int r = 0; r < 9; ++r) { const f32x4 sv = *(const f32x4*)&sf[r * 1024 + ks * 128 + k]; acc[r] += sv[0] * w0 + sv[1] * w1 + sv[2] * w2 + sv[3] * w3; }
      }
#pragma unroll
      for (int r = 0; r < 9; ++r) acc[r] += __shfl_xor(acc[r], 32);
      __syncthreads();
      if ((tid & 63) < 32) {
#pragma unroll
        for (int r = 0; r < 9; ++r) sf[((tid >> 6) * 9 + r) * 32 + cl] = acc[r];
      }
      __syncthreads();
      for (int i = tid; i < 288; i += 256) {
        const int r = i >> 5, c2 = i & 31;
        const float v = sf[(0 * 9 + r) * 32 + c2] + sf[(1 * 9 + r) * 32 + c2] + sf[(2 * 9 + r) * 32 + c2] + sf[(3 * 9 + r) * 32 + c2];
        const int cc = (j % 96) * 32 + c2;
        p.mod[(size_t)(l * 9 + r) * 3072 + cc] = v + p.mod_b[l * 3072 + cc];
      }
      __syncthreads();
    } else if (it < N_WIN + N_WOUT + N_MOD + N_PADI) {
      int j = it - (N_WIN + N_WOUT + N_MOD); int idx = j * 256 + tid;
      int l = idx >> 17; int rem = idx & 131071; int m = rem >> 10, k = rem & 1023;
      float v = (l == 1 && m < 32) ? p.vw1[k * 32 + m] : 0.f;
      p.win_t[(size_t)l * NPAD * 1024 + (size_t)(4096 + m) * 1024 + k] = (h16)v;
    } else {
      if (tid < 16) {
        double inv = 1.0; for (int i = 0; i < tid; ++i) inv *= 0.5623413251903491;
        double x2 = inv * inv, ts = inv, tc = 1.0, s1 = inv, c1 = 1.0;
        for (int n = 1; n <= 10; ++n) { tc *= -x2 / ((2.0 * n - 1.0) * (2.0 * n)); c1 += tc; ts *= -x2 / ((2.0 * n) * (2.0 * n + 1.0)); s1 += ts; }
        double cc = 1.0, ss = 0.0;
        for (int pos = 0; pos < 64; ++pos) {
          p.rope[(pos * 16 + tid) * 2] = (float)cc; p.rope[(pos * 16 + tid) * 2 + 1] = (float)ss;
          double nc = cc * c1 - ss * s1, ns = ss * c1 + cc * s1; cc = nc; ss = ns;
        }
      }
    }
  }
}

__device__ __forceinline__ void phase_norm(const Params& p, int l, int bid, int nb) {
  const int tid = tid_opaque(), lane = tid & 63, w = tid >> 6;
  for (int row = bid * 4 + w; row < NTOK; row += nb * 4) {
    const float* src = (l == 0) ? (row < NLAT ? p.x + (size_t)row * 1024 : p.ctx + (size_t)(row - NLAT) * 1024)
                                : (row < NLAT ? p.out + (size_t)row * 1024 : p.xc1 + (size_t)(row - NLAT) * 1024);
    const int mr = row < NLAT ? (row >> 12) : 8;
    const float* md = p.mod + (size_t)(l * 9 + mr) * 3072;
    const float* nw = p.norm_w + l * 1024;
    f32x4 v[4]; float ss = 0.f;
#pragma unroll
    for (int i = 0; i < 4; ++i) { v[i] = *(const f32x4*)(src + i * 256 + lane * 4); ss += v[i][0] * v[i][0] + v[i][1] * v[i][1] + v[i][2] * v[i][2] + v[i][3] * v[i][3]; }
    ss = wave_sum_dpp(ss);
    const float rs = rsqrtf(ss * (1.f / 1024.f) + 1e-6f);
#pragma unroll
    for (int i = 0; i < 4; ++i) {
      const int col = i * 256 + lane * 4;
      f32x4 nwv = *(const f32x4*)(nw + col), sc = *(const f32x4*)(md + 1024 + col), sh = *(const f32x4*)(md + col);
      half4 o;
#pragma unroll
      for (int j = 0; j < 4; ++j) o[j] = (h16)(v[i][j] * rs * nwv[j] * (1.f + sc[j]) + sh[j]);
      *(half4*)(p.hy + (size_t)row * 1024 + col) = o;
    }
  }
}

template <int MODE>
__device__ __forceinline__ void phase_gemm(const Params& p, int l, int bid, int nb, char* smem) {
  const h16* A = p.hy;
  const h16* Bt = MODE == 0 ? p.win_t + (size_t)l * NPAD * 1024 : p.wout_t + (size_t)l * 1024 * 1024;
  const int ntn = MODE == 0 ? (l == 1 ? 33 : 32) : 8;
  const int ntm = (MODE == 1 && l == 1) ? 256 : 272;
  const int tid = tid_opaque(), lane = tid & 63, w = tid >> 6, wr = w >> 1, wc = w & 1, lq = lane & 31, hh = lane >> 5;
  h16* As = (h16*)smem; h16* Bs = As + 128 * 72;
  const int ldrow = tid >> 3, ldch = (tid & 7) * 8;
  for (int tile = bid; tile < ntm * ntn; tile += nb) {
    const int tm = tile / ntn, tn = tile % ntn;
    const h16* Ag = A + (size_t)(tm * 128 + ldrow) * 1024 + ldch; const h16* Bg = Bt + (size_t)(tn * 128 + ldrow) * 1024 + ldch;
    f32x16 acc[2][2];
#pragma unroll
    for (int i = 0; i < 2; ++i)
#pragma unroll
      for (int j = 0; j < 2; ++j)
#pragma unroll
        for (int r = 0; r < 16; ++r) acc[i][j][r] = 0.f;
    u32x4 ra[4], rb[4];
#pragma unroll
    for (int i = 0; i < 4; ++i) { ra[i] = *(const u32x4*)(Ag + (size_t)i * 32 * 1024); rb[i] = *(const u32x4*)(Bg + (size_t)i * 32 * 1024); }
#pragma unroll 1
    for (int kt = 0; kt < 16; ++kt) {
      __syncthreads();
#pragma unroll
      for (int i = 0; i < 4; ++i) { *(u32x4*)(As + (ldrow + i * 32) * 72 + ldch) = ra[i]; *(u32x4*)(Bs + (ldrow + i * 32) * 72 + ldch) = rb[i]; }
      __syncthreads();
      if (kt + 1 < 16) {
#pragma unroll
        for (int i = 0; i < 4; ++i) { ra[i] = *(const u32x4*)(Ag + (size_t)i * 32 * 1024 + (kt + 1) * 64); rb[i] = *(const u32x4*)(Bg + (size_t)i * 32 * 1024 + (kt + 1) * 64); }
      }
#pragma unroll
      for (int s = 0; s < 4; ++s) {
        half8 a[2], b[2];
#pragma unroll
        for (int i = 0; i < 2; ++i) { a[i] = *(const half8*)(As + (64 * wr + 32 * i + lq) * 72 + 16 * s + 8 * hh); b[i] = *(const half8*)(Bs + (64 * wc + 32 * i + lq) * 72 + 16 * s + 8 * hh); }
#pragma unroll
        for (int i = 0; i < 2; ++i)
#pragma unroll
          for (int j = 0; j < 2; ++j) {
            if (MODE == 0) acc[i][j] = __builtin_amdgcn_mfma_f32_32x32x16_f16(b[j], a[i], acc[i][j], 0, 0, 0);
            else acc[i][j] = __builtin_amdgcn_mfma_f32_32x32x16_f16(a[i], b[j], acc[i][j], 0, 0, 0);
          }
      }
    }
    if (MODE == 0) {
      if (tn < 32) {
        __syncthreads();
        h16* Cs = (h16*)smem;
#pragma unroll
        for (int i = 0; i < 2; ++i)
#pragma unroll
          for (int j = 0; j < 2; ++j)
#pragma unroll
            for (int g = 0; g < 4; ++g) {
              half4 o;
#pragma unroll
              for (int q = 0; q < 4; ++q) o[q] = (h16)acc[i][j][4 * g + q];
              *(half4*)(Cs + (64 * wr + 32 * i + lq) * 136 + 64 * wc + 32 * j + 8 * g + 4 * hh) = o;
            }
        __syncthreads();
#pragma unroll
        for (int q = 0; q < 8; ++q) {
          const int id = tid + q * 256; const int row = id >> 4, ch = id & 15;
          *(u32x4*)(p.P + (size_t)(tm * 128 + row) * PC + tn * 128 + ch * 8) = *(const u32x4*)(Cs + row * 136 + ch * 8);
        }
      } else if (wc == 0) {
#pragma unroll
        for (int i = 0; i < 2; ++i)
#pragma unroll
          for (int r = 0; r < 16; ++r) ((float*)(p.F + (size_t)(tm * 128 + 64 * wr + 32 * i + lq) * 1536))[(r & 3) + 8 * (r >> 2) + 4 * hh] = acc[i][0][r];
      }
    } else {
#pragma unroll
      for (int i = 0; i < 2; ++i)
#pragma unroll
        for (int r = 0; r < 16; ++r) {
          const int row = tm * 128 + 64 * wr + 32 * i + (r & 3) + 8 * (r >> 2) + 4 * hh;
          const int mr = row < NLAT ? (row >> 12) : 8;
          const float* gp = p.mod + (size_t)(l * 9 + mr) * 3072 + 2048 + tn * 128 + 64 * wc + lq;
          const float* xo; float* dst;
          if (l == 0) { if (row < NLAT) { xo = p.x + (size_t)row * 1024; dst = p.out + (size_t)row * 1024; } else { xo = p.ctx + (size_t)(row - NLAT) * 1024; dst = p.xc1 + (size_t)(row - NLAT) * 1024; } }
          else { xo = p.out + (size_t)row * 1024; dst = p.out + (size_t)row * 1024; }
          const int col = tn * 128 + 64 * wc + lq;
#pragma unroll
          for (int j = 0; j < 2; ++j) dst[col + 32 * j] = xo[col + 32 * j] + gp[32 * j] * acc[i][j][r];
        }
    }
  }
}

#define LOAD_COL34(arr, base, t0, Tn) \
  _Pragma("unroll") for (int q_ = 0; q_ < 34; ++q_) { const int t_ = (t0) - 1 + q_; arr[q_] = (t_ >= 0 && t_ < (Tn)) ? (base)[(long)t_ * PC] : (h16)0.f; }

__device__ __forceinline__ void phase_feat(const Params& p, int l, int bid, int nb, char* smem) {
  const int tid = tid_opaque();
  float* in = (float*)smem;
  float* zt = in + 32 * 256;
  for (int item = bid; item < 1088; item += nb) {
    int b, t0, Tn, rowbase; bool isctx;
    if (item < 1024) { b = item >> 7; t0 = (item & 127) * 32; Tn = 4096; rowbase = b * 4096; isctx = false; }
    else { int j = item - 1024; b = j >> 3; t0 = (j & 7) * 32; Tn = 256; rowbase = NLAT + b * 256; isctx = true; }
    {
      const int col = 1152 + tid;
      const float mp = p.mu_prev[l * 1792 + col], mn = p.mu_next[l * 1792 + col];
      const h16* base = p.P + (size_t)rowbase * PC + col;
      h16 xv[34];
      LOAD_COL34(xv, base, t0, Tn)
#pragma unroll
      for (int tt = 0; tt < 32; ++tt) {
        const float prev = (float)xv[tt], cur = (float)xv[tt + 1], nxt = (float)xv[tt + 2];
        float sv = cur + mp * (prev - cur) + mn * (nxt - cur);
        if (tid < 128) { const float e2 = __expf(2.f * sv); sv = 1.f - 2.f / (e2 + 1.f); }
        in[tt * 256 + tid] = sv;
      }
      if (l == 1) {
#pragma unroll
        for (int i = 0; i < 4; ++i) { int id = tid + i * 256; zt[id] = ((const float*)(p.F + (size_t)(rowbase + t0 + (id >> 5)) * 1536))[id & 31]; }
      }
    }
    __syncthreads();
#pragma unroll 1
    for (int c = tid; c < 384; c += 256) {
      const int col = 768 + c;
      const float mp = p.mu_prev[l * 1792 + col], mn = p.mu_next[l * 1792 + col];
      const h16* base = p.P + (size_t)rowbase * PC + col;
      h16 xv[34];
      LOAD_COL34(xv, base, t0, Tn)
      h16* dst = p.VB + (size_t)(rowbase + t0) * 384 + c;
      if (l == 0) {
#pragma unroll
        for (int tt = 0; tt < 32; ++tt) {
          const float prev = (float)xv[tt], cur = (float)xv[tt + 1], nxt = (float)xv[tt + 2];
          dst[tt * 384] = (h16)(cur + mp * (prev - cur) + mn * (nxt - cur));
        }
      } else {
        const float vbv = p.vb[c];
#pragma unroll 1
        for (int hf = 0; hf < 2; ++hf) {
          h16 vfv[16]; float ga[16];
#pragma unroll
          for (int tt = 0; tt < 16; ++tt) { vfv[tt] = dst[(hf * 16 + tt) * 384]; ga[tt] = vbv; }
#pragma unroll 1
          for (int m = 0; m < 32; m += 4) {
            const float w0 = p.vw2[m * 384 + c], w1 = p.vw2[(m + 1) * 384 + c], w2 = p.vw2[(m + 2) * 384 + c], w3 = p.vw2[(m + 3) * 384 + c];
#pragma unroll
            for (int tt = 0; tt < 16; ++tt) { const f32x4 z = *(const f32x4*)&zt[(hf * 16 + tt) * 32 + m]; ga[tt] += z[0] * w0 + z[1] * w1 + z[2] * w2 + z[3] * w3; }
          }
#pragma unroll
          for (int tt = 0; tt < 16; ++tt) {
            const float prev = hf ? (float)xv[16 + tt] : (float)xv[tt], cur = hf ? (float)xv[17 + tt] : (float)xv[tt + 1], nxt = hf ? (float)xv[18 + tt] : (float)xv[tt + 2];
            const float sv = cur + mp * (prev - cur) + mn * (nxt - cur);
            dst[(hf * 16 + tt) * 384] = (h16)(sv + ((float)vfv[tt] - sv) * sigmoidf_(ga[tt]));
          }
        }
      }
    }
#pragma unroll 1
    for (int oc = tid; oc < 1536; oc += 256) {
      const int slot = oc / 384, c = oc % 384, dir = slot & 1, kind = slot >> 1;
      const float* wm = (kind == 0 ? p.w2 : p.a2) + (size_t)((l * 2 + dir) * 64) * 384 + c;
      const float bias = (kind == 0 ? p.w0 : p.a0)[(l * 2 + dir) * 384 + c];
      const int io = (kind == 0 ? 0 : 128) + dir * 64;
      float acc[32];
#pragma unroll
      for (int tt = 0; tt < 32; ++tt) acc[tt] = bias;
#pragma unroll 1
      for (int r = 0; r < 64; r += 4) {
        const float w0 = wm[(size_t)r * 384], w1 = wm[(size_t)(r + 1) * 384], w2 = wm[(size_t)(r + 2) * 384], w3 = wm[(size_t)(r + 3) * 384];
#pragma unroll
        for (int tt = 0; tt < 32; ++tt) { f32x4 iv = *(const f32x4*)&in[tt * 256 + io + r]; acc[tt] += iv[0] * w0 + iv[1] * w1 + iv[2] * w2 + iv[3] * w3; }
      }
      const float mul = kind == 0 ? 0.6065306597126334f : 1.f;
#pragma unroll
      for (int tt = 0; tt < 32; ++tt) p.F[(size_t)(rowbase + t0 + tt) * 1536 + slot * 384 + c] = (h16)(mul * sigmoidf_(acc[tt]));
    }
    {
      const int head = tid >> 5, pr = tid & 31, half = pr >> 4, i = pr & 15;
      const int colbase = head < 6 ? 3072 + head * 64 : 3456 + (head - 6) * 64;
      const int d1 = half * 32 + i;
      const float qs = head < 6 ? 0.125f : 1.f;
      h16* pp = p.P + (size_t)(rowbase + t0) * PC + colbase + d1;
#pragma unroll
      for (int tq = 0; tq < 32; tq += 8) {
        h16 x1[8], x2[8];
#pragma unroll
        for (int u = 0; u < 8; ++u) { x1[u] = pp[(size_t)(tq + u) * PC]; x2[u] = pp[(size_t)(tq + u) * PC + 16]; }
#pragma unroll
        for (int u = 0; u < 8; ++u) {
          const int t = t0 + tq + u;
          float cs = 1.f, sn = 0.f;
          if (!isctx) { const int pos = half == 0 ? (t >> 6) : (t & 63); const f32x2 r2 = *(const f32x2*)&p.rope[(pos * 16 + i) * 2]; cs = r2[0]; sn = r2[1]; }
          const float a = (float)x1[u], bq = (float)x2[u];
          pp[(size_t)(tq + u) * PC] = (h16)((a * cs - bq * sn) * qs);
          pp[(size_t)(tq + u) * PC + 16] = (h16)((a * sn + bq * cs) * qs);
        }
      }
    }
    if (tid < 128) {
      const int g = tid >> 6, d = tid & 63;
      const h16* base = p.P + (size_t)(rowbase + t0) * PC + 3584 + tid;
      h16* dst = p.VT + (size_t)((b * 2 + g) * 64 + d) * VTS + (isctx ? 4096 + t0 : t0);
      half8 v[4];
#pragma unroll
      for (int q = 0; q < 4; ++q)
#pragma unroll
        for (int j = 0; j < 8; ++j) v[q][j] = base[(size_t)(q * 8 + j) * PC];
#pragma unroll
      for (int q = 0; q < 4; ++q) *(half8*)(dst + q * 8) = v[q];
    }
    __syncthreads();
  }
}

__device__ __forceinline__ float red16(float x) {
  x += dpp_mov<0xB1>(x);
  x += dpp_mov<0x4E>(x);
  x += dpp_mov<0x141>(x);
  x += dpp_mov<0x140>(x);
  return x;
}
#define LDS_BARRIER() do { asm volatile("s_waitcnt lgkmcnt(0)" ::: "memory"); __builtin_amdgcn_s_barrier(); asm volatile("" ::: "memory"); } while (0)
constexpr int RREC = 336;
struct RwkvPf { h16 rr[10], kr[10], v[8], e[8], al[8]; };

__device__ __forceinline__ void rwkv_chain(const Params& p, int l, int item, char* smem) {
  const int tid = tid_opaque(), lane = tid & 63, w = tid >> 6;
  const int chain = item >> 2, vq = item & 3;
  const int dir = chain / 48, b = (chain % 48) / 6, h = chain % 6;
  float* opb = (float*)smem;
  float* ybuf = opb + 2 * 16 * RREC;
  constexpr int NCH = 272;
  if (w < 2) {
    const int rl = tid >> 3, kq = tid & 7;
    float S[8];
#pragma unroll
    for (int j = 0; j < 8; ++j) S[j] = 0.f;
    __builtin_amdgcn_s_setprio(3);
    LDS_BARRIER();
#pragma unroll 1
    for (int ci = 0; ci < NCH; ++ci) {
      const float* op = opb + (ci & 1) * 16 * RREC;
      float* yb = ybuf + (ci & 1) * 256;
      f32x4 aA = *(const f32x4*)(op + 8 * kq + 64), aB = *(const f32x4*)(op + 8 * kq + 68);
#pragma unroll
      for (int step = 0; step < 16; ++step) {
        const float* o = op + step * RREC + 8 * kq;
        const f32x4 wA = *(const f32x4*)(o), wB = *(const f32x4*)(o + 4);
        const f32x4 bA = *(const f32x4*)(o + 128), bB = *(const f32x4*)(o + 132);
        const f32x4 kA = *(const f32x4*)(o + 192), kB = *(const f32x4*)(o + 196);
        const f32x4 rA = *(const f32x4*)(o + 256), rB = *(const f32x4*)(o + 260);
        const float vv = op[step * RREC + 320 + rl];
        f32x4 naA = aA, naB = aB;
        if (step + 1 < 16) { naA = *(const f32x4*)(o + RREC + 64); naB = *(const f32x4*)(o + RREC + 68); }
        const float d0 = S[0] * aA[0] + S[1] * aA[1] + S[2] * aA[2] + S[3] * aA[3];
        const float d1 = S[4] * aB[0] + S[5] * aB[1] + S[6] * aB[2] + S[7] * aB[3];
        const float sa = red8(d0 + d1);
#pragma unroll
        for (int j = 0; j < 4; ++j) {
          S[j] = S[j] * wA[j] + sa * bA[j] + vv * kA[j];
          S[4 + j] = S[4 + j] * wB[j] + sa * bB[j] + vv * kB[j];
        }
        const float y0 = S[0] * rA[0] + S[1] * rA[1] + S[2] * rA[2] + S[3] * rA[3];
        const float y1 = S[4] * rB[0] + S[5] * rB[1] + S[6] * rB[2] + S[7] * rB[3];
        const float yy = red8(y0 + y1);
        if (kq == 0) yb[step * 16 + rl] = yy;
        aA = naA; aB = naB;
      }
      LDS_BARRIER();
    }
    __builtin_amdgcn_s_setprio(0);
  } else {
    const int lw = w - 2, lt = tid - 128;
    const int hc = h * 64 + lane;
    const float mpr = p.mu_prev[l * 1792 + hc], mnr = p.mu_next[l * 1792 + hc];
    const float mpk = p.mu_prev[l * 1792 + 384 + hc], mnk = p.mu_next[l * 1792 + 384 + hc];
    const float kkw = p.k_k[l * 384 + hc], kaw = p.k_a[l * 384 + hc];
    RwkvPf pfA, pfB;
#define RWKV_ISSUE(ci_, PF) { const int seg_ = (ci_) >= 16; const int Tn_ = seg_ ? 4096 : 256; const int rb_ = seg_ ? b * 4096 : NLAT + b * 256; const int s0_ = (seg_ ? (ci_) - 16 : (ci_)) * 16 + 8 * lw; \
    _Pragma("unroll") for (int q = 0; q < 10; ++q) { int t_ = dir == 0 ? s0_ - 1 + q : Tn_ - s0_ - q; t_ = t_ < 0 ? 0 : (t_ >= Tn_ ? Tn_ - 1 : t_); const h16* pr = p.P + (size_t)(rb_ + t_) * PC + hc; \
      PF.rr[q] = pr[0]; PF.kr[q] = pr[384]; } \
    _Pragma("unroll") for (int i = 0; i < 8; ++i) { const int t_ = dir == 0 ? s0_ + i : Tn_ - 1 - (s0_ + i); const size_t row = (size_t)rb_ + t_; \
      PF.v[i] = p.VB[row * 384 + hc]; PF.e[i] = p.F[row * 1536 + dir * 384 + hc]; PF.al[i] = p.F[row * 1536 + (2 + dir) * 384 + hc]; } }
#define RWKV_STAGE(ci_, PF) { float* op_ = opb + ((ci_) & 1) * 16 * RREC; \
    const int seg = (ci_) >= 16; const int Tn = seg ? 4096 : 256; const int c0 = (seg ? (ci_) - 16 : (ci_)) * 16; \
    _Pragma("unroll") for (int i = 0; i < 8; ++i) { \
      const int step = lw * 8 + i; const int t = dir == 0 ? c0 + step : Tn - 1 - (c0 + step); \
      const float rlo = (float)PF.rr[i], r0 = (float)PF.rr[i + 1], rhi = (float)PF.rr[i + 2]; \
      const float klo = (float)PF.kr[i], k0 = (float)PF.kr[i + 1], khi = (float)PF.kr[i + 2]; \
      const float rm = t > 0 ? (dir ? rhi : rlo) : 0.f, rp = t + 1 < Tn ? (dir ? rlo : rhi) : 0.f; \
      const float km = t > 0 ? (dir ? khi : klo) : 0.f, kp = t + 1 < Tn ? (dir ? klo : khi) : 0.f; \
      const float vv = (float)PF.v[i], e = (float)PF.e[i], al = (float)PF.al[i]; \
      const float rs = r0 + mpr * (rm - r0) + mnr * (rp - r0); \
      const float ks = k0 + mpk * (km - k0) + mnk * (kp - k0); \
      const float kkr = ks * kkw; \
      const float n2 = wave_sum_dpp(kkr * kkr); \
      const float kk = kkr / fmaxf(sqrtf(n2), 1e-12f); \
      float* o = op_ + step * RREC + lane; \
      o[0] = __expf(-e); o[64] = -kk; o[128] = kk * al; o[192] = ks * (1.f + (al - 1.f) * kaw); o[256] = rs; \
      if ((lane >> 4) == vq) op_[step * RREC + 320 + (lane & 15)] = vv; } }
#define RWKV_WRITE(cj_) { const int seg = (cj_) >= 16; const int Tn = seg ? 4096 : 256; const int rowbase = seg ? b * 4096 : NLAT + b * 256; const int c0 = (seg ? (cj_) - 16 : (cj_)) * 16; \
    if (seg == 1 || l == 0) { const float* yb = ybuf + ((cj_) & 1) * 256; \
      _Pragma("unroll") for (int i = 0; i < 2; ++i) { const int idx = lt + i * 128; const int step = idx >> 4, ch = idx & 15; \
        const int t = dir == 0 ? c0 + step : Tn - 1 - (c0 + step); \
        const h16 yv = (h16)yb[idx]; \
        if (dir == 0) p.P[(size_t)(rowbase + t) * PC + 768 + h * 64 + 16 * vq + ch] = yv; \
        else p.hy[(size_t)(rowbase + t) * 1024 + h * 64 + 16 * vq + ch] = yv; } } }
    RWKV_ISSUE(0, pfA)
    RWKV_STAGE(0, pfA)
    RWKV_ISSUE(1, pfB)
    RWKV_ISSUE(2, pfA)
    LDS_BARRIER();
#pragma unroll 1
    for (int ci = 0; ci < NCH; ci += 2) {
      if (ci + 1 < NCH) RWKV_STAGE(ci + 1, pfB)
      if (ci + 3 < NCH) RWKV_ISSUE(ci + 3, pfB)
      if (ci >= 1) RWKV_WRITE(ci - 1)
      LDS_BARRIER();
      if (ci + 2 < NCH) RWKV_STAGE(ci + 2, pfA)
      if (ci + 4 < NCH) RWKV_ISSUE(ci + 4, pfA)
      RWKV_WRITE(ci)
      LDS_BARRIER();
    }
    RWKV_WRITE(NCH - 1)
  }
}

constexpr int HREC = 224;
struct HgrnPf { h16 f[4], q[4], iv[4]; };
__device__ __forceinline__ void hgrn_chain(const Params& p, int l, int item, char* smem) {
  const int tid = tid_opaque(), lane = tid & 63, w = tid >> 6;
  const int chain = item >> 1, vh = item & 1;
  const int dir = chain / 32, b = (chain % 32) / 4, h = chain % 4;
  float* op = (float*)smem;
  float* ybuf = op + 16 * HREC;
  const int hc = h * 64 + lane;
  float lb = 0.f;
  if (l == 1) lb = sigmoidf_(p.lb_logits[(dir * 2 + 1) * 256 + hc] - p.lb_logits[(dir * 2 + 0) * 256 + hc]);
  const int fcol = 1792 + 256 * (1 + dir) + hc;
  const int vc = tid >> 3, kq = tid & 7;
  float S[8];
#pragma unroll
  for (int j = 0; j < 8; ++j) S[j] = 0.f;
  HgrnPf pfA, pfB;
#define HGRN_ISSUE(ci_, PF) { const int seg_ = (ci_) >= 16; const int Tn_ = seg_ ? 4096 : 256; const int rb_ = seg_ ? b * 4096 : NLAT + b * 256; const int c0_ = (seg_ ? (ci_) - 16 : (ci_)) * 16; \
    _Pragma("unroll") for (int i = 0; i < 4; ++i) { const int step = w * 4 + i; const int t = dir == 0 ? c0_ + step : Tn_ - 1 - (c0_ + step); const h16* pr = p.P + ((size_t)rb_ + t) * PC; \
      PF.f[i] = pr[fcol]; PF.q[i] = pr[1792 + hc]; PF.iv[i] = pr[1792 + 768 + hc]; } }
#define HGRN_CHUNK(ci_, PF) { \
    const int seg = (ci_) >= 16; const int Tn = seg ? 4096 : 256; const int rowbase = seg ? b * 4096 : NLAT + b * 256; const int c0 = (seg ? (ci_) - 16 : (ci_)) * 16; \
    _Pragma("unroll") for (int i = 0; i < 4; ++i) { \
      const int step = w * 4 + i; \
      float* o = op + step * HREC + lane; \
      const float f = lb + (1.f - lb) * sigmoidf_((float)PF.f[i]); \
      o[0] = f; o[64] = 1.f - f; o[128] = (float)PF.q[i]; \
      if ((lane >> 5) == vh) op[step * HREC + 192 + (lane & 31)] = (float)PF.iv[i]; } \
    LDS_BARRIER(); \
    if ((ci_) + 2 < 272) HGRN_ISSUE((ci_) + 2, PF) \
    _Pragma("unroll") for (int step = 0; step < 16; ++step) { \
      const float* o = op + step * HREC + 8 * kq; \
      const f32x4 fA = *(const f32x4*)(o), fB = *(const f32x4*)(o + 4); \
      const f32x4 gA = *(const f32x4*)(o + 64), gB = *(const f32x4*)(o + 68); \
      const f32x4 qA = *(const f32x4*)(o + 128), qB = *(const f32x4*)(o + 132); \
      const float iv = op[step * HREC + 192 + vc]; \
      const float f[8] = {fA[0], fA[1], fA[2], fA[3], fB[0], fB[1], fB[2], fB[3]}; \
      const float g[8] = {gA[0], gA[1], gA[2], gA[3], gB[0], gB[1], gB[2], gB[3]}; \
      const float q[8] = {qA[0], qA[1], qA[2], qA[3], qB[0], qB[1], qB[2], qB[3]}; \
      float acc = 0.f; \
      _Pragma("unroll") for (int j = 0; j < 8; ++j) { S[j] = S[j] * f[j] + g[j] * iv; acc += S[j] * q[j]; } \
      ybuf[step * 256 + tid] = acc; } \
    LDS_BARRIER(); \
    if (seg == 1 || l == 0) { \
      _Pragma("unroll") for (int i = 0; i < 2; ++i) { \
        const int idx = tid + i * 256; const int step = idx >> 5, ch = idx & 31; \
        const int t = dir == 0 ? c0 + step : Tn - 1 - (c0 + step); \
        const float* yb = ybuf + step * 256 + ch * 8; \
        const f32x4 y0 = *(const f32x4*)(yb), y1 = *(const f32x4*)(yb + 4); \
        const f32x4 ys = y0 + y1; \
        const h16 ov = (h16)((ys[0] + ys[1]) + (ys[2] + ys[3])); \
        if (dir == 0) p.P[(size_t)(rowbase + t) * PC + 1152 + h * 64 + 32 * vh + ch] = ov; \
        else p.hy[(size_t)(rowbase + t) * 1024 + 384 + h * 64 + 32 * vh + ch] = ov; } } }
  HGRN_ISSUE(0, pfA)
  HGRN_ISSUE(1, pfB)
  __builtin_amdgcn_s_setprio(2);
#pragma unroll 1
  for (int ci = 0; ci < 272; ci += 2) {
    HGRN_CHUNK(ci, pfA)
    HGRN_CHUNK(ci + 1, pfB)
  }
  __builtin_amdgcn_s_setprio(0);
}

__device__ __forceinline__ void attn_unit(const Params& p, int l, int u) {
  const int tid = tid_opaque(), lane = tid & 63, w = tid >> 6, lq = lane & 31, hh = lane >> 5;
  int b, head, qrow_base, qpos0; bool isctx;
  if (u < 1536) { b = u / 192; int rem = u % 192; int blk = rem / 6; head = rem % 6; qpos0 = blk * 128 + w * 32; qrow_base = b * 4096; isctx = false; }
  else { int j = u - 1536; b = j / 12; int rem = j % 12; int qb = rem / 6; head = rem % 6; qpos0 = qb * 128 + w * 32; qrow_base = NLAT + b * 256; isctx = true; }
  const int g = head / 3;
  const size_t qrow = (size_t)qrow_base + qpos0 + lq;
  half8 qf[4];
#pragma unroll
  for (int s = 0; s < 4; ++s) qf[s] = *(const half8*)(p.P + qrow * PC + 3072 + head * 64 + 16 * s + 8 * hh);
  const float sinkv = p.sink[l * 6 + head];
  float m = sinkv, lsum = hh == 0 ? 1.f : 0.f;
  f32x16 O[2];
#pragma unroll
  for (int r = 0; r < 16; ++r) { O[0][r] = 0.f; O[1][r] = 0.f; }
  const h16* vt = p.VT + (size_t)((b * 2 + g) * 64) * VTS;
  int nband = 0, kstart = 0;
  if (!isctx) { kstart = max(0, qpos0 - 128); const int kend = min(4096, qpos0 + 160); nband = (kend - kstart) >> 5; }
  const int ntiles = nband + 8;
  for (int ti = 0; ti < ntiles; ++ti) {
    const bool band = ti < nband;
    const int kt = band ? kstart + ti * 32 : (ti - nband) * 32;
    const size_t krow = band ? (size_t)b * 4096 + kt + lq : (size_t)NLAT + b * 256 + kt + lq;
    const int vidx = band ? kt : 4096 + kt;
    const h16* kp = p.P + krow * PC + 3456 + g * 64 + 8 * hh;
    f32x16 sacc;
#pragma unroll
    for (int r = 0; r < 16; ++r) sacc[r] = 0.f;
#pragma unroll
    for (int s = 0; s < 4; ++s) { half8 kf = *(const half8*)(kp + 16 * s); sacc = __builtin_amdgcn_mfma_f32_32x32x16_f16(kf, qf[s], sacc, 0, 0, 0); }
    float mx = -INFINITY;
#pragma unroll
    for (int r = 0; r < 16; ++r) {
      float sv = sacc[r];
      if (band) { const int dlt = kt + (r & 3) + 8 * (r >> 2) + 4 * hh - (qpos0 + lq); if (dlt > 128 || dlt < -128) sv = -INFINITY; }
      sacc[r] = sv; mx = fmaxf(mx, sv);
    }
    mx = fmaxf(mx, __shfl_xor(mx, 32));
    const float mn = fmaxf(m, mx); const float corr = __expf(m - mn); m = mn;
    float ps = 0.f; half8 pb[2];
#pragma unroll
    for (int r = 0; r < 16; ++r) { const float pv = __expf(sacc[r] - mn); ps += pv; pb[r >> 3][r & 7] = (h16)pv; }
    lsum = lsum * corr + ps;
#pragma unroll
    for (int r = 0; r < 16; ++r) { O[0][r] *= corr; O[1][r] *= corr; }
#pragma unroll
    for (int s2 = 0; s2 < 2; ++s2)
#pragma unroll
      for (int dt = 0; dt < 2; ++dt) {
        const h16* vp = vt + (size_t)(dt * 32 + lq) * VTS + vidx + 16 * s2 + 4 * hh;
        const half4 lo = *(const half4*)vp, hi = *(const half4*)(vp + 8);
        const half8 vf = {lo[0], lo[1], lo[2], lo[3], hi[0], hi[1], hi[2], hi[3]};
        O[dt] = __builtin_amdgcn_mfma_f32_32x32x16_f16(vf, pb[s2], O[dt], 0, 0, 0);
      }
  }
  lsum += __shfl_xor(lsum, 32);
  const float inv = 1.f / lsum;
#pragma unroll
  for (int dt = 0; dt < 2; ++dt)
#pragma unroll
    for (int g4 = 0; g4 < 4; ++g4) {
      const int d0 = dt * 32 + 8 * g4 + 4 * hh;
      const half4 ga = *(const half4*)(p.P + qrow * PC + 3712 + head * 64 + d0);
      half4 o;
#pragma unroll
      for (int j = 0; j < 4; ++j) { const float gv = (float)ga[j]; o[j] = (h16)(O[dt][g4 * 4 + j] * inv * siluf_(gv)); }
      *(half4*)(p.hy + qrow * 1024 + 640 + head * 64 + d0) = o;
    }
}

__device__ __forceinline__ void phase_mix(const Params& p, int l, int bid, int nb, char* smem, int sub) {
  const int nunits = l == 0 ? 1536 + 96 : 1536;
  if (nb >= 640) {
    if (bid < 384) { if (sub & 1) rwkv_chain(p, l, bid, smem); }
    else if (bid < 512) { if (sub & 2) hgrn_chain(p, l, bid - 384, smem); }
    else if (sub & 4) for (int u = bid - 512; u < nunits; u += nb - 512) attn_unit(p, l, u);
  } else {
    for (int it = bid; it < 512 + nunits; it += nb) {
      if (it < 384) rwkv_chain(p, l, it, smem);
      else if (it < 512) hgrn_chain(p, l, it - 384, smem);
      else attn_unit(p, l, it - 512);
      __syncthreads();
    }
  }
}

__device__ __forceinline__ void phase_readout(const Params& p, int l, int bid, int nb) {
  const int tid = tid_opaque(), lane = tid & 63, w = tid >> 6;
  const int nrows = l == 1 ? NLAT : NTOK;
  for (int row = bid * 4 + w; row < nrows; row += nb * 4) {
    int t, Tn;
    if (row < NLAT) { t = row & 4095; Tn = 4096; } else { t = (row - NLAT) & 255; Tn = 256; }
    const h16* pr = p.P + (size_t)row * PC;
    const h16* fr = p.F + (size_t)row * 1536;
    h16* yo = p.hy + (size_t)row * 1024;
    const bool hp = t > 0, hn = t + 1 < Tn;
#pragma unroll
    for (int h = 0; h < 6; ++h) {
      const int c = h * 64 + lane;
      const float y = (float)pr[768 + c] + (float)yo[c];
      const float mean = wave_sum_dpp(y) * (1.f / 64.f);
      const float yc = y - mean;
      const float var = wave_sum_dpp(yc * yc) * (1.f / 64.f);
      const float yn = yc * rsqrtf(var + 64e-5f) * p.gn_w[l * 384 + c] + p.gn_b[l * 384 + c];
      float sh[3];
#pragma unroll
      for (int q = 0; q < 3; ++q) {
        const int col = (q == 0 ? 0 : (q == 1 ? 384 : 1408)) + c;
        const float mp = p.mu_prev[l * 1792 + col], mn = p.mu_next[l * 1792 + col];
        const float cur = (float)pr[col];
        const float prv = hp ? (float)pr[col - PC] : 0.f, nxt = hn ? (float)pr[col + PC] : 0.f;
        sh[q] = cur + mp * (prv - cur) + mn * (nxt - cur);
      }
      const float v = (float)p.VB[(size_t)row * 384 + c];
      const float bonus = wave_sum_dpp(sh[0] * sh[1] * p.r_k[l * 384 + c]) * v;
      yo[c] = (h16)((yn + bonus) * siluf_(sh[2]));
    }
#pragma unroll
    for (int h = 0; h < 4; ++h) {
      const int c = h * 64 + lane;
      const float o = (float)pr[1152 + c] + (float)yo[384 + c];
      const float ms = wave_sum_dpp(o * o) * (1.f / 64.f);
      const float on = o * rsqrtf(ms + 1e-6f);
      yo[384 + c] = (h16)(on * p.hg_norm_w[l * 256 + c] * siluf_((float)pr[2816 + c]));
    }
  }
}

__device__ __forceinline__ void phase_final(const Params& p, int bid, int nb) {
  const int tid = tid_opaque(), lane = tid & 63, w = tid >> 6;
  for (int row = bid * 4 + w; row < NLAT; row += nb * 4) {
    float* src = p.out + (size_t)row * 1024;
    f32x4 v[4]; float ss = 0.f;
#pragma unroll
    for (int i = 0; i < 4; ++i) { v[i] = *(const f32x4*)(src + i * 256 + lane * 4); ss += v[i][0] * v[i][0] + v[i][1] * v[i][1] + v[i][2] * v[i][2] + v[i][3] * v[i][3]; }
    ss = wave_sum_dpp(ss);
    const float rs = rsqrtf(ss * (1.f / 1024.f) + 1e-6f);
#pragma unroll
    for (int i = 0; i < 4; ++i) {
      const int col = i * 256 + lane * 4;
      const f32x4 nwv = *(const f32x4*)(p.final_w + col);
      f32x4 o;
#pragma unroll
      for (int j = 0; j < 4; ++j) o[j] = v[i][j] * rs * nwv[j];
      *(f32x4*)(src + col) = o;
    }
  }
}

__global__ void __launch_bounds__(256, 3) __attribute__((target("no-packed-fp32-ops"))) mega(Params p, int ph_lo, int ph_hi, int coop) {
  __shared__ __attribute__((aligned(16))) char smem[SMEM_BYTES];
  __shared__ uint4 xb_words;
  XcdBarrier xb; xb.bar = p.bar; xb.x = 0; xb.st = (volatile LAS unsigned*)&xb_words;
  if (coop) { if (threadIdx.x == 0) xb_words = make_uint4(0u, 0u, 0u, 0u); __syncthreads(); xb = xcd_barrier_post(p.bar, (volatile LAS unsigned*)&xb_words); }
  if (coop) for (int i = 0; i < EXTRA_SYNCS; ++i) { xcd_barrier(xb); }
  if (coop == 2) cg::this_grid().sync();
  for (int ph = ph_lo; ph < ph_hi; ++ph) {
    for (int rep = 0; rep < (((PROBE_MASK >> ph) & 1) ? 2 : 1); ++rep) {
      int bid = blockIdx.x, nb = gridDim.x;
      asm volatile("" : "+s"(bid), "+s"(nb));
      if (ph == 0) phase_prep(p, bid, nb, smem);
      else if (ph == 13) phase_final(p, bid, nb);
      else {
        const int l = (ph - 1) / 6, s = (ph - 1) % 6;
        if (s == 0) phase_norm(p, l, bid, nb);
        else if (s == 1) phase_gemm<0>(p, l, bid, nb, smem);
        else if (s == 2) phase_feat(p, l, bid, nb, smem);
        else if (s == 3) phase_mix(p, l, bid, nb, smem, rep ? PROBE_SUB : 7);
        else if (s == 4) phase_readout(p, l, bid, nb);
        else phase_gemm<1>(p, l, bid, nb, smem);
      }
      if (PROBE_MASK && rep == 0 && ((PROBE_MASK >> ph) & 1)) { xcd_barrier(xb); }
    }
    if (coop && ph + 1 < ph_hi) { xcd_barrier(xb); }
  }
}

extern "C" void kernel_launch(void* const* d_in, const int* in_sizes, int n_in, void* d_out, int out_size, void* d_ws, size_t ws_size, hipStream_t stream) {
  static int grid_blocks = 0;
  if (!grid_blocks) {
    int dev = 0, cus = 0, per_cu = 0;
    hipGetDevice(&dev);
    hipDeviceGetAttribute(&cus, hipDeviceAttributeMultiprocessorCount, dev);
    hipOccupancyMaxActiveBlocksPerMultiprocessor(&per_cu, mega, 256, 0);
    if (per_cu < 1) per_cu = 1;
    grid_blocks = cus * per_cu;
  }
  Params p{};
  const float* const* in = (const float* const*)d_in;
  p.x = in[0]; p.c = in[1]; p.ctx = in[2]; p.c_ctx = in[3]; p.mod_w = in[4]; p.mod_b = in[5]; p.norm_w = in[6]; p.w_in = in[7]; p.w_out = in[8];
  p.mu_prev = in[9]; p.mu_next = in[10]; p.w0 = in[11]; p.w2 = in[12]; p.a0 = in[13]; p.a2 = in[14]; p.k_k = in[15]; p.k_a = in[16]; p.r_k = in[17];
  p.gn_w = in[18]; p.gn_b = in[19]; p.vw1 = in[20]; p.vw2 = in[21]; p.vb = in[22]; p.lb_logits = in[23]; p.hg_norm_w = in[24]; p.sink = in[25]; p.final_w = in[26];
  p.out = (float*)d_out;
  char* ws = (char*)d_ws; size_t off = 0;
  auto take = [&](size_t bytes) { char* r = ws + off; off += (bytes + 255) & ~(size_t)255; return r; };
  p.win_t = (h16*)take((size_t)2 * NPAD * 1024 * 2);
  p.wout_t = (h16*)take((size_t)2 * 1024 * 1024 * 2);
  p.mod = (float*)take((size_t)2 * 9 * 3072 * 4);
  p.rope = (float*)take((size_t)64 * 16 * 2 * 4);
  p.hy = (h16*)take((size_t)NTOK * 1024 * 2);
  p.P = (h16*)take((size_t)NTOK * PC * 2);
  p.F = (h16*)take((size_t)NTOK * 1536 * 2);
  p.VB = (h16*)take((size_t)NTOK * 384 * 2);
  p.VT = (h16*)take((size_t)16 * 64 * VTS * 2);
  p.xc1 = (float*)take((size_t)2048 * 1024 * 4);
  p.bar = (unsigned*)take(16384);
  if (off > ws_size) fprintf(stderr, "workspace too small: need %zu have %zu\n", off, ws_size);
#if SINGLE_LAUNCH
  hipMemsetAsync(p.bar, 0, 16384, stream);
  int lo = 0, hi = 14, coop = 1;
  void* args[] = {&p, &lo, &hi, &coop};
  hipError_t e = hipLaunchCooperativeKernel((void*)mega, dim3(grid_blocks), dim3(256), args, 0, stream);
  if (e != hipSuccess) fprintf(stderr, "cooperative launch failed: %s (grid %d)\n", hipGetErrorString(e), grid_blocks);
#else
  for (int ph = 0; ph < 14; ++ph) mega<<<grid_blocks, 256, 0, stream>>>(p, ph, ph + 1, 0);
#endif
}
```

```cpp
#include <hip/hip_runtime.h>
#include <hip/hip_cooperative_groups.h>
#include <cstdio>
#include <cstdint>
namespace cg = cooperative_groups;

typedef _Float16 h16;
typedef _Float16 half8 __attribute__((ext_vector_type(8)));
typedef _Float16 half4 __attribute__((ext_vector_type(4)));
typedef float f32x16 __attribute__((ext_vector_type(16)));
typedef float f32x4 __attribute__((ext_vector_type(4)));
typedef float f32x2 __attribute__((ext_vector_type(2)));
typedef unsigned u32x4 __attribute__((ext_vector_type(4)));
typedef _Float16 half2v __attribute__((ext_vector_type(2)));

constexpr int NLAT = 32768, NTOK = 34816;
constexpr int PC = 4160;
constexpr int NPAD = 4224;
constexpr int VTS = 4352;
constexpr int SMEM_BYTES = 49152;

#ifndef EXTRA_SYNCS
#define EXTRA_SYNCS 0
#endif
#ifndef PROBE_SUB
#define PROBE_SUB 7
#endif
#ifndef PROBE_MASK
#define PROBE_MASK 0
#endif
#ifndef SINGLE_LAUNCH
#define SINGLE_LAUNCH 1
#endif

struct Params {
  const float *x, *c, *ctx, *c_ctx, *mod_w, *mod_b, *norm_w, *w_in, *w_out;
  const float *mu_prev, *mu_next, *w0, *w2, *a0, *a2, *k_k, *k_a, *r_k, *gn_w, *gn_b;
  const float *vw1, *vw2, *vb, *lb_logits, *hg_norm_w, *sink, *final_w;
  float* out;
  h16 *win_t, *wout_t, *wl_t;
  float* mod;
  h16 *hy, *P, *F, *VB;
  h16* VT;
  float* xc1;
  float* rope;
  unsigned* bar;
};

__device__ __forceinline__ int tid_opaque() { int t = threadIdx.x; asm volatile("" : "+v"(t)); return t; }
__device__ __forceinline__ float wave_sum(float v) {
#pragma unroll
  for (int o = 32; o > 0; o >>= 1) v += __shfl_xor(v, o);
  return v;
}
__device__ __forceinline__ float sigmoidf_(float x) { return 1.f / (1.f + __expf(-x)); }
__device__ __forceinline__ float siluf_(float x) { return x / (1.f + __expf(-x)); }
template <int CTRL> __device__ __forceinline__ float dpp_mov(float x) {
  return __int_as_float(__builtin_amdgcn_update_dpp(0, __float_as_int(x), CTRL, 0xf, 0xf, true));
}
__device__ __forceinline__ float wave_sum_dpp(float x) {
  x += dpp_mov<0xB1>(x);
  x += dpp_mov<0x4E>(x);
  x += dpp_mov<0x141>(x);
  x += dpp_mov<0x140>(x);
  const int xi = __float_as_int(x);
  return __int_as_float(__builtin_amdgcn_readlane(xi, 0)) + __int_as_float(__builtin_amdgcn_readlane(xi, 16)) +
         __int_as_float(__builtin_amdgcn_readlane(xi, 32)) + __int_as_float(__builtin_amdgcn_readlane(xi, 48));
}
__device__ __forceinline__ float red8(float x) {
  x += dpp_mov<0xB1>(x);
  x += dpp_mov<0x4E>(x);
  x += dpp_mov<0x141>(x);
  return x;
}

#define XB_TMO      128
#define XB_XCNT(j)  (256  + 64 * (j))
#define XB_XSUB(j)  (1280 + 64 * (j))
#define XB_XGEN(j)  (2304 + 64 * (j))
#define XB_TOP      3328
#define XB_TOPGEN   3392
#define XCD_BAR_WORDS 3456
#define XB_SPIN_CAP (1u << 18)
#define LAS __attribute__((address_space(3)))
__device__ __forceinline__ unsigned xb_ld(unsigned* p)              { return __hip_atomic_load(p, __ATOMIC_RELAXED, __HIP_MEMORY_SCOPE_AGENT); }
__device__ __forceinline__ unsigned xb_add(unsigned* p, unsigned v) { return __hip_atomic_fetch_add(p, v, __ATOMIC_RELAXED, __HIP_MEMORY_SCOPE_AGENT); }
__device__ __forceinline__ unsigned xb_xcc_id() { return (unsigned)__builtin_amdgcn_s_getreg((3 << 11) | 20) & 0xFu; }
#define XB_SPIN(cond, bar) do { unsigned _sp = 0; while (cond) { __builtin_amdgcn_s_sleep(1); \
    if ((++_sp & 255u) == 0u) { if (xb_ld(&(bar)[XB_TMO])) break; if (_sp > XB_SPIN_CAP) { atomicAdd(&(bar)[XB_TMO], 1u); break; } } } } while (0)
struct XcdBarrier { unsigned* bar; unsigned x; volatile LAS unsigned* st; };
__device__ __forceinline__ XcdBarrier xcd_barrier_post(unsigned* bar, volatile LAS unsigned* st) {
  XcdBarrier b; b.bar = bar; b.x = xb_xcc_id(); b.st = st;
  if (threadIdx.x == 0) (void)xb_add(&bar[XB_XCNT(b.x)], 1u);
  return b;
}
__device__ __forceinline__ void xcd_barrier_complete(unsigned* bar, unsigned x, unsigned& nloc, unsigned& nx) {
  const unsigned G = gridDim.x * gridDim.y * gridDim.z;
  unsigned sum, cnt, mine, sp = 0u;
  for (;;) {
    sum = 0u; cnt = 0u; mine = 0u;
#pragma unroll
    for (unsigned j = 0; j < 16; ++j) { const unsigned c = xb_ld(&bar[XB_XCNT(j)]); sum += c; cnt += (c > 0u) ? 1u : 0u; mine = (j == x) ? c : mine; }
    if (sum == G) break;
    __builtin_amdgcn_s_sleep(1);
    if ((++sp & 255u) == 0u) { if (xb_ld(&bar[XB_TMO])) break; if (sp > XB_SPIN_CAP) { atomicAdd(&bar[XB_TMO], 1u); break; } }
  }
  nloc = mine > 0u ? mine : 1u; nx = cnt > 0u ? cnt : 1u;
}
__device__ __forceinline__ void xcd_barrier(const XcdBarrier& b) {
  asm volatile("s_waitcnt vmcnt(0)" ::: "memory");
  __syncthreads();
  if (threadIdx.x == 0) {
    unsigned* bar = b.bar;
    __builtin_amdgcn_s_waitcnt(0);
    unsigned nloc = b.st[0], nx = b.st[1];
    if (nloc == 0u) { xcd_barrier_complete(bar, b.x, nloc, nx); b.st[0] = nloc; b.st[1] = nx; }
    const unsigned old = xb_add(&bar[XB_XSUB(b.x)], 1u);
    const unsigned gen = old / nloc;
    if (old + 1u == (gen + 1u) * nloc) {
      __builtin_amdgcn_fence(__ATOMIC_RELEASE, "agent");
      asm volatile("s_waitcnt vmcnt(0)" ::: "memory");
      const unsigned og = xb_add(&bar[XB_TOP], 1u);
      const unsigned tg = og / nx;
      if (og + 1u == (tg + 1u) * nx) xb_add(&bar[XB_TOPGEN], 1u);
      else XB_SPIN(xb_ld(&bar[XB_TOPGEN]) == tg, bar);
      __builtin_amdgcn_fence(__ATOMIC_ACQUIRE, "agent");
      xb_add(&bar[XB_XGEN(b.x)], 1u);
      asm volatile("s_waitcnt vmcnt(0)" ::: "memory");
    } else {
      XB_SPIN(xb_ld(&bar[XB_XGEN(b.x)]) == gen, bar);
      __builtin_amdgcn_fence(__ATOMIC_ACQUIRE, "agent");
      asm volatile("s_waitcnt vmcnt(0)" ::: "memory");
    }
  }
  __syncthreads();
}

__device__ __forceinline__ void phase_prep(const Params& p, int bid, int nb, char* smem) {
  const int tid = tid_opaque();
  float* sf = (float*)smem;
  constexpr int N_WIN = 2048, N_WOUT = 512, N_MOD = 192, N_PADI = 1024, N_WL = 768;
  constexpr int total = N_WIN + N_WOUT + N_MOD + N_PADI + N_WL + 1;
  for (int it = bid; it < total; it += nb) {
    if (it < N_WIN + N_WOUT) {
      const float* src; h16* dst; int ncols, kt, ntile;
      if (it < N_WIN) { int l = it >> 10, r = it & 1023; kt = r >> 6; ntile = r & 63; src = p.w_in + (size_t)l * 1024 * 4096; dst = p.win_t + (size_t)l * NPAD * 1024; ncols = 4096; }
      else { int j = it - N_WIN; int l = j >> 8, r = j & 255; kt = r >> 4; ntile = r & 15; src = p.w_out + (size_t)l * 1024 * 1024; dst = p.wout_t + (size_t)l * 1024 * 1024; ncols = 1024; }
      for (int i = tid; i < 4096; i += 256) { int kk = i >> 6, nn = i & 63; sf[kk * 65 + nn] = src[(size_t)(kt * 64 + kk) * ncols + ntile * 64 + nn]; }
      __syncthreads();
      for (int i = tid; i < 4096; i += 256) { int nn = i >> 6, kk = i & 63; dst[(size_t)(ntile * 64 + nn) * 1024 + kt * 64 + kk] = (h16)sf[kk * 65 + nn]; }
      __syncthreads();
    } else if (it < N_WIN + N_WOUT + N_MOD) {
      const int j = it - N_WIN - N_WOUT; const int l = j / 96; const int cl = tid & 31, ks = tid >> 5; const int col = (j % 96) * 32 + cl;
      for (int i = tid; i < 9 * 1024; i += 256) { int r = i >> 10, k = i & 1023; float v = r < 8 ? p.c[r * 1024 + k] : p.c_ctx[k]; sf[i] = siluf_(v); }
      __syncthreads();
      float acc[9];
#pragma unroll
      for (int r = 0; r < 9; ++r) acc[r] = 0.f;
      const float* mw = p.mod_w + (size_t)l * 1024 * 3072 + (size_t)(ks * 128) * 3072 + col;
#pragma unroll 2
      for (int k = 0; k < 128; k += 4) {
        const float w0 = mw[(size_t)k * 3072], w1 = mw[(size_t)(k + 1) * 3072], w2 = mw[(size_t)(k + 2) * 3072], w3 = mw[(size_t)(k + 3) * 3072];
#pragma unroll
        for (int r = 0; r < 9; ++r) { const f32x4 sv = *(const f32x4*)&sf[r * 1024 + ks * 128 + k]; acc[r] += sv[0] * w0 + sv[1] * w1 + sv[2] * w2 + sv[3] * w3; }
      }
#pragma unroll
      for (int r = 0; r < 9; ++r) acc[r] += __shfl_xor(acc[r], 32);
      __syncthreads();
      if ((tid & 63) < 32) {
#pragma unroll
        for (int r = 0; r < 9; ++r) sf[((tid >> 6) * 9 + r) * 32 + cl] = acc[r];
      }
      __syncthreads();
      for (int i = tid; i < 288; i += 256) {
        const int r = i >> 5, c2 = i & 31;
        const float v = sf[(0 * 9 + r) * 32 + c2] + sf[(1 * 9 + r) * 32 + c2] + sf[(2 * 9 + r) * 32 + c2] + sf[(3 * 9 + r) * 32 + c2];
        const int cc = (j % 96) * 32 + c2;
        p.mod[(size_t)(l * 9 + r) * 3072 + cc] = v + p.mod_b[l * 3072 + cc];
      }
      __syncthreads();
    } else if (it < N_WIN + N_WOUT + N_MOD + N_PADI) {
      int j = it - (N_WIN + N_WOUT + N_MOD); int idx = j * 256 + tid;
      int l = idx >> 17; int rem = idx & 131071; int m = rem >> 10, k = rem & 1023;
      float v = (l == 1 && m < 32) ? p.vw1[k * 32 + m] : 0.f;
      p.win_t[(size_t)l * NPAD * 1024 + (size_t)(4096 + m) * 1024 + k] = (h16)v;
    } else if (it < N_WIN + N_WOUT + N_MOD + N_PADI + N_WL) {
      const int idx = (it - (N_WIN + N_WOUT + N_MOD + N_PADI)) * 256 + tid;
      const int r = idx & 63, c = (idx >> 6) % 384, ls = idx / (384 * 64); const int l = ls >> 2, slot = ls & 3, dir = slot & 1, kind = slot >> 1;
      const float v = (kind == 0 ? p.w2 : p.a2)[((size_t)(l * 2 + dir) * 64 + r) * 384 + c];
      p.wl_t[idx] = (h16)v;
    } else {
      if (tid < 16) {
        double inv = 1.0; for (int i = 0; i < tid; ++i) inv *= 0.5623413251903491;
        double x2 = inv * inv, ts = inv, tc = 1.0, s1 = inv, c1 = 1.0;
        for (int n = 1; n <= 10; ++n) { tc *= -x2 / ((2.0 * n - 1.0) * (2.0 * n)); c1 += tc; ts *= -x2 / ((2.0 * n) * (2.0 * n + 1.0)); s1 += ts; }
        double cc = 1.0, ss = 0.0;
        for (int pos = 0; pos < 64; ++pos) {
          p.rope[(pos * 16 + tid) * 2] = (float)cc; p.rope[(pos * 16 + tid) * 2 + 1] = (float)ss;
          double nc = cc * c1 - ss * s1, ns = ss * c1 + cc * s1; cc = nc; ss = ns;
        }
      }
    }
  }
}

__device__ __forceinline__ void phase_norm(const Params& p, int l, int bid, int nb) {
  const int tid = tid_opaque(), lane = tid & 63, w = tid >> 6;
  for (int row = bid * 4 + w; row < NTOK; row += nb * 4) {
    const float* src = (l == 0) ? (row < NLAT ? p.x + (size_t)row * 1024 : p.ctx + (size_t)(row - NLAT) * 1024)
                                : (row < NLAT ? p.out + (size_t)row * 1024 : p.xc1 + (size_t)(row - NLAT) * 1024);
    const int mr = row < NLAT ? (row >> 12) : 8;
    const float* md = p.mod + (size_t)(l * 9 + mr) * 3072;
    const float* nw = p.norm_w + l * 1024;
    f32x4 v[4]; float ss = 0.f;
#pragma unroll
    for (int i = 0; i < 4; ++i) { v[i] = *(const f32x4*)(src + i * 256 + lane * 4); ss += v[i][0] * v[i][0] + v[i][1] * v[i][1] + v[i][2] * v[i][2] + v[i][3] * v[i][3]; }
    ss = wave_sum_dpp(ss);
    const float rs = rsqrtf(ss * (1.f / 1024.f) + 1e-6f);
#pragma unroll
    for (int i = 0; i < 4; ++i) {
      const int col = i * 256 + lane * 4;
      f32x4 nwv = *(const f32x4*)(nw + col), sc = *(const f32x4*)(md + 1024 + col), sh = *(const f32x4*)(md + col);
      half4 o;
#pragma unroll
      for (int j = 0; j < 4; ++j) o[j] = (h16)(v[i][j] * rs * nwv[j] * (1.f + sc[j]) + sh[j]);
      *(half4*)(p.hy + (size_t)row * 1024 + col) = o;
    }
  }
}

template <int MODE>
__device__ __forceinline__ void phase_gemm(const Params& p, int l, int bid, int nb, char* smem) {
  const h16* A = p.hy;
  const h16* Bt = MODE == 0 ? p.win_t + (size_t)l * NPAD * 1024 : p.wout_t + (size_t)l * 1024 * 1024;
  const int ntn = MODE == 0 ? (l == 1 ? 33 : 32) : 8;
  const int ntm = (MODE == 1 && l == 1) ? 256 : 272;
  const int tid = tid_opaque(), lane = tid & 63, w = tid >> 6, wr = w >> 1, wc = w & 1, lq = lane & 31, hh = lane >> 5;
  h16* As = (h16*)smem; h16* Bs = As + 128 * 72;
  const int ldrow = tid >> 3, ldch = (tid & 7) * 8;
  for (int tile = bid; tile < ntm * ntn; tile += nb) {
    int tm, tn;
    {
      const int mper = ntm >> 3;
      const int nmain = MODE == 0 ? 32 : 8;
      if (tile < ntm * nmain) {
        const int x = tile & 7, sq = tile >> 3;
        const int strip = sq / (mper * 8), rem = sq - strip * (mper * 8);
        tm = x * mper + (rem >> 3); tn = strip * 8 + (rem & 7);
      } else { tm = tile - ntm * nmain; tn = nmain; }
    }
    const h16* Ag = A + (size_t)(tm * 128 + ldrow) * 1024 + ldch; const h16* Bg = Bt + (size_t)(tn * 128 + ldrow) * 1024 + ldch;
    f32x16 acc[2][2];
#pragma unroll
    for (int i = 0; i < 2; ++i)
#pragma unroll
      for (int j = 0; j < 2; ++j)
#pragma unroll
        for (int r = 0; r < 16; ++r) acc[i][j][r] = 0.f;
    u32x4 ra[4], rb[4];
#pragma unroll
    for (int i = 0; i < 4; ++i) { ra[i] = *(const u32x4*)(Ag + (size_t)i * 32 * 1024); rb[i] = *(const u32x4*)(Bg + (size_t)i * 32 * 1024); }
#pragma unroll 1
    for (int kt = 0; kt < 16; ++kt) {
      __syncthreads();
#pragma unroll
      for (int i = 0; i < 4; ++i) { *(u32x4*)(As + (ldrow + i * 32) * 72 + ldch) = ra[i]; *(u32x4*)(Bs + (ldrow + i * 32) * 72 + ldch) = rb[i]; }
      __syncthreads();
      if (kt + 1 < 16) {
#pragma unroll
        for (int i = 0; i < 4; ++i) { ra[i] = *(const u32x4*)(Ag + (size_t)i * 32 * 1024 + (kt + 1) * 64); rb[i] = *(const u32x4*)(Bg + (size_t)i * 32 * 1024 + (kt + 1) * 64); }
      }
#pragma unroll
      for (int s = 0; s < 4; ++s) {
        half8 a[2], b[2];
#pragma unroll
        for (int i = 0; i < 2; ++i) { a[i] = *(const half8*)(As + (64 * wr + 32 * i + lq) * 72 + 16 * s + 8 * hh); b[i] = *(const half8*)(Bs + (64 * wc + 32 * i + lq) * 72 + 16 * s + 8 * hh); }
#pragma unroll
        for (int i = 0; i < 2; ++i)
#pragma unroll
          for (int j = 0; j < 2; ++j) {
            if (MODE == 0) acc[i][j] = __builtin_amdgcn_mfma_f32_32x32x16_f16(b[j], a[i], acc[i][j], 0, 0, 0);
            else acc[i][j] = __builtin_amdgcn_mfma_f32_32x32x16_f16(a[i], b[j], acc[i][j], 0, 0, 0);
          }
      }
    }
    if (MODE == 0) {
      if (tn < 32) {
        __syncthreads();
        h16* Cs = (h16*)smem;
#pragma unroll
        for (int i = 0; i < 2; ++i)
#pragma unroll
          for (int j = 0; j < 2; ++j)
#pragma unroll
            for (int g = 0; g < 4; ++g) {
              half4 o;
#pragma unroll
              for (int q = 0; q < 4; ++q) o[q] = (h16)acc[i][j][4 * g + q];
              *(half4*)(Cs + (64 * wr + 32 * i + lq) * 136 + 64 * wc + 32 * j + 8 * g + 4 * hh) = o;
            }
        __syncthreads();
#pragma unroll
        for (int q = 0; q < 8; ++q) {
          const int id = tid + q * 256; const int row = id >> 4, ch = id & 15;
          *(u32x4*)(p.P + (size_t)(tm * 128 + row) * PC + tn * 128 + ch * 8) = *(const u32x4*)(Cs + row * 136 + ch * 8);
        }
      } else if (wc == 0) {
#pragma unroll
        for (int i = 0; i < 2; ++i)
#pragma unroll
          for (int r = 0; r < 16; ++r) ((float*)(p.F + (size_t)(tm * 128 + 64 * wr + 32 * i + lq) * 1536))[(r & 3) + 8 * (r >> 2) + 4 * hh] = acc[i][0][r];
      }
    } else {
#pragma unroll
      for (int i = 0; i < 2; ++i)
#pragma unroll
        for (int r = 0; r < 16; ++r) {
          const int row = tm * 128 + 64 * wr + 32 * i + (r & 3) + 8 * (r >> 2) + 4 * hh;
          const int mr = row < NLAT ? (row >> 12) : 8;
          const float* gp = p.mod + (size_t)(l * 9 + mr) * 3072 + 2048 + tn * 128 + 64 * wc + lq;
          const float* xo; float* dst;
          if (l == 0) { if (row < NLAT) { xo = p.x + (size_t)row * 1024; dst = p.out + (size_t)row * 1024; } else { xo = p.ctx + (size_t)(row - NLAT) * 1024; dst = p.xc1 + (size_t)(row - NLAT) * 1024; } }
          else { xo = p.out + (size_t)row * 1024; dst = p.out + (size_t)row * 1024; }
          const int col = tn * 128 + 64 * wc + lq;
#pragma unroll
          for (int j = 0; j < 2; ++j) dst[col + 32 * j] = xo[col + 32 * j] + gp[32 * j] * acc[i][j][r];
        }
    }
  }
}

#define LOAD_COL34(arr, base, t0, Tn) \
  _Pragma("unroll") for (int q_ = 0; q_ < 34; ++q_) { const int t_ = (t0) - 1 + q_; arr[q_] = (t_ >= 0 && t_ < (Tn)) ? (base)[(long)t_ * PC] : (h16)0.f; }

__device__ __forceinline__ void phase_feat(const Params& p, int l, int bid, int nb, char* smem) {
  const int tid = tid_opaque();
  h16* inh = (h16*)smem;
  float* zt = (float*)(smem + 32 * 264 * 2);
  for (int item = bid; item < 1088; item += nb) {
    int b, t0, Tn, rowbase; bool isctx;
    if (item < 1024) { b = item >> 7; t0 = (item & 127) * 32; Tn = 4096; rowbase = b * 4096; isctx = false; }
    else { int j = item - 1024; b = j >> 3; t0 = (j & 7) * 32; Tn = 256; rowbase = NLAT + b * 256; isctx = true; }
    {
      const int col = 1152 + tid;
      const float mp = p.mu_prev[l * 1792 + col], mn = p.mu_next[l * 1792 + col];
      const h16* base = p.P + (size_t)rowbase * PC + col;
      h16 xv[34];
      LOAD_COL34(xv, base, t0, Tn)
#pragma unroll
      for (int tt = 0; tt < 32; ++tt) {
        const float prev = (float)xv[tt], cur = (float)xv[tt + 1], nxt = (float)xv[tt + 2];
        float sv = cur + mp * (prev - cur) + mn * (nxt - cur);
        if (tid < 128) { const float e2 = __expf(2.f * sv); sv = 1.f - 2.f / (e2 + 1.f); }
        inh[tt * 264 + tid] = (h16)sv;
      }
      if (l == 1) {
#pragma unroll
        for (int i = 0; i < 4; ++i) { int id = tid + i * 256; zt[id] = ((const float*)(p.F + (size_t)(rowbase + t0 + (id >> 5)) * 1536))[id & 31]; }
      }
    }
    __syncthreads();
#pragma unroll 1
    for (int c = tid; c < 384; c += 256) {
      const int col = 768 + c;
      const float mp = p.mu_prev[l * 1792 + col], mn = p.mu_next[l * 1792 + col];
      const h16* base = p.P + (size_t)rowbase * PC + col;
      h16 xv[34];
      LOAD_COL34(xv, base, t0, Tn)
      h16* dst = p.VB + (size_t)(rowbase + t0) * 384 + c;
      if (l == 0) {
#pragma unroll
        for (int tt = 0; tt < 32; ++tt) {
          const float prev = (float)xv[tt], cur = (float)xv[tt + 1], nxt = (float)xv[tt + 2];
          dst[tt * 384] = (h16)(cur + mp * (prev - cur) + mn * (nxt - cur));
        }
      } else {
        const float vbv = p.vb[c];
#pragma unroll 1
        for (int hf = 0; hf < 2; ++hf) {
          h16 vfv[16]; float ga[16];
#pragma unroll
          for (int tt = 0; tt < 16; ++tt) { vfv[tt] = dst[(hf * 16 + tt) * 384]; ga[tt] = vbv; }
#pragma unroll 1
          for (int m = 0; m < 32; m += 4) {
            const float w0 = p.vw2[m * 384 + c], w1 = p.vw2[(m + 1) * 384 + c], w2 = p.vw2[(m + 2) * 384 + c], w3 = p.vw2[(m + 3) * 384 + c];
#pragma unroll
            for (int tt = 0; tt < 16; ++tt) { const f32x4 z = *(const f32x4*)&zt[(hf * 16 + tt) * 32 + m]; ga[tt] += z[0] * w0 + z[1] * w1 + z[2] * w2 + z[3] * w3; }
          }
#pragma unroll
          for (int tt = 0; tt < 16; ++tt) {
            const float prev = hf ? (float)xv[16 + tt] : (float)xv[tt], cur = hf ? (float)xv[17 + tt] : (float)xv[tt + 1], nxt = hf ? (float)xv[18 + tt] : (float)xv[tt + 2];
            const float sv = cur + mp * (prev - cur) + mn * (nxt - cur);
            dst[(hf * 16 + tt) * 384] = (h16)(sv + ((float)vfv[tt] - sv) * sigmoidf_(ga[tt]));
          }
        }
      }
    }
    {
      const int w = tid >> 6, lane = tid & 63, lq = tid & 31, hh = lane >> 5;
      const int slot = w, dir = slot & 1, kind = slot >> 1;
      const int io = (kind == 0 ? 0 : 128) + dir * 64;
      half8 xin[4];
#pragma unroll
      for (int ks = 0; ks < 4; ++ks) xin[ks] = *(const half8*)(inh + lq * 264 + io + 16 * ks + 8 * hh);
      const h16* wl = p.wl_t + (size_t)((l * 4 + slot) * 384) * 64;
      const float* bias = (kind == 0 ? p.w0 : p.a0) + (l * 2 + dir) * 384;
      const float mul = kind == 0 ? 0.6065306597126334f : 1.f;
      h16* ost = (h16*)(smem + 32 * 264 * 2 + 4096) + w * (32 * 72);
      h16* fbase = p.F + (size_t)(rowbase + t0) * 1536 + slot * 384;
#pragma unroll 1
      for (int np = 0; np < 6; ++np) {
#pragma unroll
        for (int n2 = 0; n2 < 2; ++n2) {
          const int nt = np * 2 + n2;
          f32x16 acc;
#pragma unroll
          for (int g = 0; g < 4; ++g) { const f32x4 bv = *(const f32x4*)(bias + nt * 32 + 8 * g + 4 * hh); acc[4 * g] = bv[0]; acc[4 * g + 1] = bv[1]; acc[4 * g + 2] = bv[2]; acc[4 * g + 3] = bv[3]; }
#pragma unroll
          for (int ks = 0; ks < 4; ++ks) {
            const half8 wf = *(const half8*)(wl + (size_t)(nt * 32 + lq) * 64 + 16 * ks + 8 * hh);
            acc = __builtin_amdgcn_mfma_f32_32x32x16_f16(wf, xin[ks], acc, 0, 0, 0);
          }
#pragma unroll
          for (int g = 0; g < 4; ++g) {
            half4 o;
#pragma unroll
            for (int j = 0; j < 4; ++j) o[j] = (h16)(mul * sigmoidf_(acc[4 * g + j]));
            *(half4*)(ost + lq * 72 + n2 * 32 + 8 * g + 4 * hh) = o;
          }
        }
        asm volatile("s_waitcnt lgkmcnt(0)" ::: "memory");
#pragma unroll
        for (int q = 0; q < 4; ++q) {
          const int id = lane + q * 64; const int rr = id >> 3, ch = id & 7;
          *(u32x4*)(fbase + (size_t)rr * 1536 + np * 64 + ch * 8) = *(const u32x4*)(ost + rr * 72 + ch * 8);
        }
        asm volatile("s_waitcnt lgkmcnt(0)" ::: "memory");
      }
    }
    {
      const int head = tid >> 5, pr = tid & 31, half = pr >> 4, i = pr & 15;
      const int colbase = head < 6 ? 3072 + head * 64 : 3456 + (head - 6) * 64;
      const int d1 = half * 32 + i;
      const float qs = head < 6 ? 0.125f : 1.f;
      h16* pp = p.P + (size_t)(rowbase + t0) * PC + colbase + d1;
#pragma unroll
      for (int tq = 0; tq < 32; tq += 8) {
        h16 x1[8], x2[8];
#pragma unroll
        for (int u = 0; u < 8; ++u) { x1[u] = pp[(size_t)(tq + u) * PC]; x2[u] = pp[(size_t)(tq + u) * PC + 16]; }
#pragma unroll
        for (int u = 0; u < 8; ++u) {
          const int t = t0 + tq + u;
          float cs = 1.f, sn = 0.f;
          if (!isctx) { const int pos = half == 0 ? (t >> 6) : (t & 63); const f32x2 r2 = *(const f32x2*)&p.rope[(pos * 16 + i) * 2]; cs = r2[0]; sn = r2[1]; }
          const float a = (float)x1[u], bq = (float)x2[u];
          pp[(size_t)(tq + u) * PC] = (h16)((a * cs - bq * sn) * qs);
          pp[(size_t)(tq + u) * PC + 16] = (h16)((a * sn + bq * cs) * qs);
        }
      }
    }
    if (tid < 128) {
      const int g = tid >> 6, d = tid & 63;
      const h16* base = p.P + (size_t)(rowbase + t0) * PC + 3584 + tid;
      h16* dst = p.VT + (size_t)((b * 2 + g) * 64 + d) * VTS + (isctx ? 4096 + t0 : t0);
      half8 v[4];
#pragma unroll
      for (int q = 0; q < 4; ++q)
#pragma unroll
        for (int j = 0; j < 8; ++j) v[q][j] = base[(size_t)(q * 8 + j) * PC];
#pragma unroll
      for (int q = 0; q < 4; ++q) *(half8*)(dst + q * 8) = v[q];
    }
    __syncthreads();
  }
}

__device__ __forceinline__ float red16(float x) {
  x += dpp_mov<0xB1>(x);
  x += dpp_mov<0x4E>(x);
  x += dpp_mov<0x141>(x);
  x += dpp_mov<0x140>(x);
  return x;
}
#define LDS_BARRIER() do { asm volatile("s_waitcnt lgkmcnt(0)" ::: "memory"); __builtin_amdgcn_s_barrier(); asm volatile("" ::: "memory"); } while (0)
constexpr int RREC = 336;
struct RwkvPf { h16 rr[10], kr[10], v[8], e[8], al[8]; };

__device__ __forceinline__ void rwkv_chain(const Params& p, int l, int item, char* smem) {
  const int tid = tid_opaque(), lane = tid & 63, w = tid >> 6;
  const int chain = item >> 2, vq = item & 3;
  const int dir = chain / 48, b = (chain % 48) / 6, h = chain % 6;
  float* opb = (float*)smem;
  float* ybuf = opb + 2 * 16 * RREC;
  constexpr int NCH = 272;
  if (w < 2) {
    const int rl = tid >> 3, kq = tid & 7;
    float S[8];
#pragma unroll
    for (int j = 0; j < 8; ++j) S[j] = 0.f;
    __builtin_amdgcn_s_setprio(3);
    LDS_BARRIER();
#pragma unroll 1
    for (int ci = 0; ci < NCH; ++ci) {
      const float* op = opb + (ci & 1) * 16 * RREC;
      float* yb = ybuf + (ci & 1) * 256;
      f32x4 aA = *(const f32x4*)(op + 8 * kq + 64), aB = *(const f32x4*)(op + 8 * kq + 68);
#pragma unroll
      for (int step = 0; step < 16; ++step) {
        const float* o = op + step * RREC + 8 * kq;
        const f32x4 wA = *(const f32x4*)(o), wB = *(const f32x4*)(o + 4);
        const f32x4 bA = *(const f32x4*)(o + 128), bB = *(const f32x4*)(o + 132);
        const f32x4 kA = *(const f32x4*)(o + 192), kB = *(const f32x4*)(o + 196);
        const f32x4 rA = *(const f32x4*)(o + 256), rB = *(const f32x4*)(o + 260);
        const float vv = op[step * RREC + 320 + rl];
        f32x4 naA = aA, naB = aB;
        if (step + 1 < 16) { naA = *(const f32x4*)(o + RREC + 64); naB = *(const f32x4*)(o + RREC + 68); }
        const float d0 = S[0] * aA[0] + S[1] * aA[1] + S[2] * aA[2] + S[3] * aA[3];
        const float d1 = S[4] * aB[0] + S[5] * aB[1] + S[6] * aB[2] + S[7] * aB[3];
        const float sa = red8(d0 + d1);
#pragma unroll
        for (int j = 0; j < 4; ++j) {
          S[j] = S[j] * wA[j] + sa * bA[j] + vv * kA[j];
          S[4 + j] = S[4 + j] * wB[j] + sa * bB[j] + vv * kB[j];
        }
        const float y0 = S[0] * rA[0] + S[1] * rA[1] + S[2] * rA[2] + S[3] * rA[3];
        const float y1 = S[4] * rB[0] + S[5] * rB[1] + S[6] * rB[2] + S[7] * rB[3];
        const float yy = red8(y0 + y1);
        if (kq == 0) yb[step * 16 + rl] = yy;
        aA = naA; aB = naB;
      }
      LDS_BARRIER();
    }
    __builtin_amdgcn_s_setprio(0);
  } else {
    const int lw = w - 2, lt = tid - 128;
    const int hc = h * 64 + lane;
    const float mpr = p.mu_prev[l * 1792 + hc], mnr = p.mu_next[l * 1792 + hc];
    const float mpk = p.mu_prev[l * 1792 + 384 + hc], mnk = p.mu_next[l * 1792 + 384 + hc];
    const float kkw = p.k_k[l * 384 + hc], kaw = p.k_a[l * 384 + hc];
    RwkvPf pfA, pfB;
#define RWKV_ISSUE(ci_, PF) { const int seg_ = (ci_) >= 16; const int Tn_ = seg_ ? 4096 : 256; const int rb_ = seg_ ? b * 4096 : NLAT + b * 256; const int s0_ = (seg_ ? (ci_) - 16 : (ci_)) * 16 + 8 * lw; \
    _Pragma("unroll") for (int q = 0; q < 10; ++q) { int t_ = dir == 0 ? s0_ - 1 + q : Tn_ - s0_ - q; t_ = t_ < 0 ? 0 : (t_ >= Tn_ ? Tn_ - 1 : t_); const h16* pr = p.P + (size_t)(rb_ + t_) * PC + hc; \
      PF.rr[q] = pr[0]; PF.kr[q] = pr[384]; } \
    _Pragma("unroll") for (int i = 0; i < 8; ++i) { const int t_ = dir == 0 ? s0_ + i : Tn_ - 1 - (s0_ + i); const size_t row = (size_t)rb_ + t_; \
      PF.v[i] = p.VB[row * 384 + hc]; PF.e[i] = p.F[row * 1536 + dir * 384 + hc]; PF.al[i] = p.F[row * 1536 + (2 + dir) * 384 + hc]; } }
#define RWKV_STAGE(ci_, PF) { float* op_ = opb + ((ci_) & 1) * 16 * RREC; \
    const int seg = (ci_) >= 16; const int Tn = seg ? 4096 : 256; const int c0 = (seg ? (ci_) - 16 : (ci_)) * 16; \
    _Pragma("unroll") for (int i = 0; i < 8; ++i) { \
      const int step = lw * 8 + i; const int t = dir == 0 ? c0 + step : Tn - 1 - (c0 + step); \
      const float rlo = (float)PF.rr[i], r0 = (float)PF.rr[i + 1], rhi = (float)PF.rr[i + 2]; \
      const float klo = (float)PF.kr[i], k0 = (float)PF.kr[i + 1], khi = (float)PF.kr[i + 2]; \
      const float rm = t > 0 ? (dir ? rhi : rlo) : 0.f, rp = t + 1 < Tn ? (dir ? rlo : rhi) : 0.f; \
      const float km = t > 0 ? (dir ? khi : klo) : 0.f, kp = t + 1 < Tn ? (dir ? klo : khi) : 0.f; \
      const float vv = (float)PF.v[i], e = (float)PF.e[i], al = (float)PF.al[i]; \
      const float rs = r0 + mpr * (rm - r0) + mnr * (rp - r0); \
      const float ks = k0 + mpk * (km - k0) + mnk * (kp - k0); \
      const float kkr = ks * kkw; \
      const float n2 = wave_sum_dpp(kkr * kkr); \
      const float kk = kkr / fmaxf(sqrtf(n2), 1e-12f); \
      float* o = op_ + step * RREC + lane; \
      o[0] = __expf(-e); o[64] = -kk; o[128] = kk * al; o[192] = ks * (1.f + (al - 1.f) * kaw); o[256] = rs; \
      if ((lane >> 4) == vq) op_[step * RREC + 320 + (lane & 15)] = vv; } }
#define RWKV_WRITE(cj_) { const int seg = (cj_) >= 16; const int Tn = seg ? 4096 : 256; const int rowbase = seg ? b * 4096 : NLAT + b * 256; const int c0 = (seg ? (cj_) - 16 : (cj_)) * 16; \
    if (seg == 1 || l == 0) { const float* yb = ybuf + ((cj_) & 1) * 256; \
      _Pragma("unroll") for (int i = 0; i < 2; ++i) { const int idx = lt + i * 128; const int step = idx >> 4, ch = idx & 15; \
        const int t = dir == 0 ? c0 + step : Tn - 1 - (c0 + step); \
        const h16 yv = (h16)yb[idx]; \
        if (dir == 0) p.P[(size_t)(rowbase + t) * PC + 768 + h * 64 + 16 * vq + ch] = yv; \
        else p.hy[(size_t)(rowbase + t) * 1024 + h * 64 + 16 * vq + ch] = yv; } } }
    RWKV_ISSUE(0, pfA)
    RWKV_STAGE(0, pfA)
    RWKV_ISSUE(1, pfB)
    RWKV_ISSUE(2, pfA)
    LDS_BARRIER();
#pragma unroll 1
    for (int ci = 0; ci < NCH; ci += 2) {
      if (ci + 1 < NCH) RWKV_STAGE(ci + 1, pfB)
      if (ci + 3 < NCH) RWKV_ISSUE(ci + 3, pfB)
      if (ci >= 1) RWKV_WRITE(ci - 1)
      LDS_BARRIER();
      if (ci + 2 < NCH) RWKV_STAGE(ci + 2, pfA)
      if (ci + 4 < NCH) RWKV_ISSUE(ci + 4, pfA)
      RWKV_WRITE(ci)
      LDS_BARRIER();
    }
    RWKV_WRITE(NCH - 1)
  }
}

constexpr int HREC = 224;
struct HgrnPf { h16 f[4], q[4], iv[4]; };
__device__ __forceinline__ void hgrn_chain(const Params& p, int l, int item, char* smem) {
  const int tid = tid_opaque(), lane = tid & 63, w = tid >> 6;
  const int chain = item >> 1, vh = item & 1;
  const int dir = chain / 32, b = (chain % 32) / 4, h = chain % 4;
  float* op = (float*)smem;
  float* ybuf = op + 16 * HREC;
  const int hc = h * 64 + lane;
  float lb = 0.f;
  if (l == 1) lb = sigmoidf_(p.lb_logits[(dir * 2 + 1) * 256 + hc] - p.lb_logits[(dir * 2 + 0) * 256 + hc]);
  const int fcol = 1792 + 256 * (1 + dir) + hc;
  const int vc = tid >> 3, kq = tid & 7;
  float S[8];
#pragma unroll
  for (int j = 0; j < 8; ++j) S[j] = 0.f;
  HgrnPf pfA, pfB;
#define HGRN_ISSUE(ci_, PF) { const int seg_ = (ci_) >= 16; const int Tn_ = seg_ ? 4096 : 256; const int rb_ = seg_ ? b * 4096 : NLAT + b * 256; const int c0_ = (seg_ ? (ci_) - 16 : (ci_)) * 16; \
    _Pragma("unroll") for (int i = 0; i < 4; ++i) { const int step = w * 4 + i; const int t = dir == 0 ? c0_ + step : Tn_ - 1 - (c0_ + step); const h16* pr = p.P + ((size_t)rb_ + t) * PC; \
      PF.f[i] = pr[fcol]; PF.q[i] = pr[1792 + hc]; PF.iv[i] = pr[1792 + 768 + hc]; } }
#define HGRN_CHUNK(ci_, PF) { \
    const int seg = (ci_) >= 16; const int Tn = seg ? 4096 : 256; const int rowbase = seg ? b * 4096 : NLAT + b * 256; const int c0 = (seg ? (ci_) - 16 : (ci_)) * 16; \
    _Pragma("unroll") for (int i = 0; i < 4; ++i) { \
      const int step = w * 4 + i; \
      float* o = op + step * HREC + lane; \
      const float f = lb + (1.f - lb) * sigmoidf_((float)PF.f[i]); \
      o[0] = f; o[64] = 1.f - f; o[128] = (float)PF.q[i]; \
      if ((lane >> 5) == vh) op[step * HREC + 192 + (lane & 31)] = (float)PF.iv[i]; } \
    LDS_BARRIER(); \
    if ((ci_) + 2 < 272) HGRN_ISSUE((ci_) + 2, PF) \
    _Pragma("unroll") for (int step = 0; step < 16; ++step) { \
      const float* o = op + step * HREC + 8 * kq; \
      const f32x4 fA = *(const f32x4*)(o), fB = *(const f32x4*)(o + 4); \
      const f32x4 gA = *(const f32x4*)(o + 64), gB = *(const f32x4*)(o + 68); \
      const f32x4 qA = *(const f32x4*)(o + 128), qB = *(const f32x4*)(o + 132); \
      const float iv = op[step * HREC + 192 + vc]; \
      const float f[8] = {fA[0], fA[1], fA[2], fA[3], fB[0], fB[1], fB[2], fB[3]}; \
      const float g[8] = {gA[0], gA[1], gA[2], gA[3], gB[0], gB[1], gB[2], gB[3]}; \
      const float q[8] = {qA[0], qA[1], qA[2], qA[3], qB[0], qB[1], qB[2], qB[3]}; \
      float acc = 0.f; \
      _Pragma("unroll") for (int j = 0; j < 8; ++j) { S[j] = S[j] * f[j] + g[j] * iv; acc += S[j] * q[j]; } \
      ybuf[step * 256 + tid] = acc; } \
    LDS_BARRIER(); \
    if (seg == 1 || l == 0) { \
      _Pragma("unroll") for (int i = 0; i < 2; ++i) { \
        const int idx = tid + i * 256; const int step = idx >> 5, ch = idx & 31; \
        const int t = dir == 0 ? c0 + step : Tn - 1 - (c0 + step); \
        const float* yb = ybuf + step * 256 + ch * 8; \
        const f32x4 y0 = *(const f32x4*)(yb), y1 = *(const f32x4*)(yb + 4); \
        const f32x4 ys = y0 + y1; \
        const h16 ov = (h16)((ys[0] + ys[1]) + (ys[2] + ys[3])); \
        if (dir == 0) p.P[(size_t)(rowbase + t) * PC + 1152 + h * 64 + 32 * vh + ch] = ov; \
        else p.hy[(size_t)(rowbase + t) * 1024 + 384 + h * 64 + 32 * vh + ch] = ov; } } }
  HGRN_ISSUE(0, pfA)
  HGRN_ISSUE(1, pfB)
  __builtin_amdgcn_s_setprio(2);
#pragma unroll 1
  for (int ci = 0; ci < 272; ci += 2) {
    HGRN_CHUNK(ci, pfA)
    HGRN_CHUNK(ci + 1, pfB)
  }
  __builtin_amdgcn_s_setprio(0);
}

__device__ __forceinline__ void attn_unit(const Params& p, int l, int u) {
  const int tid = tid_opaque(), lane = tid & 63, w = tid >> 6, lq = lane & 31, hh = lane >> 5;
  int b, head, qrow_base, qpos0; bool isctx;
  if (u < 1536) { b = u / 192; int rem = u % 192; int blk = rem / 6; head = rem % 6; qpos0 = blk * 128 + w * 32; qrow_base = b * 4096; isctx = false; }
  else { int j = u - 1536; b = j / 12; int rem = j % 12; int qb = rem / 6; head = rem % 6; qpos0 = qb * 128 + w * 32; qrow_base = NLAT + b * 256; isctx = true; }
  const int g = head / 3;
  const size_t qrow = (size_t)qrow_base + qpos0 + lq;
  half8 qf[4];
#pragma unroll
  for (int s = 0; s < 4; ++s) qf[s] = *(const half8*)(p.P + qrow * PC + 3072 + head * 64 + 16 * s + 8 * hh);
  const float sinkv = p.sink[l * 6 + head];
  float m = sinkv, lsum = hh == 0 ? 1.f : 0.f;
  f32x16 O[2];
#pragma unroll
  for (int r = 0; r < 16; ++r) { O[0][r] = 0.f; O[1][r] = 0.f; }
  const h16* vt = p.VT + (size_t)((b * 2 + g) * 64) * VTS;
  int nband = 0, kstart = 0;
  if (!isctx) { kstart = max(0, qpos0 - 128); const int kend = min(4096, qpos0 + 160); nband = (kend - kstart) >> 5; }
  const int ntiles = nband + 8;
  for (int ti = 0; ti < ntiles; ++ti) {
    const bool band = ti < nband;
    const int kt = band ? kstart + ti * 32 : (ti - nband) * 32;
    const size_t krow = band ? (size_t)b * 4096 + kt + lq : (size_t)NLAT + b * 256 + kt + lq;
    const int vidx = band ? kt : 4096 + kt;
    const h16* kp = p.P + krow * PC + 3456 + g * 64 + 8 * hh;
    f32x16 sacc;
#pragma unroll
    for (int r = 0; r < 16; ++r) sacc[r] = 0.f;
#pragma unroll
    for (int s = 0; s < 4; ++s) { half8 kf = *(const half8*)(kp + 16 * s); sacc = __builtin_amdgcn_mfma_f32_32x32x16_f16(kf, qf[s], sacc, 0, 0, 0); }
    float mx = -INFINITY;
#pragma unroll
    for (int r = 0; r < 16; ++r) {
      float sv = sacc[r];
      if (band) { const int dlt = kt + (r & 3) + 8 * (r >> 2) + 4 * hh - (qpos0 + lq); if (dlt > 128 || dlt < -128) sv = -INFINITY; }
      sacc[r] = sv; mx = fmaxf(mx, sv);
    }
    mx = fmaxf(mx, __shfl_xor(mx, 32));
    const float mn = fmaxf(m, mx); const float corr = __expf(m - mn); m = mn;
    float ps = 0.f; half8 pb[2];
#pragma unroll
    for (int r = 0; r < 16; ++r) { const float pv = __expf(sacc[r] - mn); ps += pv; pb[r >> 3][r & 7] = (h16)pv; }
    lsum = lsum * corr + ps;
#pragma unroll
    for (int r = 0; r < 16; ++r) { O[0][r] *= corr; O[1][r] *= corr; }
#pragma unroll
    for (int s2 = 0; s2 < 2; ++s2)
#pragma unroll
      for (int dt = 0; dt < 2; ++dt) {
        const h16* vp = vt + (size_t)(dt * 32 + lq) * VTS + vidx + 16 * s2 + 4 * hh;
        const half4 lo = *(const half4*)vp, hi = *(const half4*)(vp + 8);
        const half8 vf = {lo[0], lo[1], lo[2], lo[3], hi[0], hi[1], hi[2], hi[3]};
        O[dt] = __builtin_amdgcn_mfma_f32_32x32x16_f16(vf, pb[s2], O[dt], 0, 0, 0);
      }
  }
  lsum += __shfl_xor(lsum, 32);
  const float inv = 1.f / lsum;
#pragma unroll
  for (int dt = 0; dt < 2; ++dt)
#pragma unroll
    for (int g4 = 0; g4 < 4; ++g4) {
      const int d0 = dt * 32 + 8 * g4 + 4 * hh;
      const half4 ga = *(const half4*)(p.P + qrow * PC + 3712 + head * 64 + d0);
      half4 o;
#pragma unroll
      for (int j = 0; j < 4; ++j) { const float gv = (float)ga[j]; o[j] = (h16)(O[dt][g4 * 4 + j] * inv * siluf_(gv)); }
      *(half4*)(p.hy + qrow * 1024 + 640 + head * 64 + d0) = o;
    }
}

__device__ __forceinline__ void phase_mix(const Params& p, int l, int bid, int nb, char* smem, int sub) {
  const int nunits = l == 0 ? 1536 + 96 : 1536;
  if (nb >= 640) {
    if (bid < 384) { if (sub & 1) rwkv_chain(p, l, bid, smem); }
    else if (bid < 512) { if (sub & 2) hgrn_chain(p, l, bid - 384, smem); }
    else if (sub & 4) for (int u = bid - 512; u < nunits; u += nb - 512) attn_unit(p, l, u);
  } else {
    for (int it = bid; it < 512 + nunits; it += nb) {
      if (it < 384) rwkv_chain(p, l, it, smem);
      else if (it < 512) hgrn_chain(p, l, it - 384, smem);
      else attn_unit(p, l, it - 512);
      __syncthreads();
    }
  }
}

__device__ __forceinline__ float sum4(const f32x4 v) { return (v[0] + v[1]) + (v[2] + v[3]); }
__device__ __forceinline__ f32x4 h4f(const half4 h) { return (f32x4){(float)h[0], (float)h[1], (float)h[2], (float)h[3]}; }
__device__ __forceinline__ void phase_readout(const Params& p, int l, int bid, int nb, bool dummy) {
  const int tid = tid_opaque(), lane = tid & 63, w = tid >> 6;
  const int nrows = l == 1 ? NLAT : NTOK;
  const int hl = lane >> 4, c4 = (lane & 15) * 4;
#pragma unroll 2
  for (int it = bid * 4 + w; it < nrows * 3; it += nb * 4) {
    const int row = it / 3, q = it - row * 3;
    int t, Tn;
    if (row < NLAT) { t = row & 4095; Tn = 4096; } else { t = (row - NLAT) & 255; Tn = 256; }
    const h16* pr = p.P + (size_t)row * PC;
    h16* yo = p.hy + (size_t)row * 1024;
    h16* yw = dummy ? p.F + (size_t)row * 1536 : yo;
    if (q < 2) {
      const int head = q * 4 + hl; const bool valid = head < 6; const int c = (valid ? head : 5) * 64 + c4;
      const bool hp = t > 0, hn = t + 1 < Tn;
      const f32x4 y = h4f(*(const half4*)(pr + 768 + c)) + h4f(*(const half4*)(yo + c));
      f32x4 sh[3];
#pragma unroll
      for (int k = 0; k < 3; ++k) {
        const int col = (k == 0 ? 0 : (k == 1 ? 384 : 1408)) + c;
        const f32x4 cur = h4f(*(const half4*)(pr + col));
        const f32x4 prv = hp ? h4f(*(const half4*)(pr + col - PC)) : (f32x4){0.f, 0.f, 0.f, 0.f};
        const f32x4 nxt = hn ? h4f(*(const half4*)(pr + col + PC)) : (f32x4){0.f, 0.f, 0.f, 0.f};
        const f32x4 mp = *(const f32x4*)(p.mu_prev + l * 1792 + col), mn = *(const f32x4*)(p.mu_next + l * 1792 + col);
        sh[k] = cur + mp * (prv - cur) + mn * (nxt - cur);
      }
      const f32x4 v = h4f(*(const half4*)(p.VB + (size_t)row * 384 + c));
      const f32x4 gw = *(const f32x4*)(p.gn_w + l * 384 + c), gb = *(const f32x4*)(p.gn_b + l * 384 + c), rk = *(const f32x4*)(p.r_k + l * 384 + c);
      const float mean = red16(sum4(y)) * (1.f / 64.f);
      const f32x4 yc = y - mean;
      const float var = red16(sum4(yc * yc)) * (1.f / 64.f);
      const float rs = rsqrtf(var + 64e-5f);
      const float bs = red16(sum4(sh[0] * sh[1] * rk));
      half4 o;
#pragma unroll
      for (int j = 0; j < 4; ++j) o[j] = (h16)((yc[j] * rs * gw[j] + gb[j] + bs * v[j]) * siluf_(sh[2][j]));
      if (valid) *(half4*)(yw + c) = o;
    } else {
      const int c = hl * 64 + c4;
      const f32x4 o = h4f(*(const half4*)(pr + 1152 + c)) + h4f(*(const half4*)(yo + 384 + c));
      const f32x4 g = h4f(*(const half4*)(pr + 2816 + c));
      const f32x4 nw = *(const f32x4*)(p.hg_norm_w + l * 256 + c);
      const float ms = red16(sum4(o * o)) * (1.f / 64.f);
      const float rs = rsqrtf(ms + 1e-6f);
      half4 ov;
#pragma unroll
      for (int j = 0; j < 4; ++j) ov[j] = (h16)(o[j] * rs * nw[j] * siluf_(g[j]));
      *(half4*)(yw + 384 + c) = ov;
    }
  }
}

__device__ __forceinline__ void phase_final(const Params& p, int bid, int nb) {
  const int tid = tid_opaque(), lane = tid & 63, w = tid >> 6;
  for (int row = bid * 4 + w; row < NLAT; row += nb * 4) {
    float* src = p.out + (size_t)row * 1024;
    f32x4 v[4]; float ss = 0.f;
#pragma unroll
    for (int i = 0; i < 4; ++i) { v[i] = *(const f32x4*)(src + i * 256 + lane * 4); ss += v[i][0] * v[i][0] + v[i][1] * v[i][1] + v[i][2] * v[i][2] + v[i][3] * v[i][3]; }
    ss = wave_sum_dpp(ss);
    const float rs = rsqrtf(ss * (1.f / 1024.f) + 1e-6f);
#pragma unroll
    for (int i = 0; i < 4; ++i) {
      const int col = i * 256 + lane * 4;
      const f32x4 nwv = *(const f32x4*)(p.final_w + col);
      f32x4 o;
#pragma unroll
      for (int j = 0; j < 4; ++j) o[j] = v[i][j] * rs * nwv[j];
      *(f32x4*)(src + col) = o;
    }
  }
}

__global__ void __launch_bounds__(256, 3) __attribute__((target("no-packed-fp32-ops"))) mega(Params p, int ph_lo, int ph_hi, int coop) {
  __shared__ __attribute__((aligned(16))) char smem[SMEM_BYTES];
  __shared__ uint4 xb_words;
  XcdBarrier xb; xb.bar = p.bar; xb.x = 0; xb.st = (volatile LAS unsigned*)&xb_words;
  if (coop) { if (threadIdx.x == 0) xb_words = make_uint4(0u, 0u, 0u, 0u); __syncthreads(); xb = xcd_barrier_post(p.bar, (volatile LAS unsigned*)&xb_words); }
  if (coop) for (int i = 0; i < EXTRA_SYNCS; ++i) { xcd_barrier(xb); }
  if (coop == 2) cg::this_grid().sync();
  for (int ph = ph_lo; ph < ph_hi; ++ph) {
    for (int rep = 0; rep < (((PROBE_MASK >> ph) & 1) ? 2 : 1); ++rep) {
      int bid = blockIdx.x, nb = gridDim.x;
      asm volatile("" : "+s"(bid), "+s"(nb));
      if (ph == 0) phase_prep(p, bid, nb, smem);
      else if (ph == 13) phase_final(p, bid, nb);
      else {
        const int l = (ph - 1) / 6, s = (ph - 1) % 6;
        if (s == 0) phase_norm(p, l, bid, nb);
        else if (s == 1) phase_gemm<0>(p, l, bid, nb, smem);
        else if (s == 2) phase_feat(p, l, bid, nb, smem);
        else if (s == 3) phase_mix(p, l, bid, nb, smem, rep ? PROBE_SUB : 7);
        else if (s == 4) phase_readout(p, l, bid, nb, PROBE_MASK && ((PROBE_MASK >> ph) & 1) && rep == 0);
        else phase_gemm<1>(p, l, bid, nb, smem);
      }
      if (PROBE_MASK && rep == 0 && ((PROBE_MASK >> ph) & 1)) { xcd_barrier(xb); }
    }
    if (coop && ph + 1 < ph_hi) { xcd_barrier(xb); }
  }
}

extern "C" void kernel_launch(void* const* d_in, const int* in_sizes, int n_in, void* d_out, int out_size, void* d_ws, size_t ws_size, hipStream_t stream) {
  static int grid_blocks = 0;
  if (!grid_blocks) {
    int dev = 0, cus = 0, per_cu = 0;
    hipGetDevice(&dev);
    hipDeviceGetAttribute(&cus, hipDeviceAttributeMultiprocessorCount, dev);
    hipOccupancyMaxActiveBlocksPerMultiprocessor(&per_cu, mega, 256, 0);
    if (per_cu < 1) per_cu = 1;
    grid_blocks = cus * per_cu;
  }
  Params p{};
  const float* const* in = (const float* const*)d_in;
  p.x = in[0]; p.c = in[1]; p.ctx = in[2]; p.c_ctx = in[3]; p.mod_w = in[4]; p.mod_b = in[5]; p.norm_w = in[6]; p.w_in = in[7]; p.w_out = in[8];
  p.mu_prev = in[9]; p.mu_next = in[10]; p.w0 = in[11]; p.w2 = in[12]; p.a0 = in[13]; p.a2 = in[14]; p.k_k = in[15]; p.k_a = in[16]; p.r_k = in[17];
  p.gn_w = in[18]; p.gn_b = in[19]; p.vw1 = in[20]; p.vw2 = in[21]; p.vb = in[22]; p.lb_logits = in[23]; p.hg_norm_w = in[24]; p.sink = in[25]; p.final_w = in[26];
  p.out = (float*)d_out;
  char* ws = (char*)d_ws; size_t off = 0;
  auto take = [&](size_t bytes) { char* r = ws + off; off += (bytes + 255) & ~(size_t)255; return r; };
  p.win_t = (h16*)take((size_t)2 * NPAD * 1024 * 2);
  p.wout_t = (h16*)take((size_t)2 * 1024 * 1024 * 2);
  p.wl_t = (h16*)take((size_t)2 * 4 * 384 * 64 * 2);
  p.mod = (float*)take((size_t)2 * 9 * 3072 * 4);
  p.rope = (float*)take((size_t)64 * 16 * 2 * 4);
  p.hy = (h16*)take((size_t)NTOK * 1024 * 2);
  p.P = (h16*)take((size_t)NTOK * PC * 2);
  p.F = (h16*)take((size_t)NTOK * 1536 * 2);
  p.VB = (h16*)take((size_t)NTOK * 384 * 2);
  p.VT = (h16*)take((size_t)16 * 64 * VTS * 2);
  p.xc1 = (float*)take((size_t)2048 * 1024 * 4);
  p.bar = (unsigned*)take(16384);
  if (off > ws_size) fprintf(stderr, "workspace too small: need %zu have %zu\n", off, ws_size);
#if SINGLE_LAUNCH
  hipMemsetAsync(p.bar, 0, 16384, stream);
  int lo = 0, hi = 14, coop = 1;
  void* args[] = {&p, &lo, &hi, &coop};
  hipError_t e = hipLaunchCooperativeKernel((void*)mega, dim3(grid_blocks), dim3(256), args, 0, stream);
  if (e != hipSuccess) fprintf(stderr, "cooperative launch failed: %s (grid %d)\n", hipGetErrorString(e), grid_blocks);
#else
  for (int ph = 0; ph < 14; ++ph) mega<<<grid_blocks, 256, 0, stream>>>(p, ph, ph + 1, 0);
#endif
}
```

```cpp
#include <hip/hip_runtime.h>
#include <hip/hip_cooperative_groups.h>
#include <cstdio>
#include <cstdint>
namespace cg = cooperative_groups;

typedef _Float16 h16;
typedef _Float16 half8 __attribute__((ext_vector_type(8)));
typedef _Float16 half4 __attribute__((ext_vector_type(4)));
typedef float f32x16 __attribute__((ext_vector_type(16)));
typedef float f32x4 __attribute__((ext_vector_type(4)));
typedef float f32x2 __attribute__((ext_vector_type(2)));
typedef unsigned u32x4 __attribute__((ext_vector_type(4)));
typedef _Float16 half2v __attribute__((ext_vector_type(2)));

constexpr int NLAT = 32768, NTOK = 34816;
constexpr int PC = 4160;
constexpr int NPAD = 4224;
constexpr int VTS = 4352;
constexpr int SMEM_BYTES = 49152;

#ifndef EXTRA_SYNCS
#define EXTRA_SYNCS 0
#endif
#ifndef PROBE_SUB
#define PROBE_SUB 7
#endif
#ifndef PROBE_MASK
#define PROBE_MASK 0
#endif
#ifndef SINGLE_LAUNCH
#define SINGLE_LAUNCH 1
#endif

struct Params {
  const float *x, *c, *ctx, *c_ctx, *mod_w, *mod_b, *norm_w, *w_in, *w_out;
  const float *mu_prev, *mu_next, *w0, *w2, *a0, *a2, *k_k, *k_a, *r_k, *gn_w, *gn_b;
  const float *vw1, *vw2, *vb, *lb_logits, *hg_norm_w, *sink, *final_w;
  float* out;
  h16 *win_t, *wout_t, *wl_t;
  float* mod;
  h16 *hy, *P, *F, *VB;
  h16* VT;
  float* xc1;
  float* rope;
  unsigned* bar;
};

__device__ __forceinline__ int tid_opaque() { int t = threadIdx.x; asm volatile("" : "+v"(t)); return t; }
__device__ __forceinline__ float wave_sum(float v) {
#pragma unroll
  for (int o = 32; o > 0; o >>= 1) v += __shfl_xor(v, o);
  return v;
}
__device__ __forceinline__ float sigmoidf_(float x) { return 1.f / (1.f + __expf(-x)); }
__device__ __forceinline__ float siluf_(float x) { return x / (1.f + __expf(-x)); }
template <int CTRL> __device__ __forceinline__ float dpp_mov(float x) {
  return __int_as_float(__builtin_amdgcn_update_dpp(0, __float_as_int(x), CTRL, 0xf, 0xf, true));
}
__device__ __forceinline__ float wave_sum_dpp(float x) {
  x += dpp_mov<0xB1>(x);
  x += dpp_mov<0x4E>(x);
  x += dpp_mov<0x141>(x);
  x += dpp_mov<0x140>(x);
  const int xi = __float_as_int(x);
  return __int_as_float(__builtin_amdgcn_readlane(xi, 0)) + __int_as_float(__builtin_amdgcn_readlane(xi, 16)) +
         __int_as_float(__builtin_amdgcn_readlane(xi, 32)) + __int_as_float(__builtin_amdgcn_readlane(xi, 48));
}
__device__ __forceinline__ float red8(float x) {
  x += dpp_mov<0xB1>(x);
  x += dpp_mov<0x4E>(x);
  x += dpp_mov<0x141>(x);
  return x;
}

#define XB_TMO      128
#define XB_XCNT(j)  (256  + 64 * (j))
#define XB_XSUB(j)  (1280 + 64 * (j))
#define XB_XGEN(j)  (2304 + 64 * (j))
#define XB_TOP      3328
#define XB_TOPGEN   3392
#define XCD_BAR_WORDS 3456
#define XB_SPIN_CAP (1u << 18)
#define LAS __attribute__((address_space(3)))
__device__ __forceinline__ unsigned xb_ld(unsigned* p)              { return __hip_atomic_load(p, __ATOMIC_RELAXED, __HIP_MEMORY_SCOPE_AGENT); }
__device__ __forceinline__ unsigned xb_add(unsigned* p, unsigned v) { return __hip_atomic_fetch_add(p, v, __ATOMIC_RELAXED, __HIP_MEMORY_SCOPE_AGENT); }
__device__ __forceinline__ unsigned xb_xcc_id() { return (unsigned)__builtin_amdgcn_s_getreg((3 << 11) | 20) & 0xFu; }
#define XB_SPIN(cond, bar) do { unsigned _sp = 0; while (cond) { __builtin_amdgcn_s_sleep(1); \
    if ((++_sp & 255u) == 0u) { if (xb_ld(&(bar)[XB_TMO])) break; if (_sp > XB_SPIN_CAP) { atomicAdd(&(bar)[XB_TMO], 1u); break; } } } } while (0)
struct XcdBarrier { unsigned* bar; unsigned x; volatile LAS unsigned* st; };
__device__ __forceinline__ XcdBarrier xcd_barrier_post(unsigned* bar, volatile LAS unsigned* st) {
  XcdBarrier b; b.bar = bar; b.x = xb_xcc_id(); b.st = st;
  if (threadIdx.x == 0) (void)xb_add(&bar[XB_XCNT(b.x)], 1u);
  return b;
}
__device__ __forceinline__ void xcd_barrier_complete(unsigned* bar, unsigned x, unsigned& nloc, unsigned& nx) {
  const unsigned G = gridDim.x * gridDim.y * gridDim.z;
  unsigned sum, cnt, mine, sp = 0u;
  for (;;) {
    sum = 0u; cnt = 0u; mine = 0u;
#pragma unroll
    for (unsigned j = 0; j < 16; ++j) { const unsigned c = xb_ld(&bar[XB_XCNT(j)]); sum += c; cnt += (c > 0u) ? 1u : 0u; mine = (j == x) ? c : mine; }
    if (sum == G) break;
    __builtin_amdgcn_s_sleep(1);
    if ((++sp & 255u) == 0u) { if (xb_ld(&bar[XB_TMO])) break; if (sp > XB_SPIN_CAP) { atomicAdd(&bar[XB_TMO], 1u); break; } }
  }
  nloc = mine > 0u ? mine : 1u; nx = cnt > 0u ? cnt : 1u;
}
__device__ __forceinline__ void xcd_barrier(const XcdBarrier& b) {
  asm volatile("s_waitcnt vmcnt(0)" ::: "memory");
  __syncthreads();
  if (threadIdx.x == 0) {
    unsigned* bar = b.bar;
    __builtin_amdgcn_s_waitcnt(0);
    unsigned nloc = b.st[0], nx = b.st[1];
    if (nloc == 0u) { xcd_barrier_complete(bar, b.x, nloc, nx); b.st[0] = nloc; b.st[1] = nx; }
    const unsigned old = xb_add(&bar[XB_XSUB(b.x)], 1u);
    const unsigned gen = old / nloc;
    if (old + 1u == (gen + 1u) * nloc) {
      __builtin_amdgcn_fence(__ATOMIC_RELEASE, "agent");
      asm volatile("s_waitcnt vmcnt(0)" ::: "memory");
      const unsigned og = xb_add(&bar[XB_TOP], 1u);
      const unsigned tg = og / nx;
      if (og + 1u == (tg + 1u) * nx) xb_add(&bar[XB_TOPGEN], 1u);
      else XB_SPIN(xb_ld(&bar[XB_TOPGEN]) == tg, bar);
      __builtin_amdgcn_fence(__ATOMIC_ACQUIRE, "agent");
      xb_add(&bar[XB_XGEN(b.x)], 1u);
      asm volatile("s_waitcnt vmcnt(0)" ::: "memory");
    } else {
      XB_SPIN(xb_ld(&bar[XB_XGEN(b.x)]) == gen, bar);
      __builtin_amdgcn_fence(__ATOMIC_ACQUIRE, "agent");
      asm volatile("s_waitcnt vmcnt(0)" ::: "memory");
    }
  }
  __syncthreads();
}

__device__ __forceinline__ void phase_prep(const Params& p, int bid, int nb, char* smem) {
  const int tid = tid_opaque();
  float* sf = (float*)smem;
  constexpr int N_WIN = 2048, N_WOUT = 512, N_MOD = 192, N_PADI = 1024, N_WL = 768;
  constexpr int total = N_WIN + N_WOUT + N_MOD + N_PADI + N_WL + 1;
  for (int it = bid; it < total; it += nb) {
    if (it < N_WIN + N_WOUT) {
      const float* src; h16* dst; int ncols, kt, ntile;
      if (it < N_WIN) { int l = it >> 10, r = it & 1023; kt = r >> 6; ntile = r & 63; src = p.w_in + (size_t)l * 1024 * 4096; dst = p.win_t + (size_t)l * NPAD * 1024; ncols = 4096; }
      else { int j = it - N_WIN; int l = j >> 8, r = j & 255; kt = r >> 4; ntile = r & 15; src = p.w_out + (size_t)l * 1024 * 1024; dst = p.wout_t + (size_t)l * 1024 * 1024; ncols = 1024; }
      for (int i = tid; i < 4096; i += 256) { int kk = i >> 6, nn = i & 63; sf[kk * 65 + nn] = src[(size_t)(kt * 64 + kk) * ncols + ntile * 64 + nn]; }
      __syncthreads();
      const bool rkperm = it < N_WIN && ntile < 12;
      for (int i = tid; i < 4096; i += 256) {
        int nn = i >> 6, kk = i & 63;
        const int nrow = rkperm ? ((ntile % 6) * 128 + 2 * nn + ntile / 6) : (ntile * 64 + nn);
        dst[(size_t)nrow * 1024 + kt * 64 + kk] = (h16)sf[kk * 65 + nn];
      }
      __syncthreads();
    } else if (it < N_WIN + N_WOUT + N_MOD) {
      const int j = it - N_WIN - N_WOUT; const int l = j / 96; const int cl = tid & 31, ks = tid >> 5; const int col = (j % 96) * 32 + cl;
      for (int i = tid; i < 9 * 1024; i += 256) { int r = i >> 10, k = i & 1023; float v = r < 8 ? p.c[r * 1024 + k] : p.c_ctx[k]; sf[i] = siluf_(v); }
      __syncthreads();
      float acc[9];
#pragma unroll
      for (int r = 0; r < 9; ++r) acc[r] = 0.f;
      const float* mw = p.mod_w + (size_t)l * 1024 * 3072 + (size_t)(ks * 128) * 3072 + col;
#pragma unroll 2
      for (int k = 0; k < 128; k += 4) {
        const float w0 = mw[(size_t)k * 3072], w1 = mw[(size_t)(k + 1) * 3072], w2 = mw[(size_t)(k + 2) * 3072], w3 = mw[(size_t)(k + 3) * 3072];
#pragma unroll
        for (int r = 0; r < 9; ++r) { const f32x4 sv = *(const f32x4*)&sf[r * 1024 + ks * 128 + k]; acc[r] += sv[0] * w0 + sv[1] * w1 + sv[2] * w2 + sv[3] * w3; }
      }
#pragma unroll
      for (int r = 0; r < 9; ++r) acc[r] += __shfl_xor(acc[r], 32);
      __syncthreads();
      if ((tid & 63) < 32) {
#pragma unroll
        for (int r = 0; r < 9; ++r) sf[((tid >> 6) * 9 + r) * 32 + cl] = acc[r];
      }
      __syncthreads();
      for (int i = tid; i < 288; i += 256) {
        const int r = i >> 5, c2 = i & 31;
        const float v = sf[(0 * 9 + r) * 32 + c2] + sf[(1 * 9 + r) * 32 + c2] + sf[(2 * 9 + r) * 32 + c2] + sf[(3 * 9 + r) * 32 + c2];
        const int cc = (j % 96) * 32 + c2;
        p.mod[(size_t)(l * 9 + r) * 3072 + cc] = v + p.mod_b[l * 3072 + cc];
      }
      __syncthreads();
    } else if (it < N_WIN + N_WOUT + N_MOD + N_PADI) {
      int j = it - (N_WIN + N_WOUT + N_MOD); int idx = j * 256 + tid;
      int l = idx >> 17; int rem = idx & 131071; int m = rem >> 10, k = rem & 1023;
      float v = (l == 1 && m < 32) ? p.vw1[k * 32 + m] : 0.f;
      p.win_t[(size_t)l * NPAD * 1024 + (size_t)(4096 + m) * 1024 + k] = (h16)v;
    } else if (it < N_WIN + N_WOUT + N_MOD + N_PADI + N_WL) {
      const int idx = (it - (N_WIN + N_WOUT + N_MOD + N_PADI)) * 256 + tid;
      const int r = idx & 63, c = (idx >> 6) % 384, ls = idx / (384 * 64); const int l = ls >> 2, slot = ls & 3, dir = slot & 1, kind = slot >> 1;
      const float v = (kind == 0 ? p.w2 : p.a2)[((size_t)(l * 2 + dir) * 64 + r) * 384 + c];
      p.wl_t[idx] = (h16)v;
    } else {
      if (tid < 16) {
        double inv = 1.0; for (int i = 0; i < tid; ++i) inv *= 0.5623413251903491;
        double x2 = inv * inv, ts = inv, tc = 1.0, s1 = inv, c1 = 1.0;
        for (int n = 1; n <= 10; ++n) { tc *= -x2 / ((2.0 * n - 1.0) * (2.0 * n)); c1 += tc; ts *= -x2 / ((2.0 * n) * (2.0 * n + 1.0)); s1 += ts; }
        double cc = 1.0, ss = 0.0;
        for (int pos = 0; pos < 64; ++pos) {
          p.rope[(pos * 16 + tid) * 2] = (float)cc; p.rope[(pos * 16 + tid) * 2 + 1] = (float)ss;
          double nc = cc * c1 - ss * s1, ns = ss * c1 + cc * s1; cc = nc; ss = ns;
        }
      }
    }
  }
}

__device__ __forceinline__ void phase_norm(const Params& p, int l, int bid, int nb) {
  const int tid = tid_opaque(), lane = tid & 63, w = tid >> 6;
  for (int row = bid * 4 + w; row < NTOK; row += nb * 4) {
    const float* src = (l == 0) ? (row < NLAT ? p.x + (size_t)row * 1024 : p.ctx + (size_t)(row - NLAT) * 1024)
                                : (row < NLAT ? p.out + (size_t)row * 1024 : p.xc1 + (size_t)(row - NLAT) * 1024);
    const int mr = row < NLAT ? (row >> 12) : 8;
    const float* md = p.mod + (size_t)(l * 9 + mr) * 3072;
    const float* nw = p.norm_w + l * 1024;
    f32x4 v[4]; float ss = 0.f;
#pragma unroll
    for (int i = 0; i < 4; ++i) { v[i] = *(const f32x4*)(src + i * 256 + lane * 4); ss += v[i][0] * v[i][0] + v[i][1] * v[i][1] + v[i][2] * v[i][2] + v[i][3] * v[i][3]; }
    ss = wave_sum_dpp(ss);
    const float rs = rsqrtf(ss * (1.f / 1024.f) + 1e-6f);
#pragma unroll
    for (int i = 0; i < 4; ++i) {
      const int col = i * 256 + lane * 4;
      f32x4 nwv = *(const f32x4*)(nw + col), sc = *(const f32x4*)(md + 1024 + col), sh = *(const f32x4*)(md + col);
      half4 o;
#pragma unroll
      for (int j = 0; j < 4; ++j) o[j] = (h16)(v[i][j] * rs * nwv[j] * (1.f + sc[j]) + sh[j]);
      *(half4*)(p.hy + (size_t)row * 1024 + col) = o;
    }
  }
}

template <int MODE>
__device__ __forceinline__ void phase_gemm(const Params& p, int l, int bid, int nb, char* smem) {
  const h16* A = p.hy;
  const h16* Bt = MODE == 0 ? p.win_t + (size_t)l * NPAD * 1024 : p.wout_t + (size_t)l * 1024 * 1024;
  const int ntn = MODE == 0 ? (l == 1 ? 33 : 32) : 8;
  const int ntm = (MODE == 1 && l == 1) ? 256 : 272;
  const int tid = tid_opaque(), lane = tid & 63, w = tid >> 6, wr = w >> 1, wc = w & 1, lq = lane & 31, hh = lane >> 5;
  h16* As = (h16*)smem; h16* Bs = As + 128 * 72;
  const int ldrow = tid >> 3, ldch = (tid & 7) * 8;
  for (int tile = bid; tile < ntm * ntn; tile += nb) {
    int tm, tn;
    {
      const int mper = ntm >> 3;
      const int nmain = MODE == 0 ? 32 : 8;
      if (tile < ntm * nmain) {
        const int x = tile & 7, sq = tile >> 3;
        const int strip = sq / (mper * 8), rem = sq - strip * (mper * 8);
        tm = x * mper + (rem >> 3); tn = strip * 8 + (rem & 7);
      } else { tm = tile - ntm * nmain; tn = nmain; }
    }
    const h16* Ag = A + (size_t)(tm * 128 + ldrow) * 1024 + ldch; const h16* Bg = Bt + (size_t)(tn * 128 + ldrow) * 1024 + ldch;
    f32x16 acc[2][2];
#pragma unroll
    for (int i = 0; i < 2; ++i)
#pragma unroll
      for (int j = 0; j < 2; ++j)
#pragma unroll
        for (int r = 0; r < 16; ++r) acc[i][j][r] = 0.f;
    u32x4 ra[4], rb[4];
#pragma unroll
    for (int i = 0; i < 4; ++i) { ra[i] = *(const u32x4*)(Ag + (size_t)i * 32 * 1024); rb[i] = *(const u32x4*)(Bg + (size_t)i * 32 * 1024); }
#pragma unroll 1
    for (int kt = 0; kt < 16; ++kt) {
      __syncthreads();
#pragma unroll
      for (int i = 0; i < 4; ++i) { *(u32x4*)(As + (ldrow + i * 32) * 72 + ldch) = ra[i]; *(u32x4*)(Bs + (ldrow + i * 32) * 72 + ldch) = rb[i]; }
      __syncthreads();
      if (kt + 1 < 16) {
#pragma unroll
        for (int i = 0; i < 4; ++i) { ra[i] = *(const u32x4*)(Ag + (size_t)i * 32 * 1024 + (kt + 1) * 64); rb[i] = *(const u32x4*)(Bg + (size_t)i * 32 * 1024 + (kt + 1) * 64); }
      }
#pragma unroll
      for (int s = 0; s < 4; ++s) {
        half8 a[2], b[2];
#pragma unroll
        for (int i = 0; i < 2; ++i) { a[i] = *(const half8*)(As + (64 * wr + 32 * i + lq) * 72 + 16 * s + 8 * hh); b[i] = *(const half8*)(Bs + (64 * wc + 32 * i + lq) * 72 + 16 * s + 8 * hh); }
#pragma unroll
        for (int i = 0; i < 2; ++i)
#pragma unroll
          for (int j = 0; j < 2; ++j) {
            if (MODE == 0) acc[i][j] = __builtin_amdgcn_mfma_f32_32x32x16_f16(b[j], a[i], acc[i][j], 0, 0, 0);
            else acc[i][j] = __builtin_amdgcn_mfma_f32_32x32x16_f16(a[i], b[j], acc[i][j], 0, 0, 0);
          }
      }
    }
    if (MODE == 0) {
      if (tn < 32) {
        __syncthreads();
        h16* Cs = (h16*)smem;
#pragma unroll
        for (int i = 0; i < 2; ++i)
#pragma unroll
          for (int j = 0; j < 2; ++j)
#pragma unroll
            for (int g = 0; g < 4; ++g) {
              half4 o;
#pragma unroll
              for (int q = 0; q < 4; ++q) o[q] = (h16)acc[i][j][4 * g + q];
              *(half4*)(Cs + (64 * wr + 32 * i + lq) * 136 + 64 * wc + 32 * j + 8 * g + 4 * hh) = o;
            }
        __syncthreads();
#pragma unroll
        for (int q = 0; q < 8; ++q) {
          const int id = tid + q * 256; const int row = id >> 4, ch = id & 15;
          *(u32x4*)(p.P + (size_t)(tm * 128 + row) * PC + tn * 128 + ch * 8) = *(const u32x4*)(Cs + row * 136 + ch * 8);
        }
      } else if (wc == 0) {
#pragma unroll
        for (int i = 0; i < 2; ++i)
#pragma unroll
          for (int r = 0; r < 16; ++r) ((float*)(p.F + (size_t)(tm * 128 + 64 * wr + 32 * i + lq) * 1536))[(r & 3) + 8 * (r >> 2) + 4 * hh] = acc[i][0][r];
      }
    } else {
      const int row0 = tm * 128;
      const int mr = row0 < NLAT ? (row0 >> 12) : 8;
      const int col = tn * 128 + 64 * wc + lq;
      const float* gp = p.mod + (size_t)(l * 9 + mr) * 3072 + 2048 + col;
      const float g0 = gp[0], g1 = gp[32];
      const float* xs0; float* xd0;
      if (l == 0) { if (row0 < NLAT) { xs0 = p.x + (size_t)row0 * 1024; xd0 = p.out + (size_t)row0 * 1024; } else { xs0 = p.ctx + (size_t)(row0 - NLAT) * 1024; xd0 = p.xc1 + (size_t)(row0 - NLAT) * 1024; } }
      else { xs0 = p.out + (size_t)row0 * 1024; xd0 = p.out + (size_t)row0 * 1024; }
      const float* __restrict__ xsrc = xs0 + (size_t)(64 * wr + 4 * hh) * 1024 + col;
      float* __restrict__ xdst = xd0 + (size_t)(64 * wr + 4 * hh) * 1024 + col;
#pragma unroll
      for (int i = 0; i < 2; ++i)
#pragma unroll
        for (int r = 0; r < 16; ++r) {
          const int ro = (32 * i + (r & 3) + 8 * (r >> 2)) * 1024;
          xdst[ro] = xsrc[ro] + g0 * acc[i][0][r];
          xdst[ro + 32] = xsrc[ro + 32] + g1 * acc[i][1][r];
        }
    }
  }
}

#define LOAD_COL34(arr, base, t0, Tn) \
  _Pragma("unroll") for (int q_ = 0; q_ < 34; ++q_) { const int t_ = (t0) - 1 + q_; arr[q_] = (t_ >= 0 && t_ < (Tn)) ? (base)[(long)t_ * PC] : (h16)0.f; }

__device__ __forceinline__ void phase_feat(const Params& p, int l, int bid, int nb, char* smem, bool dry) {
  const int tid = tid_opaque();
  h16* inh = (h16*)smem;
  float* zt = (float*)(smem + 32 * 264 * 2);
  for (int item = bid; item < 1088; item += nb) {
    int b, t0, Tn, rowbase; bool isctx;
    if (item < 1024) { b = item >> 7; t0 = (item & 127) * 32; Tn = 4096; rowbase = b * 4096; isctx = false; }
    else { int j = item - 1024; b = j >> 3; t0 = (j & 7) * 32; Tn = 256; rowbase = NLAT + b * 256; isctx = true; }
    {
      const int col = 1152 + tid;
      const float mp = p.mu_prev[l * 1792 + col], mn = p.mu_next[l * 1792 + col];
      const h16* base = p.P + (size_t)rowbase * PC + col;
      h16 xv[34];
      LOAD_COL34(xv, base, t0, Tn)
#pragma unroll
      for (int tt = 0; tt < 32; ++tt) {
        const float prev = (float)xv[tt], cur = (float)xv[tt + 1], nxt = (float)xv[tt + 2];
        float sv = cur + mp * (prev - cur) + mn * (nxt - cur);
        if (tid < 128) { const float e2 = __expf(2.f * sv); sv = 1.f - 2.f / (e2 + 1.f); }
        inh[tt * 264 + tid] = (h16)sv;
      }
      if (l == 1) {
#pragma unroll
        for (int i = 0; i < 4; ++i) { int id = tid + i * 256; zt[id] = ((const float*)(p.F + (size_t)(rowbase + t0 + (id >> 5)) * 1536))[id & 31]; }
      }
    }
    __syncthreads();
#pragma unroll 1
    for (int c = tid; c < 384; c += 256) {
      const int col = 768 + c;
      const float mp = p.mu_prev[l * 1792 + col], mn = p.mu_next[l * 1792 + col];
      const h16* base = p.P + (size_t)rowbase * PC + col;
      h16 xv[34];
      LOAD_COL34(xv, base, t0, Tn)
      h16* dst = p.VB + (size_t)(rowbase + t0) * 384 + c;
      if (l == 0) {
#pragma unroll
        for (int tt = 0; tt < 32; ++tt) {
          const float prev = (float)xv[tt], cur = (float)xv[tt + 1], nxt = (float)xv[tt + 2];
          dst[tt * 384] = (h16)(cur + mp * (prev - cur) + mn * (nxt - cur));
        }
      } else {
        const float vbv = p.vb[c];
#pragma unroll 1
        for (int hf = 0; hf < 2; ++hf) {
          h16 vfv[16]; float ga[16];
#pragma unroll
          for (int tt = 0; tt < 16; ++tt) { vfv[tt] = dst[(hf * 16 + tt) * 384]; ga[tt] = vbv; }
#pragma unroll 1
          for (int m = 0; m < 32; m += 4) {
            const float w0 = p.vw2[m * 384 + c], w1 = p.vw2[(m + 1) * 384 + c], w2 = p.vw2[(m + 2) * 384 + c], w3 = p.vw2[(m + 3) * 384 + c];
#pragma unroll
            for (int tt = 0; tt < 16; ++tt) { const f32x4 z = *(const f32x4*)&zt[(hf * 16 + tt) * 32 + m]; ga[tt] += z[0] * w0 + z[1] * w1 + z[2] * w2 + z[3] * w3; }
          }
#pragma unroll
          for (int tt = 0; tt < 16; ++tt) {
            const float prev = hf ? (float)xv[16 + tt] : (float)xv[tt], cur = hf ? (float)xv[17 + tt] : (float)xv[tt + 1], nxt = hf ? (float)xv[18 + tt] : (float)xv[tt + 2];
            const float sv = cur + mp * (prev - cur) + mn * (nxt - cur);
            dst[(hf * 16 + tt) * 384] = (h16)(sv + ((float)vfv[tt] - sv) * sigmoidf_(ga[tt]));
          }
        }
      }
    }
    {
      const int w = tid >> 6, lane = tid & 63, lq = tid & 31, hh = lane >> 5;
      const int dir = w & 1, chalf = w >> 1;
      half8 xin[2][4];
#pragma unroll
      for (int kind = 0; kind < 2; ++kind)
#pragma unroll
        for (int ks = 0; ks < 4; ++ks) xin[kind][ks] = *(const half8*)(inh + lq * 264 + kind * 128 + dir * 64 + 16 * ks + 8 * hh);
      h16* ost = (h16*)(smem + 32 * 264 * 2 + 4096) + w * (32 * 72);
      h16* fbase = p.F + (size_t)(rowbase + t0) * 1536 + dir * 768 + chalf * 384;
#pragma unroll 1
      for (int np = 0; np < 6; ++np) {
        const int c0 = chalf * 192 + np * 32;
        f32x16 acc[2];
#pragma unroll
        for (int kind = 0; kind < 2; ++kind) {
          const float* bias = (kind == 0 ? p.w0 : p.a0) + (l * 2 + dir) * 384 + c0;
          const h16* wl = p.wl_t + (size_t)((l * 4 + kind * 2 + dir) * 384 + c0) * 64;
#pragma unroll
          for (int g = 0; g < 4; ++g) { const f32x4 bv = *(const f32x4*)(bias + 8 * g + 4 * hh); acc[kind][4 * g] = bv[0]; acc[kind][4 * g + 1] = bv[1]; acc[kind][4 * g + 2] = bv[2]; acc[kind][4 * g + 3] = bv[3]; }
#pragma unroll
          for (int ks = 0; ks < 4; ++ks) {
            const half8 wf = *(const half8*)(wl + (size_t)lq * 64 + 16 * ks + 8 * hh);
            acc[kind] = __builtin_amdgcn_mfma_f32_32x32x16_f16(wf, xin[kind][ks], acc[kind], 0, 0, 0);
          }
        }
#pragma unroll
        for (int g = 0; g < 4; ++g) {
          half8 o;
#pragma unroll
          for (int j = 0; j < 4; ++j) { o[2 * j] = (h16)(0.6065306597126334f * sigmoidf_(acc[0][4 * g + j])); o[2 * j + 1] = (h16)sigmoidf_(acc[1][4 * g + j]); }
          *(half8*)(ost + lq * 72 + 16 * g + 8 * hh) = o;
        }
        asm volatile("s_waitcnt lgkmcnt(0)" ::: "memory");
#pragma unroll
        for (int q = 0; q < 4; ++q) {
          const int id = lane + q * 64; const int rr = id >> 3, ch = id & 7;
          *(u32x4*)(fbase + (size_t)rr * 1536 + np * 64 + ch * 8) = *(const u32x4*)(ost + rr * 72 + ch * 8);
        }
        asm volatile("s_waitcnt lgkmcnt(0)" ::: "memory");
      }
    }
    {
      const int head = tid >> 5, pr = tid & 31, half = pr >> 4, i = pr & 15;
      const int colbase = head < 6 ? 3072 + head * 64 : 3456 + (head - 6) * 64;
      const int d1 = half * 32 + i;
      const float qs = (head < 6 && !dry) ? 0.125f : 1.f;
      h16* pp = p.P + (size_t)(rowbase + t0) * PC + colbase + d1;
#pragma unroll
      for (int tq = 0; tq < 32; tq += 8) {
        h16 x1[8], x2[8];
#pragma unroll
        for (int u = 0; u < 8; ++u) { x1[u] = pp[(size_t)(tq + u) * PC]; x2[u] = pp[(size_t)(tq + u) * PC + 16]; }
#pragma unroll
        for (int u = 0; u < 8; ++u) {
          const int t = t0 + tq + u;
          float cs = 1.f, sn = 0.f;
          if (!isctx && !dry) { const int pos = half == 0 ? (t >> 6) : (t & 63); const f32x2 r2 = *(const f32x2*)&p.rope[(pos * 16 + i) * 2]; cs = r2[0]; sn = r2[1]; }
          const float a = (float)x1[u], bq = (float)x2[u];
          pp[(size_t)(tq + u) * PC] = (h16)((a * cs - bq * sn) * qs);
          pp[(size_t)(tq + u) * PC + 16] = (h16)((a * sn + bq * cs) * qs);
        }
      }
    }
    if (tid < 128) {
      const int g = tid >> 6, d = tid & 63;
      const h16* base = p.P + (size_t)(rowbase + t0) * PC + 3584 + tid;
      h16* dst = p.VT + (size_t)((b * 2 + g) * 64 + d) * VTS + (isctx ? 4096 + t0 : t0);
      half8 v[4];
#pragma unroll
      for (int q = 0; q < 4; ++q)
#pragma unroll
        for (int j = 0; j < 8; ++j) v[q][j] = base[(size_t)(q * 8 + j) * PC];
#pragma unroll
      for (int q = 0; q < 4; ++q) *(half8*)(dst + q * 8) = v[q];
    }
    __syncthreads();
  }
}

__device__ __forceinline__ float ulo(unsigned u) { return (float)__builtin_bit_cast(h16, (unsigned short)(u & 0xffffu)); }
__device__ __forceinline__ float uhi(unsigned u) { return (float)__builtin_bit_cast(h16, (unsigned short)(u >> 16)); }
__device__ __forceinline__ float red16(float x) {
  x += dpp_mov<0xB1>(x);
  x += dpp_mov<0x4E>(x);
  x += dpp_mov<0x141>(x);
  x += dpp_mov<0x140>(x);
  return x;
}
#define LDS_BARRIER() do { asm volatile("s_waitcnt lgkmcnt(0)" ::: "memory"); __builtin_amdgcn_s_barrier(); asm volatile("" ::: "memory"); } while (0)
constexpr int RREC = 336;
struct RwkvPf { unsigned rk[10]; h16 v[8]; unsigned ea[8]; };

__device__ __forceinline__ void rwkv_chain(const Params& p, int l, int item, char* smem) {
  const int tid = tid_opaque(), lane = tid & 63, w = tid >> 6;
  const int chain = item >> 2, vq = item & 3;
  const int dir = chain / 48, b = (chain % 48) / 6, h = chain % 6;
  float* opb = (float*)smem;
  float* ybuf = opb + 2 * 16 * RREC;
  constexpr int NCH = 272;
  if (w < 2) {
    const int rl = tid >> 3, kq = tid & 7;
    float S[8];
#pragma unroll
    for (int j = 0; j < 8; ++j) S[j] = 0.f;
    __builtin_amdgcn_s_setprio(3);
    LDS_BARRIER();
#pragma unroll 1
    for (int ci = 0; ci < NCH; ++ci) {
      const float* op = opb + (ci & 1) * 16 * RREC;
      float* yb = ybuf + (ci & 1) * 256;
      f32x4 aA = *(const f32x4*)(op + 8 * kq + 64), aB = *(const f32x4*)(op + 8 * kq + 68);
#pragma unroll
      for (int step = 0; step < 16; ++step) {
        const float* o = op + step * RREC + 8 * kq;
        const f32x4 wA = *(const f32x4*)(o), wB = *(const f32x4*)(o + 4);
        const f32x4 bA = *(const f32x4*)(o + 128), bB = *(const f32x4*)(o + 132);
        const f32x4 kA = *(const f32x4*)(o + 192), kB = *(const f32x4*)(o + 196);
        const f32x4 rA = *(const f32x4*)(o + 256), rB = *(const f32x4*)(o + 260);
        const float vv = op[step * RREC + 320 + rl];
        f32x4 naA = aA, naB = aB;
        if (step + 1 < 16) { naA = *(const f32x4*)(o + RREC + 64); naB = *(const f32x4*)(o + RREC + 68); }
        const float d0 = S[0] * aA[0] + S[1] * aA[1] + S[2] * aA[2] + S[3] * aA[3];
        const float d1 = S[4] * aB[0] + S[5] * aB[1] + S[6] * aB[2] + S[7] * aB[3];
        const float sa = red8(d0 + d1);
#pragma unroll
        for (int j = 0; j < 4; ++j) {
          S[j] = S[j] * wA[j] + sa * bA[j] + vv * kA[j];
          S[4 + j] = S[4 + j] * wB[j] + sa * bB[j] + vv * kB[j];
        }
        const float y0 = S[0] * rA[0] + S[1] * rA[1] + S[2] * rA[2] + S[3] * rA[3];
        const float y1 = S[4] * rB[0] + S[5] * rB[1] + S[6] * rB[2] + S[7] * rB[3];
        const float yy = red8(y0 + y1);
        if (kq == 0) yb[step * 16 + rl] = yy;
        aA = naA; aB = naB;
      }
      LDS_BARRIER();
    }
    __builtin_amdgcn_s_setprio(0);
  } else {
    const int lw = w - 2, lt = tid - 128;
    const int hc = h * 64 + lane;
    const float mpr = p.mu_prev[l * 1792 + hc], mnr = p.mu_next[l * 1792 + hc];
    const float mpk = p.mu_prev[l * 1792 + 384 + hc], mnk = p.mu_next[l * 1792 + 384 + hc];
    const float kkw = p.k_k[l * 384 + hc], kaw = p.k_a[l * 384 + hc];
    RwkvPf pfA, pfB;
#define RWKV_ISSUE(ci_, PF) { const int seg_ = (ci_) >= 16; const int Tn_ = seg_ ? 4096 : 256; const int rb_ = seg_ ? b * 4096 : NLAT + b * 256; const int s0_ = (seg_ ? (ci_) - 16 : (ci_)) * 16 + 8 * lw; \
    _Pragma("unroll") for (int q = 0; q < 10; ++q) { int t_ = dir == 0 ? s0_ - 1 + q : Tn_ - s0_ - q; t_ = t_ < 0 ? 0 : (t_ >= Tn_ ? Tn_ - 1 : t_); \
      PF.rk[q] = ((const unsigned*)(p.P + (size_t)(rb_ + t_) * PC + h * 128))[lane]; } \
    _Pragma("unroll") for (int i = 0; i < 8; ++i) { const int t_ = dir == 0 ? s0_ + i : Tn_ - 1 - (s0_ + i); const size_t row = (size_t)rb_ + t_; \
      PF.v[i] = p.VB[row * 384 + hc]; PF.ea[i] = ((const unsigned*)(p.F + row * 1536 + dir * 768))[hc]; } }
#define RWKV_STAGE(ci_, PF) { float* op_ = opb + ((ci_) & 1) * 16 * RREC; \
    const int seg = (ci_) >= 16; const int Tn = seg ? 4096 : 256; const int c0 = (seg ? (ci_) - 16 : (ci_)) * 16; \
    _Pragma("unroll") for (int i = 0; i < 8; ++i) { \
      const int step = lw * 8 + i; const int t = dir == 0 ? c0 + step : Tn - 1 - (c0 + step); \
      const float rlo = ulo(PF.rk[i]), r0 = ulo(PF.rk[i + 1]), rhi = ulo(PF.rk[i + 2]); \
      const float klo = uhi(PF.rk[i]), k0 = uhi(PF.rk[i + 1]), khi = uhi(PF.rk[i + 2]); \
      const float rm = t > 0 ? (dir ? rhi : rlo) : 0.f, rp = t + 1 < Tn ? (dir ? rlo : rhi) : 0.f; \
      const float km = t > 0 ? (dir ? khi : klo) : 0.f, kp = t + 1 < Tn ? (dir ? klo : khi) : 0.f; \
      const float vv = (float)PF.v[i], e = ulo(PF.ea[i]), al = uhi(PF.ea[i]); \
      const float rs = r0 + mpr * (rm - r0) + mnr * (rp - r0); \
      const float ks = k0 + mpk * (km - k0) + mnk * (kp - k0); \
      const float kkr = ks * kkw; \
      const float n2 = wave_sum_dpp(kkr * kkr); \
      const float kk = kkr / fmaxf(sqrtf(n2), 1e-12f); \
      float* o = op_ + step * RREC + lane; \
      o[0] = __expf(-e); o[64] = -kk; o[128] = kk * al; o[192] = ks * (1.f + (al - 1.f) * kaw); o[256] = rs; \
      if ((lane >> 4) == vq) op_[step * RREC + 320 + (lane & 15)] = vv; } }
#define RWKV_WRITE(cj_) { const int seg = (cj_) >= 16; const int Tn = seg ? 4096 : 256; const int rowbase = seg ? b * 4096 : NLAT + b * 256; const int c0 = (seg ? (cj_) - 16 : (cj_)) * 16; \
    if (seg == 1 || l == 0) { const float* yb = ybuf + ((cj_) & 1) * 256; \
      _Pragma("unroll") for (int i = 0; i < 2; ++i) { const int idx = lt + i * 128; const int step = idx >> 4, ch = idx & 15; \
        const int t = dir == 0 ? c0 + step : Tn - 1 - (c0 + step); \
        const h16 yv = (h16)yb[idx]; \
        if (dir == 0) p.P[(size_t)(rowbase + t) * PC + 768 + h * 64 + 16 * vq + ch] = yv; \
        else p.hy[(size_t)(rowbase + t) * 1024 + h * 64 + 16 * vq + ch] = yv; } } }
    RWKV_ISSUE(0, pfA)
    RWKV_STAGE(0, pfA)
    RWKV_ISSUE(1, pfB)
    RWKV_ISSUE(2, pfA)
    LDS_BARRIER();
#pragma unroll 1
    for (int ci = 0; ci < NCH; ci += 2) {
      if (ci + 1 < NCH) RWKV_STAGE(ci + 1, pfB)
      if (ci + 3 < NCH) RWKV_ISSUE(ci + 3, pfB)
      if (ci >= 1) RWKV_WRITE(ci - 1)
      LDS_BARRIER();
      if (ci + 2 < NCH) RWKV_STAGE(ci + 2, pfA)
      if (ci + 4 < NCH) RWKV_ISSUE(ci + 4, pfA)
      RWKV_WRITE(ci)
      LDS_BARRIER();
    }
    RWKV_WRITE(NCH - 1)
  }
}

constexpr int HREC = 224;
struct HgrnPf { h16 f[4], q[4], iv[4]; };
__device__ __forceinline__ void hgrn_chain(const Params& p, int l, int item, char* smem) {
  const int tid = tid_opaque(), lane = tid & 63, w = tid >> 6;
  const int chain = item >> 1, vh = item & 1;
  const int dir = chain / 32, b = (chain % 32) / 4, h = chain % 4;
  float* op = (float*)smem;
  float* ybuf = op + 16 * HREC;
  const int hc = h * 64 + lane;
  float lb = 0.f;
  if (l == 1) lb = sigmoidf_(p.lb_logits[(dir * 2 + 1) * 256 + hc] - p.lb_logits[(dir * 2 + 0) * 256 + hc]);
  const int fcol = 1792 + 256 * (1 + dir) + hc;
  const int vc = tid >> 3, kq = tid & 7;
  float S[8];
#pragma unroll
  for (int j = 0; j < 8; ++j) S[j] = 0.f;
  HgrnPf pfA, pfB;
#define HGRN_ISSUE(ci_, PF) { const int seg_ = (ci_) >= 16; const int Tn_ = seg_ ? 4096 : 256; const int rb_ = seg_ ? b * 4096 : NLAT + b * 256; const int c0_ = (seg_ ? (ci_) - 16 : (ci_)) * 16; \
    _Pragma("unroll") for (int i = 0; i < 4; ++i) { const int step = w * 4 + i; const int t = dir == 0 ? c0_ + step : Tn_ - 1 - (c0_ + step); const h16* pr = p.P + ((size_t)rb_ + t) * PC; \
      PF.f[i] = pr[fcol]; PF.q[i] = pr[1792 + hc]; PF.iv[i] = pr[1792 + 768 + hc]; } }
#define HGRN_CHUNK(ci_, PF) { \
    const int seg = (ci_) >= 16; const int Tn = seg ? 4096 : 256; const int rowbase = seg ? b * 4096 : NLAT + b * 256; const int c0 = (seg ? (ci_) - 16 : (ci_)) * 16; \
    _Pragma("unroll") for (int i = 0; i < 4; ++i) { \
      const int step = w * 4 + i; \
      float* o = op + step * HREC + lane; \
      const float f = lb + (1.f - lb) * sigmoidf_((float)PF.f[i]); \
      o[0] = f; o[64] = 1.f - f; o[128] = (float)PF.q[i]; \
      if ((lane >> 5) == vh) op[step * HREC + 192 + (lane & 31)] = (float)PF.iv[i]; } \
    LDS_BARRIER(); \
    if ((ci_) + 2 < 272) HGRN_ISSUE((ci_) + 2, PF) \
    _Pragma("unroll") for (int step = 0; step < 16; ++step) { \
      const float* o = op + step * HREC + 8 * kq; \
      const f32x4 fA = *(const f32x4*)(o), fB = *(const f32x4*)(o + 4); \
      const f32x4 gA = *(const f32x4*)(o + 64), gB = *(const f32x4*)(o + 68); \
      const f32x4 qA = *(const f32x4*)(o + 128), qB = *(const f32x4*)(o + 132); \
      const float iv = op[step * HREC + 192 + vc]; \
      const float f[8] = {fA[0], fA[1], fA[2], fA[3], fB[0], fB[1], fB[2], fB[3]}; \
      const float g[8] = {gA[0], gA[1], gA[2], gA[3], gB[0], gB[1], gB[2], gB[3]}; \
      const float q[8] = {qA[0], qA[1], qA[2], qA[3], qB[0], qB[1], qB[2], qB[3]}; \
      float acc = 0.f; \
      _Pragma("unroll") for (int j = 0; j < 8; ++j) { S[j] = S[j] * f[j] + g[j] * iv; acc += S[j] * q[j]; } \
      ybuf[step * 256 + tid] = acc; } \
    LDS_BARRIER(); \
    if (seg == 1 || l == 0) { \
      _Pragma("unroll") for (int i = 0; i < 2; ++i) { \
        const int idx = tid + i * 256; const int step = idx >> 5, ch = idx & 31; \
        const int t = dir == 0 ? c0 + step : Tn - 1 - (c0 + step); \
        const float* yb = ybuf + step * 256 + ch * 8; \
        const f32x4 y0 = *(const f32x4*)(yb), y1 = *(const f32x4*)(yb + 4); \
        const f32x4 ys = y0 + y1; \
        const h16 ov = (h16)((ys[0] + ys[1]) + (ys[2] + ys[3])); \
        if (dir == 0) p.P[(size_t)(rowbase + t) * PC + 1152 + h * 64 + 32 * vh + ch] = ov; \
        else p.hy[(size_t)(rowbase + t) * 1024 + 384 + h * 64 + 32 * vh + ch] = ov; } } }
  HGRN_ISSUE(0, pfA)
  HGRN_ISSUE(1, pfB)
  __builtin_amdgcn_s_setprio(2);
#pragma unroll 1
  for (int ci = 0; ci < 272; ci += 2) {
    HGRN_CHUNK(ci, pfA)
    HGRN_CHUNK(ci + 1, pfB)
  }
  __builtin_amdgcn_s_setprio(0);
}

__device__ __forceinline__ void attn_unit(const Params& p, int l, int u) {
  const int tid = tid_opaque(), lane = tid & 63, w = tid >> 6, lq = lane & 31, hh = lane >> 5;
  int b, head, qrow_base, qpos0; bool isctx;
  if (u < 1536) { b = u / 192; int rem = u % 192; int blk = rem / 6; head = rem % 6; qpos0 = blk * 128 + w * 32; qrow_base = b * 4096; isctx = false; }
  else { int j = u - 1536; b = j / 12; int rem = j % 12; int qb = rem / 6; head = rem % 6; qpos0 = qb * 128 + w * 32; qrow_base = NLAT + b * 256; isctx = true; }
  const int g = head / 3;
  const size_t qrow = (size_t)qrow_base + qpos0 + lq;
  half8 qf[4];
#pragma unroll
  for (int s = 0; s < 4; ++s) qf[s] = *(const half8*)(p.P + qrow * PC + 3072 + head * 64 + 16 * s + 8 * hh);
  const float sinkv = p.sink[l * 6 + head];
  float m = sinkv, lsum = hh == 0 ? 1.f : 0.f;
  f32x16 O[2];
#pragma unroll
  for (int r = 0; r < 16; ++r) { O[0][r] = 0.f; O[1][r] = 0.f; }
  const h16* vt = p.VT + (size_t)((b * 2 + g) * 64) * VTS;
  int nband = 0, kstart = 0;
  if (!isctx) { kstart = max(0, qpos0 - 128); const int kend = min(4096, qpos0 + 160); nband = (kend - kstart) >> 5; }
  const int ntiles = nband + 8;
  for (int ti = 0; ti < ntiles; ++ti) {
    const bool band = ti < nband;
    const int kt = band ? kstart + ti * 32 : (ti - nband) * 32;
    const size_t krow = band ? (size_t)b * 4096 + kt + lq : (size_t)NLAT + b * 256 + kt + lq;
    const int vidx = band ? kt : 4096 + kt;
    const h16* kp = p.P + krow * PC + 3456 + g * 64 + 8 * hh;
    f32x16 sacc;
#pragma unroll
    for (int r = 0; r < 16; ++r) sacc[r] = 0.f;
#pragma unroll
    for (int s = 0; s < 4; ++s) { half8 kf = *(const half8*)(kp + 16 * s); sacc = __builtin_amdgcn_mfma_f32_32x32x16_f16(kf, qf[s], sacc, 0, 0, 0); }
    float mx = -INFINITY;
#pragma unroll
    for (int r = 0; r < 16; ++r) {
      float sv = sacc[r];
      if (band) { const int dlt = kt + (r & 3) + 8 * (r >> 2) + 4 * hh - (qpos0 + lq); if (dlt > 128 || dlt < -128) sv = -INFINITY; }
      sacc[r] = sv; mx = fmaxf(mx, sv);
    }
    mx = fmaxf(mx, __shfl_xor(mx, 32));
    const float mn = fmaxf(m, mx); const float corr = __expf(m - mn); m = mn;
    float ps = 0.f; half8 pb[2];
#pragma unroll
    for (int r = 0; r < 16; ++r) { const float pv = __expf(sacc[r] - mn); ps += pv; pb[r >> 3][r & 7] = (h16)pv; }
    lsum = lsum * corr + ps;
#pragma unroll
    for (int r = 0; r < 16; ++r) { O[0][r] *= corr; O[1][r] *= corr; }
#pragma unroll
    for (int s2 = 0; s2 < 2; ++s2)
#pragma unroll
      for (int dt = 0; dt < 2; ++dt) {
        const h16* vp = vt + (size_t)(dt * 32 + lq) * VTS + vidx + 16 * s2 + 4 * hh;
        const half4 lo = *(const half4*)vp, hi = *(const half4*)(vp + 8);
        const half8 vf = {lo[0], lo[1], lo[2], lo[3], hi[0], hi[1], hi[2], hi[3]};
        O[dt] = __builtin_amdgcn_mfma_f32_32x32x16_f16(vf, pb[s2], O[dt], 0, 0, 0);
      }
  }
  lsum += __shfl_xor(lsum, 32);
  const float inv = 1.f / lsum;
#pragma unroll
  for (int dt = 0; dt < 2; ++dt)
#pragma unroll
    for (int g4 = 0; g4 < 4; ++g4) {
      const int d0 = dt * 32 + 8 * g4 + 4 * hh;
      const half4 ga = *(const half4*)(p.P + qrow * PC + 3712 + head * 64 + d0);
      half4 o;
#pragma unroll
      for (int j = 0; j < 4; ++j) { const float gv = (float)ga[j]; o[j] = (h16)(O[dt][g4 * 4 + j] * inv * siluf_(gv)); }
      *(half4*)(p.hy + qrow * 1024 + 640 + head * 64 + d0) = o;
    }
}

__device__ __forceinline__ void phase_mix(const Params& p, int l, int bid, int nb, char* smem, int sub) {
  const int nunits = l == 0 ? 1536 + 96 : 1536;
  if (nb >= 640) {
    if (bid < 384) { if (sub & 1) rwkv_chain(p, l, bid, smem); }
    else if (bid < 512) { if (sub & 2) hgrn_chain(p, l, bid - 384, smem); }
    else if (sub & 4) for (int u = bid - 512; u < nunits; u += nb - 512) attn_unit(p, l, u);
  } else {
    for (int it = bid; it < 512 + nunits; it += nb) {
      if (it < 384) rwkv_chain(p, l, it, smem);
      else if (it < 512) hgrn_chain(p, l, it - 384, smem);
      else attn_unit(p, l, it - 512);
      __syncthreads();
    }
  }
}

__device__ __forceinline__ float sum4(const f32x4 v) { return (v[0] + v[1]) + (v[2] + v[3]); }
__device__ __forceinline__ f32x4 h4f(const half4 h) { return (f32x4){(float)h[0], (float)h[1], (float)h[2], (float)h[3]}; }
__device__ __forceinline__ void phase_readout(const Params& p, int l, int bid, int nb, bool dummy) {
  const int tid = tid_opaque(), lane = tid & 63, w = tid >> 6;
  const int nrows = l == 1 ? NLAT : NTOK;
  const int hl = lane >> 4, c4 = (lane & 15) * 4;
#pragma unroll 2
  for (int it = bid * 4 + w; it < nrows * 3; it += nb * 4) {
    const int row = it / 3, q = it - row * 3;
    int t, Tn;
    if (row < NLAT) { t = row & 4095; Tn = 4096; } else { t = (row - NLAT) & 255; Tn = 256; }
    const h16* pr = p.P + (size_t)row * PC;
    h16* yo = p.hy + (size_t)row * 1024;
    h16* yw = dummy ? p.F + (size_t)row * 1536 : yo;
    if (q < 2) {
      const int head = q * 4 + hl; const bool valid = head < 6; const int c = (valid ? head : 5) * 64 + c4;
      const bool hp = t > 0, hn = t + 1 < Tn;
      const f32x4 y = h4f(*(const half4*)(pr + 768 + c)) + h4f(*(const half4*)(yo + c));
      f32x4 sh[3];
      {
        const h16* prk = pr + (valid ? head : 5) * 128 + 2 * c4;
        const half8 cur8 = *(const half8*)prk;
        half8 prv8, nxt8;
#pragma unroll
        for (int j = 0; j < 8; ++j) { prv8[j] = (h16)0.f; nxt8[j] = (h16)0.f; }
        if (hp) prv8 = *(const half8*)(prk - PC);
        if (hn) nxt8 = *(const half8*)(prk + PC);
#pragma unroll
        for (int k = 0; k < 2; ++k) {
          const f32x4 cur = {(float)cur8[k], (float)cur8[2 + k], (float)cur8[4 + k], (float)cur8[6 + k]};
          const f32x4 prv = {(float)prv8[k], (float)prv8[2 + k], (float)prv8[4 + k], (float)prv8[6 + k]};
          const f32x4 nxt = {(float)nxt8[k], (float)nxt8[2 + k], (float)nxt8[4 + k], (float)nxt8[6 + k]};
          const f32x4 mp = *(const f32x4*)(p.mu_prev + l * 1792 + k * 384 + c), mn = *(const f32x4*)(p.mu_next + l * 1792 + k * 384 + c);
          sh[k] = cur + mp * (prv - cur) + mn * (nxt - cur);
        }
        const int col = 1408 + c;
        const f32x4 cur = h4f(*(const half4*)(pr + col));
        const f32x4 prv = hp ? h4f(*(const half4*)(pr + col - PC)) : (f32x4){0.f, 0.f, 0.f, 0.f};
        const f32x4 nxt = hn ? h4f(*(const half4*)(pr + col + PC)) : (f32x4){0.f, 0.f, 0.f, 0.f};
        const f32x4 mp = *(const f32x4*)(p.mu_prev + l * 1792 + col), mn = *(const f32x4*)(p.mu_next + l * 1792 + col);
        sh[2] = cur + mp * (prv - cur) + mn * (nxt - cur);
      }
      const f32x4 v = h4f(*(const half4*)(p.VB + (size_t)row * 384 + c));
      const f32x4 gw = *(const f32x4*)(p.gn_w + l * 384 + c), gb = *(const f32x4*)(p.gn_b + l * 384 + c), rk = *(const f32x4*)(p.r_k + l * 384 + c);
      const float mean = red16(sum4(y)) * (1.f / 64.f);
      const f32x4 yc = y - mean;
      const float var = red16(sum4(yc * yc)) * (1.f / 64.f);
      const float rs = rsqrtf(var + 64e-5f);
      const float bs = red16(sum4(sh[0] * sh[1] * rk));
      half4 o;
#pragma unroll
      for (int j = 0; j < 4; ++j) o[j] = (h16)((yc[j] * rs * gw[j] + gb[j] + bs * v[j]) * siluf_(sh[2][j]));
      if (valid) *(half4*)(yw + c) = o;
    } else {
      const int c = hl * 64 + c4;
      const f32x4 o = h4f(*(const half4*)(pr + 1152 + c)) + h4f(*(const half4*)(yo + 384 + c));
      const f32x4 g = h4f(*(const half4*)(pr + 2816 + c));
      const f32x4 nw = *(const f32x4*)(p.hg_norm_w + l * 256 + c);
      const float ms = red16(sum4(o * o)) * (1.f / 64.f);
      const float rs = rsqrtf(ms + 1e-6f);
      half4 ov;
#pragma unroll
      for (int j = 0; j < 4; ++j) ov[j] = (h16)(o[j] * rs * nw[j] * siluf_(g[j]));
      *(half4*)(yw + 384 + c) = ov;
    }
  }
}

__device__ __forceinline__ void phase_final(const Params& p, int bid, int nb) {
  const int tid = tid_opaque(), lane = tid & 63, w = tid >> 6;
  for (int row = bid * 4 + w; row < NLAT; row += nb * 4) {
    float* src = p.out + (size_t)row * 1024;
    f32x4 v[4]; float ss = 0.f;
#pragma unroll
    for (int i = 0; i < 4; ++i) { v[i] = *(const f32x4*)(src + i * 256 + lane * 4); ss += v[i][0] * v[i][0] + v[i][1] * v[i][1] + v[i][2] * v[i][2] + v[i][3] * v[i][3]; }
    ss = wave_sum_dpp(ss);
    const float rs = rsqrtf(ss * (1.f / 1024.f) + 1e-6f);
#pragma unroll
    for (int i = 0; i < 4; ++i) {
      const int col = i * 256 + lane * 4;
      const f32x4 nwv = *(const f32x4*)(p.final_w + col);
      f32x4 o;
#pragma unroll
      for (int j = 0; j < 4; ++j) o[j] = v[i][j] * rs * nwv[j];
      *(f32x4*)(src + col) = o;
    }
  }
}

__global__ void __launch_bounds__(256, 3) __attribute__((target("no-packed-fp32-ops"))) mega(Params p, int ph_lo, int ph_hi, int coop) {
  __shared__ __attribute__((aligned(16))) char smem[SMEM_BYTES];
  __shared__ uint4 xb_words;
  XcdBarrier xb; xb.bar = p.bar; xb.x = 0; xb.st = (volatile LAS unsigned*)&xb_words;
  if (coop) { if (threadIdx.x == 0) xb_words = make_uint4(0u, 0u, 0u, 0u); __syncthreads(); xb = xcd_barrier_post(p.bar, (volatile LAS unsigned*)&xb_words); }
  if (coop) for (int i = 0; i < EXTRA_SYNCS; ++i) { xcd_barrier(xb); }
  if (coop == 2) cg::this_grid().sync();
  for (int ph = ph_lo; ph < ph_hi; ++ph) {
    for (int rep = 0; rep < (((PROBE_MASK >> ph) & 1) ? 2 : 1); ++rep) {
      int bid = blockIdx.x, nb = gridDim.x;
      asm volatile("" : "+s"(bid), "+s"(nb));
      if (ph == 0) phase_prep(p, bid, nb, smem);
      else if (ph == 13) phase_final(p, bid, nb);
      else {
        const int l = (ph - 1) / 6, s = (ph - 1) % 6;
        if (s == 0) phase_norm(p, l, bid, nb);
        else if (s == 1) phase_gemm<0>(p, l, bid, nb, smem);
        else if (s == 2) phase_feat(p, l, bid, nb, smem, PROBE_MASK && ((PROBE_MASK >> ph) & 1) && rep == 0);
        else if (s == 3) phase_mix(p, l, bid, nb, smem, rep ? PROBE_SUB : 7);
        else if (s == 4) phase_readout(p, l, bid, nb, PROBE_MASK && ((PROBE_MASK >> ph) & 1) && rep == 0);
        else phase_gemm<1>(p, l, bid, nb, smem);
      }
      if (PROBE_MASK && rep == 0 && ((PROBE_MASK >> ph) & 1)) { xcd_barrier(xb); }
    }
    if (coop && ph + 1 < ph_hi) { xcd_barrier(xb); }
  }
}

extern "C" void kernel_launch(void* const* d_in, const int* in_sizes, int n_in, void* d_out, int out_size, void* d_ws, size_t ws_size, hipStream_t stream) {
  static int grid_blocks = 0;
  if (!grid_blocks) {
    int dev = 0, cus = 0, per_cu = 0;
    hipGetDevice(&dev);
    hipDeviceGetAttribute(&cus, hipDeviceAttributeMultiprocessorCount, dev);
    hipOccupancyMaxActiveBlocksPerMultiprocessor(&per_cu, mega, 256, 0);
    if (per_cu < 1) per_cu = 1;
    grid_blocks = cus * per_cu;
  }
  Params p{};
  const float* const* in = (const float* const*)d_in;
  p.x = in[0]; p.c = in[1]; p.ctx = in[2]; p.c_ctx = in[3]; p.mod_w = in[4]; p.mod_b = in[5]; p.norm_w = in[6]; p.w_in = in[7]; p.w_out = in[8];
  p.mu_prev = in[9]; p.mu_next = in[10]; p.w0 = in[11]; p.w2 = in[12]; p.a0 = in[13]; p.a2 = in[14]; p.k_k = in[15]; p.k_a = in[16]; p.r_k = in[17];
  p.gn_w = in[18]; p.gn_b = in[19]; p.vw1 = in[20]; p.vw2 = in[21]; p.vb = in[22]; p.lb_logits = in[23]; p.hg_norm_w = in[24]; p.sink = in[25]; p.final_w = in[26];
  p.out = (float*)d_out;
  char* ws = (char*)d_ws; size_t off = 0;
  auto take = [&](size_t bytes) { char* r = ws + off; off += (bytes + 255) & ~(size_t)255; return r; };
  p.win_t = (h16*)take((size_t)2 * NPAD * 1024 * 2);
  p.wout_t = (h16*)take((size_t)2 * 1024 * 1024 * 2);
  p.wl_t = (h16*)take((size_t)2 * 4 * 384 * 64 * 2);
  p.mod = (float*)take((size_t)2 * 9 * 3072 * 4);
  p.rope = (float*)take((size_t)64 * 16 * 2 * 4);
  p.hy = (h16*)take((size_t)NTOK * 1024 * 2);
  p.P = (h16*)take((size_t)NTOK * PC * 2);
  p.F = (h16*)take((size_t)NTOK * 1536 * 2);
  p.VB = (h16*)take((size_t)NTOK * 384 * 2);
  p.VT = (h16*)take((size_t)16 * 64 * VTS * 2);
  p.xc1 = (float*)take((size_t)2048 * 1024 * 4);
  p.bar = (unsigned*)take(16384);
  if (off > ws_size) fprintf(stderr, "workspace too small: need %zu have %zu\n", off, ws_size);
#if SINGLE_LAUNCH
  hipMemsetAsync(p.bar, 0, 16384, stream);
  int lo = 0, hi = 14, coop = 1;
  void* args[] = {&p, &lo, &hi, &coop};
  hipError_t e = hipLaunchCooperativeKernel((void*)mega, dim3(grid_blocks), dim3(256), args, 0, stream);
  if (e != hipSuccess) fprintf(stderr, "cooperative launch failed: %s (grid %d)\n", hipGetErrorString(e), grid_blocks);
#else
  for (int ph = 0; ph < 14; ++ph) mega<<<grid_blocks, 256, 0, stream>>>(p, ph, ph + 1, 0);
#endif
}
```

```cpp
#include <hip/hip_runtime.h>
#include <hip/hip_cooperative_groups.h>
#include <cstdio>
#include <cstdint>
namespace cg = cooperative_groups;

typedef _Float16 h16;
typedef _Float16 half8 __attribute__((ext_vector_type(8)));
typedef _Float16 half4 __attribute__((ext_vector_type(4)));
typedef float f32x16 __attribute__((ext_vector_type(16)));
typedef float f32x4 __attribute__((ext_vector_type(4)));
typedef float f32x2 __attribute__((ext_vector_type(2)));
typedef unsigned u32x4 __attribute__((ext_vector_type(4)));
typedef _Float16 half2v __attribute__((ext_vector_type(2)));

constexpr int NLAT = 32768, NTOK = 34816;
constexpr int PC = 4160;
constexpr int NPAD = 4224;
constexpr int VTS = 4352;
constexpr int SMEM_BYTES = 49152;

#ifndef EXTRA_SYNCS
#define EXTRA_SYNCS 0
#endif
#ifndef PROBE_SUB
#define PROBE_SUB 7
#endif
#ifndef PROBE_MASK
#define PROBE_MASK 0
#endif
#ifndef SINGLE_LAUNCH
#define SINGLE_LAUNCH 1
#endif

struct Params {
  const float *x, *c, *ctx, *c_ctx, *mod_w, *mod_b, *norm_w, *w_in, *w_out;
  const float *mu_prev, *mu_next, *w0, *w2, *a0, *a2, *k_k, *k_a, *r_k, *gn_w, *gn_b;
  const float *vw1, *vw2, *vb, *lb_logits, *hg_norm_w, *sink, *final_w;
  float* out;
  h16 *win_t, *wout_t, *wl_t;
  float* mod;
  h16 *hy, *P, *F, *VB;
  h16* VT;
  float* xc1;
  float* rope;
  unsigned* bar;
};

__device__ __forceinline__ int tid_opaque() { int t = threadIdx.x; asm volatile("" : "+v"(t)); return t; }
__device__ __forceinline__ float wave_sum(float v) {
#pragma unroll
  for (int o = 32; o > 0; o >>= 1) v += __shfl_xor(v, o);
  return v;
}
__device__ __forceinline__ float sigmoidf_(float x) { return 1.f / (1.f + __expf(-x)); }
__device__ __forceinline__ float siluf_(float x) { return x / (1.f + __expf(-x)); }
template <int CTRL> __device__ __forceinline__ float dpp_mov(float x) {
  return __int_as_float(__builtin_amdgcn_update_dpp(0, __float_as_int(x), CTRL, 0xf, 0xf, true));
}
__device__ __forceinline__ float wave_sum_dpp(float x) {
  x += dpp_mov<0xB1>(x);
  x += dpp_mov<0x4E>(x);
  x += dpp_mov<0x141>(x);
  x += dpp_mov<0x140>(x);
  const int xi = __float_as_int(x);
  return __int_as_float(__builtin_amdgcn_readlane(xi, 0)) + __int_as_float(__builtin_amdgcn_readlane(xi, 16)) +
         __int_as_float(__builtin_amdgcn_readlane(xi, 32)) + __int_as_float(__builtin_amdgcn_readlane(xi, 48));
}
__device__ __forceinline__ float red8(float x) {
  x += dpp_mov<0xB1>(x);
  x += dpp_mov<0x4E>(x);
  x += dpp_mov<0x141>(x);
  return x;
}

#define XB_TMO      128
#define XB_XCNT(j)  (256  + 64 * (j))
#define XB_XSUB(j)  (1280 + 64 * (j))
#define XB_XGEN(j)  (2304 + 64 * (j))
#define XB_TOP      3328
#define XB_TOPGEN   3392
#define XCD_BAR_WORDS 3456
#define XB_SPIN_CAP (1u << 18)
#define LAS __attribute__((address_space(3)))
__device__ __forceinline__ unsigned xb_ld(unsigned* p)              { return __hip_atomic_load(p, __ATOMIC_RELAXED, __HIP_MEMORY_SCOPE_AGENT); }
__device__ __forceinline__ unsigned xb_add(unsigned* p, unsigned v) { return __hip_atomic_fetch_add(p, v, __ATOMIC_RELAXED, __HIP_MEMORY_SCOPE_AGENT); }
__device__ __forceinline__ unsigned xb_xcc_id() { return (unsigned)__builtin_amdgcn_s_getreg((3 << 11) | 20) & 0xFu; }
#define XB_SPIN(cond, bar) do { unsigned _sp = 0; while (cond) { __builtin_amdgcn_s_sleep(1); \
    if ((++_sp & 255u) == 0u) { if (xb_ld(&(bar)[XB_TMO])) break; if (_sp > XB_SPIN_CAP) { atomicAdd(&(bar)[XB_TMO], 1u); break; } } } } while (0)
struct XcdBarrier { unsigned* bar; unsigned x; volatile LAS unsigned* st; };
__device__ __forceinline__ XcdBarrier xcd_barrier_post(unsigned* bar, volatile LAS unsigned* st) {
  XcdBarrier b; b.bar = bar; b.x = xb_xcc_id(); b.st = st;
  if (threadIdx.x == 0) (void)xb_add(&bar[XB_XCNT(b.x)], 1u);
  return b;
}
__device__ __forceinline__ void xcd_barrier_complete(unsigned* bar, unsigned x, unsigned& nloc, unsigned& nx) {
  const unsigned G = gridDim.x * gridDim.y * gridDim.z;
  unsigned sum, cnt, mine, sp = 0u;
  for (;;) {
    sum = 0u; cnt = 0u; mine = 0u;
#pragma unroll
    for (unsigned j = 0; j < 16; ++j) { const unsigned c = xb_ld(&bar[XB_XCNT(j)]); sum += c; cnt += (c > 0u) ? 1u : 0u; mine = (j == x) ? c : mine; }
    if (sum == G) break;
    __builtin_amdgcn_s_sleep(1);
    if ((++sp & 255u) == 0u) { if (xb_ld(&bar[XB_TMO])) break; if (sp > XB_SPIN_CAP) { atomicAdd(&bar[XB_TMO], 1u); break; } }
  }
  nloc = mine > 0u ? mine : 1u; nx = cnt > 0u ? cnt : 1u;
}
__device__ __forceinline__ void xcd_barrier(const XcdBarrier& b) {
  asm volatile("s_waitcnt vmcnt(0)" ::: "memory");
  __syncthreads();
  if (threadIdx.x == 0) {
    unsigned* bar = b.bar;
    __builtin_amdgcn_s_waitcnt(0);
    unsigned nloc = b.st[0], nx = b.st[1];
    if (nloc == 0u) { xcd_barrier_complete(bar, b.x, nloc, nx); b.st[0] = nloc; b.st[1] = nx; }
    const unsigned old = xb_add(&bar[XB_XSUB(b.x)], 1u);
    const unsigned gen = old / nloc;
    if (old + 1u == (gen + 1u) * nloc) {
      __builtin_amdgcn_fence(__ATOMIC_RELEASE, "agent");
      asm volatile("s_waitcnt vmcnt(0)" ::: "memory");
      const unsigned og = xb_add(&bar[XB_TOP], 1u);
      const unsigned tg = og / nx;
      if (og + 1u == (tg + 1u) * nx) xb_add(&bar[XB_TOPGEN], 1u);
      else XB_SPIN(xb_ld(&bar[XB_TOPGEN]) == tg, bar);
      __builtin_amdgcn_fence(__ATOMIC_ACQUIRE, "agent");
      xb_add(&bar[XB_XGEN(b.x)], 1u);
      asm volatile("s_waitcnt vmcnt(0)" ::: "memory");
    } else {
      XB_SPIN(xb_ld(&bar[XB_XGEN(b.x)]) == gen, bar);
      __builtin_amdgcn_fence(__ATOMIC_ACQUIRE, "agent");
      asm volatile("s_waitcnt vmcnt(0)" ::: "memory");
    }
  }
  __syncthreads();
}

__device__ __forceinline__ void phase_prep(const Params& p, int bid, int nb, char* smem) {
  const int tid = tid_opaque();
  float* sf = (float*)smem;
  constexpr int N_WIN = 2048, N_WOUT = 512, N_MOD = 192, N_PADI = 1024, N_WL = 768;
  constexpr int total = N_WIN + N_WOUT + N_MOD + N_PADI + N_WL + 1;
  for (int it = bid; it < total; it += nb) {
    if (it < N_WIN + N_WOUT) {
      const float* src; h16* dst; int ncols, kt, ntile;
      if (it < N_WIN) { int l = it >> 10, r = it & 1023; kt = r >> 6; ntile = r & 63; src = p.w_in + (size_t)l * 1024 * 4096; dst = p.win_t + (size_t)l * NPAD * 1024; ncols = 4096; }
      else { int j = it - N_WIN; int l = j >> 8, r = j & 255; kt = r >> 4; ntile = r & 15; src = p.w_out + (size_t)l * 1024 * 1024; dst = p.wout_t + (size_t)l * 1024 * 1024; ncols = 1024; }
      for (int i = tid; i < 4096; i += 256) { int kk = i >> 6, nn = i & 63; sf[kk * 65 + nn] = src[(size_t)(kt * 64 + kk) * ncols + ntile * 64 + nn]; }
      __syncthreads();
      const bool rkperm = it < N_WIN && ntile < 12;
      for (int i = tid; i < 4096; i += 256) {
        int nn = i >> 6, kk = i & 63;
        const int nrow = rkperm ? ((ntile % 6) * 128 + 2 * nn + ntile / 6) : (ntile * 64 + nn);
        dst[(size_t)nrow * 1024 + kt * 64 + kk] = (h16)sf[kk * 65 + nn];
      }
      __syncthreads();
    } else if (it < N_WIN + N_WOUT + N_MOD) {
      const int j = it - N_WIN - N_WOUT; const int l = j / 96; const int cl = tid & 31, ks = tid >> 5; const int col = (j % 96) * 32 + cl;
      for (int i = tid; i < 9 * 1024; i += 256) { int r = i >> 10, k = i & 1023; float v = r < 8 ? p.c[r * 1024 + k] : p.c_ctx[k]; sf[i] = siluf_(v); }
      __syncthreads();
      float acc[9];
#pragma unroll
      for (int r = 0; r < 9; ++r) acc[r] = 0.f;
      const float* mw = p.mod_w + (size_t)l * 1024 * 3072 + (size_t)(ks * 128) * 3072 + col;
#pragma unroll 2
      for (int k = 0; k < 128; k += 4) {
        const float w0 = mw[(size_t)k * 3072], w1 = mw[(size_t)(k + 1) * 3072], w2 = mw[(size_t)(k + 2) * 3072], w3 = mw[(size_t)(k + 3) * 3072];
#pragma unroll
        for (int r = 0; r < 9; ++r) { const f32x4 sv = *(const f32x4*)&sf[r * 1024 + ks * 128 + k]; acc[r] += sv[0] * w0 + sv[1] * w1 + sv[2] * w2 + sv[3] * w3; }
      }
#pragma unroll
      for (int r = 0; r < 9; ++r) acc[r] += __shfl_xor(acc[r], 32);
      __syncthreads();
      if ((tid & 63) < 32) {
#pragma unroll
        for (int r = 0; r < 9; ++r) sf[((tid >> 6) * 9 + r) * 32 + cl] = acc[r];
      }
      __syncthreads();
      for (int i = tid; i < 288; i += 256) {
        const int r = i >> 5, c2 = i & 31;
        const float v = sf[(0 * 9 + r) * 32 + c2] + sf[(1 * 9 + r) * 32 + c2] + sf[(2 * 9 + r) * 32 + c2] + sf[(3 * 9 + r) * 32 + c2];
        const int cc = (j % 96) * 32 + c2;
        p.mod[(size_t)(l * 9 + r) * 3072 + cc] = v + p.mod_b[l * 3072 + cc];
      }
      __syncthreads();
    } else if (it < N_WIN + N_WOUT + N_MOD + N_PADI) {
      int j = it - (N_WIN + N_WOUT + N_MOD); int idx = j * 256 + tid;
      int l = idx >> 17; int rem = idx & 131071; int m = rem >> 10, k = rem & 1023;
      float v = (l == 1 && m < 32) ? p.vw1[k * 32 + m] : 0.f;
      p.win_t[(size_t)l * NPAD * 1024 + (size_t)(4096 + m) * 1024 + k] = (h16)v;
    } else if (it < N_WIN + N_WOUT + N_MOD + N_PADI + N_WL) {
      const int idx = (it - (N_WIN + N_WOUT + N_MOD + N_PADI)) * 256 + tid;
      const int r = idx & 63, c = (idx >> 6) % 384, ls = idx / (384 * 64); const int l = ls >> 2, slot = ls & 3, dir = slot & 1, kind = slot >> 1;
      const float v = (kind == 0 ? p.w2 : p.a2)[((size_t)(l * 2 + dir) * 64 + r) * 384 + c];
      p.wl_t[idx] = (h16)v;
    } else {
      if (tid < 16) {
        double inv = 1.0; for (int i = 0; i < tid; ++i) inv *= 0.5623413251903491;
        double x2 = inv * inv, ts = inv, tc = 1.0, s1 = inv, c1 = 1.0;
        for (int n = 1; n <= 10; ++n) { tc *= -x2 / ((2.0 * n - 1.0) * (2.0 * n)); c1 += tc; ts *= -x2 / ((2.0 * n) * (2.0 * n + 1.0)); s1 += ts; }
        double cc = 1.0, ss = 0.0;
        for (int pos = 0; pos < 64; ++pos) {
          p.rope[(pos * 16 + tid) * 2] = (float)cc; p.rope[(pos * 16 + tid) * 2 + 1] = (float)ss;
          double nc = cc * c1 - ss * s1, ns = ss * c1 + cc * s1; cc = nc; ss = ns;
        }
      }
    }
  }
}

__device__ __forceinline__ void phase_norm(const Params& p, int l, int bid, int nb) {
  const int tid = tid_opaque(), lane = tid & 63, w = tid >> 6;
  for (int row = bid * 4 + w; row < NTOK; row += nb * 4) {
    const float* src = (l == 0) ? (row < NLAT ? p.x + (size_t)row * 1024 : p.ctx + (size_t)(row - NLAT) * 1024)
                                : (row < NLAT ? p.out + (size_t)row * 1024 : p.xc1 + (size_t)(row - NLAT) * 1024);
    const int mr = row < NLAT ? (row >> 12) : 8;
    const float* md = p.mod + (size_t)(l * 9 + mr) * 3072;
    const float* nw = p.norm_w + l * 1024;
    f32x4 v[4]; float ss = 0.f;
#pragma unroll
    for (int i = 0; i < 4; ++i) { v[i] = *(const f32x4*)(src + i * 256 + lane * 4); ss += v[i][0] * v[i][0] + v[i][1] * v[i][1] + v[i][2] * v[i][2] + v[i][3] * v[i][3]; }
    ss = wave_sum_dpp(ss);
    const float rs = rsqrtf(ss * (1.f / 1024.f) + 1e-6f);
#pragma unroll
    for (int i = 0; i < 4; ++i) {
      const int col = i * 256 + lane * 4;
      f32x4 nwv = *(const f32x4*)(nw + col), sc = *(const f32x4*)(md + 1024 + col), sh = *(const f32x4*)(md + col);
      half4 o;
#pragma unroll
      for (int j = 0; j < 4; ++j) o[j] = (h16)(v[i][j] * rs * nwv[j] * (1.f + sc[j]) + sh[j]);
      *(half4*)(p.hy + (size_t)row * 1024 + col) = o;
    }
  }
}

template <int MODE>
__device__ __forceinline__ void phase_gemm(const Params& p, int l, int bid, int nb, char* smem) {
  const h16* A = p.hy;
  const h16* Bt = MODE == 0 ? p.win_t + (size_t)l * NPAD * 1024 : p.wout_t + (size_t)l * 1024 * 1024;
  const int ntn = MODE == 0 ? (l == 1 ? 33 : 32) : 8;
  const int ntm = (MODE == 1 && l == 1) ? 256 : 272;
  const int tid = tid_opaque(), lane = tid & 63, w = tid >> 6, wr = w >> 1, wc = w & 1, lq = lane & 31, hh = lane >> 5;
  h16* As = (h16*)smem; h16* Bs = As + 128 * 72;
  const int ldrow = tid >> 3, ldch = (tid & 7) * 8;
  for (int tile = bid; tile < ntm * ntn; tile += nb) {
    int tm, tn;
    {
      const int mper = ntm >> 3;
      const int nmain = MODE == 0 ? 32 : 8;
      if (tile < ntm * nmain) {
        const int x = tile & 7, sq = tile >> 3;
        const int strip = sq / (mper * 8), rem = sq - strip * (mper * 8);
        tm = x * mper + (rem >> 3); tn = strip * 8 + (rem & 7);
      } else { tm = tile - ntm * nmain; tn = nmain; }
    }
    const h16* Ag = A + (size_t)(tm * 128 + ldrow) * 1024 + ldch; const h16* Bg = Bt + (size_t)(tn * 128 + ldrow) * 1024 + ldch;
    f32x16 acc[2][2];
#pragma unroll
    for (int i = 0; i < 2; ++i)
#pragma unroll
      for (int j = 0; j < 2; ++j)
#pragma unroll
        for (int r = 0; r < 16; ++r) acc[i][j][r] = 0.f;
    u32x4 ra[4], rb[4];
#pragma unroll
    for (int i = 0; i < 4; ++i) { ra[i] = *(const u32x4*)(Ag + (size_t)i * 32 * 1024); rb[i] = *(const u32x4*)(Bg + (size_t)i * 32 * 1024); }
#pragma unroll 1
    for (int kt = 0; kt < 16; ++kt) {
      __syncthreads();
#pragma unroll
      for (int i = 0; i < 4; ++i) { *(u32x4*)(As + (ldrow + i * 32) * 72 + ldch) = ra[i]; *(u32x4*)(Bs + (ldrow + i * 32) * 72 + ldch) = rb[i]; }
      __syncthreads();
      if (kt + 1 < 16) {
#pragma unroll
        for (int i = 0; i < 4; ++i) { ra[i] = *(const u32x4*)(Ag + (size_t)i * 32 * 1024 + (kt + 1) * 64); rb[i] = *(const u32x4*)(Bg + (size_t)i * 32 * 1024 + (kt + 1) * 64); }
      }
#pragma unroll
      for (int s = 0; s < 4; ++s) {
        half8 a[2], b[2];
#pragma unroll
        for (int i = 0; i < 2; ++i) { a[i] = *(const half8*)(As + (64 * wr + 32 * i + lq) * 72 + 16 * s + 8 * hh); b[i] = *(const half8*)(Bs + (64 * wc + 32 * i + lq) * 72 + 16 * s + 8 * hh); }
#pragma unroll
        for (int i = 0; i < 2; ++i)
#pragma unroll
          for (int j = 0; j < 2; ++j) {
            if (MODE == 0) acc[i][j] = __builtin_amdgcn_mfma_f32_32x32x16_f16(b[j], a[i], acc[i][j], 0, 0, 0);
            else acc[i][j] = __builtin_amdgcn_mfma_f32_32x32x16_f16(a[i], b[j], acc[i][j], 0, 0, 0);
          }
      }
    }
    if (MODE == 0) {
      if (tn < 32) {
        __syncthreads();
        h16* Cs = (h16*)smem;
#pragma unroll
        for (int i = 0; i < 2; ++i)
#pragma unroll
          for (int j = 0; j < 2; ++j)
#pragma unroll
            for (int g = 0; g < 4; ++g) {
              half4 o;
#pragma unroll
              for (int q = 0; q < 4; ++q) o[q] = (h16)acc[i][j][4 * g + q];
              *(half4*)(Cs + (64 * wr + 32 * i + lq) * 136 + 64 * wc + 32 * j + 8 * g + 4 * hh) = o;
            }
        __syncthreads();
#pragma unroll
        for (int q = 0; q < 8; ++q) {
          const int id = tid + q * 256; const int row = id >> 4, ch = id & 15;
          *(u32x4*)(p.P + (size_t)(tm * 128 + row) * PC + tn * 128 + ch * 8) = *(const u32x4*)(Cs + row * 136 + ch * 8);
        }
      } else if (wc == 0) {
#pragma unroll
        for (int i = 0; i < 2; ++i)
#pragma unroll
          for (int r = 0; r < 16; ++r) ((float*)(p.F + (size_t)(tm * 128 + 64 * wr + 32 * i + lq) * 1536))[(r & 3) + 8 * (r >> 2) + 4 * hh] = acc[i][0][r];
      }
    } else {
      const int row0 = tm * 128;
      const int mr = row0 < NLAT ? (row0 >> 12) : 8;
      const int col = tn * 128 + 64 * wc + lq;
      const float* gp = p.mod + (size_t)(l * 9 + mr) * 3072 + 2048 + col;
      const float g0 = gp[0], g1 = gp[32];
      const float* xs0; float* xd0;
      if (l == 0) { if (row0 < NLAT) { xs0 = p.x + (size_t)row0 * 1024; xd0 = p.out + (size_t)row0 * 1024; } else { xs0 = p.ctx + (size_t)(row0 - NLAT) * 1024; xd0 = p.xc1 + (size_t)(row0 - NLAT) * 1024; } }
      else { xs0 = p.out + (size_t)row0 * 1024; xd0 = p.out + (size_t)row0 * 1024; }
      const float* __restrict__ xsrc = xs0 + (size_t)(64 * wr + 4 * hh) * 1024 + col;
      float* __restrict__ xdst = xd0 + (size_t)(64 * wr + 4 * hh) * 1024 + col;
#pragma unroll
      for (int i = 0; i < 2; ++i)
#pragma unroll
        for (int r = 0; r < 16; ++r) {
          const int ro = (32 * i + (r & 3) + 8 * (r >> 2)) * 1024;
          xdst[ro] = xsrc[ro] + g0 * acc[i][0][r];
          xdst[ro + 32] = xsrc[ro + 32] + g1 * acc[i][1][r];
        }
    }
  }
}

#define LOAD_COL34(arr, base, t0, Tn) \
  _Pragma("unroll") for (int q_ = 0; q_ < 34; ++q_) { const int t_ = (t0) - 1 + q_; arr[q_] = (t_ >= 0 && t_ < (Tn)) ? (base)[(long)t_ * PC] : (h16)0.f; }

__device__ __forceinline__ void phase_feat(const Params& p, int l, int bid, int nb, char* smem, bool dry) {
  const int tid = tid_opaque();
  h16* inh = (h16*)smem;
  float* zt = (float*)(smem + 32 * 264 * 2);
  for (int item = bid; item < 1088; item += nb) {
    int b, t0, Tn, rowbase; bool isctx;
    if (item < 1024) { b = item >> 7; t0 = (item & 127) * 32; Tn = 4096; rowbase = b * 4096; isctx = false; }
    else { int j = item - 1024; b = j >> 3; t0 = (j & 7) * 32; Tn = 256; rowbase = NLAT + b * 256; isctx = true; }
    {
      const int col = 1152 + tid;
      const float mp = p.mu_prev[l * 1792 + col], mn = p.mu_next[l * 1792 + col];
      const h16* base = p.P + (size_t)rowbase * PC + col;
      h16 xv[34];
      LOAD_COL34(xv, base, t0, Tn)
#pragma unroll
      for (int tt = 0; tt < 32; ++tt) {
        const float prev = (float)xv[tt], cur = (float)xv[tt + 1], nxt = (float)xv[tt + 2];
        float sv = cur + mp * (prev - cur) + mn * (nxt - cur);
        if (tid < 128) { const float e2 = __expf(2.f * sv); sv = 1.f - 2.f / (e2 + 1.f); }
        inh[tt * 264 + tid] = (h16)sv;
      }
      if (l == 1) {
#pragma unroll
        for (int i = 0; i < 4; ++i) { int id = tid + i * 256; zt[id] = ((const float*)(p.F + (size_t)(rowbase + t0 + (id >> 5)) * 1536))[id & 31]; }
      }
    }
    __syncthreads();
#pragma unroll 1
    for (int c = tid; c < 384; c += 256) {
      const int col = 768 + c;
      const float mp = p.mu_prev[l * 1792 + col], mn = p.mu_next[l * 1792 + col];
      const h16* base = p.P + (size_t)rowbase * PC + col;
      h16 xv[34];
      LOAD_COL34(xv, base, t0, Tn)
      h16* dst = p.VB + (size_t)(rowbase + t0) * 384 + c;
      if (l == 0) {
#pragma unroll
        for (int tt = 0; tt < 32; ++tt) {
          const float prev = (float)xv[tt], cur = (float)xv[tt + 1], nxt = (float)xv[tt + 2];
          dst[tt * 384] = (h16)(cur + mp * (prev - cur) + mn * (nxt - cur));
        }
      } else {
        const float vbv = p.vb[c];
#pragma unroll 1
        for (int hf = 0; hf < 2; ++hf) {
          h16 vfv[16]; float ga[16];
#pragma unroll
          for (int tt = 0; tt < 16; ++tt) { vfv[tt] = dst[(hf * 16 + tt) * 384]; ga[tt] = vbv; }
#pragma unroll 1
          for (int m = 0; m < 32; m += 4) {
            const float w0 = p.vw2[m * 384 + c], w1 = p.vw2[(m + 1) * 384 + c], w2 = p.vw2[(m + 2) * 384 + c], w3 = p.vw2[(m + 3) * 384 + c];
#pragma unroll
            for (int tt = 0; tt < 16; ++tt) { const f32x4 z = *(const f32x4*)&zt[(hf * 16 + tt) * 32 + m]; ga[tt] += z[0] * w0 + z[1] * w1 + z[2] * w2 + z[3] * w3; }
          }
#pragma unroll
          for (int tt = 0; tt < 16; ++tt) {
            const float prev = hf ? (float)xv[16 + tt] : (float)xv[tt], cur = hf ? (float)xv[17 + tt] : (float)xv[tt + 1], nxt = hf ? (float)xv[18 + tt] : (float)xv[tt + 2];
            const float sv = cur + mp * (prev - cur) + mn * (nxt - cur);
            dst[(hf * 16 + tt) * 384] = (h16)(sv + ((float)vfv[tt] - sv) * sigmoidf_(ga[tt]));
          }
        }
      }
    }
    {
      const int w = tid >> 6, lane = tid & 63, lq = tid & 31, hh = lane >> 5;
      const int dir = w & 1, chalf = w >> 1;
      half8 xin[2][4];
#pragma unroll
      for (int kind = 0; kind < 2; ++kind)
#pragma unroll
        for (int ks = 0; ks < 4; ++ks) xin[kind][ks] = *(const half8*)(inh + lq * 264 + kind * 128 + dir * 64 + 16 * ks + 8 * hh);
      h16* ost = (h16*)(smem + 32 * 264 * 2 + 4096) + w * (32 * 72);
      h16* fbase = p.F + (size_t)(rowbase + t0) * 1536 + dir * 768 + chalf * 384;
#pragma unroll 1
      for (int np = 0; np < 6; ++np) {
        const int c0 = chalf * 192 + np * 32;
        f32x16 acc[2];
#pragma unroll
        for (int kind = 0; kind < 2; ++kind) {
          const float* bias = (kind == 0 ? p.w0 : p.a0) + (l * 2 + dir) * 384 + c0;
          const h16* wl = p.wl_t + (size_t)((l * 4 + kind * 2 + dir) * 384 + c0) * 64;
#pragma unroll
          for (int g = 0; g < 4; ++g) { const f32x4 bv = *(const f32x4*)(bias + 8 * g + 4 * hh); acc[kind][4 * g] = bv[0]; acc[kind][4 * g + 1] = bv[1]; acc[kind][4 * g + 2] = bv[2]; acc[kind][4 * g + 3] = bv[3]; }
#pragma unroll
          for (int ks = 0; ks < 4; ++ks) {
            const half8 wf = *(const half8*)(wl + (size_t)lq * 64 + 16 * ks + 8 * hh);
            acc[kind] = __builtin_amdgcn_mfma_f32_32x32x16_f16(wf, xin[kind][ks], acc[kind], 0, 0, 0);
          }
        }
#pragma unroll
        for (int g = 0; g < 4; ++g) {
          half8 o;
#pragma unroll
          for (int j = 0; j < 4; ++j) { o[2 * j] = (h16)(0.6065306597126334f * sigmoidf_(acc[0][4 * g + j])); o[2 * j + 1] = (h16)sigmoidf_(acc[1][4 * g + j]); }
          *(half8*)(ost + lq * 72 + 16 * g + 8 * hh) = o;
        }
        asm volatile("s_waitcnt lgkmcnt(0)" ::: "memory");
#pragma unroll
        for (int q = 0; q < 4; ++q) {
          const int id = lane + q * 64; const int rr = id >> 3, ch = id & 7;
          *(u32x4*)(fbase + (size_t)rr * 1536 + np * 64 + ch * 8) = *(const u32x4*)(ost + rr * 72 + ch * 8);
        }
        asm volatile("s_waitcnt lgkmcnt(0)" ::: "memory");
      }
    }
    {
      const int head = tid >> 5, pr = tid & 31, half = pr >> 4, i = pr & 15;
      const int colbase = head < 6 ? 3072 + head * 64 : 3456 + (head - 6) * 64;
      const int d1 = half * 32 + i;
      const float qs = (head < 6 && !dry) ? 0.125f : 1.f;
      h16* pp = p.P + (size_t)(rowbase + t0) * PC + colbase + d1;
#pragma unroll
      for (int tq = 0; tq < 32; tq += 8) {
        h16 x1[8], x2[8];
#pragma unroll
        for (int u = 0; u < 8; ++u) { x1[u] = pp[(size_t)(tq + u) * PC]; x2[u] = pp[(size_t)(tq + u) * PC + 16]; }
#pragma unroll
        for (int u = 0; u < 8; ++u) {
          const int t = t0 + tq + u;
          float cs = 1.f, sn = 0.f;
          if (!isctx && !dry) { const int pos = half == 0 ? (t >> 6) : (t & 63); const f32x2 r2 = *(const f32x2*)&p.rope[(pos * 16 + i) * 2]; cs = r2[0]; sn = r2[1]; }
          const float a = (float)x1[u], bq = (float)x2[u];
          pp[(size_t)(tq + u) * PC] = (h16)((a * cs - bq * sn) * qs);
          pp[(size_t)(tq + u) * PC + 16] = (h16)((a * sn + bq * cs) * qs);
        }
      }
    }
    if (tid < 128) {
      const int g = tid >> 6, d = tid & 63;
      const h16* base = p.P + (size_t)(rowbase + t0) * PC + 3584 + tid;
      h16* dst = p.VT + (size_t)((b * 2 + g) * 64 + d) * VTS + (isctx ? 4096 + t0 : t0);
      half8 v[4];
#pragma unroll
      for (int q = 0; q < 4; ++q)
#pragma unroll
        for (int j = 0; j < 8; ++j) v[q][j] = base[(size_t)(q * 8 + j) * PC];
#pragma unroll
      for (int q = 0; q < 4; ++q) *(half8*)(dst + q * 8) = v[q];
    }
    __syncthreads();
  }
}

__device__ __forceinline__ float ulo(unsigned u) { return (float)__builtin_bit_cast(h16, (unsigned short)(u & 0xffffu)); }
__device__ __forceinline__ float uhi(unsigned u) { return (float)__builtin_bit_cast(h16, (unsigned short)(u >> 16)); }
__device__ __forceinline__ float red16(float x) {
  x += dpp_mov<0xB1>(x);
  x += dpp_mov<0x4E>(x);
  x += dpp_mov<0x141>(x);
  x += dpp_mov<0x140>(x);
  return x;
}
#define LDS_BARRIER() do { asm volatile("s_waitcnt lgkmcnt(0)" ::: "memory"); __builtin_amdgcn_s_barrier(); asm volatile("" ::: "memory"); } while (0)
constexpr int RREC = 336;
struct RwkvPf { unsigned rk[10]; h16 v[8]; unsigned ea[8]; };

__device__ __forceinline__ void rwkv_chain(const Params& p, int l, int item, char* smem) {
  const int tid0 = tid_opaque();
  const int tid = (item >= 256) ? (tid0 ^ 128) : tid0;
  const int lane = tid & 63, w = tid >> 6;
  const int chain = item >> 2, vq = item & 3;
  const int dir = chain / 48, b = (chain % 48) / 6, h = chain % 6;
  float* opb = (float*)smem;
  float* ybuf = opb + 2 * 16 * RREC;
  constexpr int NCH = 272;
  if (w < 2) {
    const int rl = tid >> 3, kq = tid & 7;
    float S[8];
#pragma unroll
    for (int j = 0; j < 8; ++j) S[j] = 0.f;
    __builtin_amdgcn_s_setprio(3);
    LDS_BARRIER();
#pragma unroll 1
    for (int ci = 0; ci < NCH; ++ci) {
      const float* op = opb + (ci & 1) * 16 * RREC;
      float* yb = ybuf + (ci & 1) * 256;
      f32x4 aA = *(const f32x4*)(op + 8 * kq + 64), aB = *(const f32x4*)(op + 8 * kq + 68);
#pragma unroll
      for (int step = 0; step < 16; ++step) {
        const float* o = op + step * RREC + 8 * kq;
        const f32x4 wA = *(const f32x4*)(o), wB = *(const f32x4*)(o + 4);
        const f32x4 bA = *(const f32x4*)(o + 128), bB = *(const f32x4*)(o + 132);
        const f32x4 kA = *(const f32x4*)(o + 192), kB = *(const f32x4*)(o + 196);
        const f32x4 rA = *(const f32x4*)(o + 256), rB = *(const f32x4*)(o + 260);
        const float vv = op[step * RREC + 320 + rl];
        f32x4 naA = aA, naB = aB;
        if (step + 1 < 16) { naA = *(const f32x4*)(o + RREC + 64); naB = *(const f32x4*)(o + RREC + 68); }
        const float d0 = S[0] * aA[0] + S[1] * aA[1] + S[2] * aA[2] + S[3] * aA[3];
        const float d1 = S[4] * aB[0] + S[5] * aB[1] + S[6] * aB[2] + S[7] * aB[3];
        const float sa = red8(d0 + d1);
#pragma unroll
        for (int j = 0; j < 4; ++j) {
          S[j] = S[j] * wA[j] + sa * bA[j] + vv * kA[j];
          S[4 + j] = S[4 + j] * wB[j] + sa * bB[j] + vv * kB[j];
        }
        const float y0 = S[0] * rA[0] + S[1] * rA[1] + S[2] * rA[2] + S[3] * rA[3];
        const float y1 = S[4] * rB[0] + S[5] * rB[1] + S[6] * rB[2] + S[7] * rB[3];
        const float yy = red8(y0 + y1);
        if (kq == 0) yb[step * 16 + rl] = yy;
        aA = naA; aB = naB;
      }
      LDS_BARRIER();
    }
    __builtin_amdgcn_s_setprio(0);
  } else {
    const int lw = w - 2, lt = tid - 128;
    const int hc = h * 64 + lane;
    const float mpr = p.mu_prev[l * 1792 + hc], mnr = p.mu_next[l * 1792 + hc];
    const float mpk = p.mu_prev[l * 1792 + 384 + hc], mnk = p.mu_next[l * 1792 + 384 + hc];
    const float kkw = p.k_k[l * 384 + hc], kaw = p.k_a[l * 384 + hc];
    RwkvPf pfA, pfB;
#define RWKV_ISSUE(ci_, PF) { const int seg_ = (ci_) >= 16; const int Tn_ = seg_ ? 4096 : 256; const int rb_ = seg_ ? b * 4096 : NLAT + b * 256; const int s0_ = (seg_ ? (ci_) - 16 : (ci_)) * 16 + 8 * lw; \
    _Pragma("unroll") for (int q = 0; q < 10; ++q) { int t_ = dir == 0 ? s0_ - 1 + q : Tn_ - s0_ - q; t_ = t_ < 0 ? 0 : (t_ >= Tn_ ? Tn_ - 1 : t_); \
      PF.rk[q] = ((const unsigned*)(p.P + (size_t)(rb_ + t_) * PC + h * 128))[lane]; } \
    _Pragma("unroll") for (int i = 0; i < 8; ++i) { const int t_ = dir == 0 ? s0_ + i : Tn_ - 1 - (s0_ + i); const size_t row = (size_t)rb_ + t_; \
      PF.v[i] = p.VB[row * 384 + hc]; PF.ea[i] = ((const unsigned*)(p.F + row * 1536 + dir * 768))[hc]; } }
#define RWKV_STAGE(ci_, PF) { float* op_ = opb + ((ci_) & 1) * 16 * RREC; \
    const int seg = (ci_) >= 16; const int Tn = seg ? 4096 : 256; const int c0 = (seg ? (ci_) - 16 : (ci_)) * 16; \
    _Pragma("unroll") for (int i = 0; i < 8; ++i) { \
      const int step = lw * 8 + i; const int t = dir == 0 ? c0 + step : Tn - 1 - (c0 + step); \
      const float rlo = ulo(PF.rk[i]), r0 = ulo(PF.rk[i + 1]), rhi = ulo(PF.rk[i + 2]); \
      const float klo = uhi(PF.rk[i]), k0 = uhi(PF.rk[i + 1]), khi = uhi(PF.rk[i + 2]); \
      const float rm = t > 0 ? (dir ? rhi : rlo) : 0.f, rp = t + 1 < Tn ? (dir ? rlo : rhi) : 0.f; \
      const float km = t > 0 ? (dir ? khi : klo) : 0.f, kp = t + 1 < Tn ? (dir ? klo : khi) : 0.f; \
      const float vv = (float)PF.v[i], e = ulo(PF.ea[i]), al = uhi(PF.ea[i]); \
      const float rs = r0 + mpr * (rm - r0) + mnr * (rp - r0); \
      const float ks = k0 + mpk * (km - k0) + mnk * (kp - k0); \
      const float kkr = ks * kkw; \
      const float n2 = wave_sum_dpp(kkr * kkr); \
      const float kk = kkr / fmaxf(sqrtf(n2), 1e-12f); \
      float* o = op_ + step * RREC + lane; \
      o[0] = __expf(-e); o[64] = -kk; o[128] = kk * al; o[192] = ks * (1.f + (al - 1.f) * kaw); o[256] = rs; \
      if ((lane >> 4) == vq) op_[step * RREC + 320 + (lane & 15)] = vv; } }
#define RWKV_WRITE(cj_) { const int seg = (cj_) >= 16; const int Tn = seg ? 4096 : 256; const int rowbase = seg ? b * 4096 : NLAT + b * 256; const int c0 = (seg ? (cj_) - 16 : (cj_)) * 16; \
    if (seg == 1 || l == 0) { const float* yb = ybuf + ((cj_) & 1) * 256; \
      _Pragma("unroll") for (int i = 0; i < 2; ++i) { const int idx = lt + i * 128; const int step = idx >> 4, ch = idx & 15; \
        const int t = dir == 0 ? c0 + step : Tn - 1 - (c0 + step); \
        const h16 yv = (h16)yb[idx]; \
        if (dir == 0) p.P[(size_t)(rowbase + t) * PC + 768 + h * 64 + 16 * vq + ch] = yv; \
        else p.hy[(size_t)(rowbase + t) * 1024 + h * 64 + 16 * vq + ch] = yv; } } }
    RWKV_ISSUE(0, pfA)
    RWKV_STAGE(0, pfA)
    RWKV_ISSUE(1, pfB)
    RWKV_ISSUE(2, pfA)
    LDS_BARRIER();
#pragma unroll 1
    for (int ci = 0; ci < NCH; ci += 2) {
      if (ci + 1 < NCH) RWKV_STAGE(ci + 1, pfB)
      if (ci + 3 < NCH) RWKV_ISSUE(ci + 3, pfB)
      if (ci >= 1) RWKV_WRITE(ci - 1)
      LDS_BARRIER();
      if (ci + 2 < NCH) RWKV_STAGE(ci + 2, pfA)
      if (ci + 4 < NCH) RWKV_ISSUE(ci + 4, pfA)
      RWKV_WRITE(ci)
      LDS_BARRIER();
    }
    RWKV_WRITE(NCH - 1)
  }
}

constexpr int HREC = 224;
struct HgrnPf { h16 f[4], q[4], iv[4]; };
__device__ __forceinline__ void hgrn_chain(const Params& p, int l, int item, char* smem) {
  const int tid = tid_opaque(), lane = tid & 63, w = tid >> 6;
  const int chain = item >> 1, vh = item & 1;
  const int dir = chain / 32, b = (chain % 32) / 4, h = chain % 4;
  float* op = (float*)smem;
  float* ybuf = op + 16 * HREC;
  const int hc = h * 64 + lane;
  float lb = 0.f;
  if (l == 1) lb = sigmoidf_(p.lb_logits[(dir * 2 + 1) * 256 + hc] - p.lb_logits[(dir * 2 + 0) * 256 + hc]);
  const int fcol = 1792 + 256 * (1 + dir) + hc;
  const int vc = tid >> 3, kq = tid & 7;
  float S[8];
#pragma unroll
  for (int j = 0; j < 8; ++j) S[j] = 0.f;
  HgrnPf pfA, pfB;
#define HGRN_ISSUE(ci_, PF) { const int seg_ = (ci_) >= 16; const int Tn_ = seg_ ? 4096 : 256; const int rb_ = seg_ ? b * 4096 : NLAT + b * 256; const int c0_ = (seg_ ? (ci_) - 16 : (ci_)) * 16; \
    _Pragma("unroll") for (int i = 0; i < 4; ++i) { const int step = w * 4 + i; const int t = dir == 0 ? c0_ + step : Tn_ - 1 - (c0_ + step); const h16* pr = p.P + ((size_t)rb_ + t) * PC; \
      PF.f[i] = pr[fcol]; PF.q[i] = pr[1792 + hc]; PF.iv[i] = pr[1792 + 768 + hc]; } }
#define HGRN_CHUNK(ci_, PF) { \
    const int seg = (ci_) >= 16; const int Tn = seg ? 4096 : 256; const int rowbase = seg ? b * 4096 : NLAT + b * 256; const int c0 = (seg ? (ci_) - 16 : (ci_)) * 16; \
    _Pragma("unroll") for (int i = 0; i < 4; ++i) { \
      const int step = w * 4 + i; \
      float* o = op + step * HREC + lane; \
      const float f = lb + (1.f - lb) * sigmoidf_((float)PF.f[i]); \
      o[0] = f; o[64] = 1.f - f; o[128] = (float)PF.q[i]; \
      if ((lane >> 5) == vh) op[step * HREC + 192 + (lane & 31)] = (float)PF.iv[i]; } \
    LDS_BARRIER(); \
    if ((ci_) + 2 < 272) HGRN_ISSUE((ci_) + 2, PF) \
    _Pragma("unroll") for (int step = 0; step < 16; ++step) { \
      const float* o = op + step * HREC + 8 * kq; \
      const f32x4 fA = *(const f32x4*)(o), fB = *(const f32x4*)(o + 4); \
      const f32x4 gA = *(const f32x4*)(o + 64), gB = *(const f32x4*)(o + 68); \
      const f32x4 qA = *(const f32x4*)(o + 128), qB = *(const f32x4*)(o + 132); \
      const float iv = op[step * HREC + 192 + vc]; \
      const float f[8] = {fA[0], fA[1], fA[2], fA[3], fB[0], fB[1], fB[2], fB[3]}; \
      const float g[8] = {gA[0], gA[1], gA[2], gA[3], gB[0], gB[1], gB[2], gB[3]}; \
      const float q[8] = {qA[0], qA[1], qA[2], qA[3], qB[0], qB[1], qB[2], qB[3]}; \
      float acc = 0.f; \
      _Pragma("unroll") for (int j = 0; j < 8; ++j) { S[j] = S[j] * f[j] + g[j] * iv; acc += S[j] * q[j]; } \
      ybuf[step * 256 + tid] = acc; } \
    LDS_BARRIER(); \
    if (seg == 1 || l == 0) { \
      _Pragma("unroll") for (int i = 0; i < 2; ++i) { \
        const int idx = tid + i * 256; const int step = idx >> 5, ch = idx & 31; \
        const int t = dir == 0 ? c0 + step : Tn - 1 - (c0 + step); \
        const float* yb = ybuf + step * 256 + ch * 8; \
        const f32x4 y0 = *(const f32x4*)(yb), y1 = *(const f32x4*)(yb + 4); \
        const f32x4 ys = y0 + y1; \
        const h16 ov = (h16)((ys[0] + ys[1]) + (ys[2] + ys[3])); \
        if (dir == 0) p.P[(size_t)(rowbase + t) * PC + 1152 + h * 64 + 32 * vh + ch] = ov; \
        else p.hy[(size_t)(rowbase + t) * 1024 + 384 + h * 64 + 32 * vh + ch] = ov; } } }
  HGRN_ISSUE(0, pfA)
  HGRN_ISSUE(1, pfB)
  __builtin_amdgcn_s_setprio(2);
#pragma unroll 1
  for (int ci = 0; ci < 272; ci += 2) {
    HGRN_CHUNK(ci, pfA)
    HGRN_CHUNK(ci + 1, pfB)
  }
  __builtin_amdgcn_s_setprio(0);
}

__device__ __forceinline__ void attn_unit(const Params& p, int l, int u) {
  const int tid = tid_opaque(), lane = tid & 63, w = tid >> 6, lq = lane & 31, hh = lane >> 5;
  int b, head, qrow_base, qpos0; bool isctx;
  if (u < 1536) { b = u / 192; int rem = u % 192; int blk = rem / 6; head = rem % 6; qpos0 = blk * 128 + w * 32; qrow_base = b * 4096; isctx = false; }
  else { int j = u - 1536; b = j / 12; int rem = j % 12; int qb = rem / 6; head = rem % 6; qpos0 = qb * 128 + w * 32; qrow_base = NLAT + b * 256; isctx = true; }
  const int g = head / 3;
  const size_t qrow = (size_t)qrow_base + qpos0 + lq;
  half8 qf[4];
#pragma unroll
  for (int s = 0; s < 4; ++s) qf[s] = *(const half8*)(p.P + qrow * PC + 3072 + head * 64 + 16 * s + 8 * hh);
  const float sinkv = p.sink[l * 6 + head];
  float m = sinkv, lsum = hh == 0 ? 1.f : 0.f;
  f32x16 O[2];
#pragma unroll
  for (int r = 0; r < 16; ++r) { O[0][r] = 0.f; O[1][r] = 0.f; }
  const h16* vt = p.VT + (size_t)((b * 2 + g) * 64) * VTS;
  int nband = 0, kstart = 0;
  if (!isctx) { kstart = max(0, qpos0 - 128); const int kend = min(4096, qpos0 + 160); nband = (kend - kstart) >> 5; }
  const int ntiles = nband + 8;
  for (int ti = 0; ti < ntiles; ++ti) {
    const bool band = ti < nband;
    const int kt = band ? kstart + ti * 32 : (ti - nband) * 32;
    const size_t krow = band ? (size_t)b * 4096 + kt + lq : (size_t)NLAT + b * 256 + kt + lq;
    const int vidx = band ? kt : 4096 + kt;
    const h16* kp = p.P + krow * PC + 3456 + g * 64 + 8 * hh;
    f32x16 sacc;
#pragma unroll
    for (int r = 0; r < 16; ++r) sacc[r] = 0.f;
#pragma unroll
    for (int s = 0; s < 4; ++s) { half8 kf = *(const half8*)(kp + 16 * s); sacc = __builtin_amdgcn_mfma_f32_32x32x16_f16(kf, qf[s], sacc, 0, 0, 0); }
    float mx = -INFINITY;
#pragma unroll
    for (int r = 0; r < 16; ++r) {
      float sv = sacc[r];
      if (band) { const int dlt = kt + (r & 3) + 8 * (r >> 2) + 4 * hh - (qpos0 + lq); if (dlt > 128 || dlt < -128) sv = -INFINITY; }
      sacc[r] = sv; mx = fmaxf(mx, sv);
    }
    mx = fmaxf(mx, __shfl_xor(mx, 32));
    const float mn = fmaxf(m, mx); const float corr = __expf(m - mn); m = mn;
    float ps = 0.f; half8 pb[2];
#pragma unroll
    for (int r = 0; r < 16; ++r) { const float pv = __expf(sacc[r] - mn); ps += pv; pb[r >> 3][r & 7] = (h16)pv; }
    lsum = lsum * corr + ps;
#pragma unroll
    for (int r = 0; r < 16; ++r) { O[0][r] *= corr; O[1][r] *= corr; }
#pragma unroll
    for (int s2 = 0; s2 < 2; ++s2)
#pragma unroll
      for (int dt = 0; dt < 2; ++dt) {
        const h16* vp = vt + (size_t)(dt * 32 + lq) * VTS + vidx + 16 * s2 + 4 * hh;
        const half4 lo = *(const half4*)vp, hi = *(const half4*)(vp + 8);
        const half8 vf = {lo[0], lo[1], lo[2], lo[3], hi[0], hi[1], hi[2], hi[3]};
        O[dt] = __builtin_amdgcn_mfma_f32_32x32x16_f16(vf, pb[s2], O[dt], 0, 0, 0);
      }
  }
  lsum += __shfl_xor(lsum, 32);
  const float inv = 1.f / lsum;
#pragma unroll
  for (int dt = 0; dt < 2; ++dt)
#pragma unroll
    for (int g4 = 0; g4 < 4; ++g4) {
      const int d0 = dt * 32 + 8 * g4 + 4 * hh;
      const half4 ga = *(const half4*)(p.P + qrow * PC + 3712 + head * 64 + d0);
      half4 o;
#pragma unroll
      for (int j = 0; j < 4; ++j) { const float gv = (float)ga[j]; o[j] = (h16)(O[dt][g4 * 4 + j] * inv * siluf_(gv)); }
      *(half4*)(p.hy + qrow * 1024 + 640 + head * 64 + d0) = o;
    }
}

__device__ __forceinline__ void phase_mix(const Params& p, int l, int bid, int nb, char* smem, int sub) {
  const int nunits = l == 0 ? 1536 + 96 : 1536;
  if (nb >= 640) {
    if (bid < 384) { if (sub & 1) rwkv_chain(p, l, bid, smem); }
    else if (bid < 512) { if (sub & 2) hgrn_chain(p, l, bid - 384, smem); }
    else if (sub & 4) for (int u = bid - 512; u < nunits; u += nb - 512) attn_unit(p, l, u);
  } else {
    for (int it = bid; it < 512 + nunits; it += nb) {
      if (it < 384) rwkv_chain(p, l, it, smem);
      else if (it < 512) hgrn_chain(p, l, it - 384, smem);
      else attn_unit(p, l, it - 512);
      __syncthreads();
    }
  }
}

__device__ __forceinline__ float sum4(const f32x4 v) { return (v[0] + v[1]) + (v[2] + v[3]); }
__device__ __forceinline__ f32x4 h4f(const half4 h) { return (f32x4){(float)h[0], (float)h[1], (float)h[2], (float)h[3]}; }
__device__ __forceinline__ void phase_readout(const Params& p, int l, int bid, int nb, bool dummy) {
  const int tid = tid_opaque(), lane = tid & 63, w = tid >> 6;
  const int nrows = l == 1 ? NLAT : NTOK;
  const int hl = lane >> 4, c4 = (lane & 15) * 4;
#pragma unroll 2
  for (int it = bid * 4 + w; it < nrows * 3; it += nb * 4) {
    const int row = it / 3, q = it - row * 3;
    int t, Tn;
    if (row < NLAT) { t = row & 4095; Tn = 4096; } else { t = (row - NLAT) & 255; Tn = 256; }
    const h16* pr = p.P + (size_t)row * PC;
    h16* yo = p.hy + (size_t)row * 1024;
    h16* yw = dummy ? p.F + (size_t)row * 1536 : yo;
    if (q < 2) {
      const int head = q * 4 + hl; const bool valid = head < 6; const int c = (valid ? head : 5) * 64 + c4;
      const bool hp = t > 0, hn = t + 1 < Tn;
      const f32x4 y = h4f(*(const half4*)(pr + 768 + c)) + h4f(*(const half4*)(yo + c));
      f32x4 sh[3];
      {
        const h16* prk = pr + (valid ? head : 5) * 128 + 2 * c4;
        const half8 cur8 = *(const half8*)prk;
        half8 prv8, nxt8;
#pragma unroll
        for (int j = 0; j < 8; ++j) { prv8[j] = (h16)0.f; nxt8[j] = (h16)0.f; }
        if (hp) prv8 = *(const half8*)(prk - PC);
        if (hn) nxt8 = *(const half8*)(prk + PC);
#pragma unroll
        for (int k = 0; k < 2; ++k) {
          const f32x4 cur = {(float)cur8[k], (float)cur8[2 + k], (float)cur8[4 + k], (float)cur8[6 + k]};
          const f32x4 prv = {(float)prv8[k], (float)prv8[2 + k], (float)prv8[4 + k], (float)prv8[6 + k]};
          const f32x4 nxt = {(float)nxt8[k], (float)nxt8[2 + k], (float)nxt8[4 + k], (float)nxt8[6 + k]};
          const f32x4 mp = *(const f32x4*)(p.mu_prev + l * 1792 + k * 384 + c), mn = *(const f32x4*)(p.mu_next + l * 1792 + k * 384 + c);
          sh[k] = cur + mp * (prv - cur) + mn * (nxt - cur);
        }
        const int col = 1408 + c;
        const f32x4 cur = h4f(*(const half4*)(pr + col));
        const f32x4 prv = hp ? h4f(*(const half4*)(pr + col - PC)) : (f32x4){0.f, 0.f, 0.f, 0.f};
        const f32x4 nxt = hn ? h4f(*(const half4*)(pr + col + PC)) : (f32x4){0.f, 0.f, 0.f, 0.f};
        const f32x4 mp = *(const f32x4*)(p.mu_prev + l * 1792 + col), mn = *(const f32x4*)(p.mu_next + l * 1792 + col);
        sh[2] = cur + mp * (prv - cur) + mn * (nxt - cur);
      }
      const f32x4 v = h4f(*(const half4*)(p.VB + (size_t)row * 384 + c));
      const f32x4 gw = *(const f32x4*)(p.gn_w + l * 384 + c), gb = *(const f32x4*)(p.gn_b + l * 384 + c), rk = *(const f32x4*)(p.r_k + l * 384 + c);
      const float mean = red16(sum4(y)) * (1.f / 64.f);
      const f32x4 yc = y - mean;
      const float var = red16(sum4(yc * yc)) * (1.f / 64.f);
      const float rs = rsqrtf(var + 64e-5f);
      const float bs = red16(sum4(sh[0] * sh[1] * rk));
      half4 o;
#pragma unroll
      for (int j = 0; j < 4; ++j) o[j] = (h16)((yc[j] * rs * gw[j] + gb[j] + bs * v[j]) * siluf_(sh[2][j]));
      if (valid) *(half4*)(yw + c) = o;
    } else {
      const int c = hl * 64 + c4;
      const f32x4 o = h4f(*(const half4*)(pr + 1152 + c)) + h4f(*(const half4*)(yo + 384 + c));
      const f32x4 g = h4f(*(const half4*)(pr + 2816 + c));
      const f32x4 nw = *(const f32x4*)(p.hg_norm_w + l * 256 + c);
      const float ms = red16(sum4(o * o)) * (1.f / 64.f);
      const float rs = rsqrtf(ms + 1e-6f);
      half4 ov;
#pragma unroll
      for (int j = 0; j < 4; ++j) ov[j] = (h16)(o[j] * rs * nw[j] * siluf_(g[j]));
      *(half4*)(yw + 384 + c) = ov;
    }
  }
}

__device__ __forceinline__ void phase_final(const Params& p, int bid, int nb) {
  const int tid = tid_opaque(), lane = tid & 63, w = tid >> 6;
  for (int row = bid * 4 + w; row < NLAT; row += nb * 4) {
    float* src = p.out + (size_t)row * 1024;
    f32x4 v[4]; float ss = 0.f;
#pragma unroll
    for (int i = 0; i < 4; ++i) { v[i] = *(const f32x4*)(src + i * 256 + lane * 4); ss += v[i][0] * v[i][0] + v[i][1] * v[i][1] + v[i][2] * v[i][2] + v[i][3] * v[i][3]; }
    ss = wave_sum_dpp(ss);
    const float rs = rsqrtf(ss * (1.f / 1024.f) + 1e-6f);
#pragma unroll
    for (int i = 0; i < 4; ++i) {
      const int col = i * 256 + lane * 4;
      const f32x4 nwv = *(const f32x4*)(p.final_w + col);
      f32x4 o;
#pragma unroll
      for (int j = 0; j < 4; ++j) o[j] = v[i][j] * rs * nwv[j];
      *(f32x4*)(src + col) = o;
    }
  }
}

__global__ void __launch_bounds__(256, 3) __attribute__((target("no-packed-fp32-ops"))) mega(Params p, int ph_lo, int ph_hi, int coop) {
  __shared__ __attribute__((aligned(16))) char smem[SMEM_BYTES];
  __shared__ uint4 xb_words;
  XcdBarrier xb; xb.bar = p.bar; xb.x = 0; xb.st = (volatile LAS unsigned*)&xb_words;
  if (coop) { if (threadIdx.x == 0) xb_words = make_uint4(0u, 0u, 0u, 0u); __syncthreads(); xb = xcd_barrier_post(p.bar, (volatile LAS unsigned*)&xb_words); }
  if (coop) for (int i = 0; i < EXTRA_SYNCS; ++i) { xcd_barrier(xb); }
  if (coop == 2) cg::this_grid().sync();
  for (int ph = ph_lo; ph < ph_hi; ++ph) {
    for (int rep = 0; rep < (((PROBE_MASK >> ph) & 1) ? 2 : 1); ++rep) {
      int bid = blockIdx.x, nb = gridDim.x;
      asm volatile("" : "+s"(bid), "+s"(nb));
      if (ph == 0) phase_prep(p, bid, nb, smem);
      else if (ph == 13) phase_final(p, bid, nb);
      else {
        const int l = (ph - 1) / 6, s = (ph - 1) % 6;
        if (s == 0) phase_norm(p, l, bid, nb);
        else if (s == 1) phase_gemm<0>(p, l, bid, nb, smem);
        else if (s == 2) phase_feat(p, l, bid, nb, smem, PROBE_MASK && ((PROBE_MASK >> ph) & 1) && rep == 0);
        else if (s == 3) phase_mix(p, l, bid, nb, smem, rep ? PROBE_SUB : 7);
        else if (s == 4) phase_readout(p, l, bid, nb, PROBE_MASK && ((PROBE_MASK >> ph) & 1) && rep == 0);
        else phase_gemm<1>(p, l, bid, nb, smem);
      }
      if (PROBE_MASK && rep == 0 && ((PROBE_MASK >> ph) & 1)) { xcd_barrier(xb); }
    }
    if (coop && ph + 1 < ph_hi) { xcd_barrier(xb); }
  }
}

extern "C" void kernel_launch(void* const* d_in, const int* in_sizes, int n_in, void* d_out, int out_size, void* d_ws, size_t ws_size, hipStream_t stream) {
  static int grid_blocks = 0;
  if (!grid_blocks) {
    int dev = 0, cus = 0, per_cu = 0;
    hipGetDevice(&dev);
    hipDeviceGetAttribute(&cus, hipDeviceAttributeMultiprocessorCount, dev);
    hipOccupancyMaxActiveBlocksPerMultiprocessor(&per_cu, mega, 256, 0);
    if (per_cu < 1) per_cu = 1;
    grid_blocks = cus * per_cu;
  }
  Params p{};
  const float* const* in = (const float* const*)d_in;
  p.x = in[0]; p.c = in[1]; p.ctx = in[2]; p.c_ctx = in[3]; p.mod_w = in[4]; p.mod_b = in[5]; p.norm_w = in[6]; p.w_in = in[7]; p.w_out = in[8];
  p.mu_prev = in[9]; p.mu_next = in[10]; p.w0 = in[11]; p.w2 = in[12]; p.a0 = in[13]; p.a2 = in[14]; p.k_k = in[15]; p.k_a = in[16]; p.r_k = in[17];
  p.gn_w = in[18]; p.gn_b = in[19]; p.vw1 = in[20]; p.vw2 = in[21]; p.vb = in[22]; p.lb_logits = in[23]; p.hg_norm_w = in[24]; p.sink = in[25]; p.final_w = in[26];
  p.out = (float*)d_out;
  char* ws = (char*)d_ws; size_t off = 0;
  auto take = [&](size_t bytes) { char* r = ws + off; off += (bytes + 255) & ~(size_t)255; return r; };
  p.win_t = (h16*)take((size_t)2 * NPAD * 1024 * 2);
  p.wout_t = (h16*)take((size_t)2 * 1024 * 1024 * 2);
  p.wl_t = (h16*)take((size_t)2 * 4 * 384 * 64 * 2);
  p.mod = (float*)take((size_t)2 * 9 * 3072 * 4);
  p.rope = (float*)take((size_t)64 * 16 * 2 * 4);
  p.hy = (h16*)take((size_t)NTOK * 1024 * 2);
  p.P = (h16*)take((size_t)NTOK * PC * 2);
  p.F = (h16*)take((size_t)NTOK * 1536 * 2);
  p.VB = (h16*)take((size_t)NTOK * 384 * 2);
  p.VT = (h16*)take((size_t)16 * 64 * VTS * 2);
  p.xc1 = (float*)take((size_t)2048 * 1024 * 4);
  p.bar = (unsigned*)take(16384);
  if (off > ws_size) fprintf(stderr, "workspace too small: need %zu have %zu\n", off, ws_size);
#if SINGLE_LAUNCH
  hipMemsetAsync(p.bar, 0, 16384, stream);
  int lo = 0, hi = 14, coop = 1;
  void* args[] = {&p, &lo, &hi, &coop};
  hipError_t e = hipLaunchCooperativeKernel((void*)mega, dim3(grid_blocks), dim3(256), args, 0, stream);
  if (e != hipSuccess) fprintf(stderr, "cooperative launch failed: %s (grid %d)\n", hipGetErrorString(e), grid_blocks);
#else
  for (int ph = 0; ph < 14; ++ph) mega<<<grid_blocks, 256, 0, stream>>>(p, ph, ph + 1, 0);
#endif
}
```

```cpp
#include <hip/hip_runtime.h>
#include <hip/hip_cooperative_groups.h>
#include <cstdio>
#include <cstdint>
namespace cg = cooperative_groups;

typedef _Float16 h16;
typedef _Float16 half8 __attribute__((ext_vector_type(8)));
typedef _Float16 half4 __attribute__((ext_vector_type(4)));
typedef float f32x16 __attribute__((ext_vector_type(16)));
typedef float f32x4 __attribute__((ext_vector_type(4)));
typedef float f32x2 __attribute__((ext_vector_type(2)));
typedef unsigned u32x4 __attribute__((ext_vector_type(4)));
typedef _Float16 half2v __attribute__((ext_vector_type(2)));

constexpr int NLAT = 32768, NTOK = 34816;
constexpr int PC = 4160;
constexpr int NPAD = 4224;
constexpr int VTS = 4352;
constexpr int SMEM_BYTES = 49152;

#ifndef EXTRA_SYNCS
#define EXTRA_SYNCS 0
#endif
#ifndef PROBE_SUB
#define PROBE_SUB 7
#endif
#ifndef PROBE_MASK
#define PROBE_MASK 0
#endif
#ifndef SINGLE_LAUNCH
#define SINGLE_LAUNCH 1
#endif

struct Params {
  const float *x, *c, *ctx, *c_ctx, *mod_w, *mod_b, *norm_w, *w_in, *w_out;
  const float *mu_prev, *mu_next, *w0, *w2, *a0, *a2, *k_k, *k_a, *r_k, *gn_w, *gn_b;
  const float *vw1, *vw2, *vb, *lb_logits, *hg_norm_w, *sink, *final_w;
  float* out;
  h16 *win_t, *wout_t, *wl_t;
  float* mod;
  h16 *hy, *P, *F, *VB;
  h16* VT;
  float* xc1;
  float* rope;
  unsigned* bar;
};

__device__ __forceinline__ int tid_opaque() { int t = threadIdx.x; asm volatile("" : "+v"(t)); return t; }
__device__ __forceinline__ float wave_sum(float v) {
#pragma unroll
  for (int o = 32; o > 0; o >>= 1) v += __shfl_xor(v, o);
  return v;
}
__device__ __forceinline__ float sigmoidf_(float x) { return 1.f / (1.f + __expf(-x)); }
__device__ __forceinline__ float siluf_(float x) { return x / (1.f + __expf(-x)); }
template <int CTRL> __device__ __forceinline__ float dpp_mov(float x) {
  return __int_as_float(__builtin_amdgcn_update_dpp(0, __float_as_int(x), CTRL, 0xf, 0xf, true));
}
__device__ __forceinline__ float wave_sum_dpp(float x) {
  x += dpp_mov<0xB1>(x);
  x += dpp_mov<0x4E>(x);
  x += dpp_mov<0x141>(x);
  x += dpp_mov<0x140>(x);
  const int xi = __float_as_int(x);
  return __int_as_float(__builtin_amdgcn_readlane(xi, 0)) + __int_as_float(__builtin_amdgcn_readlane(xi, 16)) +
         __int_as_float(__builtin_amdgcn_readlane(xi, 32)) + __int_as_float(__builtin_amdgcn_readlane(xi, 48));
}
__device__ __forceinline__ float red8(float x) {
  x += dpp_mov<0xB1>(x);
  x += dpp_mov<0x4E>(x);
  x += dpp_mov<0x141>(x);
  return x;
}

#define XB_TMO      128
#define XB_XCNT(j)  (256  + 64 * (j))
#define XB_XSUB(j)  (1280 + 64 * (j))
#define XB_XGEN(j)  (2304 + 64 * (j))
#define XB_TOP      3328
#define XB_TOPGEN   3392
#define XCD_BAR_WORDS 3456
#define XB_SPIN_CAP (1u << 18)
#define LAS __attribute__((address_space(3)))
__device__ __forceinline__ unsigned xb_ld(unsigned* p)              { return __hip_atomic_load(p, __ATOMIC_RELAXED, __HIP_MEMORY_SCOPE_AGENT); }
__device__ __forceinline__ unsigned xb_add(unsigned* p, unsigned v) { return __hip_atomic_fetch_add(p, v, __ATOMIC_RELAXED, __HIP_MEMORY_SCOPE_AGENT); }
__device__ __forceinline__ unsigned xb_xcc_id() { return (unsigned)__builtin_amdgcn_s_getreg((3 << 11) | 20) & 0xFu; }
#define XB_SPIN(cond, bar) do { unsigned _sp = 0; while (cond) { __builtin_amdgcn_s_sleep(1); \
    if ((++_sp & 255u) == 0u) { if (xb_ld(&(bar)[XB_TMO])) break; if (_sp > XB_SPIN_CAP) { atomicAdd(&(bar)[XB_TMO], 1u); break; } } } } while (0)
struct XcdBarrier { unsigned* bar; unsigned x; volatile LAS unsigned* st; };
__device__ __forceinline__ XcdBarrier xcd_barrier_post(unsigned* bar, volatile LAS unsigned* st) {
  XcdBarrier b; b.bar = bar; b.x = xb_xcc_id(); b.st = st;
  if (threadIdx.x == 0) (void)xb_add(&bar[XB_XCNT(b.x)], 1u);
  return b;
}
__device__ __forceinline__ void xcd_barrier_complete(unsigned* bar, unsigned x, unsigned& nloc, unsigned& nx) {
  const unsigned G = gridDim.x * gridDim.y * gridDim.z;
  unsigned sum, cnt, mine, sp = 0u;
  for (;;) {
    sum = 0u; cnt = 0u; mine = 0u;
#pragma unroll
    for (unsigned j = 0; j < 16; ++j) { const unsigned c = xb_ld(&bar[XB_XCNT(j)]); sum += c; cnt += (c > 0u) ? 1u : 0u; mine = (j == x) ? c : mine; }
    if (sum == G) break;
    __builtin_amdgcn_s_sleep(1);
    if ((++sp & 255u) == 0u) { if (xb_ld(&bar[XB_TMO])) break; if (sp > XB_SPIN_CAP) { atomicAdd(&bar[XB_TMO], 1u); break; } }
  }
  nloc = mine > 0u ? mine : 1u; nx = cnt > 0u ? cnt : 1u;
}
__device__ __forceinline__ void xcd_barrier(const XcdBarrier& b) {
  asm volatile("s_waitcnt vmcnt(0)" ::: "memory");
  __syncthreads();
  if (threadIdx.x == 0) {
    unsigned* bar = b.bar;
    __builtin_amdgcn_s_waitcnt(0);
    unsigned nloc = b.st[0], nx = b.st[1];
    if (nloc == 0u) { xcd_barrier_complete(bar, b.x, nloc, nx); b.st[0] = nloc; b.st[1] = nx; }
    const unsigned old = xb_add(&bar[XB_XSUB(b.x)], 1u);
    const unsigned gen = old / nloc;
    if (old + 1u == (gen + 1u) * nloc) {
      __builtin_amdgcn_fence(__ATOMIC_RELEASE, "agent");
      asm volatile("s_waitcnt vmcnt(0)" ::: "memory");
      const unsigned og = xb_add(&bar[XB_TOP], 1u);
      const unsigned tg = og / nx;
      if (og + 1u == (tg + 1u) * nx) xb_add(&bar[XB_TOPGEN], 1u);
      else XB_SPIN(xb_ld(&bar[XB_TOPGEN]) == tg, bar);
      __builtin_amdgcn_fence(__ATOMIC_ACQUIRE, "agent");
      xb_add(&bar[XB_XGEN(b.x)], 1u);
      asm volatile("s_waitcnt vmcnt(0)" ::: "memory");
    } else {
      XB_SPIN(xb_ld(&bar[XB_XGEN(b.x)]) == gen, bar);
      __builtin_amdgcn_fence(__ATOMIC_ACQUIRE, "agent");
      asm volatile("s_waitcnt vmcnt(0)" ::: "memory");
    }
  }
  __syncthreads();
}

__device__ __forceinline__ void phase_prep(const Params& p, int bid, int nb, char* smem) {
  const int tid = tid_opaque();
  float* sf = (float*)smem;
  constexpr int N_WIN = 2048, N_WOUT = 512, N_MOD = 192, N_PADI = 1024, N_WL = 768;
  constexpr int total = N_WIN + N_WOUT + N_MOD + N_PADI + N_WL + 1;
  for (int it = bid; it < total; it += nb) {
    if (it < N_WIN + N_WOUT) {
      const float* src; h16* dst; int ncols, kt, ntile;
      if (it < N_WIN) { int l = it >> 10, r = it & 1023; kt = r >> 6; ntile = r & 63; src = p.w_in + (size_t)l * 1024 * 4096; dst = p.win_t + (size_t)l * NPAD * 1024; ncols = 4096; }
      else { int j = it - N_WIN; int l = j >> 8, r = j & 255; kt = r >> 4; ntile = r & 15; src = p.w_out + (size_t)l * 1024 * 1024; dst = p.wout_t + (size_t)l * 1024 * 1024; ncols = 1024; }
      for (int i = tid; i < 4096; i += 256) { int kk = i >> 6, nn = i & 63; sf[kk * 65 + nn] = src[(size_t)(kt * 64 + kk) * ncols + ntile * 64 + nn]; }
      __syncthreads();
      const bool rkperm = it < N_WIN && ntile < 12;
      for (int i = tid; i < 4096; i += 256) {
        int nn = i >> 6, kk = i & 63;
        const int nrow = rkperm ? ((ntile % 6) * 128 + 2 * nn + ntile / 6) : (ntile * 64 + nn);
        dst[(size_t)nrow * 1024 + kt * 64 + kk] = (h16)sf[kk * 65 + nn];
      }
      __syncthreads();
    } else if (it < N_WIN + N_WOUT + N_MOD) {
      const int j = it - N_WIN - N_WOUT; const int l = j / 96; const int cl = tid & 31, ks = tid >> 5; const int col = (j % 96) * 32 + cl;
      for (int i = tid; i < 9 * 1024; i += 256) { int r = i >> 10, k = i & 1023; float v = r < 8 ? p.c[r * 1024 + k] : p.c_ctx[k]; sf[i] = siluf_(v); }
      __syncthreads();
      float acc[9];
#pragma unroll
      for (int r = 0; r < 9; ++r) acc[r] = 0.f;
      const float* mw = p.mod_w + (size_t)l * 1024 * 3072 + (size_t)(ks * 128) * 3072 + col;
#pragma unroll 2
      for (int k = 0; k < 128; k += 4) {
        const float w0 = mw[(size_t)k * 3072], w1 = mw[(size_t)(k + 1) * 3072], w2 = mw[(size_t)(k + 2) * 3072], w3 = mw[(size_t)(k + 3) * 3072];
#pragma unroll
        for (int r = 0; r < 9; ++r) { const f32x4 sv = *(const f32x4*)&sf[r * 1024 + ks * 128 + k]; acc[r] += sv[0] * w0 + sv[1] * w1 + sv[2] * w2 + sv[3] * w3; }
      }
#pragma unroll
      for (int r = 0; r < 9; ++r) acc[r] += __shfl_xor(acc[r], 32);
      __syncthreads();
      if ((tid & 63) < 32) {
#pragma unroll
        for (int r = 0; r < 9; ++r) sf[((tid >> 6) * 9 + r) * 32 + cl] = acc[r];
      }
      __syncthreads();
      for (int i = tid; i < 288; i += 256) {
        const int r = i >> 5, c2 = i & 31;
        const float v = sf[(0 * 9 + r) * 32 + c2] + sf[(1 * 9 + r) * 32 + c2] + sf[(2 * 9 + r) * 32 + c2] + sf[(3 * 9 + r) * 32 + c2];
        const int cc = (j % 96) * 32 + c2;
        p.mod[(size_t)(l * 9 + r) * 3072 + cc] = v + p.mod_b[l * 3072 + cc];
      }
      __syncthreads();
    } else if (it < N_WIN + N_WOUT + N_MOD + N_PADI) {
      int j = it - (N_WIN + N_WOUT + N_MOD); int idx = j * 256 + tid;
      int l = idx >> 17; int rem = idx & 131071; int m = rem >> 10, k = rem & 1023;
      float v = (l == 1 && m < 32) ? p.vw1[k * 32 + m] : 0.f;
      p.win_t[(size_t)l * NPAD * 1024 + (size_t)(4096 + m) * 1024 + k] = (h16)v;
    } else if (it < N_WIN + N_WOUT + N_MOD + N_PADI + N_WL) {
      const int idx = (it - (N_WIN + N_WOUT + N_MOD + N_PADI)) * 256 + tid;
      const int r = idx & 63, c = (idx >> 6) % 384, ls = idx / (384 * 64); const int l = ls >> 2, slot = ls & 3, dir = slot & 1, kind = slot >> 1;
      const float v = (kind == 0 ? p.w2 : p.a2)[((size_t)(l * 2 + dir) * 64 + r) * 384 + c];
      p.wl_t[idx] = (h16)v;
    } else {
      if (tid < 16) {
        double inv = 1.0; for (int i = 0; i < tid; ++i) inv *= 0.5623413251903491;
        double x2 = inv * inv, ts = inv, tc = 1.0, s1 = inv, c1 = 1.0;
        for (int n = 1; n <= 10; ++n) { tc *= -x2 / ((2.0 * n - 1.0) * (2.0 * n)); c1 += tc; ts *= -x2 / ((2.0 * n) * (2.0 * n + 1.0)); s1 += ts; }
        double cc = 1.0, ss = 0.0;
        for (int pos = 0; pos < 64; ++pos) {
          p.rope[(pos * 16 + tid) * 2] = (float)cc; p.rope[(pos * 16 + tid) * 2 + 1] = (float)ss;
          double nc = cc * c1 - ss * s1, ns = ss * c1 + cc * s1; cc = nc; ss = ns;
        }
      }
    }
  }
}

__device__ __forceinline__ void phase_norm(const Params& p, int l, int bid, int nb) {
  const int tid = tid_opaque(), lane = tid & 63, w = tid >> 6;
  for (int row = bid * 4 + w; row < NTOK; row += nb * 4) {
    const float* src = (l == 0) ? (row < NLAT ? p.x + (size_t)row * 1024 : p.ctx + (size_t)(row - NLAT) * 1024)
                                : (row < NLAT ? p.out + (size_t)row * 1024 : p.xc1 + (size_t)(row - NLAT) * 1024);
    const int mr = row < NLAT ? (row >> 12) : 8;
    const float* md = p.mod + (size_t)(l * 9 + mr) * 3072;
    const float* nw = p.norm_w + l * 1024;
    f32x4 v[4]; float ss = 0.f;
#pragma unroll
    for (int i = 0; i < 4; ++i) { v[i] = *(const f32x4*)(src + i * 256 + lane * 4); ss += v[i][0] * v[i][0] + v[i][1] * v[i][1] + v[i][2] * v[i][2] + v[i][3] * v[i][3]; }
    ss = wave_sum_dpp(ss);
    const float rs = rsqrtf(ss * (1.f / 1024.f) + 1e-6f);
#pragma unroll
    for (int i = 0; i < 4; ++i) {
      const int col = i * 256 + lane * 4;
      f32x4 nwv = *(const f32x4*)(nw + col), sc = *(const f32x4*)(md + 1024 + col), sh = *(const f32x4*)(md + col);
      half4 o;
#pragma unroll
      for (int j = 0; j < 4; ++j) o[j] = (h16)(v[i][j] * rs * nwv[j] * (1.f + sc[j]) + sh[j]);
      *(half4*)(p.hy + (size_t)row * 1024 + col) = o;
    }
  }
}

template <int MODE>
__device__ __forceinline__ void phase_gemm(const Params& p, int l, int bid, int nb, char* smem) {
  const h16* A = p.hy;
  const h16* Bt = MODE == 0 ? p.win_t + (size_t)l * NPAD * 1024 : p.wout_t + (size_t)l * 1024 * 1024;
  const int ntn = MODE == 0 ? (l == 1 ? 33 : 32) : 8;
  const int ntm = (MODE == 1 && l == 1) ? 256 : 272;
  const int tid = tid_opaque(), lane = tid & 63, w = tid >> 6, wr = w >> 1, wc = w & 1, lq = lane & 31, hh = lane >> 5;
  h16* As = (h16*)smem; h16* Bs = As + 128 * 72;
  const int ldrow = tid >> 3, ldch = (tid & 7) * 8;
  for (int tile = bid; tile < ntm * ntn; tile += nb) {
    int tm, tn;
    {
      const int mper = ntm >> 3;
      const int nmain = MODE == 0 ? 32 : 8;
      if (tile < ntm * nmain) {
        const int x = tile & 7, sq = tile >> 3;
        const int strip = sq / (mper * 8), rem = sq - strip * (mper * 8);
        tm = x * mper + (rem >> 3); tn = strip * 8 + (rem & 7);
      } else { tm = tile - ntm * nmain; tn = nmain; }
    }
    const h16* Ag = A + (size_t)(tm * 128 + ldrow) * 1024 + ldch; const h16* Bg = Bt + (size_t)(tn * 128 + ldrow) * 1024 + ldch;
    f32x16 acc[2][2];
#pragma unroll
    for (int i = 0; i < 2; ++i)
#pragma unroll
      for (int j = 0; j < 2; ++j)
#pragma unroll
        for (int r = 0; r < 16; ++r) acc[i][j][r] = 0.f;
    u32x4 ra[4], rb[4];
#pragma unroll
    for (int i = 0; i < 4; ++i) { ra[i] = *(const u32x4*)(Ag + (size_t)i * 32 * 1024); rb[i] = *(const u32x4*)(Bg + (size_t)i * 32 * 1024); }
#pragma unroll 1
    for (int kt = 0; kt < 16; ++kt) {
      __syncthreads();
#pragma unroll
      for (int i = 0; i < 4; ++i) { *(u32x4*)(As + (ldrow + i * 32) * 72 + ldch) = ra[i]; *(u32x4*)(Bs + (ldrow + i * 32) * 72 + ldch) = rb[i]; }
      __syncthreads();
      if (kt + 1 < 16) {
#pragma unroll
        for (int i = 0; i < 4; ++i) { ra[i] = *(const u32x4*)(Ag + (size_t)i * 32 * 1024 + (kt + 1) * 64); rb[i] = *(const u32x4*)(Bg + (size_t)i * 32 * 1024 + (kt + 1) * 64); }
      }
#pragma unroll
      for (int s = 0; s < 4; ++s) {
        half8 a[2], b[2];
#pragma unroll
        for (int i = 0; i < 2; ++i) { a[i] = *(const half8*)(As + (64 * wr + 32 * i + lq) * 72 + 16 * s + 8 * hh); b[i] = *(const half8*)(Bs + (64 * wc + 32 * i + lq) * 72 + 16 * s + 8 * hh); }
#pragma unroll
        for (int i = 0; i < 2; ++i)
#pragma unroll
          for (int j = 0; j < 2; ++j) {
            if (MODE == 0) acc[i][j] = __builtin_amdgcn_mfma_f32_32x32x16_f16(b[j], a[i], acc[i][j], 0, 0, 0);
            else acc[i][j] = __builtin_amdgcn_mfma_f32_32x32x16_f16(a[i], b[j], acc[i][j], 0, 0, 0);
          }
      }
    }
    if (MODE == 0) {
      if (tn < 32) {
        __syncthreads();
        h16* Cs = (h16*)smem;
#pragma unroll
        for (int i = 0; i < 2; ++i)
#pragma unroll
          for (int j = 0; j < 2; ++j)
#pragma unroll
            for (int g = 0; g < 4; ++g) {
              half4 o;
#pragma unroll
              for (int q = 0; q < 4; ++q) o[q] = (h16)acc[i][j][4 * g + q];
              *(half4*)(Cs + (64 * wr + 32 * i + lq) * 136 + 64 * wc + 32 * j + 8 * g + 4 * hh) = o;
            }
        __syncthreads();
#pragma unroll
        for (int q = 0; q < 8; ++q) {
          const int id = tid + q * 256; const int row = id >> 4, ch = id & 15;
          *(u32x4*)(p.P + (size_t)(tm * 128 + row) * PC + tn * 128 + ch * 8) = *(const u32x4*)(Cs + row * 136 + ch * 8);
        }
      } else if (wc == 0) {
#pragma unroll
        for (int i = 0; i < 2; ++i)
#pragma unroll
          for (int r = 0; r < 16; ++r) ((float*)(p.F + (size_t)(tm * 128 + 64 * wr + 32 * i + lq) * 1536))[(r & 3) + 8 * (r >> 2) + 4 * hh] = acc[i][0][r];
      }
    } else {
      const int row0 = tm * 128;
      const int mr = row0 < NLAT ? (row0 >> 12) : 8;
      const int col = tn * 128 + 64 * wc + lq;
      const float* gp = p.mod + (size_t)(l * 9 + mr) * 3072 + 2048 + col;
      const float g0 = gp[0], g1 = gp[32];
      const float* xs0; float* xd0;
      if (l == 0) { if (row0 < NLAT) { xs0 = p.x + (size_t)row0 * 1024; xd0 = p.out + (size_t)row0 * 1024; } else { xs0 = p.ctx + (size_t)(row0 - NLAT) * 1024; xd0 = p.xc1 + (size_t)(row0 - NLAT) * 1024; } }
      else { xs0 = p.out + (size_t)row0 * 1024; xd0 = p.out + (size_t)row0 * 1024; }
      const float* __restrict__ xsrc = xs0 + (size_t)(64 * wr + 4 * hh) * 1024 + col;
      float* __restrict__ xdst = xd0 + (size_t)(64 * wr + 4 * hh) * 1024 + col;
#pragma unroll
      for (int i = 0; i < 2; ++i)
#pragma unroll
        for (int r = 0; r < 16; ++r) {
          const int ro = (32 * i + (r & 3) + 8 * (r >> 2)) * 1024;
          xdst[ro] = xsrc[ro] + g0 * acc[i][0][r];
          xdst[ro + 32] = xsrc[ro + 32] + g1 * acc[i][1][r];
        }
    }
  }
}

#define LOAD_COL34(arr, base, t0, Tn) \
  _Pragma("unroll") for (int q_ = 0; q_ < 34; ++q_) { const int t_ = (t0) - 1 + q_; arr[q_] = (t_ >= 0 && t_ < (Tn)) ? (base)[(long)t_ * PC] : (h16)0.f; }

__device__ __forceinline__ void phase_feat(const Params& p, int l, int bid, int nb, char* smem, bool dry) {
  const int tid = tid_opaque();
  h16* inh = (h16*)smem;
  float* zt = (float*)(smem + 32 * 264 * 2);
  for (int item = bid; item < 1088; item += nb) {
    int b, t0, Tn, rowbase; bool isctx;
    if (item < 1024) { b = item >> 7; t0 = (item & 127) * 32; Tn = 4096; rowbase = b * 4096; isctx = false; }
    else { int j = item - 1024; b = j >> 3; t0 = (j & 7) * 32; Tn = 256; rowbase = NLAT + b * 256; isctx = true; }
    {
      const int col = 1152 + tid;
      const float mp = p.mu_prev[l * 1792 + col], mn = p.mu_next[l * 1792 + col];
      const h16* base = p.P + (size_t)rowbase * PC + col;
      h16 xv[34];
      LOAD_COL34(xv, base, t0, Tn)
#pragma unroll
      for (int tt = 0; tt < 32; ++tt) {
        const float prev = (float)xv[tt], cur = (float)xv[tt + 1], nxt = (float)xv[tt + 2];
        float sv = cur + mp * (prev - cur) + mn * (nxt - cur);
        if (tid < 128) { const float e2 = __expf(2.f * sv); sv = 1.f - 2.f / (e2 + 1.f); }
        inh[tt * 264 + tid] = (h16)sv;
      }
      if (l == 1) {
#pragma unroll
        for (int i = 0; i < 4; ++i) { int id = tid + i * 256; zt[id] = ((const float*)(p.F + (size_t)(rowbase + t0 + (id >> 5)) * 1536))[id & 31]; }
      }
    }
    __syncthreads();
#pragma unroll 1
    for (int c = tid; c < 384; c += 256) {
      const int col = 768 + c;
      const float mp = p.mu_prev[l * 1792 + col], mn = p.mu_next[l * 1792 + col];
      const h16* base = p.P + (size_t)rowbase * PC + col;
      h16 xv[34];
      LOAD_COL34(xv, base, t0, Tn)
      h16* dst = p.VB + (size_t)(rowbase + t0) * 384 + c;
      if (l == 0) {
#pragma unroll
        for (int tt = 0; tt < 32; ++tt) {
          const float prev = (float)xv[tt], cur = (float)xv[tt + 1], nxt = (float)xv[tt + 2];
          dst[tt * 384] = (h16)(cur + mp * (prev - cur) + mn * (nxt - cur));
        }
      } else {
        const float vbv = p.vb[c];
#pragma unroll 1
        for (int hf = 0; hf < 2; ++hf) {
          h16 vfv[16]; float ga[16];
#pragma unroll
          for (int tt = 0; tt < 16; ++tt) { vfv[tt] = dst[(hf * 16 + tt) * 384]; ga[tt] = vbv; }
#pragma unroll 1
          for (int m = 0; m < 32; m += 4) {
            const float w0 = p.vw2[m * 384 + c], w1 = p.vw2[(m + 1) * 384 + c], w2 = p.vw2[(m + 2) * 384 + c], w3 = p.vw2[(m + 3) * 384 + c];
#pragma unroll
            for (int tt = 0; tt < 16; ++tt) { const f32x4 z = *(const f32x4*)&zt[(hf * 16 + tt) * 32 + m]; ga[tt] += z[0] * w0 + z[1] * w1 + z[2] * w2 + z[3] * w3; }
          }
#pragma unroll
          for (int tt = 0; tt < 16; ++tt) {
            const float prev = hf ? (float)xv[16 + tt] : (float)xv[tt], cur = hf ? (float)xv[17 + tt] : (float)xv[tt + 1], nxt = hf ? (float)xv[18 + tt] : (float)xv[tt + 2];
            const float sv = cur + mp * (prev - cur) + mn * (nxt - cur);
            dst[(hf * 16 + tt) * 384] = (h16)(sv + ((float)vfv[tt] - sv) * sigmoidf_(ga[tt]));
          }
        }
      }
    }
    {
      const int w = tid >> 6, lane = tid & 63, lq = tid & 31, hh = lane >> 5;
      const int dir = w & 1, chalf = w >> 1;
      half8 xin[2][4];
#pragma unroll
      for (int kind = 0; kind < 2; ++kind)
#pragma unroll
        for (int ks = 0; ks < 4; ++ks) xin[kind][ks] = *(const half8*)(inh + lq * 264 + kind * 128 + dir * 64 + 16 * ks + 8 * hh);
      h16* ost = (h16*)(smem + 32 * 264 * 2 + 4096) + w * (32 * 72);
      h16* fbase = p.F + (size_t)(rowbase + t0) * 1536 + dir * 768 + chalf * 384;
#pragma unroll 1
      for (int np = 0; np < 6; ++np) {
        const int c0 = chalf * 192 + np * 32;
        f32x16 acc[2];
#pragma unroll
        for (int kind = 0; kind < 2; ++kind) {
          const float* bias = (kind == 0 ? p.w0 : p.a0) + (l * 2 + dir) * 384 + c0;
          const h16* wl = p.wl_t + (size_t)((l * 4 + kind * 2 + dir) * 384 + c0) * 64;
#pragma unroll
          for (int g = 0; g < 4; ++g) { const f32x4 bv = *(const f32x4*)(bias + 8 * g + 4 * hh); acc[kind][4 * g] = bv[0]; acc[kind][4 * g + 1] = bv[1]; acc[kind][4 * g + 2] = bv[2]; acc[kind][4 * g + 3] = bv[3]; }
#pragma unroll
          for (int ks = 0; ks < 4; ++ks) {
            const half8 wf = *(const half8*)(wl + (size_t)lq * 64 + 16 * ks + 8 * hh);
            acc[kind] = __builtin_amdgcn_mfma_f32_32x32x16_f16(wf, xin[kind][ks], acc[kind], 0, 0, 0);
          }
        }
#pragma unroll
        for (int g = 0; g < 4; ++g) {
          half8 o;
#pragma unroll
          for (int j = 0; j < 4; ++j) { o[2 * j] = (h16)(0.6065306597126334f * sigmoidf_(acc[0][4 * g + j])); o[2 * j + 1] = (h16)sigmoidf_(acc[1][4 * g + j]); }
          *(half8*)(ost + lq * 72 + 16 * g + 8 * hh) = o;
        }
        asm volatile("s_waitcnt lgkmcnt(0)" ::: "memory");
#pragma unroll
        for (int q = 0; q < 4; ++q) {
          const int id = lane + q * 64; const int rr = id >> 3, ch = id & 7;
          *(u32x4*)(fbase + (size_t)rr * 1536 + np * 64 + ch * 8) = *(const u32x4*)(ost + rr * 72 + ch * 8);
        }
        asm volatile("s_waitcnt lgkmcnt(0)" ::: "memory");
      }
    }
    {
      const int head = tid >> 5, pr = tid & 31, half = pr >> 4, i = pr & 15;
      const int colbase = head < 6 ? 3072 + head * 64 : 3456 + (head - 6) * 64;
      const int d1 = half * 32 + i;
      const float qs = (head < 6 && !dry) ? 0.125f : 1.f;
      h16* pp = p.P + (size_t)(rowbase + t0) * PC + colbase + d1;
#pragma unroll
      for (int tq = 0; tq < 32; tq += 8) {
        h16 x1[8], x2[8];
#pragma unroll
        for (int u = 0; u < 8; ++u) { x1[u] = pp[(size_t)(tq + u) * PC]; x2[u] = pp[(size_t)(tq + u) * PC + 16]; }
#pragma unroll
        for (int u = 0; u < 8; ++u) {
          const int t = t0 + tq + u;
          float cs = 1.f, sn = 0.f;
          if (!isctx && !dry) { const int pos = half == 0 ? (t >> 6) : (t & 63); const f32x2 r2 = *(const f32x2*)&p.rope[(pos * 16 + i) * 2]; cs = r2[0]; sn = r2[1]; }
          const float a = (float)x1[u], bq = (float)x2[u];
          pp[(size_t)(tq + u) * PC] = (h16)((a * cs - bq * sn) * qs);
          pp[(size_t)(tq + u) * PC + 16] = (h16)((a * sn + bq * cs) * qs);
        }
      }
    }
    if (tid < 128) {
      const int g = tid >> 6, d = tid & 63;
      const h16* base = p.P + (size_t)(rowbase + t0) * PC + 3584 + tid;
      h16* dst = p.VT + (size_t)((b * 2 + g) * 64 + d) * VTS + (isctx ? 4096 + t0 : t0);
      half8 v[4];
#pragma unroll
      for (int q = 0; q < 4; ++q)
#pragma unroll
        for (int j = 0; j < 8; ++j) v[q][j] = base[(size_t)(q * 8 + j) * PC];
#pragma unroll
      for (int q = 0; q < 4; ++q) *(half8*)(dst + q * 8) = v[q];
    }
    __syncthreads();
  }
}

__device__ __forceinline__ float ulo(unsigned u) { return (float)__builtin_bit_cast(h16, (unsigned short)(u & 0xffffu)); }
__device__ __forceinline__ float uhi(unsigned u) { return (float)__builtin_bit_cast(h16, (unsigned short)(u >> 16)); }
__device__ __forceinline__ float red16(float x) {
  x += dpp_mov<0xB1>(x);
  x += dpp_mov<0x4E>(x);
  x += dpp_mov<0x141>(x);
  x += dpp_mov<0x140>(x);
  return x;
}
#define LDS_BARRIER() do { asm volatile("s_waitcnt lgkmcnt(0)" ::: "memory"); __builtin_amdgcn_s_barrier(); asm volatile("" ::: "memory"); } while (0)
constexpr int RREC = 336;
struct RwkvPf { unsigned rk[10]; h16 v[8]; unsigned ea[8]; };

__device__ __forceinline__ void rwkv_chain(const Params& p, int l, int item, char* smem) {
  const int tid0 = tid_opaque();
  const int tid = (item >= 256) ? (tid0 ^ 128) : tid0;
  const int lane = tid & 63, w = tid >> 6;
  const int chain = item >> 2, vq = item & 3;
  const int dir = chain / 48, b = (chain % 48) / 6, h = chain % 6;
  float* opb = (float*)smem;
  float* ybuf = opb + 2 * 16 * RREC;
  constexpr int NCH = 272;
  if (w < 2) {
    const int rl = tid >> 3, kq = tid & 7;
    float S[8];
#pragma unroll
    for (int j = 0; j < 8; ++j) S[j] = 0.f;
    __builtin_amdgcn_s_setprio(3);
    LDS_BARRIER();
#pragma unroll 1
    for (int ci = 0; ci < NCH; ++ci) {
      const float* op = opb + (ci & 1) * 16 * RREC;
      float* yb = ybuf + (ci & 1) * 256;
      f32x4 aA = *(const f32x4*)(op + 8 * kq + 64), aB = *(const f32x4*)(op + 8 * kq + 68);
#pragma unroll
      for (int step = 0; step < 16; ++step) {
        const float* o = op + step * RREC + 8 * kq;
        const f32x4 wA = *(const f32x4*)(o), wB = *(const f32x4*)(o + 4);
        const f32x4 bA = *(const f32x4*)(o + 128), bB = *(const f32x4*)(o + 132);
        const f32x4 kA = *(const f32x4*)(o + 192), kB = *(const f32x4*)(o + 196);
        const f32x4 rA = *(const f32x4*)(o + 256), rB = *(const f32x4*)(o + 260);
        const float vv = op[step * RREC + 320 + rl];
        f32x4 naA = aA, naB = aB;
        if (step + 1 < 16) { naA = *(const f32x4*)(o + RREC + 64); naB = *(const f32x4*)(o + RREC + 68); }
        const float d0 = S[0] * aA[0] + S[1] * aA[1] + S[2] * aA[2] + S[3] * aA[3];
        const float d1 = S[4] * aB[0] + S[5] * aB[1] + S[6] * aB[2] + S[7] * aB[3];
        const float sa = red8(d0 + d1);
#pragma unroll
        for (int j = 0; j < 4; ++j) {
          S[j] = S[j] * wA[j] + sa * bA[j] + vv * kA[j];
          S[4 + j] = S[4 + j] * wB[j] + sa * bB[j] + vv * kB[j];
        }
        const float y0 = S[0] * rA[0] + S[1] * rA[1] + S[2] * rA[2] + S[3] * rA[3];
        const float y1 = S[4] * rB[0] + S[5] * rB[1] + S[6] * rB[2] + S[7] * rB[3];
        const float yy = red8(y0 + y1);
        if (kq == 0) yb[step * 16 + rl] = yy;
        aA = naA; aB = naB;
      }
      LDS_BARRIER();
    }
    __builtin_amdgcn_s_setprio(0);
  } else {
    const int lw = w - 2, lt = tid - 128;
    const int hc = h * 64 + lane;
    const float mpr = p.mu_prev[l * 1792 + hc], mnr = p.mu_next[l * 1792 + hc];
    const float mpk = p.mu_prev[l * 1792 + 384 + hc], mnk = p.mu_next[l * 1792 + 384 + hc];
    const float kkw = p.k_k[l * 384 + hc], kaw = p.k_a[l * 384 + hc];
    RwkvPf pfA, pfB;
#define RWKV_ISSUE(ci_, PF) { const int seg_ = (ci_) >= 16; const int Tn_ = seg_ ? 4096 : 256; const int rb_ = seg_ ? b * 4096 : NLAT + b * 256; const int s0_ = (seg_ ? (ci_) - 16 : (ci_)) * 16 + 8 * lw; \
    _Pragma("unroll") for (int q = 0; q < 10; ++q) { int t_ = dir == 0 ? s0_ - 1 + q : Tn_ - s0_ - q; t_ = t_ < 0 ? 0 : (t_ >= Tn_ ? Tn_ - 1 : t_); \
      PF.rk[q] = ((const unsigned*)(p.P + (size_t)(rb_ + t_) * PC + h * 128))[lane]; } \
    _Pragma("unroll") for (int i = 0; i < 8; ++i) { const int t_ = dir == 0 ? s0_ + i : Tn_ - 1 - (s0_ + i); const size_t row = (size_t)rb_ + t_; \
      PF.v[i] = p.VB[row * 384 + hc]; PF.ea[i] = ((const unsigned*)(p.F + row * 1536 + dir * 768))[hc]; } }
#define RWKV_STAGE(ci_, PF) { float* op_ = opb + ((ci_) & 1) * 16 * RREC; \
    const int seg = (ci_) >= 16; const int Tn = seg ? 4096 : 256; const int c0 = (seg ? (ci_) - 16 : (ci_)) * 16; \
    _Pragma("unroll") for (int i = 0; i < 8; ++i) { \
      const int step = lw * 8 + i; const int t = dir == 0 ? c0 + step : Tn - 1 - (c0 + step); \
      const float rlo = ulo(PF.rk[i]), r0 = ulo(PF.rk[i + 1]), rhi = ulo(PF.rk[i + 2]); \
      const float klo = uhi(PF.rk[i]), k0 = uhi(PF.rk[i + 1]), khi = uhi(PF.rk[i + 2]); \
      const float rm = t > 0 ? (dir ? rhi : rlo) : 0.f, rp = t + 1 < Tn ? (dir ? rlo : rhi) : 0.f; \
      const float km = t > 0 ? (dir ? khi : klo) : 0.f, kp = t + 1 < Tn ? (dir ? klo : khi) : 0.f; \
      const float vv = (float)PF.v[i], e = ulo(PF.ea[i]), al = uhi(PF.ea[i]); \
      const float rs = r0 + mpr * (rm - r0) + mnr * (rp - r0); \
      const float ks = k0 + mpk * (km - k0) + mnk * (kp - k0); \
      const float kkr = ks * kkw; \
      const float n2 = wave_sum_dpp(kkr * kkr); \
      const float kk = kkr * rsqrtf(fmaxf(n2, 1e-24f)); \
      float* o = op_ + step * RREC + lane; \
      o[0] = __expf(-e); o[64] = -kk; o[128] = kk * al; o[192] = ks * (1.f + (al - 1.f) * kaw); o[256] = rs; \
      if ((lane >> 4) == vq) op_[step * RREC + 320 + (lane & 15)] = vv; } }
#define RWKV_WRITE(cj_) { const int seg = (cj_) >= 16; const int Tn = seg ? 4096 : 256; const int rowbase = seg ? b * 4096 : NLAT + b * 256; const int c0 = (seg ? (cj_) - 16 : (cj_)) * 16; \
    if (seg == 1 || l == 0) { const float* yb = ybuf + ((cj_) & 1) * 256; \
      _Pragma("unroll") for (int i = 0; i < 2; ++i) { const int idx = lt + i * 128; const int step = idx >> 4, ch = idx & 15; \
        const int t = dir == 0 ? c0 + step : Tn - 1 - (c0 + step); \
        const h16 yv = (h16)yb[idx]; \
        if (dir == 0) p.P[(size_t)(rowbase + t) * PC + 768 + h * 64 + 16 * vq + ch] = yv; \
        else p.hy[(size_t)(rowbase + t) * 1024 + h * 64 + 16 * vq + ch] = yv; } } }
    RWKV_ISSUE(0, pfA)
    RWKV_STAGE(0, pfA)
    RWKV_ISSUE(1, pfB)
    RWKV_ISSUE(2, pfA)
    LDS_BARRIER();
#pragma unroll 1
    for (int ci = 0; ci < NCH; ci += 2) {
      if (ci + 1 < NCH) RWKV_STAGE(ci + 1, pfB)
      if (ci + 3 < NCH) RWKV_ISSUE(ci + 3, pfB)
      if (ci >= 1) RWKV_WRITE(ci - 1)
      LDS_BARRIER();
      if (ci + 2 < NCH) RWKV_STAGE(ci + 2, pfA)
      if (ci + 4 < NCH) RWKV_ISSUE(ci + 4, pfA)
      RWKV_WRITE(ci)
      LDS_BARRIER();
    }
    RWKV_WRITE(NCH - 1)
  }
}

constexpr int HREC = 224;
struct HgrnPf { h16 f[4], q[4], iv[4]; };
__device__ __forceinline__ void hgrn_chain(const Params& p, int l, int item, char* smem) {
  const int tid = tid_opaque(), lane = tid & 63, w = tid >> 6;
  const int chain = item >> 1, vh = item & 1;
  const int dir = chain / 32, b = (chain % 32) / 4, h = chain % 4;
  float* op = (float*)smem;
  float* ybuf = op + 16 * HREC;
  const int hc = h * 64 + lane;
  float lb = 0.f;
  if (l == 1) lb = sigmoidf_(p.lb_logits[(dir * 2 + 1) * 256 + hc] - p.lb_logits[(dir * 2 + 0) * 256 + hc]);
  const int fcol = 1792 + 256 * (1 + dir) + hc;
  const int vc = tid >> 3, kq = tid & 7;
  float S[8];
#pragma unroll
  for (int j = 0; j < 8; ++j) S[j] = 0.f;
  HgrnPf pfA, pfB;
#define HGRN_ISSUE(ci_, PF) { const int seg_ = (ci_) >= 16; const int Tn_ = seg_ ? 4096 : 256; const int rb_ = seg_ ? b * 4096 : NLAT + b * 256; const int c0_ = (seg_ ? (ci_) - 16 : (ci_)) * 16; \
    _Pragma("unroll") for (int i = 0; i < 4; ++i) { const int step = w * 4 + i; const int t = dir == 0 ? c0_ + step : Tn_ - 1 - (c0_ + step); const h16* pr = p.P + ((size_t)rb_ + t) * PC; \
      PF.f[i] = pr[fcol]; PF.q[i] = pr[1792 + hc]; PF.iv[i] = pr[1792 + 768 + hc]; } }
#define HGRN_CHUNK(ci_, PF) { \
    const int seg = (ci_) >= 16; const int Tn = seg ? 4096 : 256; const int rowbase = seg ? b * 4096 : NLAT + b * 256; const int c0 = (seg ? (ci_) - 16 : (ci_)) * 16; \
    _Pragma("unroll") for (int i = 0; i < 4; ++i) { \
      const int step = w * 4 + i; \
      float* o = op + step * HREC + lane; \
      const float f = lb + (1.f - lb) * sigmoidf_((float)PF.f[i]); \
      o[0] = f; o[64] = 1.f - f; o[128] = (float)PF.q[i]; \
      if ((lane >> 5) == vh) op[step * HREC + 192 + (lane & 31)] = (float)PF.iv[i]; } \
    LDS_BARRIER(); \
    if ((ci_) + 2 < 272) HGRN_ISSUE((ci_) + 2, PF) \
    _Pragma("unroll") for (int step = 0; step < 16; ++step) { \
      const float* o = op + step * HREC + 8 * kq; \
      const f32x4 fA = *(const f32x4*)(o), fB = *(const f32x4*)(o + 4); \
      const f32x4 gA = *(const f32x4*)(o + 64), gB = *(const f32x4*)(o + 68); \
      const f32x4 qA = *(const f32x4*)(o + 128), qB = *(const f32x4*)(o + 132); \
      const float iv = op[step * HREC + 192 + vc]; \
      const float f[8] = {fA[0], fA[1], fA[2], fA[3], fB[0], fB[1], fB[2], fB[3]}; \
      const float g[8] = {gA[0], gA[1], gA[2], gA[3], gB[0], gB[1], gB[2], gB[3]}; \
      const float q[8] = {qA[0], qA[1], qA[2], qA[3], qB[0], qB[1], qB[2], qB[3]}; \
      float acc = 0.f; \
      _Pragma("unroll") for (int j = 0; j < 8; ++j) { S[j] = S[j] * f[j] + g[j] * iv; acc += S[j] * q[j]; } \
      ybuf[step * 256 + tid] = acc; } \
    LDS_BARRIER(); \
    if (seg == 1 || l == 0) { \
      _Pragma("unroll") for (int i = 0; i < 2; ++i) { \
        const int idx = tid + i * 256; const int step = idx >> 5, ch = idx & 31; \
        const int t = dir == 0 ? c0 + step : Tn - 1 - (c0 + step); \
        const float* yb = ybuf + step * 256 + ch * 8; \
        const f32x4 y0 = *(const f32x4*)(yb), y1 = *(const f32x4*)(yb + 4); \
        const f32x4 ys = y0 + y1; \
        const h16 ov = (h16)((ys[0] + ys[1]) + (ys[2] + ys[3])); \
        if (dir == 0) p.P[(size_t)(rowbase + t) * PC + 1152 + h * 64 + 32 * vh + ch] = ov; \
        else p.hy[(size_t)(rowbase + t) * 1024 + 384 + h * 64 + 32 * vh + ch] = ov; } } }
  HGRN_ISSUE(0, pfA)
  HGRN_ISSUE(1, pfB)
  __builtin_amdgcn_s_setprio(2);
#pragma unroll 1
  for (int ci = 0; ci < 272; ci += 2) {
    HGRN_CHUNK(ci, pfA)
    HGRN_CHUNK(ci + 1, pfB)
  }
  __builtin_amdgcn_s_setprio(0);
}

__device__ __forceinline__ void attn_unit(const Params& p, int l, int u) {
  const int tid = tid_opaque(), lane = tid & 63, w = tid >> 6, lq = lane & 31, hh = lane >> 5;
  int b, head, qrow_base, qpos0; bool isctx;
  if (u < 1536) { b = u / 192; int rem = u % 192; int blk = rem / 6; head = rem % 6; qpos0 = blk * 128 + w * 32; qrow_base = b * 4096; isctx = false; }
  else { int j = u - 1536; b = j / 12; int rem = j % 12; int qb = rem / 6; head = rem % 6; qpos0 = qb * 128 + w * 32; qrow_base = NLAT + b * 256; isctx = true; }
  const int g = head / 3;
  const size_t qrow = (size_t)qrow_base + qpos0 + lq;
  half8 qf[4];
#pragma unroll
  for (int s = 0; s < 4; ++s) qf[s] = *(const half8*)(p.P + qrow * PC + 3072 + head * 64 + 16 * s + 8 * hh);
  const float sinkv = p.sink[l * 6 + head];
  float m = sinkv, lsum = hh == 0 ? 1.f : 0.f;
  f32x16 O[2];
#pragma unroll
  for (int r = 0; r < 16; ++r) { O[0][r] = 0.f; O[1][r] = 0.f; }
  const h16* vt = p.VT + (size_t)((b * 2 + g) * 64) * VTS;
  int nband = 0, kstart = 0;
  if (!isctx) { kstart = max(0, qpos0 - 128); const int kend = min(4096, qpos0 + 160); nband = (kend - kstart) >> 5; }
  const int ntiles = nband + 8;
  for (int ti = 0; ti < ntiles; ++ti) {
    const bool band = ti < nband;
    const int kt = band ? kstart + ti * 32 : (ti - nband) * 32;
    const size_t krow = band ? (size_t)b * 4096 + kt + lq : (size_t)NLAT + b * 256 + kt + lq;
    const int vidx = band ? kt : 4096 + kt;
    const h16* kp = p.P + krow * PC + 3456 + g * 64 + 8 * hh;
    f32x16 sacc;
#pragma unroll
    for (int r = 0; r < 16; ++r) sacc[r] = 0.f;
#pragma unroll
    for (int s = 0; s < 4; ++s) { half8 kf = *(const half8*)(kp + 16 * s); sacc = __builtin_amdgcn_mfma_f32_32x32x16_f16(kf, qf[s], sacc, 0, 0, 0); }
    float mx = -INFINITY;
#pragma unroll
    for (int r = 0; r < 16; ++r) {
      float sv = sacc[r];
      if (band) { const int dlt = kt + (r & 3) + 8 * (r >> 2) + 4 * hh - (qpos0 + lq); if (dlt > 128 || dlt < -128) sv = -INFINITY; }
      sacc[r] = sv; mx = fmaxf(mx, sv);
    }
    mx = fmaxf(mx, __shfl_xor(mx, 32));
    const float mn = fmaxf(m, mx); const float corr = __expf(m - mn); m = mn;
    float ps = 0.f; half8 pb[2];
#pragma unroll
    for (int r = 0; r < 16; ++r) { const float pv = __expf(sacc[r] - mn); ps += pv; pb[r >> 3][r & 7] = (h16)pv; }
    lsum = lsum * corr + ps;
#pragma unroll
    for (int r = 0; r < 16; ++r) { O[0][r] *= corr; O[1][r] *= corr; }
#pragma unroll
    for (int s2 = 0; s2 < 2; ++s2)
#pragma unroll
      for (int dt = 0; dt < 2; ++dt) {
        const h16* vp = vt + (size_t)(dt * 32 + lq) * VTS + vidx + 16 * s2 + 4 * hh;
        const half4 lo = *(const half4*)vp, hi = *(const half4*)(vp + 8);
        const half8 vf = {lo[0], lo[1], lo[2], lo[3], hi[0], hi[1], hi[2], hi[3]};
        O[dt] = __builtin_amdgcn_mfma_f32_32x32x16_f16(vf, pb[s2], O[dt], 0, 0, 0);
      }
  }
  lsum += __shfl_xor(lsum, 32);
  const float inv = 1.f / lsum;
#pragma unroll
  for (int dt = 0; dt < 2; ++dt)
#pragma unroll
    for (int g4 = 0; g4 < 4; ++g4) {
      const int d0 = dt * 32 + 8 * g4 + 4 * hh;
      const half4 ga = *(const half4*)(p.P + qrow * PC + 3712 + head * 64 + d0);
      half4 o;
#pragma unroll
      for (int j = 0; j < 4; ++j) { const float gv = (float)ga[j]; o[j] = (h16)(O[dt][g4 * 4 + j] * inv * siluf_(gv)); }
      *(half4*)(p.hy + qrow * 1024 + 640 + head * 64 + d0) = o;
    }
}

__device__ __forceinline__ void phase_mix(const Params& p, int l, int bid, int nb, char* smem, int sub) {
  const int nunits = l == 0 ? 1536 + 96 : 1536;
  if (nb >= 640) {
    if (bid < 384) { if (sub & 1) rwkv_chain(p, l, bid, smem); }
    else if (bid < 512) { if (sub & 2) hgrn_chain(p, l, bid - 384, smem); }
    else if (sub & 4) for (int u = bid - 512; u < nunits; u += nb - 512) attn_unit(p, l, u);
  } else {
    for (int it = bid; it < 512 + nunits; it += nb) {
      if (it < 384) rwkv_chain(p, l, it, smem);
      else if (it < 512) hgrn_chain(p, l, it - 384, smem);
      else attn_unit(p, l, it - 512);
      __syncthreads();
    }
  }
}

__device__ __forceinline__ float sum4(const f32x4 v) { return (v[0] + v[1]) + (v[2] + v[3]); }
__device__ __forceinline__ f32x4 h4f(const half4 h) { return (f32x4){(float)h[0], (float)h[1], (float)h[2], (float)h[3]}; }
__device__ __forceinline__ void phase_readout(const Params& p, int l, int bid, int nb, bool dummy) {
  const int tid = tid_opaque(), lane = tid & 63, w = tid >> 6;
  const int nrows = l == 1 ? NLAT : NTOK;
  const int hl = lane >> 4, c4 = (lane & 15) * 4;
#pragma unroll 2
  for (int it = bid * 4 + w; it < nrows * 3; it += nb * 4) {
    const int row = it / 3, q = it - row * 3;
    int t, Tn;
    if (row < NLAT) { t = row & 4095; Tn = 4096; } else { t = (row - NLAT) & 255; Tn = 256; }
    const h16* pr = p.P + (size_t)row * PC;
    h16* yo = p.hy + (size_t)row * 1024;
    h16* yw = dummy ? p.F + (size_t)row * 1536 : yo;
    if (q < 2) {
      const int head = q * 4 + hl; const bool valid = head < 6; const int c = (valid ? head : 5) * 64 + c4;
      const bool hp = t > 0, hn = t + 1 < Tn;
      const f32x4 y = h4f(*(const half4*)(pr + 768 + c)) + h4f(*(const half4*)(yo + c));
      f32x4 sh[3];
      {
        const h16* prk = pr + (valid ? head : 5) * 128 + 2 * c4;
        const half8 cur8 = *(const half8*)prk;
        half8 prv8, nxt8;
#pragma unroll
        for (int j = 0; j < 8; ++j) { prv8[j] = (h16)0.f; nxt8[j] = (h16)0.f; }
        if (hp) prv8 = *(const half8*)(prk - PC);
        if (hn) nxt8 = *(const half8*)(prk + PC);
#pragma unroll
        for (int k = 0; k < 2; ++k) {
          const f32x4 cur = {(float)cur8[k], (float)cur8[2 + k], (float)cur8[4 + k], (float)cur8[6 + k]};
          const f32x4 prv = {(float)prv8[k], (float)prv8[2 + k], (float)prv8[4 + k], (float)prv8[6 + k]};
          const f32x4 nxt = {(float)nxt8[k], (float)nxt8[2 + k], (float)nxt8[4 + k], (float)nxt8[6 + k]};
          const f32x4 mp = *(const f32x4*)(p.mu_prev + l * 1792 + k * 384 + c), mn = *(const f32x4*)(p.mu_next + l * 1792 + k * 384 + c);
          sh[k] = cur + mp * (prv - cur) + mn * (nxt - cur);
        }
        const int col = 1408 + c;
        const f32x4 cur = h4f(*(const half4*)(pr + col));
        const f32x4 prv = hp ? h4f(*(const half4*)(pr + col - PC)) : (f32x4){0.f, 0.f, 0.f, 0.f};
        const f32x4 nxt = hn ? h4f(*(const half4*)(pr + col + PC)) : (f32x4){0.f, 0.f, 0.f, 0.f};
        const f32x4 mp = *(const f32x4*)(p.mu_prev + l * 1792 + col), mn = *(const f32x4*)(p.mu_next + l * 1792 + col);
        sh[2] = cur + mp * (prv - cur) + mn * (nxt - cur);
      }
      const f32x4 v = h4f(*(const half4*)(p.VB + (size_t)row * 384 + c));
      const f32x4 gw = *(const f32x4*)(p.gn_w + l * 384 + c), gb = *(const f32x4*)(p.gn_b + l * 384 + c), rk = *(const f32x4*)(p.r_k + l * 384 + c);
      const float mean = red16(sum4(y)) * (1.f / 64.f);
      const f32x4 yc = y - mean;
      const float var = red16(sum4(yc * yc)) * (1.f / 64.f);
      const float rs = rsqrtf(var + 64e-5f);
      const float bs = red16(sum4(sh[0] * sh[1] * rk));
      half4 o;
#pragma unroll
      for (int j = 0; j < 4; ++j) o[j] = (h16)((yc[j] * rs * gw[j] + gb[j] + bs * v[j]) * siluf_(sh[2][j]));
      if (valid) *(half4*)(yw + c) = o;
    } else {
      const int c = hl * 64 + c4;
      const f32x4 o = h4f(*(const half4*)(pr + 1152 + c)) + h4f(*(const half4*)(yo + 384 + c));
      const f32x4 g = h4f(*(const half4*)(pr + 2816 + c));
      const f32x4 nw = *(const f32x4*)(p.hg_norm_w + l * 256 + c);
      const float ms = red16(sum4(o * o)) * (1.f / 64.f);
      const float rs = rsqrtf(ms + 1e-6f);
      half4 ov;
#pragma unroll
      for (int j = 0; j < 4; ++j) ov[j] = (h16)(o[j] * rs * nw[j] * siluf_(g[j]));
      *(half4*)(yw + 384 + c) = ov;
    }
  }
}

__device__ __forceinline__ void phase_final(const Params& p, int bid, int nb) {
  const int tid = tid_opaque(), lane = tid & 63, w = tid >> 6;
  for (int row = bid * 4 + w; row < NLAT; row += nb * 4) {
    float* src = p.out + (size_t)row * 1024;
    f32x4 v[4]; float ss = 0.f;
#pragma unroll
    for (int i = 0; i < 4; ++i) { v[i] = *(const f32x4*)(src + i * 256 + lane * 4); ss += v[i][0] * v[i][0] + v[i][1] * v[i][1] + v[i][2] * v[i][2] + v[i][3] * v[i][3]; }
    ss = wave_sum_dpp(ss);
    const float rs = rsqrtf(ss * (1.f / 1024.f) + 1e-6f);
#pragma unroll
    for (int i = 0; i < 4; ++i) {
      const int col = i * 256 + lane * 4;
      const f32x4 nwv = *(const f32x4*)(p.final_w + col);
      f32x4 o;
#pragma unroll
      for (int j = 0; j < 4; ++j) o[j] = v[i][j] * rs * nwv[j];
      *(f32x4*)(src + col) = o;
    }
  }
}

__global__ void __launch_bounds__(256, 3) __attribute__((target("no-packed-fp32-ops"))) mega(Params p, int ph_lo, int ph_hi, int coop) {
  __shared__ __attribute__((aligned(16))) char smem[SMEM_BYTES];
  __shared__ uint4 xb_words;
  XcdBarrier xb; xb.bar = p.bar; xb.x = 0; xb.st = (volatile LAS unsigned*)&xb_words;
  if (coop) { if (threadIdx.x == 0) xb_words = make_uint4(0u, 0u, 0u, 0u); __syncthreads(); xb = xcd_barrier_post(p.bar, (volatile LAS unsigned*)&xb_words); }
  if (coop) for (int i = 0; i < EXTRA_SYNCS; ++i) { xcd_barrier(xb); }
  if (coop == 2) cg::this_grid().sync();
  for (int ph = ph_lo; ph < ph_hi; ++ph) {
    for (int rep = 0; rep < (((PROBE_MASK >> ph) & 1) ? 2 : 1); ++rep) {
      int bid = blockIdx.x, nb = gridDim.x;
      asm volatile("" : "+s"(bid), "+s"(nb));
      if (ph == 0) phase_prep(p, bid, nb, smem);
      else if (ph == 13) phase_final(p, bid, nb);
      else {
        const int l = (ph - 1) / 6, s = (ph - 1) % 6;
        if (s == 0) phase_norm(p, l, bid, nb);
        else if (s == 1) phase_gemm<0>(p, l, bid, nb, smem);
        else if (s == 2) phase_feat(p, l, bid, nb, smem, PROBE_MASK && ((PROBE_MASK >> ph) & 1) && rep == 0);
        else if (s == 3) phase_mix(p, l, bid, nb, smem, rep ? PROBE_SUB : 7);
        else if (s == 4) phase_readout(p, l, bid, nb, PROBE_MASK && ((PROBE_MASK >> ph) & 1) && rep == 0);
        else phase_gemm<1>(p, l, bid, nb, smem);
      }
      if (PROBE_MASK && rep == 0 && ((PROBE_MASK >> ph) & 1)) { xcd_barrier(xb); }
    }
    if (coop && ph + 1 < ph_hi) { xcd_barrier(xb); }
  }
}

extern "C" void kernel_launch(void* const* d_in, const int* in_sizes, int n_in, void* d_out, int out_size, void* d_ws, size_t ws_size, hipStream_t stream) {
  static int grid_blocks = 0;
  if (!grid_blocks) {
    int dev = 0, cus = 0, per_cu = 0;
    hipGetDevice(&dev);
    hipDeviceGetAttribute(&cus, hipDeviceAttributeMultiprocessorCount, dev);
    hipOccupancyMaxActiveBlocksPerMultiprocessor(&per_cu, mega, 256, 0);
    if (per_cu < 1) per_cu = 1;
    grid_blocks = cus * per_cu;
  }
  Params p{};
  const float* const* in = (const float* const*)d_in;
  p.x = in[0]; p.c = in[1]; p.ctx = in[2]; p.c_ctx = in[3]; p.mod_w = in[4]; p.mod_b = in[5]; p.norm_w = in[6]; p.w_in = in[7]; p.w_out = in[8];
  p.mu_prev = in[9]; p.mu_next = in[10]; p.w0 = in[11]; p.w2 = in[12]; p.a0 = in[13]; p.a2 = in[14]; p.k_k = in[15]; p.k_a = in[16]; p.r_k = in[17];
  p.gn_w = in[18]; p.gn_b = in[19]; p.vw1 = in[20]; p.vw2 = in[21]; p.vb = in[22]; p.lb_logits = in[23]; p.hg_norm_w = in[24]; p.sink = in[25]; p.final_w = in[26];
  p.out = (float*)d_out;
  char* ws = (char*)d_ws; size_t off = 0;
  auto take = [&](size_t bytes) { char* r = ws + off; off += (bytes + 255) & ~(size_t)255; return r; };
  p.win_t = (h16*)take((size_t)2 * NPAD * 1024 * 2);
  p.wout_t = (h16*)take((size_t)2 * 1024 * 1024 * 2);
  p.wl_t = (h16*)take((size_t)2 * 4 * 384 * 64 * 2);
  p.mod = (float*)take((size_t)2 * 9 * 3072 * 4);
  p.rope = (float*)take((size_t)64 * 16 * 2 * 4);
  p.hy = (h16*)take((size_t)NTOK * 1024 * 2);
  p.P = (h16*)take((size_t)NTOK * PC * 2);
  p.F = (h16*)take((size_t)NTOK * 1536 * 2);
  p.VB = (h16*)take((size_t)NTOK * 384 * 2);
  p.VT = (h16*)take((size_t)16 * 64 * VTS * 2);
  p.xc1 = (float*)take((size_t)2048 * 1024 * 4);
  p.bar = (unsigned*)take(16384);
  if (off > ws_size) fprintf(stderr, "workspace too small: need %zu have %zu\n", off, ws_size);
#if SINGLE_LAUNCH
  hipMemsetAsync(p.bar, 0, 16384, stream);
  int lo = 0, hi = 14, coop = 1;
  void* args[] = {&p, &lo, &hi, &coop};
  hipError_t e = hipLaunchCooperativeKernel((void*)mega, dim3(grid_blocks), dim3(256), args, 0, stream);
  if (e != hipSuccess) fprintf(stderr, "cooperative launch failed: %s (grid %d)\n", hipGetErrorString(e), grid_blocks);
#else
  for (int ph = 0; ph < 14; ++ph) mega<<<grid_blocks, 256, 0, stream>>>(p, ph, ph + 1, 0);
#endif
}
```

```cpp
#include <hip/hip_runtime.h>
#include <hip/hip_cooperative_groups.h>
#include <cstdio>
#include <cstdint>
namespace cg = cooperative_groups;

typedef _Float16 h16;
typedef _Float16 half8 __attribute__((ext_vector_type(8)));
typedef _Float16 half4 __attribute__((ext_vector_type(4)));
typedef float f32x16 __attribute__((ext_vector_type(16)));
typedef float f32x4 __attribute__((ext_vector_type(4)));
typedef float f32x2 __attribute__((ext_vector_type(2)));
typedef unsigned u32x4 __attribute__((ext_vector_type(4)));
typedef _Float16 half2v __attribute__((ext_vector_type(2)));

constexpr int NLAT = 32768, NTOK = 34816;
constexpr int PC = 4160;
constexpr int NPAD = 4224;
constexpr int VTS = 4352;
constexpr int SMEM_BYTES = 49152;

#ifndef EXTRA_SYNCS
#define EXTRA_SYNCS 0
#endif
#ifndef PROBE_SUB
#define PROBE_SUB 7
#endif
#ifndef PROBE_MASK
#define PROBE_MASK 0
#endif
#ifndef SINGLE_LAUNCH
#define SINGLE_LAUNCH 1
#endif

struct Params {
  const float *x, *c, *ctx, *c_ctx, *mod_w, *mod_b, *norm_w, *w_in, *w_out;
  const float *mu_prev, *mu_next, *w0, *w2, *a0, *a2, *k_k, *k_a, *r_k, *gn_w, *gn_b;
  const float *vw1, *vw2, *vb, *lb_logits, *hg_norm_w, *sink, *final_w;
  float* out;
  h16 *win_t, *wout_t, *wl_t;
  float* mod;
  h16 *hy, *P, *F, *VB;
  h16* VT;
  float* xc1;
  float* rope;
  unsigned* bar;
};

__device__ __forceinline__ int tid_opaque() { int t = threadIdx.x; asm volatile("" : "+v"(t)); return t; }
__device__ __forceinline__ float wave_sum(float v) {
#pragma unroll
  for (int o = 32; o > 0; o >>= 1) v += __shfl_xor(v, o);
  return v;
}
__device__ __forceinline__ float sigmoidf_(float x) { return 1.f / (1.f + __expf(-x)); }
__device__ __forceinline__ float siluf_(float x) { return x / (1.f + __expf(-x)); }
template <int CTRL> __device__ __forceinline__ float dpp_mov(float x) {
  return __int_as_float(__builtin_amdgcn_update_dpp(0, __float_as_int(x), CTRL, 0xf, 0xf, true));
}
__device__ __forceinline__ float wave_sum_dpp(float x) {
  x += dpp_mov<0xB1>(x);
  x += dpp_mov<0x4E>(x);
  x += dpp_mov<0x141>(x);
  x += dpp_mov<0x140>(x);
  const int xi = __float_as_int(x);
  return __int_as_float(__builtin_amdgcn_readlane(xi, 0)) + __int_as_float(__builtin_amdgcn_readlane(xi, 16)) +
         __int_as_float(__builtin_amdgcn_readlane(xi, 32)) + __int_as_float(__builtin_amdgcn_readlane(xi, 48));
}
__device__ __forceinline__ float red8(float x) {
  x += dpp_mov<0xB1>(x);
  x += dpp_mov<0x4E>(x);
  x += dpp_mov<0x141>(x);
  return x;
}

#define XB_TMO      128
#define XB_XCNT(j)  (256  + 64 * (j))
#define XB_XSUB(j)  (1280 + 64 * (j))
#define XB_XGEN(j)  (2304 + 64 * (j))
#define XB_TOP      3328
#define XB_TOPGEN   3392
#define XCD_BAR_WORDS 3456
#define XB_SPIN_CAP (1u << 18)
#define LAS __attribute__((address_space(3)))
__device__ __forceinline__ unsigned xb_ld(unsigned* p)              { return __hip_atomic_load(p, __ATOMIC_RELAXED, __HIP_MEMORY_SCOPE_AGENT); }
__device__ __forceinline__ unsigned xb_add(unsigned* p, unsigned v) { return __hip_atomic_fetch_add(p, v, __ATOMIC_RELAXED, __HIP_MEMORY_SCOPE_AGENT); }
__device__ __forceinline__ unsigned xb_xcc_id() { return (unsigned)__builtin_amdgcn_s_getreg((3 << 11) | 20) & 0xFu; }
#define XB_SPIN(cond, bar) do { unsigned _sp = 0; while (cond) { __builtin_amdgcn_s_sleep(1); \
    if ((++_sp & 255u) == 0u) { if (xb_ld(&(bar)[XB_TMO])) break; if (_sp > XB_SPIN_CAP) { atomicAdd(&(bar)[XB_TMO], 1u); break; } } } } while (0)
struct XcdBarrier { unsigned* bar; unsigned x; volatile LAS unsigned* st; };
__device__ __forceinline__ XcdBarrier xcd_barrier_post(unsigned* bar, volatile LAS unsigned* st) {
  XcdBarrier b; b.bar = bar; b.x = xb_xcc_id(); b.st = st;
  if (threadIdx.x == 0) (void)xb_add(&bar[XB_XCNT(b.x)], 1u);
  return b;
}
__device__ __forceinline__ void xcd_barrier_complete(unsigned* bar, unsigned x, unsigned& nloc, unsigned& nx) {
  const unsigned G = gridDim.x * gridDim.y * gridDim.z;
  unsigned sum, cnt, mine, sp = 0u;
  for (;;) {
    sum = 0u; cnt = 0u; mine = 0u;
#pragma unroll
    for (unsigned j = 0; j < 16; ++j) { const unsigned c = xb_ld(&bar[XB_XCNT(j)]); sum += c; cnt += (c > 0u) ? 1u : 0u; mine = (j == x) ? c : mine; }
    if (sum == G) break;
    __builtin_amdgcn_s_sleep(1);
    if ((++sp & 255u) == 0u) { if (xb_ld(&bar[XB_TMO])) break; if (sp > XB_SPIN_CAP) { atomicAdd(&bar[XB_TMO], 1u); break; } }
  }
  nloc = mine > 0u ? mine : 1u; nx = cnt > 0u ? cnt : 1u;
}
__device__ __forceinline__ void xcd_barrier(const XcdBarrier& b) {
  asm volatile("s_waitcnt vmcnt(0)" ::: "memory");
  __syncthreads();
  if (threadIdx.x == 0) {
    unsigned* bar = b.bar;
    __builtin_amdgcn_s_waitcnt(0);
    unsigned nloc = b.st[0], nx = b.st[1];
    if (nloc == 0u) { xcd_barrier_complete(bar, b.x, nloc, nx); b.st[0] = nloc; b.st[1] = nx; }
    const unsigned old = xb_add(&bar[XB_XSUB(b.x)], 1u);
    const unsigned gen = old / nloc;
    if (old + 1u == (gen + 1u) * nloc) {
      __builtin_amdgcn_fence(__ATOMIC_RELEASE, "agent");
      asm volatile("s_waitcnt vmcnt(0)" ::: "memory");
      const unsigned og = xb_add(&bar[XB_TOP], 1u);
      const unsigned tg = og / nx;
      if (og + 1u == (tg + 1u) * nx) xb_add(&bar[XB_TOPGEN], 1u);
      else XB_SPIN(xb_ld(&bar[XB_TOPGEN]) == tg, bar);
      __builtin_amdgcn_fence(__ATOMIC_ACQUIRE, "agent");
      xb_add(&bar[XB_XGEN(b.x)], 1u);
      asm volatile("s_waitcnt vmcnt(0)" ::: "memory");
    } else {
      XB_SPIN(xb_ld(&bar[XB_XGEN(b.x)]) == gen, bar);
      __builtin_amdgcn_fence(__ATOMIC_ACQUIRE, "agent");
      asm volatile("s_waitcnt vmcnt(0)" ::: "memory");
    }
  }
  __syncthreads();
}

__device__ __forceinline__ void phase_prep(const Params& p, int bid, int nb, char* smem) {
  const int tid = tid_opaque();
  float* sf = (float*)smem;
  constexpr int N_WIN = 2048, N_WOUT = 512, N_MOD = 192, N_PADI = 1024, N_WL = 768;
  constexpr int total = N_WIN + N_WOUT + N_MOD + N_PADI + N_WL + 1;
  for (int it = bid; it < total; it += nb) {
    if (it < N_WIN + N_WOUT) {
      const float* src; h16* dst; int ncols, kt, ntile;
      if (it < N_WIN) { int l = it >> 10, r = it & 1023; kt = r >> 6; ntile = r & 63; src = p.w_in + (size_t)l * 1024 * 4096; dst = p.win_t + (size_t)l * NPAD * 1024; ncols = 4096; }
      else { int j = it - N_WIN; int l = j >> 8, r = j & 255; kt = r >> 4; ntile = r & 15; src = p.w_out + (size_t)l * 1024 * 1024; dst = p.wout_t + (size_t)l * 1024 * 1024; ncols = 1024; }
      for (int i = tid; i < 4096; i += 256) { int kk = i >> 6, nn = i & 63; sf[kk * 65 + nn] = src[(size_t)(kt * 64 + kk) * ncols + ntile * 64 + nn]; }
      __syncthreads();
      const bool rkperm = it < N_WIN && ntile < 12;
      for (int i = tid; i < 4096; i += 256) {
        int nn = i >> 6, kk = i & 63;
        const int nrow = rkperm ? ((ntile % 6) * 128 + 2 * nn + ntile / 6) : (ntile * 64 + nn);
        dst[(size_t)nrow * 1024 + kt * 64 + kk] = (h16)sf[kk * 65 + nn];
      }
      __syncthreads();
    } else if (it < N_WIN + N_WOUT + N_MOD) {
      const int j = it - N_WIN - N_WOUT; const int l = j / 96; const int cl = tid & 31, ks = tid >> 5; const int col = (j % 96) * 32 + cl;
      for (int i = tid; i < 9 * 1024; i += 256) { int r = i >> 10, k = i & 1023; float v = r < 8 ? p.c[r * 1024 + k] : p.c_ctx[k]; sf[i] = siluf_(v); }
      __syncthreads();
      float acc[9];
#pragma unroll
      for (int r = 0; r < 9; ++r) acc[r] = 0.f;
      const float* mw = p.mod_w + (size_t)l * 1024 * 3072 + (size_t)(ks * 128) * 3072 + col;
#pragma unroll 2
      for (int k = 0; k < 128; k += 4) {
        const float w0 = mw[(size_t)k * 3072], w1 = mw[(size_t)(k + 1) * 3072], w2 = mw[(size_t)(k + 2) * 3072], w3 = mw[(size_t)(k + 3) * 3072];
#pragma unroll
        for (int r = 0; r < 9; ++r) { const f32x4 sv = *(const f32x4*)&sf[r * 1024 + ks * 128 + k]; acc[r] += sv[0] * w0 + sv[1] * w1 + sv[2] * w2 + sv[3] * w3; }
      }
#pragma unroll
      for (int r = 0; r < 9; ++r) acc[r] += __shfl_xor(acc[r], 32);
      __syncthreads();
      if ((tid & 63) < 32) {
#pragma unroll
        for (int r = 0; r < 9; ++r) sf[((tid >> 6) * 9 + r) * 32 + cl] = acc[r];
      }
      __syncthreads();
      for (int i = tid; i < 288; i += 256) {
        const int r = i >> 5, c2 = i & 31;
        const float v = sf[(0 * 9 + r) * 32 + c2] + sf[(1 * 9 + r) * 32 + c2] + sf[(2 * 9 + r) * 32 + c2] + sf[(3 * 9 + r) * 32 + c2];
        const int cc = (j % 96) * 32 + c2;
        p.mod[(size_t)(l * 9 + r) * 3072 + cc] = v + p.mod_b[l * 3072 + cc];
      }
      __syncthreads();
    } else if (it < N_WIN + N_WOUT + N_MOD + N_PADI) {
      int j = it - (N_WIN + N_WOUT + N_MOD); int idx = j * 256 + tid;
      int l = idx >> 17; int rem = idx & 131071; int m = rem >> 10, k = rem & 1023;
      float v = (l == 1 && m < 32) ? p.vw1[k * 32 + m] : 0.f;
      p.win_t[(size_t)l * NPAD * 1024 + (size_t)(4096 + m) * 1024 + k] = (h16)v;
    } else if (it < N_WIN + N_WOUT + N_MOD + N_PADI + N_WL) {
      const int idx = (it - (N_WIN + N_WOUT + N_MOD + N_PADI)) * 256 + tid;
      const int r = idx & 63, c = (idx >> 6) % 384, ls = idx / (384 * 64); const int l = ls >> 2, slot = ls & 3, dir = slot & 1, kind = slot >> 1;
      const float v = (kind == 0 ? p.w2 : p.a2)[((size_t)(l * 2 + dir) * 64 + r) * 384 + c];
      p.wl_t[idx] = (h16)v;
    } else {
      if (tid < 16) {
        double inv = 1.0; for (int i = 0; i < tid; ++i) inv *= 0.5623413251903491;
        double x2 = inv * inv, ts = inv, tc = 1.0, s1 = inv, c1 = 1.0;
        for (int n = 1; n <= 10; ++n) { tc *= -x2 / ((2.0 * n - 1.0) * (2.0 * n)); c1 += tc; ts *= -x2 / ((2.0 * n) * (2.0 * n + 1.0)); s1 += ts; }
        double cc = 1.0, ss = 0.0;
        for (int pos = 0; pos < 64; ++pos) {
          p.rope[(pos * 16 + tid) * 2] = (float)cc; p.rope[(pos * 16 + tid) * 2 + 1] = (float)ss;
          double nc = cc * c1 - ss * s1, ns = ss * c1 + cc * s1; cc = nc; ss = ns;
        }
      }
    }
  }
}

__device__ __forceinline__ void phase_norm(const Params& p, int l, int bid, int nb) {
  const int tid = tid_opaque(), lane = tid & 63, w = tid >> 6;
  for (int row = bid * 4 + w; row < NTOK; row += nb * 4) {
    const float* src = (l == 0) ? (row < NLAT ? p.x + (size_t)row * 1024 : p.ctx + (size_t)(row - NLAT) * 1024)
                                : (row < NLAT ? p.out + (size_t)row * 1024 : p.xc1 + (size_t)(row - NLAT) * 1024);
    const int mr = row < NLAT ? (row >> 12) : 8;
    const float* md = p.mod + (size_t)(l * 9 + mr) * 3072;
    const float* nw = p.norm_w + l * 1024;
    f32x4 v[4]; float ss = 0.f;
#pragma unroll
    for (int i = 0; i < 4; ++i) { v[i] = *(const f32x4*)(src + i * 256 + lane * 4); ss += v[i][0] * v[i][0] + v[i][1] * v[i][1] + v[i][2] * v[i][2] + v[i][3] * v[i][3]; }
    ss = wave_sum_dpp(ss);
    const float rs = rsqrtf(ss * (1.f / 1024.f) + 1e-6f);
#pragma unroll
    for (int i = 0; i < 4; ++i) {
      const int col = i * 256 + lane * 4;
      f32x4 nwv = *(const f32x4*)(nw + col), sc = *(const f32x4*)(md + 1024 + col), sh = *(const f32x4*)(md + col);
      half4 o;
#pragma unroll
      for (int j = 0; j < 4; ++j) o[j] = (h16)(v[i][j] * rs * nwv[j] * (1.f + sc[j]) + sh[j]);
      *(half4*)(p.hy + (size_t)row * 1024 + col) = o;
    }
  }
}

template <int MODE>
__device__ __forceinline__ void phase_gemm(const Params& p, int l, int bid, int nb, char* smem) {
  const h16* A = p.hy;
  const h16* Bt = MODE == 0 ? p.win_t + (size_t)l * NPAD * 1024 : p.wout_t + (size_t)l * 1024 * 1024;
  const int ntn = MODE == 0 ? (l == 1 ? 33 : 32) : 8;
  const int ntm = (MODE == 1 && l == 1) ? 256 : 272;
  const int tid = tid_opaque(), lane = tid & 63, w = tid >> 6, wr = w >> 1, wc = w & 1, lq = lane & 31, hh = lane >> 5;
  h16* As = (h16*)smem; h16* Bs = As + 128 * 72;
  const int ldrow = tid >> 3, ldch = (tid & 7) * 8;
  for (int tile = bid; tile < ntm * ntn; tile += nb) {
    int tm, tn;
    {
      const int mper = ntm >> 3;
      const int nmain = MODE == 0 ? 32 : 8;
      if (tile < ntm * nmain) {
        const int x = tile & 7, sq = tile >> 3;
        const int strip = sq / (mper * 8), rem = sq - strip * (mper * 8);
        tm = x * mper + (rem >> 3); tn = strip * 8 + (rem & 7);
      } else { tm = tile - ntm * nmain; tn = nmain; }
    }
    const h16* Ag = A + (size_t)(tm * 128 + ldrow) * 1024 + ldch; const h16* Bg = Bt + (size_t)(tn * 128 + ldrow) * 1024 + ldch;
    f32x16 acc[2][2];
#pragma unroll
    for (int i = 0; i < 2; ++i)
#pragma unroll
      for (int j = 0; j < 2; ++j)
#pragma unroll
        for (int r = 0; r < 16; ++r) acc[i][j][r] = 0.f;
    u32x4 ra[4], rb[4];
#pragma unroll
    for (int i = 0; i < 4; ++i) { ra[i] = *(const u32x4*)(Ag + (size_t)i * 32 * 1024); rb[i] = *(const u32x4*)(Bg + (size_t)i * 32 * 1024); }
#pragma unroll 1
    for (int kt = 0; kt < 16; ++kt) {
      __syncthreads();
#pragma unroll
      for (int i = 0; i < 4; ++i) { *(u32x4*)(As + (ldrow + i * 32) * 72 + ldch) = ra[i]; *(u32x4*)(Bs + (ldrow + i * 32) * 72 + ldch) = rb[i]; }
      __syncthreads();
      if (kt + 1 < 16) {
#pragma unroll
        for (int i = 0; i < 4; ++i) { ra[i] = *(const u32x4*)(Ag + (size_t)i * 32 * 1024 + (kt + 1) * 64); rb[i] = *(const u32x4*)(Bg + (size_t)i * 32 * 1024 + (kt + 1) * 64); }
      }
#pragma unroll
      for (int s = 0; s < 4; ++s) {
        half8 a[2], b[2];
#pragma unroll
        for (int i = 0; i < 2; ++i) { a[i] = *(const half8*)(As + (64 * wr + 32 * i + lq) * 72 + 16 * s + 8 * hh); b[i] = *(const half8*)(Bs + (64 * wc + 32 * i + lq) * 72 + 16 * s + 8 * hh); }
#pragma unroll
        for (int i = 0; i < 2; ++i)
#pragma unroll
          for (int j = 0; j < 2; ++j) {
            if (MODE == 0) acc[i][j] = __builtin_amdgcn_mfma_f32_32x32x16_f16(b[j], a[i], acc[i][j], 0, 0, 0);
            else acc[i][j] = __builtin_amdgcn_mfma_f32_32x32x16_f16(a[i], b[j], acc[i][j], 0, 0, 0);
          }
      }
    }
    if (MODE == 0) {
      if (tn < 32) {
        __syncthreads();
        h16* Cs = (h16*)smem;
#pragma unroll
        for (int i = 0; i < 2; ++i)
#pragma unroll
          for (int j = 0; j < 2; ++j)
#pragma unroll
            for (int g = 0; g < 4; ++g) {
              half4 o;
#pragma unroll
              for (int q = 0; q < 4; ++q) o[q] = (h16)acc[i][j][4 * g + q];
              *(half4*)(Cs + (64 * wr + 32 * i + lq) * 136 + 64 * wc + 32 * j + 8 * g + 4 * hh) = o;
            }
        __syncthreads();
#pragma unroll
        for (int q = 0; q < 8; ++q) {
          const int id = tid + q * 256; const int row = id >> 4, ch = id & 15;
          *(u32x4*)(p.P + (size_t)(tm * 128 + row) * PC + tn * 128 + ch * 8) = *(const u32x4*)(Cs + row * 136 + ch * 8);
        }
      } else if (wc == 0) {
#pragma unroll
        for (int i = 0; i < 2; ++i)
#pragma unroll
          for (int r = 0; r < 16; ++r) ((float*)(p.F + (size_t)(tm * 128 + 64 * wr + 32 * i + lq) * 1536))[(r & 3) + 8 * (r >> 2) + 4 * hh] = acc[i][0][r];
      }
    } else {
      const int row0 = tm * 128;
      const int mr = row0 < NLAT ? (row0 >> 12) : 8;
      const int col = tn * 128 + 64 * wc + lq;
      const float* gp = p.mod + (size_t)(l * 9 + mr) * 3072 + 2048 + col;
      const float g0 = gp[0], g1 = gp[32];
      const float* xs0; float* xd0;
      if (l == 0) { if (row0 < NLAT) { xs0 = p.x + (size_t)row0 * 1024; xd0 = p.out + (size_t)row0 * 1024; } else { xs0 = p.ctx + (size_t)(row0 - NLAT) * 1024; xd0 = p.xc1 + (size_t)(row0 - NLAT) * 1024; } }
      else { xs0 = p.out + (size_t)row0 * 1024; xd0 = p.out + (size_t)row0 * 1024; }
      const float* __restrict__ xsrc = xs0 + (size_t)(64 * wr + 4 * hh) * 1024 + col;
      float* __restrict__ xdst = xd0 + (size_t)(64 * wr + 4 * hh) * 1024 + col;
#pragma unroll
      for (int i = 0; i < 2; ++i)
#pragma unroll
        for (int r = 0; r < 16; ++r) {
          const int ro = (32 * i + (r & 3) + 8 * (r >> 2)) * 1024;
          xdst[ro] = xsrc[ro] + g0 * acc[i][0][r];
          xdst[ro + 32] = xsrc[ro + 32] + g1 * acc[i][1][r];
        }
    }
  }
}

#define LOAD_COL34(arr, base, t0, Tn) \
  _Pragma("unroll") for (int q_ = 0; q_ < 34; ++q_) { const int t_ = (t0) - 1 + q_; arr[q_] = (t_ >= 0 && t_ < (Tn)) ? (base)[(long)t_ * PC] : (h16)0.f; }

__device__ __forceinline__ void phase_feat(const Params& p, int l, int bid, int nb, char* smem, bool dry) {
  const int tid = tid_opaque();
  h16* inh = (h16*)smem;
  float* zt = (float*)(smem + 32 * 264 * 2);
  for (int item = bid; item < 1088; item += nb) {
    int b, t0, Tn, rowbase; bool isctx;
    if (item < 1024) { b = item >> 7; t0 = (item & 127) * 32; Tn = 4096; rowbase = b * 4096; isctx = false; }
    else { int j = item - 1024; b = j >> 3; t0 = (j & 7) * 32; Tn = 256; rowbase = NLAT + b * 256; isctx = true; }
    {
      const int col = 1152 + tid;
      const float mp = p.mu_prev[l * 1792 + col], mn = p.mu_next[l * 1792 + col];
      const h16* base = p.P + (size_t)rowbase * PC + col;
      h16 xv[34];
      LOAD_COL34(xv, base, t0, Tn)
#pragma unroll
      for (int tt = 0; tt < 32; ++tt) {
        const float prev = (float)xv[tt], cur = (float)xv[tt + 1], nxt = (float)xv[tt + 2];
        float sv = cur + mp * (prev - cur) + mn * (nxt - cur);
        if (tid < 128) { const float e2 = __expf(2.f * sv); sv = 1.f - 2.f / (e2 + 1.f); }
        inh[tt * 264 + tid] = (h16)sv;
      }
      if (l == 1) {
#pragma unroll
        for (int i = 0; i < 4; ++i) { int id = tid + i * 256; zt[id] = ((const float*)(p.F + (size_t)(rowbase + t0 + (id >> 5)) * 1536))[id & 31]; }
      }
    }
    __syncthreads();
#pragma unroll 1
    for (int c = tid; c < 384; c += 256) {
      const int col = 768 + c;
      const float mp = p.mu_prev[l * 1792 + col], mn = p.mu_next[l * 1792 + col];
      const h16* base = p.P + (size_t)rowbase * PC + col;
      h16 xv[34];
      LOAD_COL34(xv, base, t0, Tn)
      h16* dst = p.VB + (size_t)(rowbase + t0) * 384 + c;
      if (l == 0) {
#pragma unroll
        for (int tt = 0; tt < 32; ++tt) {
          const float prev = (float)xv[tt], cur = (float)xv[tt + 1], nxt = (float)xv[tt + 2];
          dst[tt * 384] = (h16)(cur + mp * (prev - cur) + mn * (nxt - cur));
        }
      } else {
        const float vbv = p.vb[c];
#pragma unroll 1
        for (int hf = 0; hf < 2; ++hf) {
          h16 vfv[16]; float ga[16];
#pragma unroll
          for (int tt = 0; tt < 16; ++tt) { vfv[tt] = dst[(hf * 16 + tt) * 384]; ga[tt] = vbv; }
#pragma unroll 1
          for (int m = 0; m < 32; m += 4) {
            const float w0 = p.vw2[m * 384 + c], w1 = p.vw2[(m + 1) * 384 + c], w2 = p.vw2[(m + 2) * 384 + c], w3 = p.vw2[(m + 3) * 384 + c];
#pragma unroll
            for (int tt = 0; tt < 16; ++tt) { const f32x4 z = *(const f32x4*)&zt[(hf * 16 + tt) * 32 + m]; ga[tt] += z[0] * w0 + z[1] * w1 + z[2] * w2 + z[3] * w3; }
          }
#pragma unroll
          for (int tt = 0; tt < 16; ++tt) {
            const float prev = hf ? (float)xv[16 + tt] : (float)xv[tt], cur = hf ? (float)xv[17 + tt] : (float)xv[tt + 1], nxt = hf ? (float)xv[18 + tt] : (float)xv[tt + 2];
            const float sv = cur + mp * (prev - cur) + mn * (nxt - cur);
            dst[(hf * 16 + tt) * 384] = (h16)(sv + ((float)vfv[tt] - sv) * sigmoidf_(ga[tt]));
          }
        }
      }
    }
    {
      const int w = tid >> 6, lane = tid & 63, lq = tid & 31, hh = lane >> 5;
      const int dir = w & 1, chalf = w >> 1;
      half8 xin[2][4];
#pragma unroll
      for (int kind = 0; kind < 2; ++kind)
#pragma unroll
        for (int ks = 0; ks < 4; ++ks) xin[kind][ks] = *(const half8*)(inh + lq * 264 + kind * 128 + dir * 64 + 16 * ks + 8 * hh);
      h16* ost = (h16*)(smem + 32 * 264 * 2 + 4096) + w * (32 * 72);
      h16* fbase = p.F + (size_t)(rowbase + t0) * 1536 + dir * 768 + chalf * 384;
#pragma unroll 1
      for (int np = 0; np < 6; ++np) {
        const int c0 = chalf * 192 + np * 32;
        f32x16 acc[2];
#pragma unroll
        for (int kind = 0; kind < 2; ++kind) {
          const float* bias = (kind == 0 ? p.w0 : p.a0) + (l * 2 + dir) * 384 + c0;
          const h16* wl = p.wl_t + (size_t)((l * 4 + kind * 2 + dir) * 384 + c0) * 64;
#pragma unroll
          for (int g = 0; g < 4; ++g) { const f32x4 bv = *(const f32x4*)(bias + 8 * g + 4 * hh); acc[kind][4 * g] = bv[0]; acc[kind][4 * g + 1] = bv[1]; acc[kind][4 * g + 2] = bv[2]; acc[kind][4 * g + 3] = bv[3]; }
#pragma unroll
          for (int ks = 0; ks < 4; ++ks) {
            const half8 wf = *(const half8*)(wl + (size_t)lq * 64 + 16 * ks + 8 * hh);
            acc[kind] = __builtin_amdgcn_mfma_f32_32x32x16_f16(wf, xin[kind][ks], acc[kind], 0, 0, 0);
          }
        }
#pragma unroll
        for (int g = 0; g < 4; ++g) {
          half8 o;
#pragma unroll
          for (int j = 0; j < 4; ++j) { o[2 * j] = (h16)(1.f - __expf(-0.6065306597126334f * sigmoidf_(acc[0][4 * g + j]))); o[2 * j + 1] = (h16)sigmoidf_(acc[1][4 * g + j]); }
          *(half8*)(ost + lq * 72 + 16 * g + 8 * hh) = o;
        }
        asm volatile("s_waitcnt lgkmcnt(0)" ::: "memory");
#pragma unroll
        for (int q = 0; q < 4; ++q) {
          const int id = lane + q * 64; const int rr = id >> 3, ch = id & 7;
          *(u32x4*)(fbase + (size_t)rr * 1536 + np * 64 + ch * 8) = *(const u32x4*)(ost + rr * 72 + ch * 8);
        }
        asm volatile("s_waitcnt lgkmcnt(0)" ::: "memory");
      }
    }
    {
      const int head = tid >> 5, pr = tid & 31, half = pr >> 4, i = pr & 15;
      const int colbase = head < 6 ? 3072 + head * 64 : 3456 + (head - 6) * 64;
      const int d1 = half * 32 + i;
      const float qs = (head < 6 && !dry) ? 0.125f : 1.f;
      h16* pp = p.P + (size_t)(rowbase + t0) * PC + colbase + d1;
#pragma unroll
      for (int tq = 0; tq < 32; tq += 8) {
        h16 x1[8], x2[8];
#pragma unroll
        for (int u = 0; u < 8; ++u) { x1[u] = pp[(size_t)(tq + u) * PC]; x2[u] = pp[(size_t)(tq + u) * PC + 16]; }
#pragma unroll
        for (int u = 0; u < 8; ++u) {
          const int t = t0 + tq + u;
          float cs = 1.f, sn = 0.f;
          if (!isctx && !dry) { const int pos = half == 0 ? (t >> 6) : (t & 63); const f32x2 r2 = *(const f32x2*)&p.rope[(pos * 16 + i) * 2]; cs = r2[0]; sn = r2[1]; }
          const float a = (float)x1[u], bq = (float)x2[u];
          pp[(size_t)(tq + u) * PC] = (h16)((a * cs - bq * sn) * qs);
          pp[(size_t)(tq + u) * PC + 16] = (h16)((a * sn + bq * cs) * qs);
        }
      }
    }
    if (tid < 128) {
      const int g = tid >> 6, d = tid & 63;
      const h16* base = p.P + (size_t)(rowbase + t0) * PC + 3584 + tid;
      h16* dst = p.VT + (size_t)((b * 2 + g) * 64 + d) * VTS + (isctx ? 4096 + t0 : t0);
      half8 v[4];
#pragma unroll
      for (int q = 0; q < 4; ++q)
#pragma unroll
        for (int j = 0; j < 8; ++j) v[q][j] = base[(size_t)(q * 8 + j) * PC];
#pragma unroll
      for (int q = 0; q < 4; ++q) *(half8*)(dst + q * 8) = v[q];
    }
    __syncthreads();
  }
}

__device__ __forceinline__ float ulo(unsigned u) { return (float)__builtin_bit_cast(h16, (unsigned short)(u & 0xffffu)); }
__device__ __forceinline__ float uhi(unsigned u) { return (float)__builtin_bit_cast(h16, (unsigned short)(u >> 16)); }
__device__ __forceinline__ float red16(float x) {
  x += dpp_mov<0xB1>(x);
  x += dpp_mov<0x4E>(x);
  x += dpp_mov<0x141>(x);
  x += dpp_mov<0x140>(x);
  return x;
}
#define LDS_BARRIER() do { asm volatile("s_waitcnt lgkmcnt(0)" ::: "memory"); __builtin_amdgcn_s_barrier(); asm volatile("" ::: "memory"); } while (0)
constexpr int RREC = 336;
struct RwkvPf { unsigned rk[10]; h16 v[8]; unsigned ea[8]; };

__device__ __forceinline__ void rwkv_chain(const Params& p, int l, int item, char* smem) {
  const int tid0 = tid_opaque();
  const int tid = (item >= 256) ? (tid0 ^ 128) : tid0;
  const int lane = tid & 63, w = tid >> 6;
  const int chain = item >> 2, vq = item & 3;
  const int dir = chain / 48, b = (chain % 48) / 6, h = chain % 6;
  float* opb = (float*)smem;
  float* ybuf = opb + 2 * 16 * RREC;
  constexpr int NCH = 272;
  if (w < 2) {
    const int rl = tid >> 3, kq = tid & 7;
    float S[8];
#pragma unroll
    for (int j = 0; j < 8; ++j) S[j] = 0.f;
    __builtin_amdgcn_s_setprio(3);
    LDS_BARRIER();
#pragma unroll 1
    for (int ci = 0; ci < NCH; ++ci) {
      const float* op = opb + (ci & 1) * 16 * RREC;
      float* yb = ybuf + (ci & 1) * 256;
      f32x4 aA = *(const f32x4*)(op + 8 * kq + 64), aB = *(const f32x4*)(op + 8 * kq + 68);
#pragma unroll
      for (int step = 0; step < 16; ++step) {
        const float* o = op + step * RREC + 8 * kq;
        const f32x4 wA = *(const f32x4*)(o), wB = *(const f32x4*)(o + 4);
        const f32x4 bA = *(const f32x4*)(o + 128), bB = *(const f32x4*)(o + 132);
        const f32x4 kA = *(const f32x4*)(o + 192), kB = *(const f32x4*)(o + 196);
        const f32x4 rA = *(const f32x4*)(o + 256), rB = *(const f32x4*)(o + 260);
        const float vv = op[step * RREC + 320 + rl];
        f32x4 naA = aA, naB = aB;
        if (step + 1 < 16) { naA = *(const f32x4*)(o + RREC + 64); naB = *(const f32x4*)(o + RREC + 68); }
        const float d0 = S[0] * aA[0] + S[1] * aA[1] + S[2] * aA[2] + S[3] * aA[3];
        const float d1 = S[4] * aB[0] + S[5] * aB[1] + S[6] * aB[2] + S[7] * aB[3];
        const float sa = red8(d0 + d1);
#pragma unroll
        for (int j = 0; j < 4; ++j) {
          S[j] = S[j] * wA[j] + sa * bA[j] + vv * kA[j];
          S[4 + j] = S[4 + j] * wB[j] + sa * bB[j] + vv * kB[j];
        }
        const float y0 = S[0] * rA[0] + S[1] * rA[1] + S[2] * rA[2] + S[3] * rA[3];
        const float y1 = S[4] * rB[0] + S[5] * rB[1] + S[6] * rB[2] + S[7] * rB[3];
        const float yy = red8(y0 + y1);
        if (kq == 0) yb[step * 16 + rl] = yy;
        aA = naA; aB = naB;
      }
      LDS_BARRIER();
    }
    __builtin_amdgcn_s_setprio(0);
  } else {
    const int lw = w - 2, lt = tid - 128;
    const int hc = h * 64 + lane;
    const float mpr = p.mu_prev[l * 1792 + hc], mnr = p.mu_next[l * 1792 + hc];
    const float mpk = p.mu_prev[l * 1792 + 384 + hc], mnk = p.mu_next[l * 1792 + 384 + hc];
    const float kkw = p.k_k[l * 384 + hc], kaw = p.k_a[l * 384 + hc];
    RwkvPf pfA, pfB;
#define RWKV_ISSUE(ci_, PF) { const int seg_ = (ci_) >= 16; const int Tn_ = seg_ ? 4096 : 256; const int rb_ = seg_ ? b * 4096 : NLAT + b * 256; const int s0_ = (seg_ ? (ci_) - 16 : (ci_)) * 16 + 8 * lw; \
    _Pragma("unroll") for (int q = 0; q < 10; ++q) { int t_ = dir == 0 ? s0_ - 1 + q : Tn_ - s0_ - q; t_ = t_ < 0 ? 0 : (t_ >= Tn_ ? Tn_ - 1 : t_); \
      PF.rk[q] = ((const unsigned*)(p.P + (size_t)(rb_ + t_) * PC + h * 128))[lane]; } \
    _Pragma("unroll") for (int i = 0; i < 8; ++i) { const int t_ = dir == 0 ? s0_ + i : Tn_ - 1 - (s0_ + i); const size_t row = (size_t)rb_ + t_; \
      PF.v[i] = p.VB[row * 384 + hc]; PF.ea[i] = ((const unsigned*)(p.F + row * 1536 + dir * 768))[hc]; } }
#define RWKV_STAGE(ci_, PF) { float* op_ = opb + ((ci_) & 1) * 16 * RREC; \
    const int seg = (ci_) >= 16; const int Tn = seg ? 4096 : 256; const int c0 = (seg ? (ci_) - 16 : (ci_)) * 16; \
    _Pragma("unroll") for (int i = 0; i < 8; ++i) { \
      const int step = lw * 8 + i; const int t = dir == 0 ? c0 + step : Tn - 1 - (c0 + step); \
      const float rlo = ulo(PF.rk[i]), r0 = ulo(PF.rk[i + 1]), rhi = ulo(PF.rk[i + 2]); \
      const float klo = uhi(PF.rk[i]), k0 = uhi(PF.rk[i + 1]), khi = uhi(PF.rk[i + 2]); \
      const float rm = t > 0 ? (dir ? rhi : rlo) : 0.f, rp = t + 1 < Tn ? (dir ? rlo : rhi) : 0.f; \
      const float km = t > 0 ? (dir ? khi : klo) : 0.f, kp = t + 1 < Tn ? (dir ? klo : khi) : 0.f; \
      const float vv = (float)PF.v[i], e = ulo(PF.ea[i]), al = uhi(PF.ea[i]); \
      const float rs = r0 + mpr * (rm - r0) + mnr * (rp - r0); \
      const float ks = k0 + mpk * (km - k0) + mnk * (kp - k0); \
      const float kkr = ks * kkw; \
      const float n2 = wave_sum_dpp(kkr * kkr); \
      const float kk = kkr * rsqrtf(fmaxf(n2, 1e-24f)); \
      float* o = op_ + step * RREC + lane; \
      o[0] = 1.f - e; o[64] = -kk; o[128] = kk * al; o[192] = ks * (1.f + (al - 1.f) * kaw); o[256] = rs; \
      if ((lane >> 4) == vq) op_[step * RREC + 320 + (lane & 15)] = vv; } }
#define RWKV_WRITE(cj_) { const int seg = (cj_) >= 16; const int Tn = seg ? 4096 : 256; const int rowbase = seg ? b * 4096 : NLAT + b * 256; const int c0 = (seg ? (cj_) - 16 : (cj_)) * 16; \
    if (seg == 1 || l == 0) { const float* yb = ybuf + ((cj_) & 1) * 256; \
      _Pragma("unroll") for (int i = 0; i < 2; ++i) { const int idx = lt + i * 128; const int step = idx >> 4, ch = idx & 15; \
        const int t = dir == 0 ? c0 + step : Tn - 1 - (c0 + step); \
        const h16 yv = (h16)yb[idx]; \
        if (dir == 0) p.P[(size_t)(rowbase + t) * PC + 768 + h * 64 + 16 * vq + ch] = yv; \
        else p.hy[(size_t)(rowbase + t) * 1024 + h * 64 + 16 * vq + ch] = yv; } } }
    RWKV_ISSUE(0, pfA)
    RWKV_STAGE(0, pfA)
    RWKV_ISSUE(1, pfB)
    RWKV_ISSUE(2, pfA)
    LDS_BARRIER();
#pragma unroll 1
    for (int ci = 0; ci < NCH; ci += 2) {
      if (ci + 1 < NCH) RWKV_STAGE(ci + 1, pfB)
      if (ci + 3 < NCH) RWKV_ISSUE(ci + 3, pfB)
      if (ci >= 1) RWKV_WRITE(ci - 1)
      LDS_BARRIER();
      if (ci + 2 < NCH) RWKV_STAGE(ci + 2, pfA)
      if (ci + 4 < NCH) RWKV_ISSUE(ci + 4, pfA)
      RWKV_WRITE(ci)
      LDS_BARRIER();
    }
    RWKV_WRITE(NCH - 1)
  }
}

constexpr int HREC = 224;
struct HgrnPf { h16 f[4], q[4], iv[4]; };
__device__ __forceinline__ void hgrn_chain(const Params& p, int l, int item, char* smem) {
  const int tid = tid_opaque(), lane = tid & 63, w = tid >> 6;
  const int chain = item >> 1, vh = item & 1;
  const int dir = chain / 32, b = (chain % 32) / 4, h = chain % 4;
  float* op = (float*)smem;
  float* ybuf = op + 16 * HREC;
  const int hc = h * 64 + lane;
  float lb = 0.f;
  if (l == 1) lb = sigmoidf_(p.lb_logits[(dir * 2 + 1) * 256 + hc] - p.lb_logits[(dir * 2 + 0) * 256 + hc]);
  const int fcol = 1792 + 256 * (1 + dir) + hc;
  const int vc = tid >> 3, kq = tid & 7;
  float S[8];
#pragma unroll
  for (int j = 0; j < 8; ++j) S[j] = 0.f;
  HgrnPf pfA, pfB;
#define HGRN_ISSUE(ci_, PF) { const int seg_ = (ci_) >= 16; const int Tn_ = seg_ ? 4096 : 256; const int rb_ = seg_ ? b * 4096 : NLAT + b * 256; const int c0_ = (seg_ ? (ci_) - 16 : (ci_)) * 16; \
    _Pragma("unroll") for (int i = 0; i < 4; ++i) { const int step = w * 4 + i; const int t = dir == 0 ? c0_ + step : Tn_ - 1 - (c0_ + step); const h16* pr = p.P + ((size_t)rb_ + t) * PC; \
      PF.f[i] = pr[fcol]; PF.q[i] = pr[1792 + hc]; PF.iv[i] = pr[1792 + 768 + hc]; } }
#define HGRN_CHUNK(ci_, PF) { \
    const int seg = (ci_) >= 16; const int Tn = seg ? 4096 : 256; const int rowbase = seg ? b * 4096 : NLAT + b * 256; const int c0 = (seg ? (ci_) - 16 : (ci_)) * 16; \
    _Pragma("unroll") for (int i = 0; i < 4; ++i) { \
      const int step = w * 4 + i; \
      float* o = op + step * HREC + lane; \
      const float f = lb + (1.f - lb) * sigmoidf_((float)PF.f[i]); \
      o[0] = f; o[128] = (float)PF.q[i]; \
      if ((lane >> 5) == vh) op[step * HREC + 192 + (lane & 31)] = (float)PF.iv[i]; } \
    LDS_BARRIER(); \
    if ((ci_) + 2 < 272) HGRN_ISSUE((ci_) + 2, PF) \
    _Pragma("unroll") for (int step = 0; step < 16; ++step) { \
      const float* o = op + step * HREC + 8 * kq; \
      const f32x4 fA = *(const f32x4*)(o), fB = *(const f32x4*)(o + 4); \
      const f32x4 qA = *(const f32x4*)(o + 128), qB = *(const f32x4*)(o + 132); \
      const float iv = op[step * HREC + 192 + vc]; \
      const float f[8] = {fA[0], fA[1], fA[2], fA[3], fB[0], fB[1], fB[2], fB[3]}; \
      const float q[8] = {qA[0], qA[1], qA[2], qA[3], qB[0], qB[1], qB[2], qB[3]}; \
      float acc = 0.f; \
      _Pragma("unroll") for (int j = 0; j < 8; ++j) { S[j] = f[j] * (S[j] - iv) + iv; acc += S[j] * q[j]; } \
      ybuf[step * 256 + tid] = acc; } \
    LDS_BARRIER(); \
    if (seg == 1 || l == 0) { \
      _Pragma("unroll") for (int i = 0; i < 2; ++i) { \
        const int idx = tid + i * 256; const int step = idx >> 5, ch = idx & 31; \
        const int t = dir == 0 ? c0 + step : Tn - 1 - (c0 + step); \
        const float* yb = ybuf + step * 256 + ch * 8; \
        const f32x4 y0 = *(const f32x4*)(yb), y1 = *(const f32x4*)(yb + 4); \
        const f32x4 ys = y0 + y1; \
        const h16 ov = (h16)((ys[0] + ys[1]) + (ys[2] + ys[3])); \
        if (dir == 0) p.P[(size_t)(rowbase + t) * PC + 1152 + h * 64 + 32 * vh + ch] = ov; \
        else p.hy[(size_t)(rowbase + t) * 1024 + 384 + h * 64 + 32 * vh + ch] = ov; } } }
  HGRN_ISSUE(0, pfA)
  HGRN_ISSUE(1, pfB)
  __builtin_amdgcn_s_setprio(2);
#pragma unroll 1
  for (int ci = 0; ci < 272; ci += 2) {
    HGRN_CHUNK(ci, pfA)
    HGRN_CHUNK(ci + 1, pfB)
  }
  __builtin_amdgcn_s_setprio(0);
}

__device__ __forceinline__ void attn_unit(const Params& p, int l, int u) {
  const int tid = tid_opaque(), lane = tid & 63, w = tid >> 6, lq = lane & 31, hh = lane >> 5;
  int b, head, qrow_base, qpos0; bool isctx;
  if (u < 1536) { b = u / 192; int rem = u % 192; int blk = rem / 6; head = rem % 6; qpos0 = blk * 128 + w * 32; qrow_base = b * 4096; isctx = false; }
  else { int j = u - 1536; b = j / 12; int rem = j % 12; int qb = rem / 6; head = rem % 6; qpos0 = qb * 128 + w * 32; qrow_base = NLAT + b * 256; isctx = true; }
  const int g = head / 3;
  const size_t qrow = (size_t)qrow_base + qpos0 + lq;
  half8 qf[4];
#pragma unroll
  for (int s = 0; s < 4; ++s) qf[s] = *(const half8*)(p.P + qrow * PC + 3072 + head * 64 + 16 * s + 8 * hh);
  const float sinkv = p.sink[l * 6 + head];
  float m = sinkv, lsum = hh == 0 ? 1.f : 0.f;
  f32x16 O[2];
#pragma unroll
  for (int r = 0; r < 16; ++r) { O[0][r] = 0.f; O[1][r] = 0.f; }
  const h16* vt = p.VT + (size_t)((b * 2 + g) * 64) * VTS;
  int nband = 0, kstart = 0;
  if (!isctx) { kstart = max(0, qpos0 - 128); const int kend = min(4096, qpos0 + 160); nband = (kend - kstart) >> 5; }
  const int ntiles = nband + 8;
  for (int ti = 0; ti < ntiles; ++ti) {
    const bool band = ti < nband;
    const int kt = band ? kstart + ti * 32 : (ti - nband) * 32;
    const size_t krow = band ? (size_t)b * 4096 + kt + lq : (size_t)NLAT + b * 256 + kt + lq;
    const int vidx = band ? kt : 4096 + kt;
    const h16* kp = p.P + krow * PC + 3456 + g * 64 + 8 * hh;
    f32x16 sacc;
#pragma unroll
    for (int r = 0; r < 16; ++r) sacc[r] = 0.f;
#pragma unroll
    for (int s = 0; s < 4; ++s) { half8 kf = *(const half8*)(kp + 16 * s); sacc = __builtin_amdgcn_mfma_f32_32x32x16_f16(kf, qf[s], sacc, 0, 0, 0); }
    float mx = -INFINITY;
#pragma unroll
    for (int r = 0; r < 16; ++r) {
      float sv = sacc[r];
      if (band) { const int dlt = kt + (r & 3) + 8 * (r >> 2) + 4 * hh - (qpos0 + lq); if (dlt > 128 || dlt < -128) sv = -INFINITY; }
      sacc[r] = sv; mx = fmaxf(mx, sv);
    }
    mx = fmaxf(mx, __shfl_xor(mx, 32));
    const float mn = fmaxf(m, mx); const float corr = __expf(m - mn); m = mn;
    float ps = 0.f; half8 pb[2];
#pragma unroll
    for (int r = 0; r < 16; ++r) { const float pv = __expf(sacc[r] - mn); ps += pv; pb[r >> 3][r & 7] = (h16)pv; }
    lsum = lsum * corr + ps;
#pragma unroll
    for (int r = 0; r < 16; ++r) { O[0][r] *= corr; O[1][r] *= corr; }
#pragma unroll
    for (int s2 = 0; s2 < 2; ++s2)
#pragma unroll
      for (int dt = 0; dt < 2; ++dt) {
        const h16* vp = vt + (size_t)(dt * 32 + lq) * VTS + vidx + 16 * s2 + 4 * hh;
        const half4 lo = *(const half4*)vp, hi = *(const half4*)(vp + 8);
        const half8 vf = {lo[0], lo[1], lo[2], lo[3], hi[0], hi[1], hi[2], hi[3]};
        O[dt] = __builtin_amdgcn_mfma_f32_32x32x16_f16(vf, pb[s2], O[dt], 0, 0, 0);
      }
  }
  lsum += __shfl_xor(lsum, 32);
  const float inv = 1.f / lsum;
#pragma unroll
  for (int dt = 0; dt < 2; ++dt)
#pragma unroll
    for (int g4 = 0; g4 < 4; ++g4) {
      const int d0 = dt * 32 + 8 * g4 + 4 * hh;
      const half4 ga = *(const half4*)(p.P + qrow * PC + 3712 + head * 64 + d0);
      half4 o;
#pragma unroll
      for (int j = 0; j < 4; ++j) { const float gv = (float)ga[j]; o[j] = (h16)(O[dt][g4 * 4 + j] * inv * siluf_(gv)); }
      *(half4*)(p.hy + qrow * 1024 + 640 + head * 64 + d0) = o;
    }
}

__device__ __forceinline__ void phase_mix(const Params& p, int l, int bid, int nb, char* smem, int sub) {
  const int nunits = l == 0 ? 1536 + 96 : 1536;
  if (nb >= 640) {
    if (bid < 384) { if (sub & 1) rwkv_chain(p, l, bid, smem); }
    else if (bid < 512) { if (sub & 2) hgrn_chain(p, l, bid - 384, smem); }
    else if (sub & 4) for (int u = bid - 512; u < nunits; u += nb - 512) attn_unit(p, l, u);
  } else {
    for (int it = bid; it < 512 + nunits; it += nb) {
      if (it < 384) rwkv_chain(p, l, it, smem);
      else if (it < 512) hgrn_chain(p, l, it - 384, smem);
      else attn_unit(p, l, it - 512);
      __syncthreads();
    }
  }
}

__device__ __forceinline__ float sum4(const f32x4 v) { return (v[0] + v[1]) + (v[2] + v[3]); }
__device__ __forceinline__ f32x4 h4f(const half4 h) { return (f32x4){(float)h[0], (float)h[1], (float)h[2], (float)h[3]}; }
__device__ __forceinline__ void phase_readout(const Params& p, int l, int bid, int nb, bool dummy) {
  const int tid = tid_opaque(), lane = tid & 63, w = tid >> 6;
  const int nrows = l == 1 ? NLAT : NTOK;
  const int hl = lane >> 4, c4 = (lane & 15) * 4;
#pragma unroll 2
  for (int it = bid * 4 + w; it < nrows * 3; it += nb * 4) {
    const int row = it / 3, q = it - row * 3;
    int t, Tn;
    if (row < NLAT) { t = row & 4095; Tn = 4096; } else { t = (row - NLAT) & 255; Tn = 256; }
    const h16* pr = p.P + (size_t)row * PC;
    h16* yo = p.hy + (size_t)row * 1024;
    h16* yw = dummy ? p.F + (size_t)row * 1536 : yo;
    if (q < 2) {
      const int head = q * 4 + hl; const bool valid = head < 6; const int c = (valid ? head : 5) * 64 + c4;
      const bool hp = t > 0, hn = t + 1 < Tn;
      const f32x4 y = h4f(*(const half4*)(pr + 768 + c)) + h4f(*(const half4*)(yo + c));
      f32x4 sh[3];
      {
        const h16* prk = pr + (valid ? head : 5) * 128 + 2 * c4;
        const half8 cur8 = *(const half8*)prk;
        half8 prv8, nxt8;
#pragma unroll
        for (int j = 0; j < 8; ++j) { prv8[j] = (h16)0.f; nxt8[j] = (h16)0.f; }
        if (hp) prv8 = *(const half8*)(prk - PC);
        if (hn) nxt8 = *(const half8*)(prk + PC);
#pragma unroll
        for (int k = 0; k < 2; ++k) {
          const f32x4 cur = {(float)cur8[k], (float)cur8[2 + k], (float)cur8[4 + k], (float)cur8[6 + k]};
          const f32x4 prv = {(float)prv8[k], (float)prv8[2 + k], (float)prv8[4 + k], (float)prv8[6 + k]};
          const f32x4 nxt = {(float)nxt8[k], (float)nxt8[2 + k], (float)nxt8[4 + k], (float)nxt8[6 + k]};
          const f32x4 mp = *(const f32x4*)(p.mu_prev + l * 1792 + k * 384 + c), mn = *(const f32x4*)(p.mu_next + l * 1792 + k * 384 + c);
          sh[k] = cur + mp * (prv - cur) + mn * (nxt - cur);
        }
        const int col = 1408 + c;
        const f32x4 cur = h4f(*(const half4*)(pr + col));
        const f32x4 prv = hp ? h4f(*(const half4*)(pr + col - PC)) : (f32x4){0.f, 0.f, 0.f, 0.f};
        const f32x4 nxt = hn ? h4f(*(const half4*)(pr + col + PC)) : (f32x4){0.f, 0.f, 0.f, 0.f};
        const f32x4 mp = *(const f32x4*)(p.mu_prev + l * 1792 + col), mn = *(const f32x4*)(p.mu_next + l * 1792 + col);
        sh[2] = cur + mp * (prv - cur) + mn * (nxt - cur);
      }
      const f32x4 v = h4f(*(const half4*)(p.VB + (size_t)row * 384 + c));
      const f32x4 gw = *(const f32x4*)(p.gn_w + l * 384 + c), gb = *(const f32x4*)(p.gn_b + l * 384 + c), rk = *(const f32x4*)(p.r_k + l * 384 + c);
      const float mean = red16(sum4(y)) * (1.f / 64.f);
      const f32x4 yc = y - mean;
      const float var = red16(sum4(yc * yc)) * (1.f / 64.f);
      const float rs = rsqrtf(var + 64e-5f);
      const float bs = red16(sum4(sh[0] * sh[1] * rk));
      half4 o;
#pragma unroll
      for (int j = 0; j < 4; ++j) o[j] = (h16)((yc[j] * rs * gw[j] + gb[j] + bs * v[j]) * siluf_(sh[2][j]));
      if (valid) *(half4*)(yw + c) = o;
    } else {
      const int c = hl * 64 + c4;
      const f32x4 o = h4f(*(const half4*)(pr + 1152 + c)) + h4f(*(const half4*)(yo + 384 + c));
      const f32x4 g = h4f(*(const half4*)(pr + 2816 + c));
      const f32x4 nw = *(const f32x4*)(p.hg_norm_w + l * 256 + c);
      const float ms = red16(sum4(o * o)) * (1.f / 64.f);
      const float rs = rsqrtf(ms + 1e-6f);
      half4 ov;
#pragma unroll
      for (int j = 0; j < 4; ++j) ov[j] = (h16)(o[j] * rs * nw[j] * siluf_(g[j]));
      *(half4*)(yw + 384 + c) = ov;
    }
  }
}

__device__ __forceinline__ void phase_final(const Params& p, int bid, int nb) {
  const int tid = tid_opaque(), lane = tid & 63, w = tid >> 6;
  for (int row = bid * 4 + w; row < NLAT; row += nb * 4) {
    float* src = p.out + (size_t)row * 1024;
    f32x4 v[4]; float ss = 0.f;
#pragma unroll
    for (int i = 0; i < 4; ++i) { v[i] = *(const f32x4*)(src + i * 256 + lane * 4); ss += v[i][0] * v[i][0] + v[i][1] * v[i][1] + v[i][2] * v[i][2] + v[i][3] * v[i][3]; }
    ss = wave_sum_dpp(ss);
    const float rs = rsqrtf(ss * (1.f / 1024.f) + 1e-6f);
#pragma unroll
    for (int i = 0; i < 4; ++i) {
      const int col = i * 256 + lane * 4;
      const f32x4 nwv = *(const f32x4*)(p.final_w + col);
      f32x4 o;
#pragma unroll
      for (int j = 0; j < 4; ++j) o[j] = v[i][j] * rs * nwv[j];
      *(f32x4*)(src + col) = o;
    }
  }
}

__global__ void __launch_bounds__(256, 3) __attribute__((target("no-packed-fp32-ops"))) mega(Params p, int ph_lo, int ph_hi, int coop) {
  __shared__ __attribute__((aligned(16))) char smem[SMEM_BYTES];
  __shared__ uint4 xb_words;
  XcdBarrier xb; xb.bar = p.bar; xb.x = 0; xb.st = (volatile LAS unsigned*)&xb_words;
  if (coop) { if (threadIdx.x == 0) xb_words = make_uint4(0u, 0u, 0u, 0u); __syncthreads(); xb = xcd_barrier_post(p.bar, (volatile LAS unsigned*)&xb_words); }
  if (coop) for (int i = 0; i < EXTRA_SYNCS; ++i) { xcd_barrier(xb); }
  if (coop == 2) cg::this_grid().sync();
  for (int ph = ph_lo; ph < ph_hi; ++ph) {
    for (int rep = 0; rep < (((PROBE_MASK >> ph) & 1) ? 2 : 1); ++rep) {
      int bid = blockIdx.x, nb = gridDim.x;
      asm volatile("" : "+s"(bid), "+s"(nb));
      if (ph == 0) phase_prep(p, bid, nb, smem);
      else if (ph == 13) phase_final(p, bid, nb);
      else {
        const int l = (ph - 1) / 6, s = (ph - 1) % 6;
        if (s == 0) phase_norm(p, l, bid, nb);
        else if (s == 1) phase_gemm<0>(p, l, bid, nb, smem);
        else if (s == 2) phase_feat(p, l, bid, nb, smem, PROBE_MASK && ((PROBE_MASK >> ph) & 1) && rep == 0);
        else if (s == 3) phase_mix(p, l, bid, nb, smem, rep ? PROBE_SUB : 7);
        else if (s == 4) phase_readout(p, l, bid, nb, PROBE_MASK && ((PROBE_MASK >> ph) & 1) && rep == 0);
        else phase_gemm<1>(p, l, bid, nb, smem);
      }
      if (PROBE_MASK && rep == 0 && ((PROBE_MASK >> ph) & 1)) { xcd_barrier(xb); }
    }
    if (coop && ph + 1 < ph_hi) { xcd_barrier(xb); }
  }
}

extern "C" void kernel_launch(void* const* d_in, const int* in_sizes, int n_in, void* d_out, int out_size, void* d_ws, size_t ws_size, hipStream_t stream) {
  static int grid_blocks = 0;
  if (!grid_blocks) {
    int dev = 0, cus = 0, per_cu = 0;
    hipGetDevice(&dev);
    hipDeviceGetAttribute(&cus, hipDeviceAttributeMultiprocessorCount, dev);
    hipOccupancyMaxActiveBlocksPerMultiprocessor(&per_cu, mega, 256, 0);
    if (per_cu < 1) per_cu = 1;
    grid_blocks = cus * per_cu;
  }
  Params p{};
  const float* const* in = (const float* const*)d_in;
  p.x = in[0]; p.c = in[1]; p.ctx = in[2]; p.c_ctx = in[3]; p.mod_w = in[4]; p.mod_b = in[5]; p.norm_w = in[6]; p.w_in = in[7]; p.w_out = in[8];
  p.mu_prev = in[9]; p.mu_next = in[10]; p.w0 = in[11]; p.w2 = in[12]; p.a0 = in[13]; p.a2 = in[14]; p.k_k = in[15]; p.k_a = in[16]; p.r_k = in[17];
  p.gn_w = in[18]; p.gn_b = in[19]; p.vw1 = in[20]; p.vw2 = in[21]; p.vb = in[22]; p.lb_logits = in[23]; p.hg_norm_w = in[24]; p.sink = in[25]; p.final_w = in[26];
  p.out = (float*)d_out;
  char* ws = (char*)d_ws; size_t off = 0;
  auto take = [&](size_t bytes) { char* r = ws + off; off += (bytes + 255) & ~(size_t)255; return r; };
  p.win_t = (h16*)take((size_t)2 * NPAD * 1024 * 2);
  p.wout_t = (h16*)take((size_t)2 * 1024 * 1024 * 2);
  p.wl_t = (h16*)take((size_t)2 * 4 * 384 * 64 * 2);
  p.mod = (float*)take((size_t)2 * 9 * 3072 * 4);
  p.rope = (float*)take((size_t)64 * 16 * 2 * 4);
  p.hy = (h16*)take((size_t)NTOK * 1024 * 2);
  p.P = (h16*)take((size_t)NTOK * PC * 2);
  p.F = (h16*)take((size_t)NTOK * 1536 * 2);
  p.VB = (h16*)take((size_t)NTOK * 384 * 2);
  p.VT = (h16*)take((size_t)16 * 64 * VTS * 2);
  p.xc1 = (float*)take((size_t)2048 * 1024 * 4);
  p.bar = (unsigned*)take(16384);
  if (off > ws_size) fprintf(stderr, "workspace too small: need %zu have %zu\n", off, ws_size);
#if SINGLE_LAUNCH
  hipMemsetAsync(p.bar, 0, 16384, stream);
  int lo = 0, hi = 14, coop = 1;
  void* args[] = {&p, &lo, &hi, &coop};
  hipError_t e = hipLaunchCooperativeKernel((void*)mega, dim3(grid_blocks), dim3(256), args, 0, stream);
  if (e != hipSuccess) fprintf(stderr, "cooperative launch failed: %s (grid %d)\n", hipGetErrorString(e), grid_blocks);
#else
  for (int ph = 0; ph < 14; ++ph) mega<<<grid_blocks, 256, 0, stream>>>(p, ph, ph + 1, 0);
#endif
}
```

```cpp
#include <hip/hip_runtime.h>
#include <hip/hip_cooperative_groups.h>
#include <cstdio>
#include <cstdint>
namespace cg = cooperative_groups;

typedef _Float16 h16;
typedef _Float16 half8 __attribute__((ext_vector_type(8)));
typedef _Float16 half4 __attribute__((ext_vector_type(4)));
typedef float f32x16 __attribute__((ext_vector_type(16)));
typedef float f32x4 __attribute__((ext_vector_type(4)));
typedef float f32x2 __attribute__((ext_vector_type(2)));
typedef unsigned u32x4 __attribute__((ext_vector_type(4)));
typedef _Float16 half2v __attribute__((ext_vector_type(2)));

constexpr int NLAT = 32768, NTOK = 34816;
constexpr int PC = 4160;
constexpr int NPAD = 4224;
constexpr int VTS = 4352;
constexpr int SMEM_BYTES = 49152;

#ifndef EXTRA_SYNCS
#define EXTRA_SYNCS 0
#endif
#ifndef PROBE_SUB
#define PROBE_SUB 7
#endif
#ifndef PROBE_MASK
#define PROBE_MASK 0
#endif
#ifndef SINGLE_LAUNCH
#define SINGLE_LAUNCH 1
#endif

struct Params {
  const float *x, *c, *ctx, *c_ctx, *mod_w, *mod_b, *norm_w, *w_in, *w_out;
  const float *mu_prev, *mu_next, *w0, *w2, *a0, *a2, *k_k, *k_a, *r_k, *gn_w, *gn_b;
  const float *vw1, *vw2, *vb, *lb_logits, *hg_norm_w, *sink, *final_w;
  float* out;
  h16 *win_t, *wout_t, *wl_t;
  float* mod;
  h16 *hy, *P, *F, *VB;
  h16* VT;
  float* xc1;
  float* rope;
  unsigned* bar;
};

__device__ __forceinline__ int tid_opaque() { int t = threadIdx.x; asm volatile("" : "+v"(t)); return t; }
__device__ __forceinline__ float wave_sum(float v) {
#pragma unroll
  for (int o = 32; o > 0; o >>= 1) v += __shfl_xor(v, o);
  return v;
}
__device__ __forceinline__ float sigmoidf_(float x) { return __builtin_amdgcn_rcpf(1.f + __expf(-x)); }
__device__ __forceinline__ float siluf_(float x) { return x * __builtin_amdgcn_rcpf(1.f + __expf(-x)); }
template <int CTRL> __device__ __forceinline__ float dpp_mov(float x) {
  return __int_as_float(__builtin_amdgcn_update_dpp(0, __float_as_int(x), CTRL, 0xf, 0xf, true));
}
__device__ __forceinline__ float wave_sum_dpp(float x) {
  x += dpp_mov<0xB1>(x);
  x += dpp_mov<0x4E>(x);
  x += dpp_mov<0x141>(x);
  x += dpp_mov<0x140>(x);
  const int xi = __float_as_int(x);
  return __int_as_float(__builtin_amdgcn_readlane(xi, 0)) + __int_as_float(__builtin_amdgcn_readlane(xi, 16)) +
         __int_as_float(__builtin_amdgcn_readlane(xi, 32)) + __int_as_float(__builtin_amdgcn_readlane(xi, 48));
}
__device__ __forceinline__ float red8(float x) {
  x += dpp_mov<0xB1>(x);
  x += dpp_mov<0x4E>(x);
  x += dpp_mov<0x141>(x);
  return x;
}

#define XB_TMO      128
#define XB_XCNT(j)  (256  + 64 * (j))
#define XB_XSUB(j)  (1280 + 64 * (j))
#define XB_XGEN(j)  (2304 + 64 * (j))
#define XB_TOP      3328
#define XB_TOPGEN   3392
#define XCD_BAR_WORDS 3456
#define XB_SPIN_CAP (1u << 18)
#define LAS __attribute__((address_space(3)))
__device__ __forceinline__ unsigned xb_ld(unsigned* p)              { return __hip_atomic_load(p, __ATOMIC_RELAXED, __HIP_MEMORY_SCOPE_AGENT); }
__device__ __forceinline__ unsigned xb_add(unsigned* p, unsigned v) { return __hip_atomic_fetch_add(p, v, __ATOMIC_RELAXED, __HIP_MEMORY_SCOPE_AGENT); }
__device__ __forceinline__ unsigned xb_xcc_id() { return (unsigned)__builtin_amdgcn_s_getreg((3 << 11) | 20) & 0xFu; }
#define XB_SPIN(cond, bar) do { unsigned _sp = 0; while (cond) { __builtin_amdgcn_s_sleep(1); \
    if ((++_sp & 255u) == 0u) { if (xb_ld(&(bar)[XB_TMO])) break; if (_sp > XB_SPIN_CAP) { atomicAdd(&(bar)[XB_TMO], 1u); break; } } } } while (0)
struct XcdBarrier { unsigned* bar; unsigned x; volatile LAS unsigned* st; };
__device__ __forceinline__ XcdBarrier xcd_barrier_post(unsigned* bar, volatile LAS unsigned* st) {
  XcdBarrier b; b.bar = bar; b.x = xb_xcc_id(); b.st = st;
  if (threadIdx.x == 0) (void)xb_add(&bar[XB_XCNT(b.x)], 1u);
  return b;
}
__device__ __forceinline__ void xcd_barrier_complete(unsigned* bar, unsigned x, unsigned& nloc, unsigned& nx) {
  const unsigned G = gridDim.x * gridDim.y * gridDim.z;
  unsigned sum, cnt, mine, sp = 0u;
  for (;;) {
    sum = 0u; cnt = 0u; mine = 0u;
#pragma unroll
    for (unsigned j = 0; j < 16; ++j) { const unsigned c = xb_ld(&bar[XB_XCNT(j)]); sum += c; cnt += (c > 0u) ? 1u : 0u; mine = (j == x) ? c : mine; }
    if (sum == G) break;
    __builtin_amdgcn_s_sleep(1);
    if ((++sp & 255u) == 0u) { if (xb_ld(&bar[XB_TMO])) break; if (sp > XB_SPIN_CAP) { atomicAdd(&bar[XB_TMO], 1u); break; } }
  }
  nloc = mine > 0u ? mine : 1u; nx = cnt > 0u ? cnt : 1u;
}
__device__ __forceinline__ void xcd_barrier(const XcdBarrier& b) {
  asm volatile("s_waitcnt vmcnt(0)" ::: "memory");
  __syncthreads();
  if (threadIdx.x == 0) {
    unsigned* bar = b.bar;
    __builtin_amdgcn_s_waitcnt(0);
    unsigned nloc = b.st[0], nx = b.st[1];
    if (nloc == 0u) { xcd_barrier_complete(bar, b.x, nloc, nx); b.st[0] = nloc; b.st[1] = nx; }
    const unsigned old = xb_add(&bar[XB_XSUB(b.x)], 1u);
    const unsigned gen = old / nloc;
    if (old + 1u == (gen + 1u) * nloc) {
      __builtin_amdgcn_fence(__ATOMIC_RELEASE, "agent");
      asm volatile("s_waitcnt vmcnt(0)" ::: "memory");
      const unsigned og = xb_add(&bar[XB_TOP], 1u);
      const unsigned tg = og / nx;
      if (og + 1u == (tg + 1u) * nx) xb_add(&bar[XB_TOPGEN], 1u);
      else XB_SPIN(xb_ld(&bar[XB_TOPGEN]) == tg, bar);
      __builtin_amdgcn_fence(__ATOMIC_ACQUIRE, "agent");
      xb_add(&bar[XB_XGEN(b.x)], 1u);
      asm volatile("s_waitcnt vmcnt(0)" ::: "memory");
    } else {
      XB_SPIN(xb_ld(&bar[XB_XGEN(b.x)]) == gen, bar);
      __builtin_amdgcn_fence(__ATOMIC_ACQUIRE, "agent");
      asm volatile("s_waitcnt vmcnt(0)" ::: "memory");
    }
  }
  __syncthreads();
}

__device__ __forceinline__ void phase_prep(const Params& p, int bid, int nb, char* smem) {
  const int tid = tid_opaque();
  float* sf = (float*)smem;
  constexpr int N_WIN = 2048, N_WOUT = 512, N_MOD = 192, N_PADI = 1024, N_WL = 768;
  constexpr int total = N_WIN + N_WOUT + N_MOD + N_PADI + N_WL + 1;
  for (int it = bid; it < total; it += nb) {
    if (it < N_WIN + N_WOUT) {
      const float* src; h16* dst; int ncols, kt, ntile;
      if (it < N_WIN) { int l = it >> 10, r = it & 1023; kt = r >> 6; ntile = r & 63; src = p.w_in + (size_t)l * 1024 * 4096; dst = p.win_t + (size_t)l * NPAD * 1024; ncols = 4096; }
      else { int j = it - N_WIN; int l = j >> 8, r = j & 255; kt = r >> 4; ntile = r & 15; src = p.w_out + (size_t)l * 1024 * 1024; dst = p.wout_t + (size_t)l * 1024 * 1024; ncols = 1024; }
      for (int i = tid; i < 4096; i += 256) { int kk = i >> 6, nn = i & 63; sf[kk * 65 + nn] = src[(size_t)(kt * 64 + kk) * ncols + ntile * 64 + nn]; }
      __syncthreads();
      const bool rkperm = it < N_WIN && ntile < 12;
      for (int i = tid; i < 4096; i += 256) {
        int nn = i >> 6, kk = i & 63;
        const int nrow = rkperm ? ((ntile % 6) * 128 + 2 * nn + ntile / 6) : (ntile * 64 + nn);
        dst[(size_t)nrow * 1024 + kt * 64 + kk] = (h16)sf[kk * 65 + nn];
      }
      __syncthreads();
    } else if (it < N_WIN + N_WOUT + N_MOD) {
      const int j = it - N_WIN - N_WOUT; const int l = j / 96; const int cl = tid & 31, ks = tid >> 5; const int col = (j % 96) * 32 + cl;
      for (int i = tid; i < 9 * 1024; i += 256) { int r = i >> 10, k = i & 1023; float v = r < 8 ? p.c[r * 1024 + k] : p.c_ctx[k]; sf[i] = siluf_(v); }
      __syncthreads();
      float acc[9];
#pragma unroll
      for (int r = 0; r < 9; ++r) acc[r] = 0.f;
      const float* mw = p.mod_w + (size_t)l * 1024 * 3072 + (size_t)(ks * 128) * 3072 + col;
#pragma unroll 2
      for (int k = 0; k < 128; k += 4) {
        const float w0 = mw[(size_t)k * 3072], w1 = mw[(size_t)(k + 1) * 3072], w2 = mw[(size_t)(k + 2) * 3072], w3 = mw[(size_t)(k + 3) * 3072];
#pragma unroll
        for (int r = 0; r < 9; ++r) { const f32x4 sv = *(const f32x4*)&sf[r * 1024 + ks * 128 + k]; acc[r] += sv[0] * w0 + sv[1] * w1 + sv[2] * w2 + sv[3] * w3; }
      }
#pragma unroll
      for (int r = 0; r < 9; ++r) acc[r] += __shfl_xor(acc[r], 32);
      __syncthreads();
      if ((tid & 63) < 32) {
#pragma unroll
        for (int r = 0; r < 9; ++r) sf[((tid >> 6) * 9 + r) * 32 + cl] = acc[r];
      }
      __syncthreads();
      for (int i = tid; i < 288; i += 256) {
        const int r = i >> 5, c2 = i & 31;
        const float v = sf[(0 * 9 + r) * 32 + c2] + sf[(1 * 9 + r) * 32 + c2] + sf[(2 * 9 + r) * 32 + c2] + sf[(3 * 9 + r) * 32 + c2];
        const int cc = (j % 96) * 32 + c2;
        p.mod[(size_t)(l * 9 + r) * 3072 + cc] = v + p.mod_b[l * 3072 + cc];
      }
      __syncthreads();
    } else if (it < N_WIN + N_WOUT + N_MOD + N_PADI) {
      int j = it - (N_WIN + N_WOUT + N_MOD); int idx = j * 256 + tid;
      int l = idx >> 17; int rem = idx & 131071; int m = rem >> 10, k = rem & 1023;
      float v = (l == 1 && m < 32) ? p.vw1[k * 32 + m] : 0.f;
      p.win_t[(size_t)l * NPAD * 1024 + (size_t)(4096 + m) * 1024 + k] = (h16)v;
    } else if (it < N_WIN + N_WOUT + N_MOD + N_PADI + N_WL) {
      const int idx = (it - (N_WIN + N_WOUT + N_MOD + N_PADI)) * 256 + tid;
      const int r = idx & 63, c = (idx >> 6) % 384, ls = idx / (384 * 64); const int l = ls >> 2, slot = ls & 3, dir = slot & 1, kind = slot >> 1;
      const float v = (kind == 0 ? p.w2 : p.a2)[((size_t)(l * 2 + dir) * 64 + r) * 384 + c];
      p.wl_t[idx] = (h16)v;
    } else {
      if (tid < 16) {
        double inv = 1.0; for (int i = 0; i < tid; ++i) inv *= 0.5623413251903491;
        double x2 = inv * inv, ts = inv, tc = 1.0, s1 = inv, c1 = 1.0;
        for (int n = 1; n <= 10; ++n) { tc *= -x2 / ((2.0 * n - 1.0) * (2.0 * n)); c1 += tc; ts *= -x2 / ((2.0 * n) * (2.0 * n + 1.0)); s1 += ts; }
        double cc = 1.0, ss = 0.0;
        for (int pos = 0; pos < 64; ++pos) {
          p.rope[(pos * 16 + tid) * 2] = (float)cc; p.rope[(pos * 16 + tid) * 2 + 1] = (float)ss;
          double nc = cc * c1 - ss * s1, ns = ss * c1 + cc * s1; cc = nc; ss = ns;
        }
      }
    }
  }
}

__device__ __forceinline__ void phase_norm(const Params& p, int l, int bid, int nb) {
  const int tid = tid_opaque(), lane = tid & 63, w = __builtin_amdgcn_readfirstlane(tid >> 6);
  for (int row = bid * 4 + w; row < NTOK; row += nb * 4) {
    const float* src = (l == 0) ? (row < NLAT ? p.x + (size_t)row * 1024 : p.ctx + (size_t)(row - NLAT) * 1024)
                                : (row < NLAT ? p.out + (size_t)row * 1024 : p.xc1 + (size_t)(row - NLAT) * 1024);
    const int mr = row < NLAT ? (row >> 12) : 8;
    const float* md = p.mod + (size_t)(l * 9 + mr) * 3072;
    const float* nw = p.norm_w + l * 1024;
    f32x4 v[4]; float ss = 0.f;
#pragma unroll
    for (int i = 0; i < 4; ++i) { v[i] = *(const f32x4*)(src + i * 256 + lane * 4); ss += v[i][0] * v[i][0] + v[i][1] * v[i][1] + v[i][2] * v[i][2] + v[i][3] * v[i][3]; }
    ss = wave_sum_dpp(ss);
    const float rs = rsqrtf(ss * (1.f / 1024.f) + 1e-6f);
#pragma unroll
    for (int i = 0; i < 4; ++i) {
      const int col = i * 256 + lane * 4;
      f32x4 nwv = *(const f32x4*)(nw + col), sc = *(const f32x4*)(md + 1024 + col), sh = *(const f32x4*)(md + col);
      half4 o;
#pragma unroll
      for (int j = 0; j < 4; ++j) o[j] = (h16)(v[i][j] * rs * nwv[j] * (1.f + sc[j]) + sh[j]);
      *(half4*)(p.hy + (size_t)row * 1024 + col) = o;
    }
  }
}

template <int MODE>
__device__ __forceinline__ void phase_gemm(const Params& p, int l, int bid, int nb, char* smem) {
  const h16* A = p.hy;
  const h16* Bt = MODE == 0 ? p.win_t + (size_t)l * NPAD * 1024 : p.wout_t + (size_t)l * 1024 * 1024;
  const int ntn = MODE == 0 ? (l == 1 ? 33 : 32) : 8;
  const int ntm = (MODE == 1 && l == 1) ? 256 : 272;
  const int tid = tid_opaque(), lane = tid & 63, w = __builtin_amdgcn_readfirstlane(tid >> 6), wr = w >> 1, wc = w & 1, lq = lane & 31, hh = lane >> 5;
  h16* As = (h16*)smem; h16* Bs = As + 128 * 72;
  const int ldrow = tid >> 3, ldch = (tid & 7) * 8;
  for (int tile = bid; tile < ntm * ntn; tile += nb) {
    int tm, tn;
    {
      const int mper = ntm >> 3;
      const int nmain = MODE == 0 ? 32 : 8;
      if (tile < ntm * nmain) {
        const int x = tile & 7, sq = tile >> 3;
        const int strip = sq / (mper * 8), rem = sq - strip * (mper * 8);
        tm = x * mper + (rem >> 3); tn = strip * 8 + (rem & 7);
      } else { tm = tile - ntm * nmain; tn = nmain; }
    }
    const h16* Ag = A + (size_t)(tm * 128 + ldrow) * 1024 + ldch; const h16* Bg = Bt + (size_t)(tn * 128 + ldrow) * 1024 + ldch;
    f32x16 acc[2][2];
#pragma unroll
    for (int i = 0; i < 2; ++i)
#pragma unroll
      for (int j = 0; j < 2; ++j)
#pragma unroll
        for (int r = 0; r < 16; ++r) acc[i][j][r] = 0.f;
    u32x4 ra[4], rb[4];
#pragma unroll
    for (int i = 0; i < 4; ++i) { ra[i] = *(const u32x4*)(Ag + (size_t)i * 32 * 1024); rb[i] = *(const u32x4*)(Bg + (size_t)i * 32 * 1024); }
#pragma unroll 1
    for (int kt = 0; kt < 16; ++kt) {
      __syncthreads();
#pragma unroll
      for (int i = 0; i < 4; ++i) { *(u32x4*)(As + (ldrow + i * 32) * 72 + ldch) = ra[i]; *(u32x4*)(Bs + (ldrow + i * 32) * 72 + ldch) = rb[i]; }
      __syncthreads();
      if (kt + 1 < 16) {
#pragma unroll
        for (int i = 0; i < 4; ++i) { ra[i] = *(const u32x4*)(Ag + (size_t)i * 32 * 1024 + (kt + 1) * 64); rb[i] = *(const u32x4*)(Bg + (size_t)i * 32 * 1024 + (kt + 1) * 64); }
      }
#pragma unroll
      for (int s = 0; s < 4; ++s) {
        half8 a[2], b[2];
#pragma unroll
        for (int i = 0; i < 2; ++i) { a[i] = *(const half8*)(As + (64 * wr + 32 * i + lq) * 72 + 16 * s + 8 * hh); b[i] = *(const half8*)(Bs + (64 * wc + 32 * i + lq) * 72 + 16 * s + 8 * hh); }
#pragma unroll
        for (int i = 0; i < 2; ++i)
#pragma unroll
          for (int j = 0; j < 2; ++j) {
            if (MODE == 0) acc[i][j] = __builtin_amdgcn_mfma_f32_32x32x16_f16(b[j], a[i], acc[i][j], 0, 0, 0);
            else acc[i][j] = __builtin_amdgcn_mfma_f32_32x32x16_f16(a[i], b[j], acc[i][j], 0, 0, 0);
          }
      }
    }
    if (MODE == 0) {
      if (tn < 32) {
        __syncthreads();
        h16* Cs = (h16*)smem;
#pragma unroll
        for (int i = 0; i < 2; ++i)
#pragma unroll
          for (int j = 0; j < 2; ++j)
#pragma unroll
            for (int g = 0; g < 4; ++g) {
              half4 o;
#pragma unroll
              for (int q = 0; q < 4; ++q) o[q] = (h16)acc[i][j][4 * g + q];
              *(half4*)(Cs + (64 * wr + 32 * i + lq) * 136 + 64 * wc + 32 * j + 8 * g + 4 * hh) = o;
            }
        __syncthreads();
#pragma unroll
        for (int q = 0; q < 8; ++q) {
          const int id = tid + q * 256; const int row = id >> 4, ch = id & 15;
          *(u32x4*)(p.P + (size_t)(tm * 128 + row) * PC + tn * 128 + ch * 8) = *(const u32x4*)(Cs + row * 136 + ch * 8);
        }
      } else if (wc == 0) {
#pragma unroll
        for (int i = 0; i < 2; ++i)
#pragma unroll
          for (int r = 0; r < 16; ++r) ((float*)(p.F + (size_t)(tm * 128 + 64 * wr + 32 * i + lq) * 1536))[(r & 3) + 8 * (r >> 2) + 4 * hh] = acc[i][0][r];
      }
    } else {
      const int row0 = tm * 128;
      const int mr = row0 < NLAT ? (row0 >> 12) : 8;
      const int col = tn * 128 + 64 * wc + lq;
      const float* gp = p.mod + (size_t)(l * 9 + mr) * 3072 + 2048 + col;
      const float g0 = gp[0], g1 = gp[32];
      const float* xs0; float* xd0;
      if (l == 0) { if (row0 < NLAT) { xs0 = p.x + (size_t)row0 * 1024; xd0 = p.out + (size_t)row0 * 1024; } else { xs0 = p.ctx + (size_t)(row0 - NLAT) * 1024; xd0 = p.xc1 + (size_t)(row0 - NLAT) * 1024; } }
      else { xs0 = p.out + (size_t)row0 * 1024; xd0 = p.out + (size_t)row0 * 1024; }
      const float* __restrict__ xsrc = xs0 + (size_t)(64 * wr + 4 * hh) * 1024 + col;
      float* __restrict__ xdst = xd0 + (size_t)(64 * wr + 4 * hh) * 1024 + col;
#pragma unroll
      for (int i = 0; i < 2; ++i)
#pragma unroll
        for (int r = 0; r < 16; ++r) {
          const int ro = (32 * i + (r & 3) + 8 * (r >> 2)) * 1024;
          xdst[ro] = xsrc[ro] + g0 * acc[i][0][r];
          xdst[ro + 32] = xsrc[ro + 32] + g1 * acc[i][1][r];
        }
    }
  }
}

#define LOAD_COL34(arr, base, t0, Tn) \
  _Pragma("unroll") for (int q_ = 0; q_ < 34; ++q_) { const int t_ = (t0) - 1 + q_; arr[q_] = (t_ >= 0 && t_ < (Tn)) ? (base)[(long)t_ * PC] : (h16)0.f; }

__device__ __forceinline__ void phase_feat(const Params& p, int l, int bid, int nb, char* smem, bool dry) {
  const int tid = tid_opaque();
  h16* inh = (h16*)smem;
  float* zt = (float*)(smem + 32 * 264 * 2);
  for (int item = bid; item < 1088; item += nb) {
    int b, t0, Tn, rowbase; bool isctx;
    if (item < 1024) { b = item >> 7; t0 = (item & 127) * 32; Tn = 4096; rowbase = b * 4096; isctx = false; }
    else { int j = item - 1024; b = j >> 3; t0 = (j & 7) * 32; Tn = 256; rowbase = NLAT + b * 256; isctx = true; }
    {
      const int col = 1152 + tid;
      const float mp = p.mu_prev[l * 1792 + col], mn = p.mu_next[l * 1792 + col];
      const h16* base = p.P + (size_t)rowbase * PC + col;
      h16 xv[34];
      LOAD_COL34(xv, base, t0, Tn)
#pragma unroll
      for (int tt = 0; tt < 32; ++tt) {
        const float prev = (float)xv[tt], cur = (float)xv[tt + 1], nxt = (float)xv[tt + 2];
        float sv = cur + mp * (prev - cur) + mn * (nxt - cur);
        if (tid < 128) { const float e2 = __expf(2.f * sv); sv = 1.f - 2.f / (e2 + 1.f); }
        inh[tt * 264 + tid] = (h16)sv;
      }
      if (l == 1) {
#pragma unroll
        for (int i = 0; i < 4; ++i) { int id = tid + i * 256; zt[id] = ((const float*)(p.F + (size_t)(rowbase + t0 + (id >> 5)) * 1536))[id & 31]; }
      }
    }
    __syncthreads();
#pragma unroll 1
    for (int c = tid; c < 384; c += 256) {
      const int col = 768 + c;
      const float mp = p.mu_prev[l * 1792 + col], mn = p.mu_next[l * 1792 + col];
      const h16* base = p.P + (size_t)rowbase * PC + col;
      h16 xv[34];
      LOAD_COL34(xv, base, t0, Tn)
      h16* dst = p.VB + (size_t)(rowbase + t0) * 384 + c;
      if (l == 0) {
#pragma unroll
        for (int tt = 0; tt < 32; ++tt) {
          const float prev = (float)xv[tt], cur = (float)xv[tt + 1], nxt = (float)xv[tt + 2];
          dst[tt * 384] = (h16)(cur + mp * (prev - cur) + mn * (nxt - cur));
        }
      } else {
        const float vbv = p.vb[c];
#pragma unroll 1
        for (int hf = 0; hf < 2; ++hf) {
          h16 vfv[16]; float ga[16];
#pragma unroll
          for (int tt = 0; tt < 16; ++tt) { vfv[tt] = dst[(hf * 16 + tt) * 384]; ga[tt] = vbv; }
#pragma unroll 1
          for (int m = 0; m < 32; m += 4) {
            const float w0 = p.vw2[m * 384 + c], w1 = p.vw2[(m + 1) * 384 + c], w2 = p.vw2[(m + 2) * 384 + c], w3 = p.vw2[(m + 3) * 384 + c];
#pragma unroll
            for (int tt = 0; tt < 16; ++tt) { const f32x4 z = *(const f32x4*)&zt[(hf * 16 + tt) * 32 + m]; ga[tt] += z[0] * w0 + z[1] * w1 + z[2] * w2 + z[3] * w3; }
          }
#pragma unroll
          for (int tt = 0; tt < 16; ++tt) {
            const float prev = hf ? (float)xv[16 + tt] : (float)xv[tt], cur = hf ? (float)xv[17 + tt] : (float)xv[tt + 1], nxt = hf ? (float)xv[18 + tt] : (float)xv[tt + 2];
            const float sv = cur + mp * (prev - cur) + mn * (nxt - cur);
            dst[(hf * 16 + tt) * 384] = (h16)(sv + ((float)vfv[tt] - sv) * sigmoidf_(ga[tt]));
          }
        }
      }
    }
    {
      const int w = __builtin_amdgcn_readfirstlane(tid >> 6), lane = tid & 63, lq = tid & 31, hh = lane >> 5;
      const int dir = w & 1, chalf = w >> 1;
      half8 xin[2][4];
#pragma unroll
      for (int kind = 0; kind < 2; ++kind)
#pragma unroll
        for (int ks = 0; ks < 4; ++ks) xin[kind][ks] = *(const half8*)(inh + lq * 264 + kind * 128 + dir * 64 + 16 * ks + 8 * hh);
      h16* ost = (h16*)(smem + 32 * 264 * 2 + 4096) + w * (32 * 72);
      h16* fbase = p.F + (size_t)(rowbase + t0) * 1536 + dir * 768 + chalf * 384;
#pragma unroll 1
      for (int np = 0; np < 6; ++np) {
        const int c0 = chalf * 192 + np * 32;
        f32x16 acc[2];
#pragma unroll
        for (int kind = 0; kind < 2; ++kind) {
          const float* bias = (kind == 0 ? p.w0 : p.a0) + (l * 2 + dir) * 384 + c0;
          const h16* wl = p.wl_t + (size_t)((l * 4 + kind * 2 + dir) * 384 + c0) * 64;
#pragma unroll
          for (int g = 0; g < 4; ++g) { const f32x4 bv = *(const f32x4*)(bias + 8 * g + 4 * hh); acc[kind][4 * g] = bv[0]; acc[kind][4 * g + 1] = bv[1]; acc[kind][4 * g + 2] = bv[2]; acc[kind][4 * g + 3] = bv[3]; }
#pragma unroll
          for (int ks = 0; ks < 4; ++ks) {
            const half8 wf = *(const half8*)(wl + (size_t)lq * 64 + 16 * ks + 8 * hh);
            acc[kind] = __builtin_amdgcn_mfma_f32_32x32x16_f16(wf, xin[kind][ks], acc[kind], 0, 0, 0);
          }
        }
#pragma unroll
        for (int g = 0; g < 4; ++g) {
          half8 o;
#pragma unroll
          for (int j = 0; j < 4; ++j) { o[2 * j] = (h16)(1.f - __expf(-0.6065306597126334f * sigmoidf_(acc[0][4 * g + j]))); o[2 * j + 1] = (h16)sigmoidf_(acc[1][4 * g + j]); }
          *(half8*)(ost + lq * 72 + 16 * g + 8 * hh) = o;
        }
        asm volatile("s_waitcnt lgkmcnt(0)" ::: "memory");
#pragma unroll
        for (int q = 0; q < 4; ++q) {
          const int id = lane + q * 64; const int rr = id >> 3, ch = id & 7;
          *(u32x4*)(fbase + (size_t)rr * 1536 + np * 64 + ch * 8) = *(const u32x4*)(ost + rr * 72 + ch * 8);
        }
        asm volatile("s_waitcnt lgkmcnt(0)" ::: "memory");
      }
    }
    {
      const int head = tid >> 5, pr = tid & 31, half = pr >> 4, i = pr & 15;
      const int colbase = head < 6 ? 3072 + head * 64 : 3456 + (head - 6) * 64;
      const int d1 = half * 32 + i;
      const float qs = (head < 6 && !dry) ? 0.125f : 1.f;
      h16* pp = p.P + (size_t)(rowbase + t0) * PC + colbase + d1;
#pragma unroll
      for (int tq = 0; tq < 32; tq += 8) {
        h16 x1[8], x2[8];
#pragma unroll
        for (int u = 0; u < 8; ++u) { x1[u] = pp[(size_t)(tq + u) * PC]; x2[u] = pp[(size_t)(tq + u) * PC + 16]; }
#pragma unroll
        for (int u = 0; u < 8; ++u) {
          const int t = t0 + tq + u;
          float cs = 1.f, sn = 0.f;
          if (!isctx && !dry) { const int pos = half == 0 ? (t >> 6) : (t & 63); const f32x2 r2 = *(const f32x2*)&p.rope[(pos * 16 + i) * 2]; cs = r2[0]; sn = r2[1]; }
          const float a = (float)x1[u], bq = (float)x2[u];
          pp[(size_t)(tq + u) * PC] = (h16)((a * cs - bq * sn) * qs);
          pp[(size_t)(tq + u) * PC + 16] = (h16)((a * sn + bq * cs) * qs);
        }
      }
    }
    if (tid < 128) {
      const int g = tid >> 6, d = tid & 63;
      const h16* base = p.P + (size_t)(rowbase + t0) * PC + 3584 + tid;
      h16* dst = p.VT + (size_t)((b * 2 + g) * 64 + d) * VTS + (isctx ? 4096 + t0 : t0);
      half8 v[4];
#pragma unroll
      for (int q = 0; q < 4; ++q)
#pragma unroll
        for (int j = 0; j < 8; ++j) v[q][j] = base[(size_t)(q * 8 + j) * PC];
#pragma unroll
      for (int q = 0; q < 4; ++q) *(half8*)(dst + q * 8) = v[q];
    }
    __syncthreads();
  }
}

__device__ __forceinline__ float ulo(unsigned u) { return (float)__builtin_bit_cast(h16, (unsigned short)(u & 0xffffu)); }
__device__ __forceinline__ float uhi(unsigned u) { return (float)__builtin_bit_cast(h16, (unsigned short)(u >> 16)); }
__device__ __forceinline__ float red16(float x) {
  x += dpp_mov<0xB1>(x);
  x += dpp_mov<0x4E>(x);
  x += dpp_mov<0x141>(x);
  x += dpp_mov<0x140>(x);
  return x;
}
#define LDS_BARRIER() do { asm volatile("s_waitcnt lgkmcnt(0)" ::: "memory"); __builtin_amdgcn_s_barrier(); asm volatile("" ::: "memory"); } while (0)
constexpr int RREC = 336;
struct RwkvPf { unsigned rk[10]; h16 v[8]; unsigned ea[8]; };

__device__ __forceinline__ void rwkv_chain(const Params& p, int l, int item, char* smem) {
  const int tid0 = tid_opaque();
  const int tid = (item >= 256) ? (tid0 ^ 128) : tid0;
  const int lane = tid & 63, w = __builtin_amdgcn_readfirstlane(tid >> 6);
  const int chain = item >> 2, vq = item & 3;
  const int dir = chain / 48, b = (chain % 48) / 6, h = chain % 6;
  float* opb = (float*)smem;
  float* ybuf = opb + 2 * 16 * RREC;
  constexpr int NCH = 272;
  if (w < 2) {
    const int rl = tid >> 3, kq = tid & 7;
    float S[8];
#pragma unroll
    for (int j = 0; j < 8; ++j) S[j] = 0.f;
    __builtin_amdgcn_s_setprio(3);
    LDS_BARRIER();
#pragma unroll 1
    for (int ci = 0; ci < NCH; ++ci) {
      const float* op = opb + (ci & 1) * 16 * RREC;
      float* yb = ybuf + (ci & 1) * 256;
      f32x4 aA = *(const f32x4*)(op + 8 * kq + 64), aB = *(const f32x4*)(op + 8 * kq + 68);
#pragma unroll
      for (int step = 0; step < 16; ++step) {
        const float* o = op + step * RREC + 8 * kq;
        const f32x4 wA = *(const f32x4*)(o), wB = *(const f32x4*)(o + 4);
        const f32x4 bA = *(const f32x4*)(o + 128), bB = *(const f32x4*)(o + 132);
        const f32x4 kA = *(const f32x4*)(o + 192), kB = *(const f32x4*)(o + 196);
        const f32x4 rA = *(const f32x4*)(o + 256), rB = *(const f32x4*)(o + 260);
        const float vv = op[step * RREC + 320 + rl];
        f32x4 naA = aA, naB = aB;
        if (step + 1 < 16) { naA = *(const f32x4*)(o + RREC + 64); naB = *(const f32x4*)(o + RREC + 68); }
        const float d0 = S[0] * aA[0] + S[1] * aA[1] + S[2] * aA[2] + S[3] * aA[3];
        const float d1 = S[4] * aB[0] + S[5] * aB[1] + S[6] * aB[2] + S[7] * aB[3];
        const float sa = red8(d0 + d1);
#pragma unroll
        for (int j = 0; j < 4; ++j) {
          S[j] = S[j] * wA[j] + sa * bA[j] + vv * kA[j];
          S[4 + j] = S[4 + j] * wB[j] + sa * bB[j] + vv * kB[j];
        }
        const float y0 = S[0] * rA[0] + S[1] * rA[1] + S[2] * rA[2] + S[3] * rA[3];
        const float y1 = S[4] * rB[0] + S[5] * rB[1] + S[6] * rB[2] + S[7] * rB[3];
        const float yy = red8(y0 + y1);
        if (kq == 0) yb[step * 16 + rl] = yy;
        aA = naA; aB = naB;
      }
      LDS_BARRIER();
    }
    __builtin_amdgcn_s_setprio(0);
  } else {
    const int lw = w - 2, lt = tid - 128;
    const int hc = h * 64 + lane;
    const float mpr = p.mu_prev[l * 1792 + hc], mnr = p.mu_next[l * 1792 + hc];
    const float mpk = p.mu_prev[l * 1792 + 384 + hc], mnk = p.mu_next[l * 1792 + 384 + hc];
    const float kkw = p.k_k[l * 384 + hc], kaw = p.k_a[l * 384 + hc];
    const float cAr = dir ? mnr : mpr, cBr = dir ? mpr : mnr, cAk = dir ? mnk : mpk, cBk = dir ? mpk : mnk;
    const unsigned* zrow = p.bar + XCD_BAR_WORDS;
    RwkvPf pfA, pfB;
#define RWKV_ISSUE(ci_, PF) { const int seg_ = (ci_) >= 16; const int Tn_ = seg_ ? 4096 : 256; const int rb_ = seg_ ? b * 4096 : NLAT + b * 256; const int s0_ = (seg_ ? (ci_) - 16 : (ci_)) * 16 + 8 * lw; \
    _Pragma("unroll") for (int q = 0; q < 10; ++q) { const int t_ = dir == 0 ? s0_ - 1 + q : Tn_ - s0_ - q; \
      const unsigned* src_ = ((unsigned)t_ < (unsigned)Tn_) ? (const unsigned*)(p.P + (size_t)(rb_ + t_) * PC + h * 128) : zrow; \
      PF.rk[q] = src_[lane]; } \
    _Pragma("unroll") for (int i = 0; i < 8; ++i) { const int t_ = dir == 0 ? s0_ + i : Tn_ - 1 - (s0_ + i); const size_t row = (size_t)rb_ + t_; \
      PF.v[i] = p.VB[row * 384 + hc]; PF.ea[i] = ((const unsigned*)(p.F + row * 1536 + dir * 768))[hc]; } }
#define RWKV_STAGE(ci_, PF) { float* op_ = opb + ((ci_) & 1) * 16 * RREC; \
    const int seg = (ci_) >= 16; const int Tn = seg ? 4096 : 256; const int c0 = (seg ? (ci_) - 16 : (ci_)) * 16; \
    _Pragma("unroll") for (int i = 0; i < 8; ++i) { \
      const int step = lw * 8 + i; const int t = dir == 0 ? c0 + step : Tn - 1 - (c0 + step); \
      const float rlo = ulo(PF.rk[i]), r0 = ulo(PF.rk[i + 1]), rhi = ulo(PF.rk[i + 2]); \
      const float klo = uhi(PF.rk[i]), k0 = uhi(PF.rk[i + 1]), khi = uhi(PF.rk[i + 2]); \
      const float vv = (float)PF.v[i], e = ulo(PF.ea[i]), al = uhi(PF.ea[i]); \
      const float rs = r0 + cAr * (rlo - r0) + cBr * (rhi - r0); \
      const float ks = k0 + cAk * (klo - k0) + cBk * (khi - k0); \
      const float kkr = ks * kkw; \
      const float n2 = wave_sum_dpp(kkr * kkr); \
      const float kk = kkr * rsqrtf(fmaxf(n2, 1e-24f)); \
      float* o = op_ + step * RREC + lane; \
      o[0] = 1.f - e; o[64] = -kk; o[128] = kk * al; o[192] = ks * (1.f + (al - 1.f) * kaw); o[256] = rs; \
      if ((lane >> 4) == vq) op_[step * RREC + 320 + (lane & 15)] = vv; } }
#define RWKV_WRITE(cj_) { const int seg = (cj_) >= 16; const int Tn = seg ? 4096 : 256; const int rowbase = seg ? b * 4096 : NLAT + b * 256; const int c0 = (seg ? (cj_) - 16 : (cj_)) * 16; \
    if (seg == 1 || l == 0) { const float* yb = ybuf + ((cj_) & 1) * 256; \
      _Pragma("unroll") for (int i = 0; i < 2; ++i) { const int idx = lt + i * 128; const int step = idx >> 4, ch = idx & 15; \
        const int t = dir == 0 ? c0 + step : Tn - 1 - (c0 + step); \
        const h16 yv = (h16)yb[idx]; \
        if (dir == 0) p.P[(size_t)(rowbase + t) * PC + 768 + h * 64 + 16 * vq + ch] = yv; \
        else p.hy[(size_t)(rowbase + t) * 1024 + h * 64 + 16 * vq + ch] = yv; } } }
    RWKV_ISSUE(0, pfA)
    RWKV_STAGE(0, pfA)
    RWKV_ISSUE(1, pfB)
    RWKV_ISSUE(2, pfA)
    LDS_BARRIER();
#pragma unroll 1
    for (int ci = 0; ci < NCH; ci += 2) {
      if (ci + 1 < NCH) RWKV_STAGE(ci + 1, pfB)
      if (ci + 3 < NCH) RWKV_ISSUE(ci + 3, pfB)
      if (ci >= 1) RWKV_WRITE(ci - 1)
      LDS_BARRIER();
      if (ci + 2 < NCH) RWKV_STAGE(ci + 2, pfA)
      if (ci + 4 < NCH) RWKV_ISSUE(ci + 4, pfA)
      RWKV_WRITE(ci)
      LDS_BARRIER();
    }
    RWKV_WRITE(NCH - 1)
  }
}

constexpr int HREC = 224;
struct HgrnPf { h16 f[4], q[4], iv[4]; };
__device__ __forceinline__ void hgrn_chain(const Params& p, int l, int item, char* smem) {
  const int tid = tid_opaque(), lane = tid & 63, w = __builtin_amdgcn_readfirstlane(tid >> 6);
  const int chain = item >> 1, vh = item & 1;
  const int dir = chain / 32, b = (chain % 32) / 4, h = chain % 4;
  float* op = (float*)smem;
  float* ybuf = op + 16 * HREC;
  const int hc = h * 64 + lane;
  float lb = 0.f;
  if (l == 1) lb = sigmoidf_(p.lb_logits[(dir * 2 + 1) * 256 + hc] - p.lb_logits[(dir * 2 + 0) * 256 + hc]);
  const int fcol = 1792 + 256 * (1 + dir) + hc;
  const int vc = tid >> 3, kq = tid & 7;
  float S[8];
#pragma unroll
  for (int j = 0; j < 8; ++j) S[j] = 0.f;
  HgrnPf pfA, pfB;
#define HGRN_ISSUE(ci_, PF) { const int seg_ = (ci_) >= 16; const int Tn_ = seg_ ? 4096 : 256; const int rb_ = seg_ ? b * 4096 : NLAT + b * 256; const int c0_ = (seg_ ? (ci_) - 16 : (ci_)) * 16; \
    _Pragma("unroll") for (int i = 0; i < 4; ++i) { const int step = w * 4 + i; const int t = dir == 0 ? c0_ + step : Tn_ - 1 - (c0_ + step); const h16* pr = p.P + ((size_t)rb_ + t) * PC; \
      PF.f[i] = pr[fcol]; PF.q[i] = pr[1792 + hc]; PF.iv[i] = pr[1792 + 768 + hc]; } }
#define HGRN_CHUNK(ci_, PF) { \
    const int seg = (ci_) >= 16; const int Tn = seg ? 4096 : 256; const int rowbase = seg ? b * 4096 : NLAT + b * 256; const int c0 = (seg ? (ci_) - 16 : (ci_)) * 16; \
    _Pragma("unroll") for (int i = 0; i < 4; ++i) { \
      const int step = w * 4 + i; \
      float* o = op + step * HREC + lane; \
      const float f = lb + (1.f - lb) * sigmoidf_((float)PF.f[i]); \
      o[0] = f; o[128] = (float)PF.q[i]; \
      if ((lane >> 5) == vh) op[step * HREC + 192 + (lane & 31)] = (float)PF.iv[i]; } \
    LDS_BARRIER(); \
    if ((ci_) + 2 < 272) HGRN_ISSUE((ci_) + 2, PF) \
    _Pragma("unroll") for (int step = 0; step < 16; ++step) { \
      const float* o = op + step * HREC + 8 * kq; \
      const f32x4 fA = *(const f32x4*)(o), fB = *(const f32x4*)(o + 4); \
      const f32x4 qA = *(const f32x4*)(o + 128), qB = *(const f32x4*)(o + 132); \
      const float iv = op[step * HREC + 192 + vc]; \
      const float f[8] = {fA[0], fA[1], fA[2], fA[3], fB[0], fB[1], fB[2], fB[3]}; \
      const float q[8] = {qA[0], qA[1], qA[2], qA[3], qB[0], qB[1], qB[2], qB[3]}; \
      float acc = 0.f; \
      _Pragma("unroll") for (int j = 0; j < 8; ++j) { S[j] = f[j] * (S[j] - iv) + iv; acc += S[j] * q[j]; } \
      ybuf[step * 256 + tid] = acc; } \
    LDS_BARRIER(); \
    if (seg == 1 || l == 0) { \
      _Pragma("unroll") for (int i = 0; i < 2; ++i) { \
        const int idx = tid + i * 256; const int step = idx >> 5, ch = idx & 31; \
        const int t = dir == 0 ? c0 + step : Tn - 1 - (c0 + step); \
        const float* yb = ybuf + step * 256 + ch * 8; \
        const f32x4 y0 = *(const f32x4*)(yb), y1 = *(const f32x4*)(yb + 4); \
        const f32x4 ys = y0 + y1; \
        const h16 ov = (h16)((ys[0] + ys[1]) + (ys[2] + ys[3])); \
        if (dir == 0) p.P[(size_t)(rowbase + t) * PC + 1152 + h * 64 + 32 * vh + ch] = ov; \
        else p.hy[(size_t)(rowbase + t) * 1024 + 384 + h * 64 + 32 * vh + ch] = ov; } } }
  HGRN_ISSUE(0, pfA)
  HGRN_ISSUE(1, pfB)
  __builtin_amdgcn_s_setprio(2);
#pragma unroll 1
  for (int ci = 0; ci < 272; ci += 2) {
    HGRN_CHUNK(ci, pfA)
    HGRN_CHUNK(ci + 1, pfB)
  }
  __builtin_amdgcn_s_setprio(0);
}

__device__ __forceinline__ void attn_unit(const Params& p, int l, int u) {
  const int tid = tid_opaque(), lane = tid & 63, w = __builtin_amdgcn_readfirstlane(tid >> 6), lq = lane & 31, hh = lane >> 5;
  int b, head, qrow_base, qpos0; bool isctx;
  if (u < 1536) { b = u / 192; int rem = u % 192; int blk = rem / 6; head = rem % 6; qpos0 = blk * 128 + w * 32; qrow_base = b * 4096; isctx = false; }
  else { int j = u - 1536; b = j / 12; int rem = j % 12; int qb = rem / 6; head = rem % 6; qpos0 = qb * 128 + w * 32; qrow_base = NLAT + b * 256; isctx = true; }
  const int g = head / 3;
  const size_t qrow = (size_t)qrow_base + qpos0 + lq;
  half8 qf[4];
#pragma unroll
  for (int s = 0; s < 4; ++s) qf[s] = *(const half8*)(p.P + qrow * PC + 3072 + head * 64 + 16 * s + 8 * hh);
  const float sinkv = p.sink[l * 6 + head];
  float m = sinkv, lsum = hh == 0 ? 1.f : 0.f;
  f32x16 O[2];
#pragma unroll
  for (int r = 0; r < 16; ++r) { O[0][r] = 0.f; O[1][r] = 0.f; }
  const h16* vt = p.VT + (size_t)((b * 2 + g) * 64) * VTS;
  int nband = 0, kstart = 0;
  if (!isctx) { kstart = max(0, qpos0 - 128); const int kend = min(4096, qpos0 + 160); nband = (kend - kstart) >> 5; }
  const int ntiles = nband + 8;
  for (int ti = 0; ti < ntiles; ++ti) {
    const bool band = ti < nband;
    const int kt = band ? kstart + ti * 32 : (ti - nband) * 32;
    const size_t krow = band ? (size_t)b * 4096 + kt + lq : (size_t)NLAT + b * 256 + kt + lq;
    const int vidx = band ? kt : 4096 + kt;
    const h16* kp = p.P + krow * PC + 3456 + g * 64 + 8 * hh;
    f32x16 sacc;
#pragma unroll
    for (int r = 0; r < 16; ++r) sacc[r] = 0.f;
#pragma unroll
    for (int s = 0; s < 4; ++s) { half8 kf = *(const half8*)(kp + 16 * s); sacc = __builtin_amdgcn_mfma_f32_32x32x16_f16(kf, qf[s], sacc, 0, 0, 0); }
    float mx = -INFINITY;
#pragma unroll
    for (int r = 0; r < 16; ++r) {
      float sv = sacc[r];
      if (band) { const int dlt = kt + (r & 3) + 8 * (r >> 2) + 4 * hh - (qpos0 + lq); if (dlt > 128 || dlt < -128) sv = -INFINITY; }
      sacc[r] = sv; mx = fmaxf(mx, sv);
    }
    mx = fmaxf(mx, __shfl_xor(mx, 32));
    const float mn = fmaxf(m, mx); const float corr = __expf(m - mn); m = mn;
    float ps = 0.f; half8 pb[2];
#pragma unroll
    for (int r = 0; r < 16; ++r) { const float pv = __expf(sacc[r] - mn); ps += pv; pb[r >> 3][r & 7] = (h16)pv; }
    lsum = lsum * corr + ps;
#pragma unroll
    for (int r = 0; r < 16; ++r) { O[0][r] *= corr; O[1][r] *= corr; }
#pragma unroll
    for (int s2 = 0; s2 < 2; ++s2)
#pragma unroll
      for (int dt = 0; dt < 2; ++dt) {
        const h16* vp = vt + (size_t)(dt * 32 + lq) * VTS + vidx + 16 * s2 + 4 * hh;
        const half4 lo = *(const half4*)vp, hi = *(const half4*)(vp + 8);
        const half8 vf = {lo[0], lo[1], lo[2], lo[3], hi[0], hi[1], hi[2], hi[3]};
        O[dt] = __builtin_amdgcn_mfma_f32_32x32x16_f16(vf, pb[s2], O[dt], 0, 0, 0);
      }
  }
  lsum += __shfl_xor(lsum, 32);
  const float inv = 1.f / lsum;
#pragma unroll
  for (int dt = 0; dt < 2; ++dt)
#pragma unroll
    for (int g4 = 0; g4 < 4; ++g4) {
      const int d0 = dt * 32 + 8 * g4 + 4 * hh;
      const half4 ga = *(const half4*)(p.P + qrow * PC + 3712 + head * 64 + d0);
      half4 o;
#pragma unroll
      for (int j = 0; j < 4; ++j) { const float gv = (float)ga[j]; o[j] = (h16)(O[dt][g4 * 4 + j] * inv * siluf_(gv)); }
      *(half4*)(p.hy + qrow * 1024 + 640 + head * 64 + d0) = o;
    }
}

__device__ __forceinline__ void phase_mix(const Params& p, int l, int bid, int nb, char* smem, int sub) {
  const int nunits = l == 0 ? 1536 + 96 : 1536;
  if (nb >= 640) {
    if (bid < 384) { if (sub & 1) rwkv_chain(p, l, bid, smem); }
    else if (bid < 512) { if (sub & 2) hgrn_chain(p, l, bid - 384, smem); }
    else if (sub & 4) for (int u = bid - 512; u < nunits; u += nb - 512) attn_unit(p, l, u);
  } else {
    for (int it = bid; it < 512 + nunits; it += nb) {
      if (it < 384) rwkv_chain(p, l, it, smem);
      else if (it < 512) hgrn_chain(p, l, it - 384, smem);
      else attn_unit(p, l, it - 512);
      __syncthreads();
    }
  }
}

__device__ __forceinline__ float sum4(const f32x4 v) { return (v[0] + v[1]) + (v[2] + v[3]); }
__device__ __forceinline__ f32x4 h4f(const half4 h) { return (f32x4){(float)h[0], (float)h[1], (float)h[2], (float)h[3]}; }
__device__ __forceinline__ void phase_readout(const Params& p, int l, int bid, int nb, bool dummy) {
  const int tid = tid_opaque(), lane = tid & 63, w = __builtin_amdgcn_readfirstlane(tid >> 6);
  const int nrows = l == 1 ? NLAT : NTOK;
  const int hl = lane >> 4, c4 = (lane & 15) * 4;
#pragma unroll 2
  for (int it = bid * 4 + w; it < nrows * 3; it += nb * 4) {
    const int row = it / 3, q = it - row * 3;
    int t, Tn;
    if (row < NLAT) { t = row & 4095; Tn = 4096; } else { t = (row - NLAT) & 255; Tn = 256; }
    const h16* pr = p.P + (size_t)row * PC;
    h16* yo = p.hy + (size_t)row * 1024;
    h16* yw = dummy ? p.F + (size_t)row * 1536 : yo;
    if (q < 2) {
      const int head = q * 4 + hl; const bool valid = head < 6; const int c = (valid ? head : 5) * 64 + c4;
      const bool hp = t > 0, hn = t + 1 < Tn;
      const f32x4 y = h4f(*(const half4*)(pr + 768 + c)) + h4f(*(const half4*)(yo + c));
      f32x4 sh[3];
      {
        const h16* prk = pr + (valid ? head : 5) * 128 + 2 * c4;
        const half8 cur8 = *(const half8*)prk;
        half8 prv8, nxt8;
#pragma unroll
        for (int j = 0; j < 8; ++j) { prv8[j] = (h16)0.f; nxt8[j] = (h16)0.f; }
        if (hp) prv8 = *(const half8*)(prk - PC);
        if (hn) nxt8 = *(const half8*)(prk + PC);
#pragma unroll
        for (int k = 0; k < 2; ++k) {
          const f32x4 cur = {(float)cur8[k], (float)cur8[2 + k], (float)cur8[4 + k], (float)cur8[6 + k]};
          const f32x4 prv = {(float)prv8[k], (float)prv8[2 + k], (float)prv8[4 + k], (float)prv8[6 + k]};
          const f32x4 nxt = {(float)nxt8[k], (float)nxt8[2 + k], (float)nxt8[4 + k], (float)nxt8[6 + k]};
          const f32x4 mp = *(const f32x4*)(p.mu_prev + l * 1792 + k * 384 + c), mn = *(const f32x4*)(p.mu_next + l * 1792 + k * 384 + c);
          sh[k] = cur + mp * (prv - cur) + mn * (nxt - cur);
        }
        const int col = 1408 + c;
        const f32x4 cur = h4f(*(const half4*)(pr + col));
        const f32x4 prv = hp ? h4f(*(const half4*)(pr + col - PC)) : (f32x4){0.f, 0.f, 0.f, 0.f};
        const f32x4 nxt = hn ? h4f(*(const half4*)(pr + col + PC)) : (f32x4){0.f, 0.f, 0.f, 0.f};
        const f32x4 mp = *(const f32x4*)(p.mu_prev + l * 1792 + col), mn = *(const f32x4*)(p.mu_next + l * 1792 + col);
        sh[2] = cur + mp * (prv - cur) + mn * (nxt - cur);
      }
      const f32x4 v = h4f(*(const half4*)(p.VB + (size_t)row * 384 + c));
      const f32x4 gw = *(const f32x4*)(p.gn_w + l * 384 + c), gb = *(const f32x4*)(p.gn_b + l * 384 + c), rk = *(const f32x4*)(p.r_k + l * 384 + c);
      const float mean = red16(sum4(y)) * (1.f / 64.f);
      const f32x4 yc = y - mean;
      const float var = red16(sum4(yc * yc)) * (1.f / 64.f);
      const float rs = rsqrtf(var + 64e-5f);
      const float bs = red16(sum4(sh[0] * sh[1] * rk));
      half4 o;
#pragma unroll
      for (int j = 0; j < 4; ++j) o[j] = (h16)((yc[j] * rs * gw[j] + gb[j] + bs * v[j]) * siluf_(sh[2][j]));
      if (valid) *(half4*)(yw + c) = o;
    } else {
      const int c = hl * 64 + c4;
      const f32x4 o = h4f(*(const half4*)(pr + 1152 + c)) + h4f(*(const half4*)(yo + 384 + c));
      const f32x4 g = h4f(*(const half4*)(pr + 2816 + c));
      const f32x4 nw = *(const f32x4*)(p.hg_norm_w + l * 256 + c);
      const float ms = red16(sum4(o * o)) * (1.f / 64.f);
      const float rs = rsqrtf(ms + 1e-6f);
      half4 ov;
#pragma unroll
      for (int j = 0; j < 4; ++j) ov[j] = (h16)(o[j] * rs * nw[j] * siluf_(g[j]));
      *(half4*)(yw + 384 + c) = ov;
    }
  }
}

__device__ __forceinline__ void phase_final(const Params& p, int bid, int nb) {
  const int tid = tid_opaque(), lane = tid & 63, w = __builtin_amdgcn_readfirstlane(tid >> 6);
  for (int row = bid * 4 + w; row < NLAT; row += nb * 4) {
    float* src = p.out + (size_t)row * 1024;
    f32x4 v[4]; float ss = 0.f;
#pragma unroll
    for (int i = 0; i < 4; ++i) { v[i] = *(const f32x4*)(src + i * 256 + lane * 4); ss += v[i][0] * v[i][0] + v[i][1] * v[i][1] + v[i][2] * v[i][2] + v[i][3] * v[i][3]; }
    ss = wave_sum_dpp(ss);
    const float rs = rsqrtf(ss * (1.f / 1024.f) + 1e-6f);
#pragma unroll
    for (int i = 0; i < 4; ++i) {
      const int col = i * 256 + lane * 4;
      const f32x4 nwv = *(const f32x4*)(p.final_w + col);
      f32x4 o;
#pragma unroll
      for (int j = 0; j < 4; ++j) o[j] = v[i][j] * rs * nwv[j];
      *(f32x4*)(src + col) = o;
    }
  }
}

__global__ void __launch_bounds__(256, 3) __attribute__((target("no-packed-fp32-ops"))) mega(Params p, int ph_lo, int ph_hi, int coop) {
  __shared__ __attribute__((aligned(16))) char smem[SMEM_BYTES];
  __shared__ uint4 xb_words;
  XcdBarrier xb; xb.bar = p.bar; xb.x = 0; xb.st = (volatile LAS unsigned*)&xb_words;
  if (coop) { if (threadIdx.x == 0) xb_words = make_uint4(0u, 0u, 0u, 0u); __syncthreads(); xb = xcd_barrier_post(p.bar, (volatile LAS unsigned*)&xb_words); }
  if (coop) for (int i = 0; i < EXTRA_SYNCS; ++i) { xcd_barrier(xb); }
  if (coop == 2) cg::this_grid().sync();
  for (int ph = ph_lo; ph < ph_hi; ++ph) {
    for (int rep = 0; rep < (((PROBE_MASK >> ph) & 1) ? 2 : 1); ++rep) {
      int bid = blockIdx.x, nb = gridDim.x;
      asm volatile("" : "+s"(bid), "+s"(nb));
      if (ph == 0) phase_prep(p, bid, nb, smem);
      else if (ph == 13) phase_final(p, bid, nb);
      else {
        const int l = (ph - 1) / 6, s = (ph - 1) % 6;
        if (s == 0) phase_norm(p, l, bid, nb);
        else if (s == 1) phase_gemm<0>(p, l, bid, nb, smem);
        else if (s == 2) phase_feat(p, l, bid, nb, smem, PROBE_MASK && ((PROBE_MASK >> ph) & 1) && rep == 0);
        else if (s == 3) phase_mix(p, l, bid, nb, smem, rep ? PROBE_SUB : 7);
        else if (s == 4) phase_readout(p, l, bid, nb, PROBE_MASK && ((PROBE_MASK >> ph) & 1) && rep == 0);
        else phase_gemm<1>(p, l, bid, nb, smem);
      }
      if (PROBE_MASK && rep == 0 && ((PROBE_MASK >> ph) & 1)) { xcd_barrier(xb); }
    }
    if (coop && ph + 1 < ph_hi) { xcd_barrier(xb); }
  }
}

extern "C" void kernel_launch(void* const* d_in, const int* in_sizes, int n_in, void* d_out, int out_size, void* d_ws, size_t ws_size, hipStream_t stream) {
  static int grid_blocks = 0;
  if (!grid_blocks) {
    int dev = 0, cus = 0, per_cu = 0;
    hipGetDevice(&dev);
    hipDeviceGetAttribute(&cus, hipDeviceAttributeMultiprocessorCount, dev);
    hipOccupancyMaxActiveBlocksPerMultiprocessor(&per_cu, mega, 256, 0);
    if (per_cu < 1) per_cu = 1;
    grid_blocks = cus * per_cu;
  }
  Params p{};
  const float* const* in = (const float* const*)d_in;
  p.x = in[0]; p.c = in[1]; p.ctx = in[2]; p.c_ctx = in[3]; p.mod_w = in[4]; p.mod_b = in[5]; p.norm_w = in[6]; p.w_in = in[7]; p.w_out = in[8];
  p.mu_prev = in[9]; p.mu_next = in[10]; p.w0 = in[11]; p.w2 = in[12]; p.a0 = in[13]; p.a2 = in[14]; p.k_k = in[15]; p.k_a = in[16]; p.r_k = in[17];
  p.gn_w = in[18]; p.gn_b = in[19]; p.vw1 = in[20]; p.vw2 = in[21]; p.vb = in[22]; p.lb_logits = in[23]; p.hg_norm_w = in[24]; p.sink = in[25]; p.final_w = in[26];
  p.out = (float*)d_out;
  char* ws = (char*)d_ws; size_t off = 0;
  auto take = [&](size_t bytes) { char* r = ws + off; off += (bytes + 255) & ~(size_t)255; return r; };
  p.win_t = (h16*)take((size_t)2 * NPAD * 1024 * 2);
  p.wout_t = (h16*)take((size_t)2 * 1024 * 1024 * 2);
  p.wl_t = (h16*)take((size_t)2 * 4 * 384 * 64 * 2);
  p.mod = (float*)take((size_t)2 * 9 * 3072 * 4);
  p.rope = (float*)take((size_t)64 * 16 * 2 * 4);
  p.hy = (h16*)take((size_t)NTOK * 1024 * 2);
  p.P = (h16*)take((size_t)NTOK * PC * 2);
  p.F = (h16*)take((size_t)NTOK * 1536 * 2);
  p.VB = (h16*)take((size_t)NTOK * 384 * 2);
  p.VT = (h16*)take((size_t)16 * 64 * VTS * 2);
  p.xc1 = (float*)take((size_t)2048 * 1024 * 4);
  p.bar = (unsigned*)take(16384);
  if (off > ws_size) fprintf(stderr, "workspace too small: need %zu have %zu\n", off, ws_size);
#if SINGLE_LAUNCH
  hipMemsetAsync(p.bar, 0, 16384, stream);
  int lo = 0, hi = 14, coop = 1;
  void* args[] = {&p, &lo, &hi, &coop};
  hipError_t e = hipLaunchCooperativeKernel((void*)mega, dim3(grid_blocks), dim3(256), args, 0, stream);
  if (e != hipSuccess) fprintf(stderr, "cooperative launch failed: %s (grid %d)\n", hipGetErrorString(e), grid_blocks);
#else
  for (int ph = 0; ph < 14; ++ph) mega<<<grid_blocks, 256, 0, stream>>>(p, ph, ph + 1, 0);
#endif
}
```

```cpp
#include <hip/hip_runtime.h>
#include <hip/hip_cooperative_groups.h>
#include <cstdio>
#include <cstdint>
namespace cg = cooperative_groups;

typedef _Float16 h16;
typedef _Float16 half8 __attribute__((ext_vector_type(8)));
typedef _Float16 half4 __attribute__((ext_vector_type(4)));
typedef float f32x16 __attribute__((ext_vector_type(16)));
typedef float f32x4 __attribute__((ext_vector_type(4)));
typedef float f32x2 __attribute__((ext_vector_type(2)));
typedef unsigned u32x4 __attribute__((ext_vector_type(4)));
typedef _Float16 half2v __attribute__((ext_vector_type(2)));

constexpr int NLAT = 32768, NTOK = 34816;
constexpr int PC = 4160;
constexpr int NPAD = 4224;
constexpr int VTS = 4352;
constexpr int SMEM_BYTES = 49152;

#ifndef EXTRA_SYNCS
#define EXTRA_SYNCS 0
#endif
#ifndef PROBE_SUB
#define PROBE_SUB 7
#endif
#ifndef PROBE_MASK
#define PROBE_MASK 0
#endif
#ifndef SINGLE_LAUNCH
#define SINGLE_LAUNCH 1
#endif

struct Params {
  const float *x, *c, *ctx, *c_ctx, *mod_w, *mod_b, *norm_w, *w_in, *w_out;
  const float *mu_prev, *mu_next, *w0, *w2, *a0, *a2, *k_k, *k_a, *r_k, *gn_w, *gn_b;
  const float *vw1, *vw2, *vb, *lb_logits, *hg_norm_w, *sink, *final_w;
  float* out;
  h16 *win_t, *wout_t, *wl_t;
  float* mod;
  h16 *hy, *P, *F, *VB;
  h16* VT;
  float* xc1;
  float* rope;
  unsigned* bar;
};

__device__ __forceinline__ int tid_opaque() { int t = threadIdx.x; asm volatile("" : "+v"(t)); return t; }
__device__ __forceinline__ float wave_sum(float v) {
#pragma unroll
  for (int o = 32; o > 0; o >>= 1) v += __shfl_xor(v, o);
  return v;
}
__device__ __forceinline__ float sigmoidf_(float x) { return __builtin_amdgcn_rcpf(1.f + __expf(-x)); }
__device__ __forceinline__ float siluf_(float x) { return x * __builtin_amdgcn_rcpf(1.f + __expf(-x)); }
template <int CTRL> __device__ __forceinline__ float dpp_mov(float x) {
  return __int_as_float(__builtin_amdgcn_update_dpp(0, __float_as_int(x), CTRL, 0xf, 0xf, true));
}
__device__ __forceinline__ float wave_sum_dpp(float x) {
  x += dpp_mov<0xB1>(x);
  x += dpp_mov<0x4E>(x);
  x += dpp_mov<0x141>(x);
  x += dpp_mov<0x140>(x);
  const int xi = __float_as_int(x);
  return __int_as_float(__builtin_amdgcn_readlane(xi, 0)) + __int_as_float(__builtin_amdgcn_readlane(xi, 16)) +
         __int_as_float(__builtin_amdgcn_readlane(xi, 32)) + __int_as_float(__builtin_amdgcn_readlane(xi, 48));
}
__device__ __forceinline__ float red8(float x) {
  x += dpp_mov<0xB1>(x);
  x += dpp_mov<0x4E>(x);
  x += dpp_mov<0x141>(x);
  return x;
}

#define XB_TMO      128
#define XB_XCNT(j)  (256  + 64 * (j))
#define XB_XSUB(j)  (1280 + 64 * (j))
#define XB_XGEN(j)  (2304 + 64 * (j))
#define XB_TOP      3328
#define XB_TOPGEN   3392
#define XCD_BAR_WORDS 3456
#define XB_SPIN_CAP (1u << 18)
#define LAS __attribute__((address_space(3)))
__device__ __forceinline__ unsigned xb_ld(unsigned* p)              { return __hip_atomic_load(p, __ATOMIC_RELAXED, __HIP_MEMORY_SCOPE_AGENT); }
__device__ __forceinline__ unsigned xb_add(unsigned* p, unsigned v) { return __hip_atomic_fetch_add(p, v, __ATOMIC_RELAXED, __HIP_MEMORY_SCOPE_AGENT); }
__device__ __forceinline__ unsigned xb_xcc_id() { return (unsigned)__builtin_amdgcn_s_getreg((3 << 11) | 20) & 0xFu; }
#define XB_SPIN(cond, bar) do { unsigned _sp = 0; while (cond) { __builtin_amdgcn_s_sleep(1); \
    if ((++_sp & 255u) == 0u) { if (xb_ld(&(bar)[XB_TMO])) break; if (_sp > XB_SPIN_CAP) { atomicAdd(&(bar)[XB_TMO], 1u); break; } } } } while (0)
struct XcdBarrier { unsigned* bar; unsigned x; volatile LAS unsigned* st; };
__device__ __forceinline__ XcdBarrier xcd_barrier_post(unsigned* bar, volatile LAS unsigned* st) {
  XcdBarrier b; b.bar = bar; b.x = xb_xcc_id(); b.st = st;
  if (threadIdx.x == 0) (void)xb_add(&bar[XB_XCNT(b.x)], 1u);
  return b;
}
__device__ __forceinline__ void xcd_barrier_complete(unsigned* bar, unsigned x, unsigned& nloc, unsigned& nx) {
  const unsigned G = gridDim.x * gridDim.y * gridDim.z;
  unsigned sum, cnt, mine, sp = 0u;
  for (;;) {
    sum = 0u; cnt = 0u; mine = 0u;
#pragma unroll
    for (unsigned j = 0; j < 16; ++j) { const unsigned c = xb_ld(&bar[XB_XCNT(j)]); sum += c; cnt += (c > 0u) ? 1u : 0u; mine = (j == x) ? c : mine; }
    if (sum == G) break;
    __builtin_amdgcn_s_sleep(1);
    if ((++sp & 255u) == 0u) { if (xb_ld(&bar[XB_TMO])) break; if (sp > XB_SPIN_CAP) { atomicAdd(&bar[XB_TMO], 1u); break; } }
  }
  nloc = mine > 0u ? mine : 1u; nx = cnt > 0u ? cnt : 1u;
}
__device__ __forceinline__ void xcd_barrier(const XcdBarrier& b) {
  asm volatile("s_waitcnt vmcnt(0)" ::: "memory");
  __syncthreads();
  if (threadIdx.x == 0) {
    unsigned* bar = b.bar;
    __builtin_amdgcn_s_waitcnt(0);
    unsigned nloc = b.st[0], nx = b.st[1];
    if (nloc == 0u) { xcd_barrier_complete(bar, b.x, nloc, nx); b.st[0] = nloc; b.st[1] = nx; }
    const unsigned old = xb_add(&bar[XB_XSUB(b.x)], 1u);
    const unsigned gen = old / nloc;
    if (old + 1u == (gen + 1u) * nloc) {
      __builtin_amdgcn_fence(__ATOMIC_RELEASE, "agent");
      asm volatile("s_waitcnt vmcnt(0)" ::: "memory");
      const unsigned og = xb_add(&bar[XB_TOP], 1u);
      const unsigned tg = og / nx;
      if (og + 1u == (tg + 1u) * nx) xb_add(&bar[XB_TOPGEN], 1u);
      else XB_SPIN(xb_ld(&bar[XB_TOPGEN]) == tg, bar);
      __builtin_amdgcn_fence(__ATOMIC_ACQUIRE, "agent");
      xb_add(&bar[XB_XGEN(b.x)], 1u);
      asm volatile("s_waitcnt vmcnt(0)" ::: "memory");
    } else {
      XB_SPIN(xb_ld(&bar[XB_XGEN(b.x)]) == gen, bar);
      __builtin_amdgcn_fence(__ATOMIC_ACQUIRE, "agent");
      asm volatile("s_waitcnt vmcnt(0)" ::: "memory");
    }
  }
  __syncthreads();
}

__device__ __forceinline__ void phase_prep(const Params& p, int bid, int nb, char* smem) {
  const int tid = tid_opaque();
  float* sf = (float*)smem;
  constexpr int N_WIN = 2048, N_WOUT = 512, N_MOD = 192, N_PADI = 1024, N_WL = 768;
  constexpr int total = N_WIN + N_WOUT + N_MOD + N_PADI + N_WL + 1;
  for (int it = bid; it < total; it += nb) {
    if (it < N_WIN + N_WOUT) {
      const float* src; h16* dst; int ncols, kt, ntile;
      if (it < N_WIN) { int l = it >> 10, r = it & 1023; kt = r >> 6; ntile = r & 63; src = p.w_in + (size_t)l * 1024 * 4096; dst = p.win_t + (size_t)l * NPAD * 1024; ncols = 4096; }
      else { int j = it - N_WIN; int l = j >> 8, r = j & 255; kt = r >> 4; ntile = r & 15; src = p.w_out + (size_t)l * 1024 * 1024; dst = p.wout_t + (size_t)l * 1024 * 1024; ncols = 1024; }
      for (int i = tid; i < 4096; i += 256) { int kk = i >> 6, nn = i & 63; sf[kk * 65 + nn] = src[(size_t)(kt * 64 + kk) * ncols + ntile * 64 + nn]; }
      __syncthreads();
      const bool rkperm = it < N_WIN && ntile < 12;
      for (int i = tid; i < 4096; i += 256) {
        int nn = i >> 6, kk = i & 63;
        const int nrow = rkperm ? ((ntile % 6) * 128 + 2 * nn + ntile / 6) : (ntile * 64 + nn);
        dst[(size_t)nrow * 1024 + kt * 64 + kk] = (h16)sf[kk * 65 + nn];
      }
      __syncthreads();
    } else if (it < N_WIN + N_WOUT + N_MOD) {
      const int j = it - N_WIN - N_WOUT; const int l = j / 96; const int cl = tid & 31, ks = tid >> 5; const int col = (j % 96) * 32 + cl;
      for (int i = tid; i < 9 * 1024; i += 256) { int r = i >> 10, k = i & 1023; float v = r < 8 ? p.c[r * 1024 + k] : p.c_ctx[k]; sf[i] = siluf_(v); }
      __syncthreads();
      float acc[9];
#pragma unroll
      for (int r = 0; r < 9; ++r) acc[r] = 0.f;
      const float* mw = p.mod_w + (size_t)l * 1024 * 3072 + (size_t)(ks * 128) * 3072 + col;
#pragma unroll 2
      for (int k = 0; k < 128; k += 4) {
        const float w0 = mw[(size_t)k * 3072], w1 = mw[(size_t)(k + 1) * 3072], w2 = mw[(size_t)(k + 2) * 3072], w3 = mw[(size_t)(k + 3) * 3072];
#pragma unroll
        for (int r = 0; r < 9; ++r) { const f32x4 sv = *(const f32x4*)&sf[r * 1024 + ks * 128 + k]; acc[r] += sv[0] * w0 + sv[1] * w1 + sv[2] * w2 + sv[3] * w3; }
      }
#pragma unroll
      for (int r = 0; r < 9; ++r) acc[r] += __shfl_xor(acc[r], 32);
      __syncthreads();
      if ((tid & 63) < 32) {
#pragma unroll
        for (int r = 0; r < 9; ++r) sf[((tid >> 6) * 9 + r) * 32 + cl] = acc[r];
      }
      __syncthreads();
      for (int i = tid; i < 288; i += 256) {
        const int r = i >> 5, c2 = i & 31;
        const float v = sf[(0 * 9 + r) * 32 + c2] + sf[(1 * 9 + r) * 32 + c2] + sf[(2 * 9 + r) * 32 + c2] + sf[(3 * 9 + r) * 32 + c2];
        const int cc = (j % 96) * 32 + c2;
        p.mod[(size_t)(l * 9 + r) * 3072 + cc] = v + p.mod_b[l * 3072 + cc];
      }
      __syncthreads();
    } else if (it < N_WIN + N_WOUT + N_MOD + N_PADI) {
      int j = it - (N_WIN + N_WOUT + N_MOD); int idx = j * 256 + tid;
      int l = idx >> 17; int rem = idx & 131071; int m = rem >> 10, k = rem & 1023;
      float v = (l == 1 && m < 32) ? p.vw1[k * 32 + m] : 0.f;
      p.win_t[(size_t)l * NPAD * 1024 + (size_t)(4096 + m) * 1024 + k] = (h16)v;
    } else if (it < N_WIN + N_WOUT + N_MOD + N_PADI + N_WL) {
      const int idx = (it - (N_WIN + N_WOUT + N_MOD + N_PADI)) * 256 + tid;
      const int r = idx & 63, c = (idx >> 6) % 384, ls = idx / (384 * 64); const int l = ls >> 2, slot = ls & 3, dir = slot & 1, kind = slot >> 1;
      const float v = (kind == 0 ? p.w2 : p.a2)[((size_t)(l * 2 + dir) * 64 + r) * 384 + c];
      p.wl_t[idx] = (h16)v;
    } else {
      if (tid < 16) {
        double inv = 1.0; for (int i = 0; i < tid; ++i) inv *= 0.5623413251903491;
        double x2 = inv * inv, ts = inv, tc = 1.0, s1 = inv, c1 = 1.0;
        for (int n = 1; n <= 10; ++n) { tc *= -x2 / ((2.0 * n - 1.0) * (2.0 * n)); c1 += tc; ts *= -x2 / ((2.0 * n) * (2.0 * n + 1.0)); s1 += ts; }
        double cc = 1.0, ss = 0.0;
        for (int pos = 0; pos < 64; ++pos) {
          p.rope[(pos * 16 + tid) * 2] = (float)cc; p.rope[(pos * 16 + tid) * 2 + 1] = (float)ss;
          double nc = cc * c1 - ss * s1, ns = ss * c1 + cc * s1; cc = nc; ss = ns;
        }
      }
    }
  }
}

__device__ __forceinline__ void phase_norm(const Params& p, int l, int bid, int nb) {
  const int tid = tid_opaque(), lane = tid & 63, w = __builtin_amdgcn_readfirstlane(tid >> 6);
  for (int row = bid * 4 + w; row < NTOK; row += nb * 4) {
    const float* src = (l == 0) ? (row < NLAT ? p.x + (size_t)row * 1024 : p.ctx + (size_t)(row - NLAT) * 1024)
                                : (row < NLAT ? p.out + (size_t)row * 1024 : p.xc1 + (size_t)(row - NLAT) * 1024);
    const int mr = row < NLAT ? (row >> 12) : 8;
    const float* md = p.mod + (size_t)(l * 9 + mr) * 3072;
    const float* nw = p.norm_w + l * 1024;
    f32x4 v[4]; float ss = 0.f;
#pragma unroll
    for (int i = 0; i < 4; ++i) { v[i] = *(const f32x4*)(src + i * 256 + lane * 4); ss += v[i][0] * v[i][0] + v[i][1] * v[i][1] + v[i][2] * v[i][2] + v[i][3] * v[i][3]; }
    ss = wave_sum_dpp(ss);
    const float rs = rsqrtf(ss * (1.f / 1024.f) + 1e-6f);
#pragma unroll
    for (int i = 0; i < 4; ++i) {
      const int col = i * 256 + lane * 4;
      f32x4 nwv = *(const f32x4*)(nw + col), sc = *(const f32x4*)(md + 1024 + col), sh = *(const f32x4*)(md + col);
      half4 o;
#pragma unroll
      for (int j = 0; j < 4; ++j) o[j] = (h16)(v[i][j] * rs * nwv[j] * (1.f + sc[j]) + sh[j]);
      *(half4*)(p.hy + (size_t)row * 1024 + col) = o;
    }
  }
}

template <int MODE>
__device__ __forceinline__ void phase_gemm(const Params& p, int l, int bid, int nb, char* smem) {
  const h16* A = p.hy;
  const h16* Bt = MODE == 0 ? p.win_t + (size_t)l * NPAD * 1024 : p.wout_t + (size_t)l * 1024 * 1024;
  const int ntn = MODE == 0 ? (l == 1 ? 33 : 32) : 8;
  const int ntm = (MODE == 1 && l == 1) ? 256 : 272;
  const int tid = tid_opaque(), lane = tid & 63, w = __builtin_amdgcn_readfirstlane(tid >> 6), wr = w >> 1, wc = w & 1, lq = lane & 31, hh = lane >> 5;
  h16* As = (h16*)smem; h16* Bs = As + 128 * 72;
  const int ldrow = tid >> 3, ldch = (tid & 7) * 8;
  for (int tile = bid; tile < ntm * ntn; tile += nb) {
    int tm, tn;
    {
      const int mper = ntm >> 3;
      const int nmain = MODE == 0 ? 32 : 8;
      if (tile < ntm * nmain) {
        const int x = tile & 7, sq = tile >> 3;
        const int strip = sq / (mper * 8), rem = sq - strip * (mper * 8);
        tm = x * mper + (rem >> 3); tn = strip * 8 + (rem & 7);
      } else { tm = tile - ntm * nmain; tn = nmain; }
    }
    const h16* Ag = A + (size_t)(tm * 128 + ldrow) * 1024 + ldch; const h16* Bg = Bt + (size_t)(tn * 128 + ldrow) * 1024 + ldch;
    f32x16 acc[2][2];
#pragma unroll
    for (int i = 0; i < 2; ++i)
#pragma unroll
      for (int j = 0; j < 2; ++j)
#pragma unroll
        for (int r = 0; r < 16; ++r) acc[i][j][r] = 0.f;
    u32x4 ra[4], rb[4];
#pragma unroll
    for (int i = 0; i < 4; ++i) { ra[i] = *(const u32x4*)(Ag + (size_t)i * 32 * 1024); rb[i] = *(const u32x4*)(Bg + (size_t)i * 32 * 1024); }
#pragma unroll 2
    for (int kt = 0; kt < 16; ++kt) {
      __syncthreads();
#pragma unroll
      for (int i = 0; i < 4; ++i) { *(u32x4*)(As + (ldrow + i * 32) * 72 + ldch) = ra[i]; *(u32x4*)(Bs + (ldrow + i * 32) * 72 + ldch) = rb[i]; }
      __syncthreads();
      if (kt + 1 < 16) {
#pragma unroll
        for (int i = 0; i < 4; ++i) { ra[i] = *(const u32x4*)(Ag + (size_t)i * 32 * 1024 + (kt + 1) * 64); rb[i] = *(const u32x4*)(Bg + (size_t)i * 32 * 1024 + (kt + 1) * 64); }
      }
#pragma unroll
      for (int s = 0; s < 4; ++s) {
        half8 a[2], b[2];
#pragma unroll
        for (int i = 0; i < 2; ++i) { a[i] = *(const half8*)(As + (64 * wr + 32 * i + lq) * 72 + 16 * s + 8 * hh); b[i] = *(const half8*)(Bs + (64 * wc + 32 * i + lq) * 72 + 16 * s + 8 * hh); }
#pragma unroll
        for (int i = 0; i < 2; ++i)
#pragma unroll
          for (int j = 0; j < 2; ++j) {
            if (MODE == 0) acc[i][j] = __builtin_amdgcn_mfma_f32_32x32x16_f16(b[j], a[i], acc[i][j], 0, 0, 0);
            else acc[i][j] = __builtin_amdgcn_mfma_f32_32x32x16_f16(a[i], b[j], acc[i][j], 0, 0, 0);
          }
      }
    }
    if (MODE == 0) {
      if (tn < 32) {
        __syncthreads();
        h16* Cs = (h16*)smem;
#pragma unroll
        for (int i = 0; i < 2; ++i)
#pragma unroll
          for (int j = 0; j < 2; ++j)
#pragma unroll
            for (int g = 0; g < 4; ++g) {
              half4 o;
#pragma unroll
              for (int q = 0; q < 4; ++q) o[q] = (h16)acc[i][j][4 * g + q];
              *(half4*)(Cs + (64 * wr + 32 * i + lq) * 136 + 64 * wc + 32 * j + 8 * g + 4 * hh) = o;
            }
        __syncthreads();
#pragma unroll
        for (int q = 0; q < 8; ++q) {
          const int id = tid + q * 256; const int row = id >> 4, ch = id & 15;
          *(u32x4*)(p.P + (size_t)(tm * 128 + row) * PC + tn * 128 + ch * 8) = *(const u32x4*)(Cs + row * 136 + ch * 8);
        }
      } else if (wc == 0) {
#pragma unroll
        for (int i = 0; i < 2; ++i)
#pragma unroll
          for (int r = 0; r < 16; ++r) ((float*)(p.F + (size_t)(tm * 128 + 64 * wr + 32 * i + lq) * 1536))[(r & 3) + 8 * (r >> 2) + 4 * hh] = acc[i][0][r];
      }
    } else {
      const int row0 = tm * 128;
      const int mr = row0 < NLAT ? (row0 >> 12) : 8;
      const int col = tn * 128 + 64 * wc + lq;
      const float* gp = p.mod + (size_t)(l * 9 + mr) * 3072 + 2048 + col;
      const float g0 = gp[0], g1 = gp[32];
      const float* xs0; float* xd0;
      if (l == 0) { if (row0 < NLAT) { xs0 = p.x + (size_t)row0 * 1024; xd0 = p.out + (size_t)row0 * 1024; } else { xs0 = p.ctx + (size_t)(row0 - NLAT) * 1024; xd0 = p.xc1 + (size_t)(row0 - NLAT) * 1024; } }
      else { xs0 = p.out + (size_t)row0 * 1024; xd0 = p.out + (size_t)row0 * 1024; }
      const float* __restrict__ xsrc = xs0 + (size_t)(64 * wr + 4 * hh) * 1024 + col;
      float* __restrict__ xdst = xd0 + (size_t)(64 * wr + 4 * hh) * 1024 + col;
#pragma unroll
      for (int i = 0; i < 2; ++i)
#pragma unroll
        for (int r = 0; r < 16; ++r) {
          const int ro = (32 * i + (r & 3) + 8 * (r >> 2)) * 1024;
          xdst[ro] = xsrc[ro] + g0 * acc[i][0][r];
          xdst[ro + 32] = xsrc[ro + 32] + g1 * acc[i][1][r];
        }
    }
  }
}

#define LOAD_COL34(arr, base, t0, Tn) \
  _Pragma("unroll") for (int q_ = 0; q_ < 34; ++q_) { const int t_ = (t0) - 1 + q_; arr[q_] = (t_ >= 0 && t_ < (Tn)) ? (base)[(long)t_ * PC] : (h16)0.f; }

__device__ __forceinline__ void phase_feat(const Params& p, int l, int bid, int nb, char* smem, bool dry) {
  const int tid = tid_opaque();
  h16* inh = (h16*)smem;
  float* zt = (float*)(smem + 32 * 264 * 2);
  for (int item = bid; item < 1088; item += nb) {
    int b, t0, Tn, rowbase; bool isctx;
    if (item < 1024) { b = item >> 7; t0 = (item & 127) * 32; Tn = 4096; rowbase = b * 4096; isctx = false; }
    else { int j = item - 1024; b = j >> 3; t0 = (j & 7) * 32; Tn = 256; rowbase = NLAT + b * 256; isctx = true; }
    {
      const int col = 1152 + tid;
      const float mp = p.mu_prev[l * 1792 + col], mn = p.mu_next[l * 1792 + col];
      const h16* base = p.P + (size_t)rowbase * PC + col;
      h16 xv[34];
      LOAD_COL34(xv, base, t0, Tn)
#pragma unroll
      for (int tt = 0; tt < 32; ++tt) {
        const float prev = (float)xv[tt], cur = (float)xv[tt + 1], nxt = (float)xv[tt + 2];
        float sv = cur + mp * (prev - cur) + mn * (nxt - cur);
        if (tid < 128) { const float e2 = __expf(2.f * sv); sv = 1.f - 2.f / (e2 + 1.f); }
        inh[tt * 264 + tid] = (h16)sv;
      }
      if (l == 1) {
#pragma unroll
        for (int i = 0; i < 4; ++i) { int id = tid + i * 256; zt[id] = ((const float*)(p.F + (size_t)(rowbase + t0 + (id >> 5)) * 1536))[id & 31]; }
      }
    }
    __syncthreads();
#pragma unroll 1
    for (int c = tid; c < 384; c += 256) {
      const int col = 768 + c;
      const float mp = p.mu_prev[l * 1792 + col], mn = p.mu_next[l * 1792 + col];
      const h16* base = p.P + (size_t)rowbase * PC + col;
      h16 xv[34];
      LOAD_COL34(xv, base, t0, Tn)
      h16* dst = p.VB + (size_t)(rowbase + t0) * 384 + c;
      if (l == 0) {
#pragma unroll
        for (int tt = 0; tt < 32; ++tt) {
          const float prev = (float)xv[tt], cur = (float)xv[tt + 1], nxt = (float)xv[tt + 2];
          dst[tt * 384] = (h16)(cur + mp * (prev - cur) + mn * (nxt - cur));
        }
      } else {
        const float vbv = p.vb[c];
#pragma unroll 1
        for (int hf = 0; hf < 2; ++hf) {
          h16 vfv[16]; float ga[16];
#pragma unroll
          for (int tt = 0; tt < 16; ++tt) { vfv[tt] = dst[(hf * 16 + tt) * 384]; ga[tt] = vbv; }
#pragma unroll 1
          for (int m = 0; m < 32; m += 4) {
            const float w0 = p.vw2[m * 384 + c], w1 = p.vw2[(m + 1) * 384 + c], w2 = p.vw2[(m + 2) * 384 + c], w3 = p.vw2[(m + 3) * 384 + c];
#pragma unroll
            for (int tt = 0; tt < 16; ++tt) { const f32x4 z = *(const f32x4*)&zt[(hf * 16 + tt) * 32 + m]; ga[tt] += z[0] * w0 + z[1] * w1 + z[2] * w2 + z[3] * w3; }
          }
#pragma unroll
          for (int tt = 0; tt < 16; ++tt) {
            const float prev = hf ? (float)xv[16 + tt] : (float)xv[tt], cur = hf ? (float)xv[17 + tt] : (float)xv[tt + 1], nxt = hf ? (float)xv[18 + tt] : (float)xv[tt + 2];
            const float sv = cur + mp * (prev - cur) + mn * (nxt - cur);
            dst[(hf * 16 + tt) * 384] = (h16)(sv + ((float)vfv[tt] - sv) * sigmoidf_(ga[tt]));
          }
        }
      }
    }
    {
      const int w = __builtin_amdgcn_readfirstlane(tid >> 6), lane = tid & 63, lq = tid & 31, hh = lane >> 5;
      const int dir = w & 1, chalf = w >> 1;
      half8 xin[2][4];
#pragma unroll
      for (int kind = 0; kind < 2; ++kind)
#pragma unroll
        for (int ks = 0; ks < 4; ++ks) xin[kind][ks] = *(const half8*)(inh + lq * 264 + kind * 128 + dir * 64 + 16 * ks + 8 * hh);
      h16* ost = (h16*)(smem + 32 * 264 * 2 + 4096) + w * (32 * 72);
      h16* fbase = p.F + (size_t)(rowbase + t0) * 1536 + dir * 768 + chalf * 384;
#pragma unroll 1
      for (int np = 0; np < 6; ++np) {
        const int c0 = chalf * 192 + np * 32;
        f32x16 acc[2];
#pragma unroll
        for (int kind = 0; kind < 2; ++kind) {
          const float* bias = (kind == 0 ? p.w0 : p.a0) + (l * 2 + dir) * 384 + c0;
          const h16* wl = p.wl_t + (size_t)((l * 4 + kind * 2 + dir) * 384 + c0) * 64;
#pragma unroll
          for (int g = 0; g < 4; ++g) { const f32x4 bv = *(const f32x4*)(bias + 8 * g + 4 * hh); acc[kind][4 * g] = bv[0]; acc[kind][4 * g + 1] = bv[1]; acc[kind][4 * g + 2] = bv[2]; acc[kind][4 * g + 3] = bv[3]; }
#pragma unroll
          for (int ks = 0; ks < 4; ++ks) {
            const half8 wf = *(const half8*)(wl + (size_t)lq * 64 + 16 * ks + 8 * hh);
            acc[kind] = __builtin_amdgcn_mfma_f32_32x32x16_f16(wf, xin[kind][ks], acc[kind], 0, 0, 0);
          }
        }
#pragma unroll
        for (int g = 0; g < 4; ++g) {
          half8 o;
#pragma unroll
          for (int j = 0; j < 4; ++j) { o[2 * j] = (h16)(1.f - __expf(-0.6065306597126334f * sigmoidf_(acc[0][4 * g + j]))); o[2 * j + 1] = (h16)sigmoidf_(acc[1][4 * g + j]); }
          *(half8*)(ost + lq * 72 + 16 * g + 8 * hh) = o;
        }
        asm volatile("s_waitcnt lgkmcnt(0)" ::: "memory");
#pragma unroll
        for (int q = 0; q < 4; ++q) {
          const int id = lane + q * 64; const int rr = id >> 3, ch = id & 7;
          *(u32x4*)(fbase + (size_t)rr * 1536 + np * 64 + ch * 8) = *(const u32x4*)(ost + rr * 72 + ch * 8);
        }
        asm volatile("s_waitcnt lgkmcnt(0)" ::: "memory");
      }
    }
    {
      const int head = tid >> 5, pr = tid & 31, half = pr >> 4, i = pr & 15;
      const int colbase = head < 6 ? 3072 + head * 64 : 3456 + (head - 6) * 64;
      const int d1 = half * 32 + i;
      const float qs = (head < 6 && !dry) ? 0.125f : 1.f;
      h16* pp = p.P + (size_t)(rowbase + t0) * PC + colbase + d1;
#pragma unroll
      for (int tq = 0; tq < 32; tq += 8) {
        h16 x1[8], x2[8];
#pragma unroll
        for (int u = 0; u < 8; ++u) { x1[u] = pp[(size_t)(tq + u) * PC]; x2[u] = pp[(size_t)(tq + u) * PC + 16]; }
#pragma unroll
        for (int u = 0; u < 8; ++u) {
          const int t = t0 + tq + u;
          float cs = 1.f, sn = 0.f;
          if (!isctx && !dry) { const int pos = half == 0 ? (t >> 6) : (t & 63); const f32x2 r2 = *(const f32x2*)&p.rope[(pos * 16 + i) * 2]; cs = r2[0]; sn = r2[1]; }
          const float a = (float)x1[u], bq = (float)x2[u];
          pp[(size_t)(tq + u) * PC] = (h16)((a * cs - bq * sn) * qs);
          pp[(size_t)(tq + u) * PC + 16] = (h16)((a * sn + bq * cs) * qs);
        }
      }
    }
    if (tid < 128) {
      const int g = tid >> 6, d = tid & 63;
      const h16* base = p.P + (size_t)(rowbase + t0) * PC + 3584 + tid;
      h16* dst = p.VT + (size_t)((b * 2 + g) * 64 + d) * VTS + (isctx ? 4096 + t0 : t0);
      half8 v[4];
#pragma unroll
      for (int q = 0; q < 4; ++q)
#pragma unroll
        for (int j = 0; j < 8; ++j) v[q][j] = base[(size_t)(q * 8 + j) * PC];
#pragma unroll
      for (int q = 0; q < 4; ++q) *(half8*)(dst + q * 8) = v[q];
    }
    __syncthreads();
  }
}

__device__ __forceinline__ float ulo(unsigned u) { return (float)__builtin_bit_cast(h16, (unsigned short)(u & 0xffffu)); }
__device__ __forceinline__ float uhi(unsigned u) { return (float)__builtin_bit_cast(h16, (unsigned short)(u >> 16)); }
__device__ __forceinline__ float red16(float x) {
  x += dpp_mov<0xB1>(x);
  x += dpp_mov<0x4E>(x);
  x += dpp_mov<0x141>(x);
  x += dpp_mov<0x140>(x);
  return x;
}
#define LDS_BARRIER() do { asm volatile("s_waitcnt lgkmcnt(0)" ::: "memory"); __builtin_amdgcn_s_barrier(); asm volatile("" ::: "memory"); } while (0)
constexpr int RREC = 336;
struct RwkvPf { unsigned rk[10]; h16 v[8]; unsigned ea[8]; };

__device__ __forceinline__ void rwkv_chain(const Params& p, int l, int item, char* smem) {
  const int tid0 = tid_opaque();
  const int tid = (item >= 256) ? (tid0 ^ 128) : tid0;
  const int lane = tid & 63, w = __builtin_amdgcn_readfirstlane(tid >> 6);
  const int chain = item >> 2, vq = item & 3;
  const int dir = chain / 48, b = (chain % 48) / 6, h = chain % 6;
  float* opb = (float*)smem;
  float* ybuf = opb + 2 * 16 * RREC;
  constexpr int NCH = 272;
  if (w < 2) {
    const int rl = tid >> 3, kq = tid & 7;
    float S[8];
#pragma unroll
    for (int j = 0; j < 8; ++j) S[j] = 0.f;
    __builtin_amdgcn_s_setprio(3);
    LDS_BARRIER();
#pragma unroll 1
    for (int ci = 0; ci < NCH; ++ci) {
      const float* op = opb + (ci & 1) * 16 * RREC;
      float* yb = ybuf + (ci & 1) * 256;
      f32x4 aA = *(const f32x4*)(op + 8 * kq + 64), aB = *(const f32x4*)(op + 8 * kq + 68);
#pragma unroll
      for (int step = 0; step < 16; ++step) {
        const float* o = op + step * RREC + 8 * kq;
        const f32x4 wA = *(const f32x4*)(o), wB = *(const f32x4*)(o + 4);
        const f32x4 bA = *(const f32x4*)(o + 128), bB = *(const f32x4*)(o + 132);
        const f32x4 kA = *(const f32x4*)(o + 192), kB = *(const f32x4*)(o + 196);
        const f32x4 rA = *(const f32x4*)(o + 256), rB = *(const f32x4*)(o + 260);
        const float vv = op[step * RREC + 320 + rl];
        f32x4 naA = aA, naB = aB;
        if (step + 1 < 16) { naA = *(const f32x4*)(o + RREC + 64); naB = *(const f32x4*)(o + RREC + 68); }
        const float d0 = S[0] * aA[0] + S[1] * aA[1] + S[2] * aA[2] + S[3] * aA[3];
        const float d1 = S[4] * aB[0] + S[5] * aB[1] + S[6] * aB[2] + S[7] * aB[3];
        const float sa = red8(d0 + d1);
#pragma unroll
        for (int j = 0; j < 4; ++j) {
          S[j] = S[j] * wA[j] + sa * bA[j] + vv * kA[j];
          S[4 + j] = S[4 + j] * wB[j] + sa * bB[j] + vv * kB[j];
        }
        const float y0 = S[0] * rA[0] + S[1] * rA[1] + S[2] * rA[2] + S[3] * rA[3];
        const float y1 = S[4] * rB[0] + S[5] * rB[1] + S[6] * rB[2] + S[7] * rB[3];
        const float yy = red8(y0 + y1);
        if (kq == 0) yb[step * 16 + rl] = yy;
        aA = naA; aB = naB;
      }
      LDS_BARRIER();
    }
    __builtin_amdgcn_s_setprio(0);
  } else {
    const int lw = w - 2, lt = tid - 128;
    const int hc = h * 64 + lane;
    const float mpr = p.mu_prev[l * 1792 + hc], mnr = p.mu_next[l * 1792 + hc];
    const float mpk = p.mu_prev[l * 1792 + 384 + hc], mnk = p.mu_next[l * 1792 + 384 + hc];
    const float kkw = p.k_k[l * 384 + hc], kaw = p.k_a[l * 384 + hc];
    const float cAr = dir ? mnr : mpr, cBr = dir ? mpr : mnr, cAk = dir ? mnk : mpk, cBk = dir ? mpk : mnk;
    const unsigned* zrow = p.bar + XCD_BAR_WORDS;
    RwkvPf pfA, pfB;
#define RWKV_ISSUE(ci_, PF) { const int seg_ = (ci_) >= 16; const int Tn_ = seg_ ? 4096 : 256; const int rb_ = seg_ ? b * 4096 : NLAT + b * 256; const int s0_ = (seg_ ? (ci_) - 16 : (ci_)) * 16 + 8 * lw; \
    _Pragma("unroll") for (int q = 0; q < 10; ++q) { const int t_ = dir == 0 ? s0_ - 1 + q : Tn_ - s0_ - q; \
      const unsigned* src_ = ((unsigned)t_ < (unsigned)Tn_) ? (const unsigned*)(p.P + (size_t)(rb_ + t_) * PC + h * 128) : zrow; \
      PF.rk[q] = src_[lane]; } \
    _Pragma("unroll") for (int i = 0; i < 8; ++i) { const int t_ = dir == 0 ? s0_ + i : Tn_ - 1 - (s0_ + i); const size_t row = (size_t)rb_ + t_; \
      PF.v[i] = p.VB[row * 384 + hc]; PF.ea[i] = ((const unsigned*)(p.F + row * 1536 + dir * 768))[hc]; } }
#define RWKV_STAGE(ci_, PF) { float* op_ = opb + ((ci_) & 1) * 16 * RREC; \
    const int seg = (ci_) >= 16; const int Tn = seg ? 4096 : 256; const int c0 = (seg ? (ci_) - 16 : (ci_)) * 16; \
    _Pragma("unroll") for (int i = 0; i < 8; ++i) { \
      const int step = lw * 8 + i; const int t = dir == 0 ? c0 + step : Tn - 1 - (c0 + step); \
      const float rlo = ulo(PF.rk[i]), r0 = ulo(PF.rk[i + 1]), rhi = ulo(PF.rk[i + 2]); \
      const float klo = uhi(PF.rk[i]), k0 = uhi(PF.rk[i + 1]), khi = uhi(PF.rk[i + 2]); \
      const float vv = (float)PF.v[i], e = ulo(PF.ea[i]), al = uhi(PF.ea[i]); \
      const float rs = r0 + cAr * (rlo - r0) + cBr * (rhi - r0); \
      const float ks = k0 + cAk * (klo - k0) + cBk * (khi - k0); \
      const float kkr = ks * kkw; \
      const float n2 = wave_sum_dpp(kkr * kkr); \
      const float kk = kkr * rsqrtf(fmaxf(n2, 1e-24f)); \
      float* o = op_ + step * RREC + lane; \
      o[0] = 1.f - e; o[64] = -kk; o[128] = kk * al; o[192] = ks * (1.f + (al - 1.f) * kaw); o[256] = rs; \
      if ((lane >> 4) == vq) op_[step * RREC + 320 + (lane & 15)] = vv; } }
#define RWKV_WRITE(cj_) { const int seg = (cj_) >= 16; const int Tn = seg ? 4096 : 256; const int rowbase = seg ? b * 4096 : NLAT + b * 256; const int c0 = (seg ? (cj_) - 16 : (cj_)) * 16; \
    if (seg == 1 || l == 0) { const float* yb = ybuf + ((cj_) & 1) * 256; \
      _Pragma("unroll") for (int i = 0; i < 2; ++i) { const int idx = lt + i * 128; const int step = idx >> 4, ch = idx & 15; \
        const int t = dir == 0 ? c0 + step : Tn - 1 - (c0 + step); \
        const h16 yv = (h16)yb[idx]; \
        if (dir == 0) p.P[(size_t)(rowbase + t) * PC + 768 + h * 64 + 16 * vq + ch] = yv; \
        else p.hy[(size_t)(rowbase + t) * 1024 + h * 64 + 16 * vq + ch] = yv; } } }
    RWKV_ISSUE(0, pfA)
    RWKV_STAGE(0, pfA)
    RWKV_ISSUE(1, pfB)
    RWKV_ISSUE(2, pfA)
    LDS_BARRIER();
#pragma unroll 1
    for (int ci = 0; ci < NCH; ci += 2) {
      if (ci + 1 < NCH) RWKV_STAGE(ci + 1, pfB)
      if (ci + 3 < NCH) RWKV_ISSUE(ci + 3, pfB)
      if (ci >= 1) RWKV_WRITE(ci - 1)
      LDS_BARRIER();
      if (ci + 2 < NCH) RWKV_STAGE(ci + 2, pfA)
      if (ci + 4 < NCH) RWKV_ISSUE(ci + 4, pfA)
      RWKV_WRITE(ci)
      LDS_BARRIER();
    }
    RWKV_WRITE(NCH - 1)
  }
}

constexpr int HREC = 224;
struct HgrnPf { h16 f[4], q[4], iv[4]; };
__device__ __forceinline__ void hgrn_chain(const Params& p, int l, int item, char* smem) {
  const int tid = tid_opaque(), lane = tid & 63, w = __builtin_amdgcn_readfirstlane(tid >> 6);
  const int chain = item >> 1, vh = item & 1;
  const int dir = chain / 32, b = (chain % 32) / 4, h = chain % 4;
  float* op = (float*)smem;
  float* ybuf = op + 16 * HREC;
  const int hc = h * 64 + lane;
  float lb = 0.f;
  if (l == 1) lb = sigmoidf_(p.lb_logits[(dir * 2 + 1) * 256 + hc] - p.lb_logits[(dir * 2 + 0) * 256 + hc]);
  const int fcol = 1792 + 256 * (1 + dir) + hc;
  const int vc = tid >> 3, kq = tid & 7;
  float S[8];
#pragma unroll
  for (int j = 0; j < 8; ++j) S[j] = 0.f;
  HgrnPf pfA, pfB;
#define HGRN_ISSUE(ci_, PF) { const int seg_ = (ci_) >= 16; const int Tn_ = seg_ ? 4096 : 256; const int rb_ = seg_ ? b * 4096 : NLAT + b * 256; const int c0_ = (seg_ ? (ci_) - 16 : (ci_)) * 16; \
    _Pragma("unroll") for (int i = 0; i < 4; ++i) { const int step = w * 4 + i; const int t = dir == 0 ? c0_ + step : Tn_ - 1 - (c0_ + step); const h16* pr = p.P + ((size_t)rb_ + t) * PC; \
      PF.f[i] = pr[fcol]; PF.q[i] = pr[1792 + hc]; PF.iv[i] = pr[1792 + 768 + hc]; } }
#define HGRN_CHUNK(ci_, PF) { \
    const int seg = (ci_) >= 16; const int Tn = seg ? 4096 : 256; const int rowbase = seg ? b * 4096 : NLAT + b * 256; const int c0 = (seg ? (ci_) - 16 : (ci_)) * 16; \
    _Pragma("unroll") for (int i = 0; i < 4; ++i) { \
      const int step = w * 4 + i; \
      float* o = op + step * HREC + lane; \
      const float f = lb + (1.f - lb) * sigmoidf_((float)PF.f[i]); \
      o[0] = f; o[128] = (float)PF.q[i]; \
      if ((lane >> 5) == vh) op[step * HREC + 192 + (lane & 31)] = (float)PF.iv[i]; } \
    LDS_BARRIER(); \
    if ((ci_) + 2 < 272) HGRN_ISSUE((ci_) + 2, PF) \
    _Pragma("unroll") for (int step = 0; step < 16; ++step) { \
      const float* o = op + step * HREC + 8 * kq; \
      const f32x4 fA = *(const f32x4*)(o), fB = *(const f32x4*)(o + 4); \
      const f32x4 qA = *(const f32x4*)(o + 128), qB = *(const f32x4*)(o + 132); \
      const float iv = op[step * HREC + 192 + vc]; \
      const float f[8] = {fA[0], fA[1], fA[2], fA[3], fB[0], fB[1], fB[2], fB[3]}; \
      const float q[8] = {qA[0], qA[1], qA[2], qA[3], qB[0], qB[1], qB[2], qB[3]}; \
      float acc = 0.f; \
      _Pragma("unroll") for (int j = 0; j < 8; ++j) { S[j] = f[j] * (S[j] - iv) + iv; acc += S[j] * q[j]; } \
      ybuf[step * 256 + tid] = acc; } \
    LDS_BARRIER(); \
    if (seg == 1 || l == 0) { \
      _Pragma("unroll") for (int i = 0; i < 2; ++i) { \
        const int idx = tid + i * 256; const int step = idx >> 5, ch = idx & 31; \
        const int t = dir == 0 ? c0 + step : Tn - 1 - (c0 + step); \
        const float* yb = ybuf + step * 256 + ch * 8; \
        const f32x4 y0 = *(const f32x4*)(yb), y1 = *(const f32x4*)(yb + 4); \
        const f32x4 ys = y0 + y1; \
        const h16 ov = (h16)((ys[0] + ys[1]) + (ys[2] + ys[3])); \
        if (dir == 0) p.P[(size_t)(rowbase + t) * PC + 1152 + h * 64 + 32 * vh + ch] = ov; \
        else p.hy[(size_t)(rowbase + t) * 1024 + 384 + h * 64 + 32 * vh + ch] = ov; } } }
  HGRN_ISSUE(0, pfA)
  HGRN_ISSUE(1, pfB)
  __builtin_amdgcn_s_setprio(2);
#pragma unroll 1
  for (int ci = 0; ci < 272; ci += 2) {
    HGRN_CHUNK(ci, pfA)
    HGRN_CHUNK(ci + 1, pfB)
  }
  __builtin_amdgcn_s_setprio(0);
}

__device__ __forceinline__ void attn_unit(const Params& p, int l, int u) {
  const int tid = tid_opaque(), lane = tid & 63, w = __builtin_amdgcn_readfirstlane(tid >> 6), lq = lane & 31, hh = lane >> 5;
  int b, head, qrow_base, qpos0; bool isctx;
  if (u < 1536) { b = u / 192; int rem = u % 192; int blk = rem / 6; head = rem % 6; qpos0 = blk * 128 + w * 32; qrow_base = b * 4096; isctx = false; }
  else { int j = u - 1536; b = j / 12; int rem = j % 12; int qb = rem / 6; head = rem % 6; qpos0 = qb * 128 + w * 32; qrow_base = NLAT + b * 256; isctx = true; }
  const int g = head / 3;
  const size_t qrow = (size_t)qrow_base + qpos0 + lq;
  half8 qf[4];
#pragma unroll
  for (int s = 0; s < 4; ++s) qf[s] = *(const half8*)(p.P + qrow * PC + 3072 + head * 64 + 16 * s + 8 * hh);
  const float sinkv = p.sink[l * 6 + head];
  float m = sinkv, lsum = hh == 0 ? 1.f : 0.f;
  f32x16 O[2];
#pragma unroll
  for (int r = 0; r < 16; ++r) { O[0][r] = 0.f; O[1][r] = 0.f; }
  const h16* vt = p.VT + (size_t)((b * 2 + g) * 64) * VTS;
  int nband = 0, kstart = 0;
  if (!isctx) { kstart = max(0, qpos0 - 128); const int kend = min(4096, qpos0 + 160); nband = (kend - kstart) >> 5; }
  const int ntiles = nband + 8;
  for (int ti = 0; ti < ntiles; ++ti) {
    const bool band = ti < nband;
    const int kt = band ? kstart + ti * 32 : (ti - nband) * 32;
    const size_t krow = band ? (size_t)b * 4096 + kt + lq : (size_t)NLAT + b * 256 + kt + lq;
    const int vidx = band ? kt : 4096 + kt;
    const h16* kp = p.P + krow * PC + 3456 + g * 64 + 8 * hh;
    f32x16 sacc;
#pragma unroll
    for (int r = 0; r < 16; ++r) sacc[r] = 0.f;
#pragma unroll
    for (int s = 0; s < 4; ++s) { half8 kf = *(const half8*)(kp + 16 * s); sacc = __builtin_amdgcn_mfma_f32_32x32x16_f16(kf, qf[s], sacc, 0, 0, 0); }
    float mx = -INFINITY;
#pragma unroll
    for (int r = 0; r < 16; ++r) {
      float sv = sacc[r];
      if (band) { const int dlt = kt + (r & 3) + 8 * (r >> 2) + 4 * hh - (qpos0 + lq); if (dlt > 128 || dlt < -128) sv = -INFINITY; }
      sacc[r] = sv; mx = fmaxf(mx, sv);
    }
    mx = fmaxf(mx, __shfl_xor(mx, 32));
    const float mn = fmaxf(m, mx); const float corr = __expf(m - mn); m = mn;
    float ps = 0.f; half8 pb[2];
#pragma unroll
    for (int r = 0; r < 16; ++r) { const float pv = __expf(sacc[r] - mn); ps += pv; pb[r >> 3][r & 7] = (h16)pv; }
    lsum = lsum * corr + ps;
#pragma unroll
    for (int r = 0; r < 16; ++r) { O[0][r] *= corr; O[1][r] *= corr; }
#pragma unroll
    for (int s2 = 0; s2 < 2; ++s2)
#pragma unroll
      for (int dt = 0; dt < 2; ++dt) {
        const h16* vp = vt + (size_t)(dt * 32 + lq) * VTS + vidx + 16 * s2 + 4 * hh;
        const half4 lo = *(const half4*)vp, hi = *(const half4*)(vp + 8);
        const half8 vf = {lo[0], lo[1], lo[2], lo[3], hi[0], hi[1], hi[2], hi[3]};
        O[dt] = __builtin_amdgcn_mfma_f32_32x32x16_f16(vf, pb[s2], O[dt], 0, 0, 0);
      }
  }
  lsum += __shfl_xor(lsum, 32);
  const float inv = 1.f / lsum;
#pragma unroll
  for (int dt = 0; dt < 2; ++dt)
#pragma unroll
    for (int g4 = 0; g4 < 4; ++g4) {
      const int d0 = dt * 32 + 8 * g4 + 4 * hh;
      const half4 ga = *(const half4*)(p.P + qrow * PC + 3712 + head * 64 + d0);
      half4 o;
#pragma unroll
      for (int j = 0; j < 4; ++j) { const float gv = (float)ga[j]; o[j] = (h16)(O[dt][g4 * 4 + j] * inv * siluf_(gv)); }
      *(half4*)(p.hy + qrow * 1024 + 640 + head * 64 + d0) = o;
    }
}

__device__ __forceinline__ void phase_mix(const Params& p, int l, int bid, int nb, char* smem, int sub) {
  const int nunits = l == 0 ? 1536 + 96 : 1536;
  if (nb >= 640) {
    if (bid < 384) { if (sub & 1) rwkv_chain(p, l, bid, smem); }
    else if (bid < 512) { if (sub & 2) hgrn_chain(p, l, bid - 384, smem); }
    else if (sub & 4) for (int u = bid - 512; u < nunits; u += nb - 512) attn_unit(p, l, u);
  } else {
    for (int it = bid; it < 512 + nunits; it += nb) {
      if (it < 384) rwkv_chain(p, l, it, smem);
      else if (it < 512) hgrn_chain(p, l, it - 384, smem);
      else attn_unit(p, l, it - 512);
      __syncthreads();
    }
  }
}

__device__ __forceinline__ float sum4(const f32x4 v) { return (v[0] + v[1]) + (v[2] + v[3]); }
__device__ __forceinline__ f32x4 h4f(const half4 h) { return (f32x4){(float)h[0], (float)h[1], (float)h[2], (float)h[3]}; }
__device__ __forceinline__ half8 zero_h8() { half8 z;
#pragma unroll
  for (int j = 0; j < 8; ++j) z[j] = (h16)0.f; return z; }
__device__ __forceinline__ half4 zero_h4() { half4 z; z[0] = z[1] = z[2] = z[3] = (h16)0.f; return z; }
__device__ __forceinline__ void phase_readout(const Params& p, int l, int bid, int nb, bool dummy) {
  const int tid = tid_opaque(), lane = tid & 63, w = __builtin_amdgcn_readfirstlane(tid >> 6);
  const int nrows = l == 1 ? NLAT : NTOK;
  const int hl = lane >> 4, c4 = (lane & 15) * 4;
  const int gw = bid * 4 + w, nper = (nb * 4) / 3;
  const int q = gw % 3, ridx = gw / 3;
  if (ridx >= nper) return;
  const int rpw = (nrows + nper - 1) / nper;
  const int r0 = ridx * rpw, r1 = min(nrows, r0 + rpw);
  if (r0 >= r1) return;
  if (q < 2) {
    const int head = q * 4 + hl; const bool valid = head < 6; const int hcl = valid ? head : 5; const int c = hcl * 64 + c4;
    const f32x4 mpr = *(const f32x4*)(p.mu_prev + l * 1792 + c), mnr = *(const f32x4*)(p.mu_next + l * 1792 + c);
    const f32x4 mpk = *(const f32x4*)(p.mu_prev + l * 1792 + 384 + c), mnk = *(const f32x4*)(p.mu_next + l * 1792 + 384 + c);
    const f32x4 mpg = *(const f32x4*)(p.mu_prev + l * 1792 + 1408 + c), mng = *(const f32x4*)(p.mu_next + l * 1792 + 1408 + c);
    const f32x4 gwt = *(const f32x4*)(p.gn_w + l * 384 + c), gbs = *(const f32x4*)(p.gn_b + l * 384 + c), rkw = *(const f32x4*)(p.r_k + l * 384 + c);
    const h16* prk = p.P + hcl * 128 + 2 * c4;
    const h16* pg = p.P + 1408 + c;
    half8 rk_prev = r0 > 0 ? *(const half8*)(prk + (size_t)(r0 - 1) * PC) : zero_h8();
    half4 g_prev = r0 > 0 ? *(const half4*)(pg + (size_t)(r0 - 1) * PC) : zero_h4();
    half8 rk_cur = *(const half8*)(prk + (size_t)r0 * PC);
    half4 g_cur = *(const half4*)(pg + (size_t)r0 * PC);
    half8 rk_next = r0 + 1 < NTOK ? *(const half8*)(prk + (size_t)(r0 + 1) * PC) : zero_h8();
    half4 g_next = r0 + 1 < NTOK ? *(const half4*)(pg + (size_t)(r0 + 1) * PC) : zero_h4();
    half4 yf_c = *(const half4*)(p.P + (size_t)r0 * PC + 768 + c), yb_c = *(const half4*)(p.hy + (size_t)r0 * 1024 + c), v_c = *(const half4*)(p.VB + (size_t)r0 * 384 + c);
#pragma unroll 1
    for (int row = r0; row < r1; ++row) {
      const bool more = row + 1 < r1;
      const half8 rk_nn = row + 2 < NTOK ? *(const half8*)(prk + (size_t)(row + 2) * PC) : zero_h8();
      const half4 g_nn = row + 2 < NTOK ? *(const half4*)(pg + (size_t)(row + 2) * PC) : zero_h4();
      half4 yf_n = yf_c, yb_n = yb_c, v_n = v_c;
      if (more) { yf_n = *(const half4*)(p.P + (size_t)(row + 1) * PC + 768 + c); yb_n = *(const half4*)(p.hy + (size_t)(row + 1) * 1024 + c); v_n = *(const half4*)(p.VB + (size_t)(row + 1) * 384 + c); }
      int t, Tn;
      if (row < NLAT) { t = row & 4095; Tn = 4096; } else { t = (row - NLAT) & 255; Tn = 256; }
      const bool hp = t > 0, hn = t + 1 < Tn;
      f32x4 sh[3];
#pragma unroll
      for (int k = 0; k < 2; ++k) {
        const f32x4 cur = {(float)rk_cur[k], (float)rk_cur[2 + k], (float)rk_cur[4 + k], (float)rk_cur[6 + k]};
        f32x4 prv = {(float)rk_prev[k], (float)rk_prev[2 + k], (float)rk_prev[4 + k], (float)rk_prev[6 + k]};
        f32x4 nxt = {(float)rk_next[k], (float)rk_next[2 + k], (float)rk_next[4 + k], (float)rk_next[6 + k]};
        if (!hp) prv = (f32x4){0.f, 0.f, 0.f, 0.f};
        if (!hn) nxt = (f32x4){0.f, 0.f, 0.f, 0.f};
        sh[k] = cur + (k == 0 ? mpr : mpk) * (prv - cur) + (k == 0 ? mnr : mnk) * (nxt - cur);
      }
      {
        const f32x4 cur = h4f(g_cur);
        f32x4 prv = h4f(g_prev), nxt = h4f(g_next);
        if (!hp) prv = (f32x4){0.f, 0.f, 0.f, 0.f};
        if (!hn) nxt = (f32x4){0.f, 0.f, 0.f, 0.f};
        sh[2] = cur + mpg * (prv - cur) + mng * (nxt - cur);
      }
      const f32x4 y = h4f(yf_c) + h4f(yb_c);
      const f32x4 v = h4f(v_c);
      const float mean = red16(sum4(y)) * (1.f / 64.f);
      const f32x4 yc = y - mean;
      const float var = red16(sum4(yc * yc)) * (1.f / 64.f);
      const float rs = rsqrtf(var + 64e-5f);
      const float bs = red16(sum4(sh[0] * sh[1] * rkw));
      half4 o;
#pragma unroll
      for (int j = 0; j < 4; ++j) o[j] = (h16)((yc[j] * rs * gwt[j] + gbs[j] + bs * v[j]) * siluf_(sh[2][j]));
      h16* yw = dummy ? p.F + (size_t)row * 1536 : p.hy + (size_t)row * 1024;
      if (valid) *(half4*)(yw + c) = o;
      rk_prev = rk_cur; rk_cur = rk_next; rk_next = rk_nn;
      g_prev = g_cur; g_cur = g_next; g_next = g_nn;
      yf_c = yf_n; yb_c = yb_n; v_c = v_n;
    }
  } else {
    const int c = hl * 64 + c4;
    const f32x4 nw = *(const f32x4*)(p.hg_norm_w + l * 256 + c);
    half4 of_c = *(const half4*)(p.P + (size_t)r0 * PC + 1152 + c), ob_c = *(const half4*)(p.hy + (size_t)r0 * 1024 + 384 + c), g_c = *(const half4*)(p.P + (size_t)r0 * PC + 2816 + c);
#pragma unroll 1
    for (int row = r0; row < r1; ++row) {
      half4 of_n = of_c, ob_n = ob_c, g_n = g_c;
      if (row + 1 < r1) { of_n = *(const half4*)(p.P + (size_t)(row + 1) * PC + 1152 + c); ob_n = *(const half4*)(p.hy + (size_t)(row + 1) * 1024 + 384 + c); g_n = *(const half4*)(p.P + (size_t)(row + 1) * PC + 2816 + c); }
      const f32x4 o = h4f(of_c) + h4f(ob_c);
      const f32x4 g = h4f(g_c);
      const float ms = red16(sum4(o * o)) * (1.f / 64.f);
      const float rs = rsqrtf(ms + 1e-6f);
      half4 ov;
#pragma unroll
      for (int j = 0; j < 4; ++j) ov[j] = (h16)(o[j] * rs * nw[j] * siluf_(g[j]));
      h16* yw = dummy ? p.F + (size_t)row * 1536 : p.hy + (size_t)row * 1024;
      *(half4*)(yw + 384 + c) = ov;
      of_c = of_n; ob_c = ob_n; g_c = g_n;
    }
  }
}

__device__ __forceinline__ void phase_final(const Params& p, int bid, int nb) {
  const int tid = tid_opaque(), lane = tid & 63, w = __builtin_amdgcn_readfirstlane(tid >> 6);
  for (int row = bid * 4 + w; row < NLAT; row += nb * 4) {
    float* src = p.out + (size_t)row * 1024;
    f32x4 v[4]; float ss = 0.f;
#pragma unroll
    for (int i = 0; i < 4; ++i) { v[i] = *(const f32x4*)(src + i * 256 + lane * 4); ss += v[i][0] * v[i][0] + v[i][1] * v[i][1] + v[i][2] * v[i][2] + v[i][3] * v[i][3]; }
    ss = wave_sum_dpp(ss);
    const float rs = rsqrtf(ss * (1.f / 1024.f) + 1e-6f);
#pragma unroll
    for (int i = 0; i < 4; ++i) {
      const int col = i * 256 + lane * 4;
      const f32x4 nwv = *(const f32x4*)(p.final_w + col);
      f32x4 o;
#pragma unroll
      for (int j = 0; j < 4; ++j) o[j] = v[i][j] * rs * nwv[j];
      *(f32x4*)(src + col) = o;
    }
  }
}

__global__ void __launch_bounds__(256, 3) __attribute__((target("no-packed-fp32-ops"))) mega(Params p, int ph_lo, int ph_hi, int coop) {
  __shared__ __attribute__((aligned(16))) char smem[SMEM_BYTES];
  __shared__ uint4 xb_words;
  XcdBarrier xb; xb.bar = p.bar; xb.x = 0; xb.st = (volatile LAS unsigned*)&xb_words;
  if (coop) { if (threadIdx.x == 0) xb_words = make_uint4(0u, 0u, 0u, 0u); __syncthreads(); xb = xcd_barrier_post(p.bar, (volatile LAS unsigned*)&xb_words); }
  if (coop) for (int i = 0; i < EXTRA_SYNCS; ++i) { xcd_barrier(xb); }
  if (coop == 2) cg::this_grid().sync();
  for (int ph = ph_lo; ph < ph_hi; ++ph) {
    for (int rep = 0; rep < (((PROBE_MASK >> ph) & 1) ? 2 : 1); ++rep) {
      int bid = blockIdx.x, nb = gridDim.x;
      asm volatile("" : "+s"(bid), "+s"(nb));
      if (ph == 0) phase_prep(p, bid, nb, smem);
      else if (ph == 13) phase_final(p, bid, nb);
      else {
        const int l = (ph - 1) / 6, s = (ph - 1) % 6;
        if (s == 0) phase_norm(p, l, bid, nb);
        else if (s == 1) phase_gemm<0>(p, l, bid, nb, smem);
        else if (s == 2) phase_feat(p, l, bid, nb, smem, PROBE_MASK && ((PROBE_MASK >> ph) & 1) && rep == 0);
        else if (s == 3) phase_mix(p, l, bid, nb, smem, rep ? PROBE_SUB : 7);
        else if (s == 4) phase_readout(p, l, bid, nb, PROBE_MASK && ((PROBE_MASK >> ph) & 1) && rep == 0);
        else phase_gemm<1>(p, l, bid, nb, smem);
      }
      if (PROBE_MASK && rep == 0 && ((PROBE_MASK >> ph) & 1)) { xcd_barrier(xb); }
    }
    if (coop && ph + 1 < ph_hi) { xcd_barrier(xb); }
  }
}

extern "C" void kernel_launch(void* const* d_in, const int* in_sizes, int n_in, void* d_out, int out_size, void* d_ws, size_t ws_size, hipStream_t stream) {
  static int grid_blocks = 0;
  if (!grid_blocks) {
    int dev = 0, cus = 0, per_cu = 0;
    hipGetDevice(&dev);
    hipDeviceGetAttribute(&cus, hipDeviceAttributeMultiprocessorCount, dev);
    hipOccupancyMaxActiveBlocksPerMultiprocessor(&per_cu, mega, 256, 0);
    if (per_cu < 1) per_cu = 1;
    grid_blocks = cus * per_cu;
  }
  Params p{};
  const float* const* in = (const float* const*)d_in;
  p.x = in[0]; p.c = in[1]; p.ctx = in[2]; p.c_ctx = in[3]; p.mod_w = in[4]; p.mod_b = in[5]; p.norm_w = in[6]; p.w_in = in[7]; p.w_out = in[8];
  p.mu_prev = in[9]; p.mu_next = in[10]; p.w0 = in[11]; p.w2 = in[12]; p.a0 = in[13]; p.a2 = in[14]; p.k_k = in[15]; p.k_a = in[16]; p.r_k = in[17];
  p.gn_w = in[18]; p.gn_b = in[19]; p.vw1 = in[20]; p.vw2 = in[21]; p.vb = in[22]; p.lb_logits = in[23]; p.hg_norm_w = in[24]; p.sink = in[25]; p.final_w = in[26];
  p.out = (float*)d_out;
  char* ws = (char*)d_ws; size_t off = 0;
  auto take = [&](size_t bytes) { char* r = ws + off; off += (bytes + 255) & ~(size_t)255; return r; };
  p.win_t = (h16*)take((size_t)2 * NPAD * 1024 * 2);
  p.wout_t = (h16*)take((size_t)2 * 1024 * 1024 * 2);
  p.wl_t = (h16*)take((size_t)2 * 4 * 384 * 64 * 2);
  p.mod = (float*)take((size_t)2 * 9 * 3072 * 4);
  p.rope = (float*)take((size_t)64 * 16 * 2 * 4);
  p.hy = (h16*)take((size_t)NTOK * 1024 * 2);
  p.P = (h16*)take((size_t)NTOK * PC * 2);
  p.F = (h16*)take((size_t)NTOK * 1536 * 2);
  p.VB = (h16*)take((size_t)NTOK * 384 * 2);
  p.VT = (h16*)take((size_t)16 * 64 * VTS * 2);
  p.xc1 = (float*)take((size_t)2048 * 1024 * 4);
  p.bar = (unsigned*)take(16384);
  if (off > ws_size) fprintf(stderr, "workspace too small: need %zu have %zu\n", off, ws_size);
#if SINGLE_LAUNCH
  hipMemsetAsync(p.bar, 0, 16384, stream);
  int lo = 0, hi = 14, coop = 1;
  void* args[] = {&p, &lo, &hi, &coop};
  hipError_t e = hipLaunchCooperativeKernel((void*)mega, dim3(grid_blocks), dim3(256), args, 0, stream);
  if (e != hipSuccess) fprintf(stderr, "cooperative launch failed: %s (grid %d)\n", hipGetErrorString(e), grid_blocks);
#else
  for (int ph = 0; ph < 14; ++ph) mega<<<grid_blocks, 256, 0, stream>>>(p, ph, ph + 1, 0);
#endif
}
```

```cpp
#include <hip/hip_runtime.h>
#include <hip/hip_cooperative_groups.h>
#include <cstdio>
#include <cstdint>
namespace cg = cooperative_groups;

typedef _Float16 h16;
typedef _Float16 half8 __attribute__((ext_vector_type(8)));
typedef _Float16 half4 __attribute__((ext_vector_type(4)));
typedef float f32x16 __attribute__((ext_vector_type(16)));
typedef float f32x4 __attribute__((ext_vector_type(4)));
typedef float f32x2 __attribute__((ext_vector_type(2)));
typedef unsigned u32x4 __attribute__((ext_vector_type(4)));
typedef _Float16 half2v __attribute__((ext_vector_type(2)));

constexpr int NLAT = 32768, NTOK = 34816;
constexpr int PC = 4160;
constexpr int NPAD = 4224;
constexpr int VTS = 4352;
constexpr int SMEM_BYTES = 49152;

#ifndef EXTRA_SYNCS
#define EXTRA_SYNCS 0
#endif
#ifndef PROBE_SUB
#define PROBE_SUB 7
#endif
#ifndef PROBE_MASK
#define PROBE_MASK 0
#endif
#ifndef SINGLE_LAUNCH
#define SINGLE_LAUNCH 1
#endif

struct Params {
  const float *x, *c, *ctx, *c_ctx, *mod_w, *mod_b, *norm_w, *w_in, *w_out;
  const float *mu_prev, *mu_next, *w0, *w2, *a0, *a2, *k_k, *k_a, *r_k, *gn_w, *gn_b;
  const float *vw1, *vw2, *vb, *lb_logits, *hg_norm_w, *sink, *final_w;
  float* out;
  h16 *win_t, *wout_t, *wl_t;
  float* mod;
  h16 *hy, *P, *F, *VB;
  h16* VT;
  float* xc1;
  float* rope;
  unsigned* bar;
};

__device__ __forceinline__ int tid_opaque() { int t = threadIdx.x; asm volatile("" : "+v"(t)); return t; }
__device__ __forceinline__ float wave_sum(float v) {
#pragma unroll
  for (int o = 32; o > 0; o >>= 1) v += __shfl_xor(v, o);
  return v;
}
__device__ __forceinline__ float sigmoidf_(float x) { return __builtin_amdgcn_rcpf(1.f + __expf(-x)); }
__device__ __forceinline__ float siluf_(float x) { return x * __builtin_amdgcn_rcpf(1.f + __expf(-x)); }
template <int CTRL> __device__ __forceinline__ float dpp_mov(float x) {
  return __int_as_float(__builtin_amdgcn_update_dpp(0, __float_as_int(x), CTRL, 0xf, 0xf, true));
}
__device__ __forceinline__ float wave_sum_dpp(float x) {
  x += dpp_mov<0xB1>(x);
  x += dpp_mov<0x4E>(x);
  x += dpp_mov<0x141>(x);
  x += dpp_mov<0x140>(x);
  const int xi = __float_as_int(x);
  return __int_as_float(__builtin_amdgcn_readlane(xi, 0)) + __int_as_float(__builtin_amdgcn_readlane(xi, 16)) +
         __int_as_float(__builtin_amdgcn_readlane(xi, 32)) + __int_as_float(__builtin_amdgcn_readlane(xi, 48));
}
__device__ __forceinline__ float red8(float x) {
  x += dpp_mov<0xB1>(x);
  x += dpp_mov<0x4E>(x);
  x += dpp_mov<0x141>(x);
  return x;
}

#define XB_TMO      128
#define XB_XCNT(j)  (256  + 64 * (j))
#define XB_XSUB(j)  (1280 + 64 * (j))
#define XB_XGEN(j)  (2304 + 64 * (j))
#define XB_TOP      3328
#define XB_TOPGEN   3392
#define XCD_BAR_WORDS 3456
#define XB_SPIN_CAP (1u << 18)
#define LAS __attribute__((address_space(3)))
__device__ __forceinline__ unsigned xb_ld(unsigned* p)              { return __hip_atomic_load(p, __ATOMIC_RELAXED, __HIP_MEMORY_SCOPE_AGENT); }
__device__ __forceinline__ unsigned xb_add(unsigned* p, unsigned v) { return __hip_atomic_fetch_add(p, v, __ATOMIC_RELAXED, __HIP_MEMORY_SCOPE_AGENT); }
__device__ __forceinline__ unsigned xb_xcc_id() { return (unsigned)__builtin_amdgcn_s_getreg((3 << 11) | 20) & 0xFu; }
#define XB_SPIN(cond, bar) do { unsigned _sp = 0; while (cond) { __builtin_amdgcn_s_sleep(1); \
    if ((++_sp & 255u) == 0u) { if (xb_ld(&(bar)[XB_TMO])) break; if (_sp > XB_SPIN_CAP) { atomicAdd(&(bar)[XB_TMO], 1u); break; } } } } while (0)
struct XcdBarrier { unsigned* bar; unsigned x; volatile LAS unsigned* st; };
__device__ __forceinline__ XcdBarrier xcd_barrier_post(unsigned* bar, volatile LAS unsigned* st) {
  XcdBarrier b; b.bar = bar; b.x = xb_xcc_id(); b.st = st;
  if (threadIdx.x == 0) (void)xb_add(&bar[XB_XCNT(b.x)], 1u);
  return b;
}
__device__ __forceinline__ void xcd_barrier_complete(unsigned* bar, unsigned x, unsigned& nloc, unsigned& nx) {
  const unsigned G = gridDim.x * gridDim.y * gridDim.z;
  unsigned sum, cnt, mine, sp = 0u;
  for (;;) {
    sum = 0u; cnt = 0u; mine = 0u;
#pragma unroll
    for (unsigned j = 0; j < 16; ++j) { const unsigned c = xb_ld(&bar[XB_XCNT(j)]); sum += c; cnt += (c > 0u) ? 1u : 0u; mine = (j == x) ? c : mine; }
    if (sum == G) break;
    __builtin_amdgcn_s_sleep(1);
    if ((++sp & 255u) == 0u) { if (xb_ld(&bar[XB_TMO])) break; if (sp > XB_SPIN_CAP) { atomicAdd(&bar[XB_TMO], 1u); break; } }
  }
  nloc = mine > 0u ? mine : 1u; nx = cnt > 0u ? cnt : 1u;
}
__device__ __forceinline__ void xcd_barrier(const XcdBarrier& b) {
  asm volatile("s_waitcnt vmcnt(0)" ::: "memory");
  __syncthreads();
  if (threadIdx.x == 0) {
    unsigned* bar = b.bar;
    __builtin_amdgcn_s_waitcnt(0);
    unsigned nloc = b.st[0], nx = b.st[1];
    if (nloc == 0u) { xcd_barrier_complete(bar, b.x, nloc, nx); b.st[0] = nloc; b.st[1] = nx; }
    const unsigned old = xb_add(&bar[XB_XSUB(b.x)], 1u);
    const unsigned gen = old / nloc;
    if (old + 1u == (gen + 1u) * nloc) {
      __builtin_amdgcn_fence(__ATOMIC_RELEASE, "agent");
      asm volatile("s_waitcnt vmcnt(0)" ::: "memory");
      const unsigned og = xb_add(&bar[XB_TOP], 1u);
      const unsigned tg = og / nx;
      if (og + 1u == (tg + 1u) * nx) xb_add(&bar[XB_TOPGEN], 1u);
      else XB_SPIN(xb_ld(&bar[XB_TOPGEN]) == tg, bar);
      __builtin_amdgcn_fence(__ATOMIC_ACQUIRE, "agent");
      xb_add(&bar[XB_XGEN(b.x)], 1u);
      asm volatile("s_waitcnt vmcnt(0)" ::: "memory");
    } else {
      XB_SPIN(xb_ld(&bar[XB_XGEN(b.x)]) == gen, bar);
      __builtin_amdgcn_fence(__ATOMIC_ACQUIRE, "agent");
      asm volatile("s_waitcnt vmcnt(0)" ::: "memory");
    }
  }
  __syncthreads();
}

__device__ __forceinline__ void phase_prep(const Params& p, int bid, int nb, char* smem) {
  const int tid = tid_opaque();
  float* sf = (float*)smem;
  constexpr int N_WIN = 2048, N_WOUT = 512, N_MOD = 192, N_PADI = 1024, N_WL = 768;
  constexpr int total = N_WIN + N_WOUT + N_MOD + N_PADI + N_WL + 1;
  for (int it = bid; it < total; it += nb) {
    if (it < N_WIN + N_WOUT) {
      const float* src; h16* dst; int ncols, kt, ntile;
      if (it < N_WIN) { int l = it >> 10, r = it & 1023; kt = r >> 6; ntile = r & 63; src = p.w_in + (size_t)l * 1024 * 4096; dst = p.win_t + (size_t)l * NPAD * 1024; ncols = 4096; }
      else { int j = it - N_WIN; int l = j >> 8, r = j & 255; kt = r >> 4; ntile = r & 15; src = p.w_out + (size_t)l * 1024 * 1024; dst = p.wout_t + (size_t)l * 1024 * 1024; ncols = 1024; }
      for (int i = tid; i < 4096; i += 256) { int kk = i >> 6, nn = i & 63; sf[kk * 65 + nn] = src[(size_t)(kt * 64 + kk) * ncols + ntile * 64 + nn]; }
      __syncthreads();
      const bool rkperm = it < N_WIN && ntile < 12;
      for (int i = tid; i < 4096; i += 256) {
        int nn = i >> 6, kk = i & 63;
        const int nrow = rkperm ? ((ntile % 6) * 128 + 2 * nn + ntile / 6) : (ntile * 64 + nn);
        dst[(size_t)nrow * 1024 + kt * 64 + kk] = (h16)sf[kk * 65 + nn];
      }
      __syncthreads();
    } else if (it < N_WIN + N_WOUT + N_MOD) {
      const int j = it - N_WIN - N_WOUT; const int l = j / 96; const int cl = tid & 31, ks = tid >> 5; const int col = (j % 96) * 32 + cl;
      for (int i = tid; i < 9 * 1024; i += 256) { int r = i >> 10, k = i & 1023; float v = r < 8 ? p.c[r * 1024 + k] : p.c_ctx[k]; sf[i] = siluf_(v); }
      __syncthreads();
      float acc[9];
#pragma unroll
      for (int r = 0; r < 9; ++r) acc[r] = 0.f;
      const float* mw = p.mod_w + (size_t)l * 1024 * 3072 + (size_t)(ks * 128) * 3072 + col;
#pragma unroll 2
      for (int k = 0; k < 128; k += 4) {
        const float w0 = mw[(size_t)k * 3072], w1 = mw[(size_t)(k + 1) * 3072], w2 = mw[(size_t)(k + 2) * 3072], w3 = mw[(size_t)(k + 3) * 3072];
#pragma unroll
        for (int r = 0; r < 9; ++r) { const f32x4 sv = *(const f32x4*)&sf[r * 1024 + ks * 128 + k]; acc[r] += sv[0] * w0 + sv[1] * w1 + sv[2] * w2 + sv[3] * w3; }
      }
#pragma unroll
      for (int r = 0; r < 9; ++r) acc[r] += __shfl_xor(acc[r], 32);
      __syncthreads();
      if ((tid & 63) < 32) {
#pragma unroll
        for (int r = 0; r < 9; ++r) sf[((tid >> 6) * 9 + r) * 32 + cl] = acc[r];
      }
      __syncthreads();
      for (int i = tid; i < 288; i += 256) {
        const int r = i >> 5, c2 = i & 31;
        const float v = sf[(0 * 9 + r) * 32 + c2] + sf[(1 * 9 + r) * 32 + c2] + sf[(2 * 9 + r) * 32 + c2] + sf[(3 * 9 + r) * 32 + c2];
        const int cc = (j % 96) * 32 + c2;
        p.mod[(size_t)(l * 9 + r) * 3072 + cc] = v + p.mod_b[l * 3072 + cc];
      }
      __syncthreads();
    } else if (it < N_WIN + N_WOUT + N_MOD + N_PADI) {
      int j = it - (N_WIN + N_WOUT + N_MOD); int idx = j * 256 + tid;
      int l = idx >> 17; int rem = idx & 131071; int m = rem >> 10, k = rem & 1023;
      float v = (l == 1 && m < 32) ? p.vw1[k * 32 + m] : 0.f;
      p.win_t[(size_t)l * NPAD * 1024 + (size_t)(4096 + m) * 1024 + k] = (h16)v;
    } else if (it < N_WIN + N_WOUT + N_MOD + N_PADI + N_WL) {
      const int idx = (it - (N_WIN + N_WOUT + N_MOD + N_PADI)) * 256 + tid;
      const int r = idx & 63, c = (idx >> 6) % 384, ls = idx / (384 * 64); const int l = ls >> 2, slot = ls & 3, dir = slot & 1, kind = slot >> 1;
      const float v = (kind == 0 ? p.w2 : p.a2)[((size_t)(l * 2 + dir) * 64 + r) * 384 + c];
      p.wl_t[idx] = (h16)v;
    } else {
      if (tid < 16) {
        double inv = 1.0; for (int i = 0; i < tid; ++i) inv *= 0.5623413251903491;
        double x2 = inv * inv, ts = inv, tc = 1.0, s1 = inv, c1 = 1.0;
        for (int n = 1; n <= 10; ++n) { tc *= -x2 / ((2.0 * n - 1.0) * (2.0 * n)); c1 += tc; ts *= -x2 / ((2.0 * n) * (2.0 * n + 1.0)); s1 += ts; }
        double cc = 1.0, ss = 0.0;
        for (int pos = 0; pos < 64; ++pos) {
          p.rope[(pos * 16 + tid) * 2] = (float)cc; p.rope[(pos * 16 + tid) * 2 + 1] = (float)ss;
          double nc = cc * c1 - ss * s1, ns = ss * c1 + cc * s1; cc = nc; ss = ns;
        }
      }
    }
  }
}

__device__ __forceinline__ void phase_norm(const Params& p, int l, int bid, int nb) {
  const int tid = tid_opaque(), lane = tid & 63, w = __builtin_amdgcn_readfirstlane(tid >> 6);
  for (int row = bid * 4 + w; row < NTOK; row += nb * 4) {
    const float* src = (l == 0) ? (row < NLAT ? p.x + (size_t)row * 1024 : p.ctx + (size_t)(row - NLAT) * 1024)
                                : (row < NLAT ? p.out + (size_t)row * 1024 : p.xc1 + (size_t)(row - NLAT) * 1024);
    const int mr = row < NLAT ? (row >> 12) : 8;
    const float* md = p.mod + (size_t)(l * 9 + mr) * 3072;
    const float* nw = p.norm_w + l * 1024;
    f32x4 v[4]; float ss = 0.f;
#pragma unroll
    for (int i = 0; i < 4; ++i) { v[i] = *(const f32x4*)(src + i * 256 + lane * 4); ss += v[i][0] * v[i][0] + v[i][1] * v[i][1] + v[i][2] * v[i][2] + v[i][3] * v[i][3]; }
    ss = wave_sum_dpp(ss);
    const float rs = rsqrtf(ss * (1.f / 1024.f) + 1e-6f);
#pragma unroll
    for (int i = 0; i < 4; ++i) {
      const int col = i * 256 + lane * 4;
      f32x4 nwv = *(const f32x4*)(nw + col), sc = *(const f32x4*)(md + 1024 + col), sh = *(const f32x4*)(md + col);
      half4 o;
#pragma unroll
      for (int j = 0; j < 4; ++j) o[j] = (h16)(v[i][j] * rs * nwv[j] * (1.f + sc[j]) + sh[j]);
      *(half4*)(p.hy + (size_t)row * 1024 + col) = o;
    }
  }
}

template <int MODE>
__device__ __forceinline__ void phase_gemm(const Params& p, int l, int bid, int nb, char* smem) {
  const h16* A = p.hy;
  const h16* Bt = MODE == 0 ? p.win_t + (size_t)l * NPAD * 1024 : p.wout_t + (size_t)l * 1024 * 1024;
  const int ntn = MODE == 0 ? (l == 1 ? 33 : 32) : 8;
  const int ntm = (MODE == 1 && l == 1) ? 256 : 272;
  const int tid = tid_opaque(), lane = tid & 63, w = __builtin_amdgcn_readfirstlane(tid >> 6), wr = w >> 1, wc = w & 1, lq = lane & 31, hh = lane >> 5;
  h16* As = (h16*)smem; h16* Bs = As + 128 * 72;
  const int ldrow = tid >> 3, ldch = (tid & 7) * 8;
  for (int tile = bid; tile < ntm * ntn; tile += nb) {
    int tm, tn;
    {
      const int mper = ntm >> 3;
      const int nmain = MODE == 0 ? 32 : 8;
      if (tile < ntm * nmain) {
        const int x = tile & 7, sq = tile >> 3;
        const int strip = sq / (mper * 8), rem = sq - strip * (mper * 8);
        tm = x * mper + (rem >> 3); tn = strip * 8 + (rem & 7);
      } else { tm = tile - ntm * nmain; tn = nmain; }
    }
    const h16* Ag = A + (size_t)(tm * 128 + ldrow) * 1024 + ldch; const h16* Bg = Bt + (size_t)(tn * 128 + ldrow) * 1024 + ldch;
    f32x16 acc[2][2];
#pragma unroll
    for (int i = 0; i < 2; ++i)
#pragma unroll
      for (int j = 0; j < 2; ++j)
#pragma unroll
        for (int r = 0; r < 16; ++r) acc[i][j][r] = 0.f;
    u32x4 ra[4], rb[4];
#pragma unroll
    for (int i = 0; i < 4; ++i) { ra[i] = *(const u32x4*)(Ag + (size_t)i * 32 * 1024); rb[i] = *(const u32x4*)(Bg + (size_t)i * 32 * 1024); }
#pragma unroll 2
    for (int kt = 0; kt < 16; ++kt) {
      __syncthreads();
#pragma unroll
      for (int i = 0; i < 4; ++i) { *(u32x4*)(As + (ldrow + i * 32) * 72 + ldch) = ra[i]; *(u32x4*)(Bs + (ldrow + i * 32) * 72 + ldch) = rb[i]; }
      __syncthreads();
      if (kt + 1 < 16) {
#pragma unroll
        for (int i = 0; i < 4; ++i) { ra[i] = *(const u32x4*)(Ag + (size_t)i * 32 * 1024 + (kt + 1) * 64); rb[i] = *(const u32x4*)(Bg + (size_t)i * 32 * 1024 + (kt + 1) * 64); }
      }
#pragma unroll
      for (int s = 0; s < 4; ++s) {
        half8 a[2], b[2];
#pragma unroll
        for (int i = 0; i < 2; ++i) { a[i] = *(const half8*)(As + (64 * wr + 32 * i + lq) * 72 + 16 * s + 8 * hh); b[i] = *(const half8*)(Bs + (64 * wc + 32 * i + lq) * 72 + 16 * s + 8 * hh); }
#pragma unroll
        for (int i = 0; i < 2; ++i)
#pragma unroll
          for (int j = 0; j < 2; ++j) {
            if (MODE == 0) acc[i][j] = __builtin_amdgcn_mfma_f32_32x32x16_f16(b[j], a[i], acc[i][j], 0, 0, 0);
            else acc[i][j] = __builtin_amdgcn_mfma_f32_32x32x16_f16(a[i], b[j], acc[i][j], 0, 0, 0);
          }
      }
    }
    if (MODE == 0) {
      if (tn < 32) {
        __syncthreads();
        h16* Cs = (h16*)smem;
#pragma unroll
        for (int i = 0; i < 2; ++i)
#pragma unroll
          for (int j = 0; j < 2; ++j)
#pragma unroll
            for (int g = 0; g < 4; ++g) {
              half4 o;
#pragma unroll
              for (int q = 0; q < 4; ++q) o[q] = (h16)acc[i][j][4 * g + q];
              *(half4*)(Cs + (64 * wr + 32 * i + lq) * 136 + 64 * wc + 32 * j + 8 * g + 4 * hh) = o;
            }
        __syncthreads();
#pragma unroll
        for (int q = 0; q < 8; ++q) {
          const int id = tid + q * 256; const int row = id >> 4, ch = id & 15;
          *(u32x4*)(p.P + (size_t)(tm * 128 + row) * PC + tn * 128 + ch * 8) = *(const u32x4*)(Cs + row * 136 + ch * 8);
        }
      } else if (wc == 0) {
#pragma unroll
        for (int i = 0; i < 2; ++i)
#pragma unroll
          for (int r = 0; r < 16; ++r) ((float*)(p.F + (size_t)(tm * 128 + 64 * wr + 32 * i + lq) * 1536))[(r & 3) + 8 * (r >> 2) + 4 * hh] = acc[i][0][r];
      }
    } else {
      const int row0 = tm * 128;
      const int mr = row0 < NLAT ? (row0 >> 12) : 8;
      const int col = tn * 128 + 64 * wc + lq;
      const float* gp = p.mod + (size_t)(l * 9 + mr) * 3072 + 2048 + col;
      const float g0 = gp[0], g1 = gp[32];
      const float* xs0; float* xd0;
      if (l == 0) { if (row0 < NLAT) { xs0 = p.x + (size_t)row0 * 1024; xd0 = p.out + (size_t)row0 * 1024; } else { xs0 = p.ctx + (size_t)(row0 - NLAT) * 1024; xd0 = p.xc1 + (size_t)(row0 - NLAT) * 1024; } }
      else { xs0 = p.out + (size_t)row0 * 1024; xd0 = p.out + (size_t)row0 * 1024; }
      const float* __restrict__ xsrc = xs0 + (size_t)(64 * wr + 4 * hh) * 1024 + col;
      float* __restrict__ xdst = xd0 + (size_t)(64 * wr + 4 * hh) * 1024 + col;
#pragma unroll
      for (int i = 0; i < 2; ++i)
#pragma unroll
        for (int r = 0; r < 16; ++r) {
          const int ro = (32 * i + (r & 3) + 8 * (r >> 2)) * 1024;
          xdst[ro] = xsrc[ro] + g0 * acc[i][0][r];
          xdst[ro + 32] = xsrc[ro + 32] + g1 * acc[i][1][r];
        }
    }
  }
}

#define LOAD_COL34(arr, base, t0, Tn) \
  _Pragma("unroll") for (int q_ = 0; q_ < 34; ++q_) { const int t_ = (t0) - 1 + q_; arr[q_] = (t_ >= 0 && t_ < (Tn)) ? (base)[(long)t_ * PC] : (h16)0.f; }

__device__ __forceinline__ void phase_feat(const Params& p, int l, int bid, int nb, char* smem, bool dry) {
  const int tid = tid_opaque();
  h16* inh = (h16*)smem;
  float* zt = (float*)(smem + 32 * 264 * 2);
  for (int item = bid; item < 1088; item += nb) {
    int b, t0, Tn, rowbase; bool isctx;
    if (item < 1024) { b = item >> 7; t0 = (item & 127) * 32; Tn = 4096; rowbase = b * 4096; isctx = false; }
    else { int j = item - 1024; b = j >> 3; t0 = (j & 7) * 32; Tn = 256; rowbase = NLAT + b * 256; isctx = true; }
    {
      const int col = 1152 + tid;
      const float mp = p.mu_prev[l * 1792 + col], mn = p.mu_next[l * 1792 + col];
      const h16* base = p.P + (size_t)rowbase * PC + col;
      h16 xv[34];
      LOAD_COL34(xv, base, t0, Tn)
#pragma unroll
      for (int tt = 0; tt < 32; ++tt) {
        const float prev = (float)xv[tt], cur = (float)xv[tt + 1], nxt = (float)xv[tt + 2];
        float sv = cur + mp * (prev - cur) + mn * (nxt - cur);
        if (tid < 128) { const float e2 = __expf(2.f * sv); sv = 1.f - 2.f / (e2 + 1.f); }
        inh[tt * 264 + tid] = (h16)sv;
      }
      if (l == 1) {
#pragma unroll
        for (int i = 0; i < 4; ++i) { int id = tid + i * 256; zt[id] = ((const float*)(p.F + (size_t)(rowbase + t0 + (id >> 5)) * 1536))[id & 31]; }
      }
    }
    __syncthreads();
#pragma unroll 1
    for (int c = tid; c < 384; c += 256) {
      const int col = 768 + c;
      const float mp = p.mu_prev[l * 1792 + col], mn = p.mu_next[l * 1792 + col];
      const h16* base = p.P + (size_t)rowbase * PC + col;
      h16 xv[34];
      LOAD_COL34(xv, base, t0, Tn)
      h16* dst = p.VB + (size_t)(rowbase + t0) * 384 + c;
      if (l == 0) {
#pragma unroll
        for (int tt = 0; tt < 32; ++tt) {
          const float prev = (float)xv[tt], cur = (float)xv[tt + 1], nxt = (float)xv[tt + 2];
          dst[tt * 384] = (h16)(cur + mp * (prev - cur) + mn * (nxt - cur));
        }
      } else {
        const float vbv = p.vb[c];
#pragma unroll 1
        for (int hf = 0; hf < 2; ++hf) {
          h16 vfv[16]; float ga[16];
#pragma unroll
          for (int tt = 0; tt < 16; ++tt) { vfv[tt] = dst[(hf * 16 + tt) * 384]; ga[tt] = vbv; }
#pragma unroll 1
          for (int m = 0; m < 32; m += 4) {
            const float w0 = p.vw2[m * 384 + c], w1 = p.vw2[(m + 1) * 384 + c], w2 = p.vw2[(m + 2) * 384 + c], w3 = p.vw2[(m + 3) * 384 + c];
#pragma unroll
            for (int tt = 0; tt < 16; ++tt) { const f32x4 z = *(const f32x4*)&zt[(hf * 16 + tt) * 32 + m]; ga[tt] += z[0] * w0 + z[1] * w1 + z[2] * w2 + z[3] * w3; }
          }
#pragma unroll
          for (int tt = 0; tt < 16; ++tt) {
            const float prev = hf ? (float)xv[16 + tt] : (float)xv[tt], cur = hf ? (float)xv[17 + tt] : (float)xv[tt + 1], nxt = hf ? (float)xv[18 + tt] : (float)xv[tt + 2];
            const float sv = cur + mp * (prev - cur) + mn * (nxt - cur);
            dst[(hf * 16 + tt) * 384] = (h16)(sv + ((float)vfv[tt] - sv) * sigmoidf_(ga[tt]));
          }
        }
      }
    }
    {
      const int w = __builtin_amdgcn_readfirstlane(tid >> 6), lane = tid & 63, lq = tid & 31, hh = lane >> 5;
      const int dir = w & 1, chalf = w >> 1;
      half8 xin[2][4];
#pragma unroll
      for (int kind = 0; kind < 2; ++kind)
#pragma unroll
        for (int ks = 0; ks < 4; ++ks) xin[kind][ks] = *(const half8*)(inh + lq * 264 + kind * 128 + dir * 64 + 16 * ks + 8 * hh);
      h16* ost = (h16*)(smem + 32 * 264 * 2 + 4096) + w * (32 * 72);
      h16* fbase = p.F + (size_t)(rowbase + t0) * 1536 + dir * 768 + chalf * 384;
#pragma unroll 1
      for (int np = 0; np < 6; ++np) {
        const int c0 = chalf * 192 + np * 32;
        f32x16 acc[2];
#pragma unroll
        for (int kind = 0; kind < 2; ++kind) {
          const float* bias = (kind == 0 ? p.w0 : p.a0) + (l * 2 + dir) * 384 + c0;
          const h16* wl = p.wl_t + (size_t)((l * 4 + kind * 2 + dir) * 384 + c0) * 64;
#pragma unroll
          for (int g = 0; g < 4; ++g) { const f32x4 bv = *(const f32x4*)(bias + 8 * g + 4 * hh); acc[kind][4 * g] = bv[0]; acc[kind][4 * g + 1] = bv[1]; acc[kind][4 * g + 2] = bv[2]; acc[kind][4 * g + 3] = bv[3]; }
#pragma unroll
          for (int ks = 0; ks < 4; ++ks) {
            const half8 wf = *(const half8*)(wl + (size_t)lq * 64 + 16 * ks + 8 * hh);
            acc[kind] = __builtin_amdgcn_mfma_f32_32x32x16_f16(wf, xin[kind][ks], acc[kind], 0, 0, 0);
          }
        }
#pragma unroll
        for (int g = 0; g < 4; ++g) {
          half8 o;
#pragma unroll
          for (int j = 0; j < 4; ++j) { o[2 * j] = (h16)(1.f - __expf(-0.6065306597126334f * sigmoidf_(acc[0][4 * g + j]))); o[2 * j + 1] = (h16)sigmoidf_(acc[1][4 * g + j]); }
          *(half8*)(ost + lq * 72 + 16 * g + 8 * hh) = o;
        }
        asm volatile("s_waitcnt lgkmcnt(0)" ::: "memory");
#pragma unroll
        for (int q = 0; q < 4; ++q) {
          const int id = lane + q * 64; const int rr = id >> 3, ch = id & 7;
          *(u32x4*)(fbase + (size_t)rr * 1536 + np * 64 + ch * 8) = *(const u32x4*)(ost + rr * 72 + ch * 8);
        }
        asm volatile("s_waitcnt lgkmcnt(0)" ::: "memory");
      }
    }
    {
      const int head = tid >> 5, pr = tid & 31, half = pr >> 4, i = pr & 15;
      const int colbase = head < 6 ? 3072 + head * 64 : 3456 + (head - 6) * 64;
      const int d1 = half * 32 + i;
      const float qs = (head < 6 && !dry) ? 0.125f : 1.f;
      h16* pp = p.P + (size_t)(rowbase + t0) * PC + colbase + d1;
      h16 x1[32], x2[32];
#pragma unroll
      for (int u = 0; u < 32; ++u) { x1[u] = pp[(size_t)u * PC]; x2[u] = pp[(size_t)u * PC + 16]; }
#pragma unroll
      for (int u = 0; u < 32; ++u) {
        const int t = t0 + u;
        float cs = 1.f, sn = 0.f;
        if (!isctx && !dry) { const int pos = half == 0 ? (t >> 6) : (t & 63); const f32x2 r2 = *(const f32x2*)&p.rope[(pos * 16 + i) * 2]; cs = r2[0]; sn = r2[1]; }
        const float a = (float)x1[u], bq = (float)x2[u];
        pp[(size_t)u * PC] = (h16)((a * cs - bq * sn) * qs);
        pp[(size_t)u * PC + 16] = (h16)((a * sn + bq * cs) * qs);
      }
    }
    if (tid < 128) {
      const int g = tid >> 6, d = tid & 63;
      const h16* base = p.P + (size_t)(rowbase + t0) * PC + 3584 + tid;
      h16* dst = p.VT + (size_t)((b * 2 + g) * 64 + d) * VTS + (isctx ? 4096 + t0 : t0);
      half8 v[4];
#pragma unroll
      for (int q = 0; q < 4; ++q)
#pragma unroll
        for (int j = 0; j < 8; ++j) v[q][j] = base[(size_t)(q * 8 + j) * PC];
#pragma unroll
      for (int q = 0; q < 4; ++q) *(half8*)(dst + q * 8) = v[q];
    }
    __syncthreads();
  }
}

__device__ __forceinline__ float ulo(unsigned u) { return (float)__builtin_bit_cast(h16, (unsigned short)(u & 0xffffu)); }
__device__ __forceinline__ float uhi(unsigned u) { return (float)__builtin_bit_cast(h16, (unsigned short)(u >> 16)); }
__device__ __forceinline__ float red16(float x) {
  x += dpp_mov<0xB1>(x);
  x += dpp_mov<0x4E>(x);
  x += dpp_mov<0x141>(x);
  x += dpp_mov<0x140>(x);
  return x;
}
#define LDS_BARRIER() do { asm volatile("s_waitcnt lgkmcnt(0)" ::: "memory"); __builtin_amdgcn_s_barrier(); asm volatile("" ::: "memory"); } while (0)
constexpr int RREC = 336;
struct RwkvPf { unsigned rk[10]; h16 v[8]; unsigned ea[8]; };

__device__ __forceinline__ void rwkv_chain(const Params& p, int l, int item, char* smem) {
  const int tid0 = tid_opaque();
  const int tid = (item >= 256) ? (tid0 ^ 128) : tid0;
  const int lane = tid & 63, w = __builtin_amdgcn_readfirstlane(tid >> 6);
  const int chain = item >> 2, vq = item & 3;
  const int dir = chain / 48, b = (chain % 48) / 6, h = chain % 6;
  float* opb = (float*)smem;
  float* ybuf = opb + 2 * 16 * RREC;
  constexpr int NCH = 272;
  if (w < 2) {
    const int rl = tid >> 3, kq = tid & 7;
    float S[8];
#pragma unroll
    for (int j = 0; j < 8; ++j) S[j] = 0.f;
    __builtin_amdgcn_s_setprio(3);
    LDS_BARRIER();
#pragma unroll 1
    for (int ci = 0; ci < NCH; ++ci) {
      const float* op = opb + (ci & 1) * 16 * RREC;
      float* yb = ybuf + (ci & 1) * 256;
      f32x4 aA = *(const f32x4*)(op + 8 * kq + 64), aB = *(const f32x4*)(op + 8 * kq + 68);
#pragma unroll
      for (int step = 0; step < 16; ++step) {
        const float* o = op + step * RREC + 8 * kq;
        const f32x4 wA = *(const f32x4*)(o), wB = *(const f32x4*)(o + 4);
        const f32x4 bA = *(const f32x4*)(o + 128), bB = *(const f32x4*)(o + 132);
        const f32x4 kA = *(const f32x4*)(o + 192), kB = *(const f32x4*)(o + 196);
        const f32x4 rA = *(const f32x4*)(o + 256), rB = *(const f32x4*)(o + 260);
        const float vv = op[step * RREC + 320 + rl];
        f32x4 naA = aA, naB = aB;
        if (step + 1 < 16) { naA = *(const f32x4*)(o + RREC + 64); naB = *(const f32x4*)(o + RREC + 68); }
        const float d0 = S[0] * aA[0] + S[1] * aA[1] + S[2] * aA[2] + S[3] * aA[3];
        const float d1 = S[4] * aB[0] + S[5] * aB[1] + S[6] * aB[2] + S[7] * aB[3];
        const float sa = red8(d0 + d1);
#pragma unroll
        for (int j = 0; j < 4; ++j) {
          S[j] = S[j] * wA[j] + sa * bA[j] + vv * kA[j];
          S[4 + j] = S[4 + j] * wB[j] + sa * bB[j] + vv * kB[j];
        }
        const float y0 = S[0] * rA[0] + S[1] * rA[1] + S[2] * rA[2] + S[3] * rA[3];
        const float y1 = S[4] * rB[0] + S[5] * rB[1] + S[6] * rB[2] + S[7] * rB[3];
        const float yy = red8(y0 + y1);
        if (kq == 0) yb[step * 16 + rl] = yy;
        aA = naA; aB = naB;
      }
      LDS_BARRIER();
    }
    __builtin_amdgcn_s_setprio(0);
  } else {
    const int lw = w - 2, lt = tid - 128;
    const int hc = h * 64 + lane;
    const float mpr = p.mu_prev[l * 1792 + hc], mnr = p.mu_next[l * 1792 + hc];
    const float mpk = p.mu_prev[l * 1792 + 384 + hc], mnk = p.mu_next[l * 1792 + 384 + hc];
    const float kkw = p.k_k[l * 384 + hc], kaw = p.k_a[l * 384 + hc];
    const float cAr = dir ? mnr : mpr, cBr = dir ? mpr : mnr, cAk = dir ? mnk : mpk, cBk = dir ? mpk : mnk;
    const unsigned* zrow = p.bar + XCD_BAR_WORDS;
    RwkvPf pfA, pfB;
#define RWKV_ISSUE(ci_, PF) { const int seg_ = (ci_) >= 16; const int Tn_ = seg_ ? 4096 : 256; const int rb_ = seg_ ? b * 4096 : NLAT + b * 256; const int s0_ = (seg_ ? (ci_) - 16 : (ci_)) * 16 + 8 * lw; \
    _Pragma("unroll") for (int q = 0; q < 10; ++q) { const int t_ = dir == 0 ? s0_ - 1 + q : Tn_ - s0_ - q; \
      const unsigned* src_ = ((unsigned)t_ < (unsigned)Tn_) ? (const unsigned*)(p.P + (size_t)(rb_ + t_) * PC + h * 128) : zrow; \
      PF.rk[q] = src_[lane]; } \
    _Pragma("unroll") for (int i = 0; i < 8; ++i) { const int t_ = dir == 0 ? s0_ + i : Tn_ - 1 - (s0_ + i); const size_t row = (size_t)rb_ + t_; \
      PF.v[i] = p.VB[row * 384 + hc]; PF.ea[i] = ((const unsigned*)(p.F + row * 1536 + dir * 768))[hc]; } }
#define RWKV_STAGE(ci_, PF) { float* op_ = opb + ((ci_) & 1) * 16 * RREC; \
    const int seg = (ci_) >= 16; const int Tn = seg ? 4096 : 256; const int c0 = (seg ? (ci_) - 16 : (ci_)) * 16; \
    _Pragma("unroll") for (int i = 0; i < 8; ++i) { \
      const int step = lw * 8 + i; const int t = dir == 0 ? c0 + step : Tn - 1 - (c0 + step); \
      const float rlo = ulo(PF.rk[i]), r0 = ulo(PF.rk[i + 1]), rhi = ulo(PF.rk[i + 2]); \
      const float klo = uhi(PF.rk[i]), k0 = uhi(PF.rk[i + 1]), khi = uhi(PF.rk[i + 2]); \
      const float vv = (float)PF.v[i], e = ulo(PF.ea[i]), al = uhi(PF.ea[i]); \
      const float rs = r0 + cAr * (rlo - r0) + cBr * (rhi - r0); \
      const float ks = k0 + cAk * (klo - k0) + cBk * (khi - k0); \
      const float kkr = ks * kkw; \
      const float n2 = wave_sum_dpp(kkr * kkr); \
      const float kk = kkr * rsqrtf(fmaxf(n2, 1e-24f)); \
      float* o = op_ + step * RREC + lane; \
      o[0] = 1.f - e; o[64] = -kk; o[128] = kk * al; o[192] = ks * (1.f + (al - 1.f) * kaw); o[256] = rs; \
      if ((lane >> 4) == vq) op_[step * RREC + 320 + (lane & 15)] = vv; } }
#define RWKV_WRITE(cj_) { const int seg = (cj_) >= 16; const int Tn = seg ? 4096 : 256; const int rowbase = seg ? b * 4096 : NLAT + b * 256; const int c0 = (seg ? (cj_) - 16 : (cj_)) * 16; \
    if (seg == 1 || l == 0) { const float* yb = ybuf + ((cj_) & 1) * 256; \
      _Pragma("unroll") for (int i = 0; i < 2; ++i) { const int idx = lt + i * 128; const int step = idx >> 4, ch = idx & 15; \
        const int t = dir == 0 ? c0 + step : Tn - 1 - (c0 + step); \
        const h16 yv = (h16)yb[idx]; \
        if (dir == 0) p.P[(size_t)(rowbase + t) * PC + 768 + h * 64 + 16 * vq + ch] = yv; \
        else p.hy[(size_t)(rowbase + t) * 1024 + h * 64 + 16 * vq + ch] = yv; } } }
    RWKV_ISSUE(0, pfA)
    RWKV_STAGE(0, pfA)
    RWKV_ISSUE(1, pfB)
    RWKV_ISSUE(2, pfA)
    LDS_BARRIER();
#pragma unroll 1
    for (int ci = 0; ci < NCH; ci += 2) {
      if (ci + 1 < NCH) RWKV_STAGE(ci + 1, pfB)
      if (ci + 3 < NCH) RWKV_ISSUE(ci + 3, pfB)
      if (ci >= 1) RWKV_WRITE(ci - 1)
      LDS_BARRIER();
      if (ci + 2 < NCH) RWKV_STAGE(ci + 2, pfA)
      if (ci + 4 < NCH) RWKV_ISSUE(ci + 4, pfA)
      RWKV_WRITE(ci)
      LDS_BARRIER();
    }
    RWKV_WRITE(NCH - 1)
  }
}

constexpr int HREC = 224;
struct HgrnPf { h16 f[4], q[4], iv[4]; };
__device__ __forceinline__ void hgrn_chain(const Params& p, int l, int item, char* smem) {
  const int tid = tid_opaque(), lane = tid & 63, w = __builtin_amdgcn_readfirstlane(tid >> 6);
  const int chain = item >> 1, vh = item & 1;
  const int dir = chain / 32, b = (chain % 32) / 4, h = chain % 4;
  float* op = (float*)smem;
  float* ybuf = op + 16 * HREC;
  const int hc = h * 64 + lane;
  float lb = 0.f;
  if (l == 1) lb = sigmoidf_(p.lb_logits[(dir * 2 + 1) * 256 + hc] - p.lb_logits[(dir * 2 + 0) * 256 + hc]);
  const int fcol = 1792 + 256 * (1 + dir) + hc;
  const int vc = tid >> 3, kq = tid & 7;
  float S[8];
#pragma unroll
  for (int j = 0; j < 8; ++j) S[j] = 0.f;
  HgrnPf pfA, pfB;
#define HGRN_ISSUE(ci_, PF) { const int seg_ = (ci_) >= 16; const int Tn_ = seg_ ? 4096 : 256; const int rb_ = seg_ ? b * 4096 : NLAT + b * 256; const int c0_ = (seg_ ? (ci_) - 16 : (ci_)) * 16; \
    _Pragma("unroll") for (int i = 0; i < 4; ++i) { const int step = w * 4 + i; const int t = dir == 0 ? c0_ + step : Tn_ - 1 - (c0_ + step); const h16* pr = p.P + ((size_t)rb_ + t) * PC; \
      PF.f[i] = pr[fcol]; PF.q[i] = pr[1792 + hc]; PF.iv[i] = pr[1792 + 768 + hc]; } }
#define HGRN_CHUNK(ci_, PF) { \
    const int seg = (ci_) >= 16; const int Tn = seg ? 4096 : 256; const int rowbase = seg ? b * 4096 : NLAT + b * 256; const int c0 = (seg ? (ci_) - 16 : (ci_)) * 16; \
    _Pragma("unroll") for (int i = 0; i < 4; ++i) { \
      const int step = w * 4 + i; \
      float* o = op + step * HREC + lane; \
      const float f = lb + (1.f - lb) * sigmoidf_((float)PF.f[i]); \
      o[0] = f; o[128] = (float)PF.q[i]; \
      if ((lane >> 5) == vh) op[step * HREC + 192 + (lane & 31)] = (float)PF.iv[i]; } \
    LDS_BARRIER(); \
    if ((ci_) + 2 < 272) HGRN_ISSUE((ci_) + 2, PF) \
    _Pragma("unroll") for (int step = 0; step < 16; ++step) { \
      const float* o = op + step * HREC + 8 * kq; \
      const f32x4 fA = *(const f32x4*)(o), fB = *(const f32x4*)(o + 4); \
      const f32x4 qA = *(const f32x4*)(o + 128), qB = *(const f32x4*)(o + 132); \
      const float iv = op[step * HREC + 192 + vc]; \
      const float f[8] = {fA[0], fA[1], fA[2], fA[3], fB[0], fB[1], fB[2], fB[3]}; \
      const float q[8] = {qA[0], qA[1], qA[2], qA[3], qB[0], qB[1], qB[2], qB[3]}; \
      float acc = 0.f; \
      _Pragma("unroll") for (int j = 0; j < 8; ++j) { S[j] = f[j] * (S[j] - iv) + iv; acc += S[j] * q[j]; } \
      ybuf[step * 256 + tid] = acc; } \
    LDS_BARRIER(); \
    if (seg == 1 || l == 0) { \
      _Pragma("unroll") for (int i = 0; i < 2; ++i) { \
        const int idx = tid + i * 256; const int step = idx >> 5, ch = idx & 31; \
        const int t = dir == 0 ? c0 + step : Tn - 1 - (c0 + step); \
        const float* yb = ybuf + step * 256 + ch * 8; \
        const f32x4 y0 = *(const f32x4*)(yb), y1 = *(const f32x4*)(yb + 4); \
        const f32x4 ys = y0 + y1; \
        const h16 ov = (h16)((ys[0] + ys[1]) + (ys[2] + ys[3])); \
        if (dir == 0) p.P[(size_t)(rowbase + t) * PC + 1152 + h * 64 + 32 * vh + ch] = ov; \
        else p.hy[(size_t)(rowbase + t) * 1024 + 384 + h * 64 + 32 * vh + ch] = ov; } } }
  HGRN_ISSUE(0, pfA)
  HGRN_ISSUE(1, pfB)
  __builtin_amdgcn_s_setprio(2);
#pragma unroll 1
  for (int ci = 0; ci < 272; ci += 2) {
    HGRN_CHUNK(ci, pfA)
    HGRN_CHUNK(ci + 1, pfB)
  }
  __builtin_amdgcn_s_setprio(0);
}

__device__ __forceinline__ void attn_unit(const Params& p, int l, int u) {
  const int tid = tid_opaque(), lane = tid & 63, w = __builtin_amdgcn_readfirstlane(tid >> 6), lq = lane & 31, hh = lane >> 5;
  int b, head, qrow_base, qpos0; bool isctx;
  if (u < 1536) { b = u / 192; int rem = u % 192; int blk = rem / 6; head = rem % 6; qpos0 = blk * 128 + w * 32; qrow_base = b * 4096; isctx = false; }
  else { int j = u - 1536; b = j / 12; int rem = j % 12; int qb = rem / 6; head = rem % 6; qpos0 = qb * 128 + w * 32; qrow_base = NLAT + b * 256; isctx = true; }
  const int g = head / 3;
  const size_t qrow = (size_t)qrow_base + qpos0 + lq;
  half8 qf[4];
#pragma unroll
  for (int s = 0; s < 4; ++s) qf[s] = *(const half8*)(p.P + qrow * PC + 3072 + head * 64 + 16 * s + 8 * hh);
  const float sinkv = p.sink[l * 6 + head];
  float m = sinkv, lsum = hh == 0 ? 1.f : 0.f;
  f32x16 O[2];
#pragma unroll
  for (int r = 0; r < 16; ++r) { O[0][r] = 0.f; O[1][r] = 0.f; }
  const h16* vt = p.VT + (size_t)((b * 2 + g) * 64) * VTS;
  int nband = 0, kstart = 0;
  if (!isctx) { kstart = max(0, qpos0 - 128); const int kend = min(4096, qpos0 + 160); nband = (kend - kstart) >> 5; }
  const int ntiles = nband + 8;
  for (int ti = 0; ti < ntiles; ++ti) {
    const bool band = ti < nband;
    const int kt = band ? kstart + ti * 32 : (ti - nband) * 32;
    const size_t krow = band ? (size_t)b * 4096 + kt + lq : (size_t)NLAT + b * 256 + kt + lq;
    const int vidx = band ? kt : 4096 + kt;
    const h16* kp = p.P + krow * PC + 3456 + g * 64 + 8 * hh;
    f32x16 sacc;
#pragma unroll
    for (int r = 0; r < 16; ++r) sacc[r] = 0.f;
#pragma unroll
    for (int s = 0; s < 4; ++s) { half8 kf = *(const half8*)(kp + 16 * s); sacc = __builtin_amdgcn_mfma_f32_32x32x16_f16(kf, qf[s], sacc, 0, 0, 0); }
    float mx = -INFINITY;
#pragma unroll
    for (int r = 0; r < 16; ++r) {
      float sv = sacc[r];
      if (band) { const int dlt = kt + (r & 3) + 8 * (r >> 2) + 4 * hh - (qpos0 + lq); if (dlt > 128 || dlt < -128) sv = -INFINITY; }
      sacc[r] = sv; mx = fmaxf(mx, sv);
    }
    mx = fmaxf(mx, __shfl_xor(mx, 32));
    const float mn = fmaxf(m, mx); const float corr = __expf(m - mn); m = mn;
    float ps = 0.f; half8 pb[2];
#pragma unroll
    for (int r = 0; r < 16; ++r) { const float pv = __expf(sacc[r] - mn); ps += pv; pb[r >> 3][r & 7] = (h16)pv; }
    lsum = lsum * corr + ps;
#pragma unroll
    for (int r = 0; r < 16; ++r) { O[0][r] *= corr; O[1][r] *= corr; }
#pragma unroll
    for (int s2 = 0; s2 < 2; ++s2)
#pragma unroll
      for (int dt = 0; dt < 2; ++dt) {
        const h16* vp = vt + (size_t)(dt * 32 + lq) * VTS + vidx + 16 * s2 + 4 * hh;
        const half4 lo = *(const half4*)vp, hi = *(const half4*)(vp + 8);
        const half8 vf = {lo[0], lo[1], lo[2], lo[3], hi[0], hi[1], hi[2], hi[3]};
        O[dt] = __builtin_amdgcn_mfma_f32_32x32x16_f16(vf, pb[s2], O[dt], 0, 0, 0);
      }
  }
  lsum += __shfl_xor(lsum, 32);
  const float inv = 1.f / lsum;
#pragma unroll
  for (int dt = 0; dt < 2; ++dt)
#pragma unroll
    for (int g4 = 0; g4 < 4; ++g4) {
      const int d0 = dt * 32 + 8 * g4 + 4 * hh;
      const half4 ga = *(const half4*)(p.P + qrow * PC + 3712 + head * 64 + d0);
      half4 o;
#pragma unroll
      for (int j = 0; j < 4; ++j) { const float gv = (float)ga[j]; o[j] = (h16)(O[dt][g4 * 4 + j] * inv * siluf_(gv)); }
      *(half4*)(p.hy + qrow * 1024 + 640 + head * 64 + d0) = o;
    }
}

__device__ __forceinline__ void phase_mix(const Params& p, int l, int bid, int nb, char* smem, int sub) {
  const int nunits = l == 0 ? 1536 + 96 : 1536;
  if (nb >= 640) {
    if (bid < 384) { if (sub & 1) rwkv_chain(p, l, bid, smem); }
    else if (bid < 512) { if (sub & 2) hgrn_chain(p, l, bid - 384, smem); }
    else if (sub & 4) for (int u = bid - 512; u < nunits; u += nb - 512) attn_unit(p, l, u);
  } else {
    for (int it = bid; it < 512 + nunits; it += nb) {
      if (it < 384) rwkv_chain(p, l, it, smem);
      else if (it < 512) hgrn_chain(p, l, it - 384, smem);
      else attn_unit(p, l, it - 512);
      __syncthreads();
    }
  }
}

__device__ __forceinline__ float sum4(const f32x4 v) { return (v[0] + v[1]) + (v[2] + v[3]); }
__device__ __forceinline__ f32x4 h4f(const half4 h) { return (f32x4){(float)h[0], (float)h[1], (float)h[2], (float)h[3]}; }
__device__ __forceinline__ half8 zero_h8() { half8 z;
#pragma unroll
  for (int j = 0; j < 8; ++j) z[j] = (h16)0.f; return z; }
__device__ __forceinline__ half4 zero_h4() { half4 z; z[0] = z[1] = z[2] = z[3] = (h16)0.f; return z; }
__device__ __forceinline__ void phase_readout(const Params& p, int l, int bid, int nb, bool dummy) {
  const int tid = tid_opaque(), lane = tid & 63, w = __builtin_amdgcn_readfirstlane(tid >> 6);
  const int nrows = l == 1 ? NLAT : NTOK;
  const int hl = lane >> 4, c4 = (lane & 15) * 4;
  const int gw = bid * 4 + w, nper = (nb * 4) / 3;
  const int q = gw % 3, ridx = gw / 3;
  if (ridx >= nper) return;
  const int rpw = (nrows + nper - 1) / nper;
  const int r0 = ridx * rpw, r1 = min(nrows, r0 + rpw);
  if (r0 >= r1) return;
  if (q < 2) {
    const int head = q * 4 + hl; const bool valid = head < 6; const int hcl = valid ? head : 5; const int c = hcl * 64 + c4;
    const f32x4 mpr = *(const f32x4*)(p.mu_prev + l * 1792 + c), mnr = *(const f32x4*)(p.mu_next + l * 1792 + c);
    const f32x4 mpk = *(const f32x4*)(p.mu_prev + l * 1792 + 384 + c), mnk = *(const f32x4*)(p.mu_next + l * 1792 + 384 + c);
    const f32x4 mpg = *(const f32x4*)(p.mu_prev + l * 1792 + 1408 + c), mng = *(const f32x4*)(p.mu_next + l * 1792 + 1408 + c);
    const f32x4 gwt = *(const f32x4*)(p.gn_w + l * 384 + c), gbs = *(const f32x4*)(p.gn_b + l * 384 + c), rkw = *(const f32x4*)(p.r_k + l * 384 + c);
    const h16* prk = p.P + hcl * 128 + 2 * c4;
    const h16* pg = p.P + 1408 + c;
    half8 rk_prev = r0 > 0 ? *(const half8*)(prk + (size_t)(r0 - 1) * PC) : zero_h8();
    half4 g_prev = r0 > 0 ? *(const half4*)(pg + (size_t)(r0 - 1) * PC) : zero_h4();
    half8 rk_cur = *(const half8*)(prk + (size_t)r0 * PC);
    half4 g_cur = *(const half4*)(pg + (size_t)r0 * PC);
    half8 rk_next = r0 + 1 < NTOK ? *(const half8*)(prk + (size_t)(r0 + 1) * PC) : zero_h8();
    half4 g_next = r0 + 1 < NTOK ? *(const half4*)(pg + (size_t)(r0 + 1) * PC) : zero_h4();
    half4 yf_c = *(const half4*)(p.P + (size_t)r0 * PC + 768 + c), yb_c = *(const half4*)(p.hy + (size_t)r0 * 1024 + c), v_c = *(const half4*)(p.VB + (size_t)r0 * 384 + c);
#pragma unroll 1
    for (int row = r0; row < r1; ++row) {
      const bool more = row + 1 < r1;
      const half8 rk_nn = row + 2 < NTOK ? *(const half8*)(prk + (size_t)(row + 2) * PC) : zero_h8();
      const half4 g_nn = row + 2 < NTOK ? *(const half4*)(pg + (size_t)(row + 2) * PC) : zero_h4();
      half4 yf_n = yf_c, yb_n = yb_c, v_n = v_c;
      if (more) { yf_n = *(const half4*)(p.P + (size_t)(row + 1) * PC + 768 + c); yb_n = *(const half4*)(p.hy + (size_t)(row + 1) * 1024 + c); v_n = *(const half4*)(p.VB + (size_t)(row + 1) * 384 + c); }
      int t, Tn;
      if (row < NLAT) { t = row & 4095; Tn = 4096; } else { t = (row - NLAT) & 255; Tn = 256; }
      const bool hp = t > 0, hn = t + 1 < Tn;
      f32x4 sh[3];
#pragma unroll
      for (int k = 0; k < 2; ++k) {
        const f32x4 cur = {(float)rk_cur[k], (float)rk_cur[2 + k], (float)rk_cur[4 + k], (float)rk_cur[6 + k]};
        f32x4 prv = {(float)rk_prev[k], (float)rk_prev[2 + k], (float)rk_prev[4 + k], (float)rk_prev[6 + k]};
        f32x4 nxt = {(float)rk_next[k], (float)rk_next[2 + k], (float)rk_next[4 + k], (float)rk_next[6 + k]};
        if (!hp) prv = (f32x4){0.f, 0.f, 0.f, 0.f};
        if (!hn) nxt = (f32x4){0.f, 0.f, 0.f, 0.f};
        sh[k] = cur + (k == 0 ? mpr : mpk) * (prv - cur) + (k == 0 ? mnr : mnk) * (nxt - cur);
      }
      {
        const f32x4 cur = h4f(g_cur);
        f32x4 prv = h4f(g_prev), nxt = h4f(g_next);
        if (!hp) prv = (f32x4){0.f, 0.f, 0.f, 0.f};
        if (!hn) nxt = (f32x4){0.f, 0.f, 0.f, 0.f};
        sh[2] = cur + mpg * (prv - cur) + mng * (nxt - cur);
      }
      const f32x4 y = h4f(yf_c) + h4f(yb_c);
      const f32x4 v = h4f(v_c);
      const float mean = red16(sum4(y)) * (1.f / 64.f);
      const f32x4 yc = y - mean;
      const float var = red16(sum4(yc * yc)) * (1.f / 64.f);
      const float rs = rsqrtf(var + 64e-5f);
      const float bs = red16(sum4(sh[0] * sh[1] * rkw));
      half4 o;
#pragma unroll
      for (int j = 0; j < 4; ++j) o[j] = (h16)((yc[j] * rs * gwt[j] + gbs[j] + bs * v[j]) * siluf_(sh[2][j]));
      h16* yw = dummy ? p.F + (size_t)row * 1536 : p.hy + (size_t)row * 1024;
      if (valid) *(half4*)(yw + c) = o;
      rk_prev = rk_cur; rk_cur = rk_next; rk_next = rk_nn;
      g_prev = g_cur; g_cur = g_next; g_next = g_nn;
      yf_c = yf_n; yb_c = yb_n; v_c = v_n;
    }
  } else {
    const int c = hl * 64 + c4;
    const f32x4 nw = *(const f32x4*)(p.hg_norm_w + l * 256 + c);
    half4 of_c = *(const half4*)(p.P + (size_t)r0 * PC + 1152 + c), ob_c = *(const half4*)(p.hy + (size_t)r0 * 1024 + 384 + c), g_c = *(const half4*)(p.P + (size_t)r0 * PC + 2816 + c);
#pragma unroll 1
    for (int row = r0; row < r1; ++row) {
      half4 of_n = of_c, ob_n = ob_c, g_n = g_c;
      if (row + 1 < r1) { of_n = *(const half4*)(p.P + (size_t)(row + 1) * PC + 1152 + c); ob_n = *(const half4*)(p.hy + (size_t)(row + 1) * 1024 + 384 + c); g_n = *(const half4*)(p.P + (size_t)(row + 1) * PC + 2816 + c); }
      const f32x4 o = h4f(of_c) + h4f(ob_c);
      const f32x4 g = h4f(g_c);
      const float ms = red16(sum4(o * o)) * (1.f / 64.f);
      const float rs = rsqrtf(ms + 1e-6f);
      half4 ov;
#pragma unroll
      for (int j = 0; j < 4; ++j) ov[j] = (h16)(o[j] * rs * nw[j] * siluf_(g[j]));
      h16* yw = dummy ? p.F + (size_t)row * 1536 : p.hy + (size_t)row * 1024;
      *(half4*)(yw + 384 + c) = ov;
      of_c = of_n; ob_c = ob_n; g_c = g_n;
    }
  }
}

__device__ __forceinline__ void phase_final(const Params& p, int bid, int nb) {
  const int tid = tid_opaque(), lane = tid & 63, w = __builtin_amdgcn_readfirstlane(tid >> 6);
  for (int row = bid * 4 + w; row < NLAT; row += nb * 4) {
    float* src = p.out + (size_t)row * 1024;
    f32x4 v[4]; float ss = 0.f;
#pragma unroll
    for (int i = 0; i < 4; ++i) { v[i] = *(const f32x4*)(src + i * 256 + lane * 4); ss += v[i][0] * v[i][0] + v[i][1] * v[i][1] + v[i][2] * v[i][2] + v[i][3] * v[i][3]; }
    ss = wave_sum_dpp(ss);
    const float rs = rsqrtf(ss * (1.f / 1024.f) + 1e-6f);
#pragma unroll
    for (int i = 0; i < 4; ++i) {
      const int col = i * 256 + lane * 4;
      const f32x4 nwv = *(const f32x4*)(p.final_w + col);
      f32x4 o;
#pragma unroll
      for (int j = 0; j < 4; ++j) o[j] = v[i][j] * rs * nwv[j];
      *(f32x4*)(src + col) = o;
    }
  }
}

__global__ void __launch_bounds__(256, 3) __attribute__((target("no-packed-fp32-ops"))) mega(Params p, int ph_lo, int ph_hi, int coop) {
  __shared__ __attribute__((aligned(16))) char smem[SMEM_BYTES];
  __shared__ uint4 xb_words;
  XcdBarrier xb; xb.bar = p.bar; xb.x = 0; xb.st = (volatile LAS unsigned*)&xb_words;
  if (coop) { if (threadIdx.x == 0) xb_words = make_uint4(0u, 0u, 0u, 0u); __syncthreads(); xb = xcd_barrier_post(p.bar, (volatile LAS unsigned*)&xb_words); }
  if (coop) for (int i = 0; i < EXTRA_SYNCS; ++i) { xcd_barrier(xb); }
  if (coop == 2) cg::this_grid().sync();
  for (int ph = ph_lo; ph < ph_hi; ++ph) {
    for (int rep = 0; rep < (((PROBE_MASK >> ph) & 1) ? 2 : 1); ++rep) {
      int bid = blockIdx.x, nb = gridDim.x;
      asm volatile("" : "+s"(bid), "+s"(nb));
      if (ph == 0) phase_prep(p, bid, nb, smem);
      else if (ph == 13) phase_final(p, bid, nb);
      else {
        const int l = (ph - 1) / 6, s = (ph - 1) % 6;
        if (s == 0) phase_norm(p, l, bid, nb);
        else if (s == 1) phase_gemm<0>(p, l, bid, nb, smem);
        else if (s == 2) phase_feat(p, l, bid, nb, smem, PROBE_MASK && ((PROBE_MASK >> ph) & 1) && rep == 0);
        else if (s == 3) phase_mix(p, l, bid, nb, smem, rep ? PROBE_SUB : 7);
        else if (s == 4) phase_readout(p, l, bid, nb, PROBE_MASK && ((PROBE_MASK >> ph) & 1) && rep == 0);
        else phase_gemm<1>(p, l, bid, nb, smem);
      }
      if (PROBE_MASK && rep == 0 && ((PROBE_MASK >> ph) & 1)) { xcd_barrier(xb); }
    }
    if (coop && ph + 1 < ph_hi) { xcd_barrier(xb); }
  }
}

extern "C" void kernel_launch(void* const* d_in, const int* in_sizes, int n_in, void* d_out, int out_size, void* d_ws, size_t ws_size, hipStream_t stream) {
  static int grid_blocks = 0;
  if (!grid_blocks) {
    int dev = 0, cus = 0, per_cu = 0;
    hipGetDevice(&dev);
    hipDeviceGetAttribute(&cus, hipDeviceAttributeMultiprocessorCount, dev);
    hipOccupancyMaxActiveBlocksPerMultiprocessor(&per_cu, mega, 256, 0);
    if (per_cu < 1) per_cu = 1;
    grid_blocks = cus * per_cu;
  }
  Params p{};
  const float* const* in = (const float* const*)d_in;
  p.x = in[0]; p.c = in[1]; p.ctx = in[2]; p.c_ctx = in[3]; p.mod_w = in[4]; p.mod_b = in[5]; p.norm_w = in[6]; p.w_in = in[7]; p.w_out = in[8];
  p.mu_prev = in[9]; p.mu_next = in[10]; p.w0 = in[11]; p.w2 = in[12]; p.a0 = in[13]; p.a2 = in[14]; p.k_k = in[15]; p.k_a = in[16]; p.r_k = in[17];
  p.gn_w = in[18]; p.gn_b = in[19]; p.vw1 = in[20]; p.vw2 = in[21]; p.vb = in[22]; p.lb_logits = in[23]; p.hg_norm_w = in[24]; p.sink = in[25]; p.final_w = in[26];
  p.out = (float*)d_out;
  char* ws = (char*)d_ws; size_t off = 0;
  auto take = [&](size_t bytes) { char* r = ws + off; off += (bytes + 255) & ~(size_t)255; return r; };
  p.win_t = (h16*)take((size_t)2 * NPAD * 1024 * 2);
  p.wout_t = (h16*)take((size_t)2 * 1024 * 1024 * 2);
  p.wl_t = (h16*)take((size_t)2 * 4 * 384 * 64 * 2);
  p.mod = (float*)take((size_t)2 * 9 * 3072 * 4);
  p.rope = (float*)take((size_t)64 * 16 * 2 * 4);
  p.hy = (h16*)take((size_t)NTOK * 1024 * 2);
  p.P = (h16*)take((size_t)NTOK * PC * 2);
  p.F = (h16*)take((size_t)NTOK * 1536 * 2);
  p.VB = (h16*)take((size_t)NTOK * 384 * 2);
  p.VT = (h16*)take((size_t)16 * 64 * VTS * 2);
  p.xc1 = (float*)take((size_t)2048 * 1024 * 4);
  p.bar = (unsigned*)take(16384);
  if (off > ws_size) fprintf(stderr, "workspace too small: need %zu have %zu\n", off, ws_size);
#if SINGLE_LAUNCH
  hipMemsetAsync(p.bar, 0, 16384, stream);
  int lo = 0, hi = 14, coop = 1;
  void* args[] = {&p, &lo, &hi, &coop};
  hipError_t e = hipLaunchCooperativeKernel((void*)mega, dim3(grid_blocks), dim3(256), args, 0, stream);
  if (e != hipSuccess) fprintf(stderr, "cooperative launch failed: %s (grid %d)\n", hipGetErrorString(e), grid_blocks);
#else
  for (int ph = 0; ph < 14; ++ph) mega<<<grid_blocks, 256, 0, stream>>>(p, ph, ph + 1, 0);
#endif
}
```

```cpp
#include <hip/hip_runtime.h>
#include <hip/hip_cooperative_groups.h>
#include <cstdio>
#include <cstdint>
namespace cg = cooperative_groups;

typedef _Float16 h16;
typedef _Float16 half8 __attribute__((ext_vector_type(8)));
typedef _Float16 half4 __attribute__((ext_vector_type(4)));
typedef float f32x16 __attribute__((ext_vector_type(16)));
typedef float f32x4 __attribute__((ext_vector_type(4)));
typedef float f32x2 __attribute__((ext_vector_type(2)));
typedef unsigned u32x4 __attribute__((ext_vector_type(4)));
typedef _Float16 half2v __attribute__((ext_vector_type(2)));

constexpr int NLAT = 32768, NTOK = 34816;
constexpr int PC = 4160;
constexpr int NPAD = 4224;
constexpr int VTS = 4352;
constexpr int SMEM_BYTES = 49152;

#ifndef EXTRA_SYNCS
#define EXTRA_SYNCS 0
#endif
#ifndef PROBE_SUB
#define PROBE_SUB 7
#endif
#ifndef PROBE_MASK
#define PROBE_MASK 0
#endif
#ifndef SINGLE_LAUNCH
#define SINGLE_LAUNCH 1
#endif

struct Params {
  const float *x, *c, *ctx, *c_ctx, *mod_w, *mod_b, *norm_w, *w_in, *w_out;
  const float *mu_prev, *mu_next, *w0, *w2, *a0, *a2, *k_k, *k_a, *r_k, *gn_w, *gn_b;
  const float *vw1, *vw2, *vb, *lb_logits, *hg_norm_w, *sink, *final_w;
  float* out;
  h16 *win_t, *wout_t, *wl_t;
  float* mod;
  h16 *hy, *P, *F, *VB;
  h16* VT;
  float* xc1;
  float* rope;
  unsigned* bar;
};

__device__ __forceinline__ int tid_opaque() { int t = threadIdx.x; asm volatile("" : "+v"(t)); return t; }
__device__ __forceinline__ float wave_sum(float v) {
#pragma unroll
  for (int o = 32; o > 0; o >>= 1) v += __shfl_xor(v, o);
  return v;
}
__device__ __forceinline__ float sigmoidf_(float x) { return __builtin_amdgcn_rcpf(1.f + __expf(-x)); }
__device__ __forceinline__ float siluf_(float x) { return x * __builtin_amdgcn_rcpf(1.f + __expf(-x)); }
template <int CTRL> __device__ __forceinline__ float dpp_mov(float x) {
  return __int_as_float(__builtin_amdgcn_update_dpp(0, __float_as_int(x), CTRL, 0xf, 0xf, true));
}
__device__ __forceinline__ float wave_sum_dpp(float x) {
  x += dpp_mov<0xB1>(x);
  x += dpp_mov<0x4E>(x);
  x += dpp_mov<0x141>(x);
  x += dpp_mov<0x140>(x);
  const int xi = __float_as_int(x);
  return __int_as_float(__builtin_amdgcn_readlane(xi, 0)) + __int_as_float(__builtin_amdgcn_readlane(xi, 16)) +
         __int_as_float(__builtin_amdgcn_readlane(xi, 32)) + __int_as_float(__builtin_amdgcn_readlane(xi, 48));
}
__device__ __forceinline__ float red8(float x) {
  x += dpp_mov<0xB1>(x);
  x += dpp_mov<0x4E>(x);
  x += dpp_mov<0x141>(x);
  return x;
}

#define XB_TMO      128
#define XB_XCNT(j)  (256  + 64 * (j))
#define XB_XSUB(j)  (1280 + 64 * (j))
#define XB_XGEN(j)  (2304 + 64 * (j))
#define XB_TOP      3328
#define XB_TOPGEN   3392
#define XCD_BAR_WORDS 3456
#define XB_SPIN_CAP (1u << 18)
#define LAS __attribute__((address_space(3)))
__device__ __forceinline__ unsigned xb_ld(unsigned* p)              { return __hip_atomic_load(p, __ATOMIC_RELAXED, __HIP_MEMORY_SCOPE_AGENT); }
__device__ __forceinline__ unsigned xb_add(unsigned* p, unsigned v) { return __hip_atomic_fetch_add(p, v, __ATOMIC_RELAXED, __HIP_MEMORY_SCOPE_AGENT); }
__device__ __forceinline__ unsigned xb_xcc_id() { return (unsigned)__builtin_amdgcn_s_getreg((3 << 11) | 20) & 0xFu; }
#define XB_SPIN(cond, bar) do { unsigned _sp = 0; while (cond) { __builtin_amdgcn_s_sleep(1); \
    if ((++_sp & 255u) == 0u) { if (xb_ld(&(bar)[XB_TMO])) break; if (_sp > XB_SPIN_CAP) { atomicAdd(&(bar)[XB_TMO], 1u); break; } } } } while (0)
struct XcdBarrier { unsigned* bar; unsigned x; volatile LAS unsigned* st; };
__device__ __forceinline__ XcdBarrier xcd_barrier_post(unsigned* bar, volatile LAS unsigned* st) {
  XcdBarrier b; b.bar = bar; b.x = xb_xcc_id(); b.st = st;
  if (threadIdx.x == 0) (void)xb_add(&bar[XB_XCNT(b.x)], 1u);
  return b;
}
__device__ __forceinline__ void xcd_barrier_complete(unsigned* bar, unsigned x, unsigned& nloc, unsigned& nx) {
  const unsigned G = gridDim.x * gridDim.y * gridDim.z;
  unsigned sum, cnt, mine, sp = 0u;
  for (;;) {
    sum = 0u; cnt = 0u; mine = 0u;
#pragma unroll
    for (unsigned j = 0; j < 16; ++j) { const unsigned c = xb_ld(&bar[XB_XCNT(j)]); sum += c; cnt += (c > 0u) ? 1u : 0u; mine = (j == x) ? c : mine; }
    if (sum == G) break;
    __builtin_amdgcn_s_sleep(1);
    if ((++sp & 255u) == 0u) { if (xb_ld(&bar[XB_TMO])) break; if (sp > XB_SPIN_CAP) { atomicAdd(&bar[XB_TMO], 1u); break; } }
  }
  nloc = mine > 0u ? mine : 1u; nx = cnt > 0u ? cnt : 1u;
}
__device__ __forceinline__ void xcd_barrier(const XcdBarrier& b) {
  asm volatile("s_waitcnt vmcnt(0)" ::: "memory");
  __syncthreads();
  if (threadIdx.x == 0) {
    unsigned* bar = b.bar;
    __builtin_amdgcn_s_waitcnt(0);
    unsigned nloc = b.st[0], nx = b.st[1];
    if (nloc == 0u) { xcd_barrier_complete(bar, b.x, nloc, nx); b.st[0] = nloc; b.st[1] = nx; }
    const unsigned old = xb_add(&bar[XB_XSUB(b.x)], 1u);
    const unsigned gen = old / nloc;
    if (old + 1u == (gen + 1u) * nloc) {
      __builtin_amdgcn_fence(__ATOMIC_RELEASE, "agent");
      asm volatile("s_waitcnt vmcnt(0)" ::: "memory");
      const unsigned og = xb_add(&bar[XB_TOP], 1u);
      const unsigned tg = og / nx;
      if (og + 1u == (tg + 1u) * nx) xb_add(&bar[XB_TOPGEN], 1u);
      else XB_SPIN(xb_ld(&bar[XB_TOPGEN]) == tg, bar);
      __builtin_amdgcn_fence(__ATOMIC_ACQUIRE, "agent");
      xb_add(&bar[XB_XGEN(b.x)], 1u);
      asm volatile("s_waitcnt vmcnt(0)" ::: "memory");
    } else {
      XB_SPIN(xb_ld(&bar[XB_XGEN(b.x)]) == gen, bar);
      __builtin_amdgcn_fence(__ATOMIC_ACQUIRE, "agent");
      asm volatile("s_waitcnt vmcnt(0)" ::: "memory");
    }
  }
  __syncthreads();
}

__device__ __forceinline__ void phase_prep(const Params& p, int bid, int nb, char* smem) {
  const int tid = tid_opaque();
  float* sf = (float*)smem;
  constexpr int N_WIN = 2048, N_WOUT = 512, N_MOD = 192, N_PADI = 1024, N_WL = 768;
  constexpr int total = N_WIN + N_WOUT + N_MOD + N_PADI + N_WL + 1;
  for (int it = bid; it < total; it += nb) {
    if (it < N_WIN + N_WOUT) {
      const float* src; h16* dst; int ncols, kt, ntile;
      if (it < N_WIN) { int l = it >> 10, r = it & 1023; kt = r >> 6; ntile = r & 63; src = p.w_in + (size_t)l * 1024 * 4096; dst = p.win_t + (size_t)l * NPAD * 1024; ncols = 4096; }
      else { int j = it - N_WIN; int l = j >> 8, r = j & 255; kt = r >> 4; ntile = r & 15; src = p.w_out + (size_t)l * 1024 * 1024; dst = p.wout_t + (size_t)l * 1024 * 1024; ncols = 1024; }
      for (int i = tid; i < 4096; i += 256) { int kk = i >> 6, nn = i & 63; sf[kk * 65 + nn] = src[(size_t)(kt * 64 + kk) * ncols + ntile * 64 + nn]; }
      __syncthreads();
      const bool rkperm = it < N_WIN && ntile < 12;
      for (int i = tid; i < 4096; i += 256) {
        int nn = i >> 6, kk = i & 63;
        const int nrow = rkperm ? ((ntile % 6) * 128 + 2 * nn + ntile / 6) : (ntile * 64 + nn);
        dst[(size_t)nrow * 1024 + kt * 64 + kk] = (h16)sf[kk * 65 + nn];
      }
      __syncthreads();
    } else if (it < N_WIN + N_WOUT + N_MOD) {
      const int j = it - N_WIN - N_WOUT; const int l = j / 96; const int cl = tid & 31, ks = tid >> 5; const int col = (j % 96) * 32 + cl;
      for (int i = tid; i < 9 * 1024; i += 256) { int r = i >> 10, k = i & 1023; float v = r < 8 ? p.c[r * 1024 + k] : p.c_ctx[k]; sf[i] = siluf_(v); }
      __syncthreads();
      float acc[9];
#pragma unroll
      for (int r = 0; r < 9; ++r) acc[r] = 0.f;
      const float* mw = p.mod_w + (size_t)l * 1024 * 3072 + (size_t)(ks * 128) * 3072 + col;
#pragma unroll 2
      for (int k = 0; k < 128; k += 4) {
        const float w0 = mw[(size_t)k * 3072], w1 = mw[(size_t)(k + 1) * 3072], w2 = mw[(size_t)(k + 2) * 3072], w3 = mw[(size_t)(k + 3) * 3072];
#pragma unroll
        for (int r = 0; r < 9; ++r) { const f32x4 sv = *(const f32x4*)&sf[r * 1024 + ks * 128 + k]; acc[r] += sv[0] * w0 + sv[1] * w1 + sv[2] * w2 + sv[3] * w3; }
      }
#pragma unroll
      for (int r = 0; r < 9; ++r) acc[r] += __shfl_xor(acc[r], 32);
      __syncthreads();
      if ((tid & 63) < 32) {
#pragma unroll
        for (int r = 0; r < 9; ++r) sf[((tid >> 6) * 9 + r) * 32 + cl] = acc[r];
      }
      __syncthreads();
      for (int i = tid; i < 288; i += 256) {
        const int r = i >> 5, c2 = i & 31;
        const float v = sf[(0 * 9 + r) * 32 + c2] + sf[(1 * 9 + r) * 32 + c2] + sf[(2 * 9 + r) * 32 + c2] + sf[(3 * 9 + r) * 32 + c2];
        const int cc = (j % 96) * 32 + c2;
        p.mod[(size_t)(l * 9 + r) * 3072 + cc] = v + p.mod_b[l * 3072 + cc];
      }
      __syncthreads();
    } else if (it < N_WIN + N_WOUT + N_MOD + N_PADI) {
      int j = it - (N_WIN + N_WOUT + N_MOD); int idx = j * 256 + tid;
      int l = idx >> 17; int rem = idx & 131071; int m = rem >> 10, k = rem & 1023;
      float v = (l == 1 && m < 32) ? p.vw1[k * 32 + m] : 0.f;
      p.win_t[(size_t)l * NPAD * 1024 + (size_t)(4096 + m) * 1024 + k] = (h16)v;
    } else if (it < N_WIN + N_WOUT + N_MOD + N_PADI + N_WL) {
      const int idx = (it - (N_WIN + N_WOUT + N_MOD + N_PADI)) * 256 + tid;
      const int r = idx & 63, c = (idx >> 6) % 384, ls = idx / (384 * 64); const int l = ls >> 2, slot = ls & 3, dir = slot & 1, kind = slot >> 1;
      const float v = (kind == 0 ? p.w2 : p.a2)[((size_t)(l * 2 + dir) * 64 + r) * 384 + c];
      p.wl_t[idx] = (h16)v;
    } else {
      if (tid < 16) {
        double inv = 1.0; for (int i = 0; i < tid; ++i) inv *= 0.5623413251903491;
        double x2 = inv * inv, ts = inv, tc = 1.0, s1 = inv, c1 = 1.0;
        for (int n = 1; n <= 10; ++n) { tc *= -x2 / ((2.0 * n - 1.0) * (2.0 * n)); c1 += tc; ts *= -x2 / ((2.0 * n) * (2.0 * n + 1.0)); s1 += ts; }
        double cc = 1.0, ss = 0.0;
        for (int pos = 0; pos < 64; ++pos) {
          p.rope[(pos * 16 + tid) * 2] = (float)cc; p.rope[(pos * 16 + tid) * 2 + 1] = (float)ss;
          double nc = cc * c1 - ss * s1, ns = ss * c1 + cc * s1; cc = nc; ss = ns;
        }
      }
    }
  }
}

__device__ __forceinline__ void phase_norm(const Params& p, int l, int bid, int nb) {
  const int tid = tid_opaque(), lane = tid & 63, w = __builtin_amdgcn_readfirstlane(tid >> 6);
  for (int row = bid * 4 + w; row < NTOK; row += nb * 4) {
    const float* src = (l == 0) ? (row < NLAT ? p.x + (size_t)row * 1024 : p.ctx + (size_t)(row - NLAT) * 1024)
                                : (row < NLAT ? p.out + (size_t)row * 1024 : p.xc1 + (size_t)(row - NLAT) * 1024);
    const int mr = row < NLAT ? (row >> 12) : 8;
    const float* md = p.mod + (size_t)(l * 9 + mr) * 3072;
    const float* nw = p.norm_w + l * 1024;
    f32x4 v[4]; float ss = 0.f;
#pragma unroll
    for (int i = 0; i < 4; ++i) { v[i] = *(const f32x4*)(src + i * 256 + lane * 4); ss += v[i][0] * v[i][0] + v[i][1] * v[i][1] + v[i][2] * v[i][2] + v[i][3] * v[i][3]; }
    ss = wave_sum_dpp(ss);
    const float rs = rsqrtf(ss * (1.f / 1024.f) + 1e-6f);
#pragma unroll
    for (int i = 0; i < 4; ++i) {
      const int col = i * 256 + lane * 4;
      f32x4 nwv = *(const f32x4*)(nw + col), sc = *(const f32x4*)(md + 1024 + col), sh = *(const f32x4*)(md + col);
      half4 o;
#pragma unroll
      for (int j = 0; j < 4; ++j) o[j] = (h16)(v[i][j] * rs * nwv[j] * (1.f + sc[j]) + sh[j]);
      *(half4*)(p.hy + (size_t)row * 1024 + col) = o;
    }
  }
}

template <int MODE>
__device__ __forceinline__ void phase_gemm(const Params& p, int l, int bid, int nb, char* smem) {
  const h16* A = p.hy;
  const h16* Bt = MODE == 0 ? p.win_t + (size_t)l * NPAD * 1024 : p.wout_t + (size_t)l * 1024 * 1024;
  const int ntn = MODE == 0 ? (l == 1 ? 33 : 32) : 8;
  const int ntm = (MODE == 1 && l == 1) ? 256 : 272;
  const int tid = tid_opaque(), lane = tid & 63, w = __builtin_amdgcn_readfirstlane(tid >> 6), wr = w >> 1, wc = w & 1, lq = lane & 31, hh = lane >> 5;
  h16* As = (h16*)smem; h16* Bs = As + 128 * 72;
  const int ldrow = tid >> 3, ldch = (tid & 7) * 8;
  for (int tile = bid; tile < ntm * ntn; tile += nb) {
    int tm, tn;
    {
      const int mper = ntm >> 3;
      const int nmain = MODE == 0 ? 32 : 8;
      if (tile < ntm * nmain) {
        const int x = tile & 7, sq = tile >> 3;
        const int strip = sq / (mper * 8), rem = sq - strip * (mper * 8);
        tm = x * mper + (rem >> 3); tn = strip * 8 + (rem & 7);
      } else { tm = tile - ntm * nmain; tn = nmain; }
    }
    const h16* Ag = A + (size_t)(tm * 128 + ldrow) * 1024 + ldch; const h16* Bg = Bt + (size_t)(tn * 128 + ldrow) * 1024 + ldch;
    f32x16 acc[2][2];
#pragma unroll
    for (int i = 0; i < 2; ++i)
#pragma unroll
      for (int j = 0; j < 2; ++j)
#pragma unroll
        for (int r = 0; r < 16; ++r) acc[i][j][r] = 0.f;
    u32x4 ra[4], rb[4];
#pragma unroll
    for (int i = 0; i < 4; ++i) { ra[i] = *(const u32x4*)(Ag + (size_t)i * 32 * 1024); rb[i] = *(const u32x4*)(Bg + (size_t)i * 32 * 1024); }
#pragma unroll 2
    for (int kt = 0; kt < 16; ++kt) {
      __syncthreads();
#pragma unroll
      for (int i = 0; i < 4; ++i) { *(u32x4*)(As + (ldrow + i * 32) * 72 + ldch) = ra[i]; *(u32x4*)(Bs + (ldrow + i * 32) * 72 + ldch) = rb[i]; }
      __syncthreads();
      if (kt + 1 < 16) {
#pragma unroll
        for (int i = 0; i < 4; ++i) { ra[i] = *(const u32x4*)(Ag + (size_t)i * 32 * 1024 + (kt + 1) * 64); rb[i] = *(const u32x4*)(Bg + (size_t)i * 32 * 1024 + (kt + 1) * 64); }
      }
#pragma unroll
      for (int s = 0; s < 4; ++s) {
        half8 a[2], b[2];
#pragma unroll
        for (int i = 0; i < 2; ++i) { a[i] = *(const half8*)(As + (64 * wr + 32 * i + lq) * 72 + 16 * s + 8 * hh); b[i] = *(const half8*)(Bs + (64 * wc + 32 * i + lq) * 72 + 16 * s + 8 * hh); }
#pragma unroll
        for (int i = 0; i < 2; ++i)
#pragma unroll
          for (int j = 0; j < 2; ++j) {
            if (MODE == 0) acc[i][j] = __builtin_amdgcn_mfma_f32_32x32x16_f16(b[j], a[i], acc[i][j], 0, 0, 0);
            else acc[i][j] = __builtin_amdgcn_mfma_f32_32x32x16_f16(a[i], b[j], acc[i][j], 0, 0, 0);
          }
      }
    }
    if (MODE == 0) {
      if (tn < 32) {
        __syncthreads();
        h16* Cs = (h16*)smem;
#pragma unroll
        for (int i = 0; i < 2; ++i)
#pragma unroll
          for (int j = 0; j < 2; ++j)
#pragma unroll
            for (int g = 0; g < 4; ++g) {
              half4 o;
#pragma unroll
              for (int q = 0; q < 4; ++q) o[q] = (h16)acc[i][j][4 * g + q];
              *(half4*)(Cs + (64 * wr + 32 * i + lq) * 136 + 64 * wc + 32 * j + 8 * g + 4 * hh) = o;
            }
        __syncthreads();
#pragma unroll
        for (int q = 0; q < 8; ++q) {
          const int id = tid + q * 256; const int row = id >> 4, ch = id & 15;
          *(u32x4*)(p.P + (size_t)(tm * 128 + row) * PC + tn * 128 + ch * 8) = *(const u32x4*)(Cs + row * 136 + ch * 8);
        }
      } else if (wc == 0) {
#pragma unroll
        for (int i = 0; i < 2; ++i)
#pragma unroll
          for (int r = 0; r < 16; ++r) ((float*)(p.F + (size_t)(tm * 128 + 64 * wr + 32 * i + lq) * 1536))[(r & 3) + 8 * (r >> 2) + 4 * hh] = acc[i][0][r];
      }
    } else {
      const int row0 = tm * 128;
      const int mr = row0 < NLAT ? (row0 >> 12) : 8;
      const int col = tn * 128 + 64 * wc + lq;
      const float* gp = p.mod + (size_t)(l * 9 + mr) * 3072 + 2048 + col;
      const float g0 = gp[0], g1 = gp[32];
      const float* xs0; float* xd0;
      if (l == 0) { if (row0 < NLAT) { xs0 = p.x + (size_t)row0 * 1024; xd0 = p.out + (size_t)row0 * 1024; } else { xs0 = p.ctx + (size_t)(row0 - NLAT) * 1024; xd0 = p.xc1 + (size_t)(row0 - NLAT) * 1024; } }
      else { xs0 = p.out + (size_t)row0 * 1024; xd0 = p.out + (size_t)row0 * 1024; }
      const float* __restrict__ xsrc = xs0 + (size_t)(64 * wr + 4 * hh) * 1024 + col;
      float* __restrict__ xdst = xd0 + (size_t)(64 * wr + 4 * hh) * 1024 + col;
#pragma unroll
      for (int i = 0; i < 2; ++i)
#pragma unroll
        for (int r = 0; r < 16; ++r) {
          const int ro = (32 * i + (r & 3) + 8 * (r >> 2)) * 1024;
          xdst[ro] = xsrc[ro] + g0 * acc[i][0][r];
          xdst[ro + 32] = xsrc[ro + 32] + g1 * acc[i][1][r];
        }
    }
  }
}

#define LOAD_COL34(arr, base, t0, Tn) \
  _Pragma("unroll") for (int q_ = 0; q_ < 34; ++q_) { const int t_ = (t0) - 1 + q_; arr[q_] = (t_ >= 0 && t_ < (Tn)) ? (base)[(long)t_ * PC] : (h16)0.f; }

__device__ __forceinline__ void phase_feat(const Params& p, int l, int bid, int nb, char* smem, bool dry) {
  const int tid = tid_opaque();
  h16* inh = (h16*)smem;
  float* zt = (float*)(smem + 32 * 264 * 2);
  for (int item = bid; item < 1088; item += nb) {
    int b, t0, Tn, rowbase; bool isctx;
    if (item < 1024) { b = item >> 7; t0 = (item & 127) * 32; Tn = 4096; rowbase = b * 4096; isctx = false; }
    else { int j = item - 1024; b = j >> 3; t0 = (j & 7) * 32; Tn = 256; rowbase = NLAT + b * 256; isctx = true; }
    {
      const int col = 1152 + tid;
      const float mp = p.mu_prev[l * 1792 + col], mn = p.mu_next[l * 1792 + col];
      const h16* base = p.P + (size_t)rowbase * PC + col;
      h16 xv[34];
      LOAD_COL34(xv, base, t0, Tn)
#pragma unroll
      for (int tt = 0; tt < 32; ++tt) {
        const float prev = (float)xv[tt], cur = (float)xv[tt + 1], nxt = (float)xv[tt + 2];
        float sv = cur + mp * (prev - cur) + mn * (nxt - cur);
        if (tid < 128) { const float e2 = __expf(2.f * sv); sv = 1.f - 2.f / (e2 + 1.f); }
        inh[tt * 264 + tid] = (h16)sv;
      }
      if (l == 1) {
#pragma unroll
        for (int i = 0; i < 4; ++i) { int id = tid + i * 256; zt[id] = ((const float*)(p.F + (size_t)(rowbase + t0 + (id >> 5)) * 1536))[id & 31]; }
      }
    }
    __syncthreads();
#pragma unroll 1
    for (int c = tid; c < 384; c += 256) {
      const int col = 768 + c;
      const float mp = p.mu_prev[l * 1792 + col], mn = p.mu_next[l * 1792 + col];
      const h16* base = p.P + (size_t)rowbase * PC + col;
      h16 xv[34];
      LOAD_COL34(xv, base, t0, Tn)
      h16* dst = p.VB + (size_t)(rowbase + t0) * 384 + c;
      if (l == 0) {
#pragma unroll
        for (int tt = 0; tt < 32; ++tt) {
          const float prev = (float)xv[tt], cur = (float)xv[tt + 1], nxt = (float)xv[tt + 2];
          dst[tt * 384] = (h16)(cur + mp * (prev - cur) + mn * (nxt - cur));
        }
      } else {
        const float vbv = p.vb[c];
#pragma unroll 1
        for (int hf = 0; hf < 2; ++hf) {
          h16 vfv[16]; float ga[16];
#pragma unroll
          for (int tt = 0; tt < 16; ++tt) { vfv[tt] = dst[(hf * 16 + tt) * 384]; ga[tt] = vbv; }
#pragma unroll 1
          for (int m = 0; m < 32; m += 4) {
            const float w0 = p.vw2[m * 384 + c], w1 = p.vw2[(m + 1) * 384 + c], w2 = p.vw2[(m + 2) * 384 + c], w3 = p.vw2[(m + 3) * 384 + c];
#pragma unroll
            for (int tt = 0; tt < 16; ++tt) { const f32x4 z = *(const f32x4*)&zt[(hf * 16 + tt) * 32 + m]; ga[tt] += z[0] * w0 + z[1] * w1 + z[2] * w2 + z[3] * w3; }
          }
#pragma unroll
          for (int tt = 0; tt < 16; ++tt) {
            const float prev = hf ? (float)xv[16 + tt] : (float)xv[tt], cur = hf ? (float)xv[17 + tt] : (float)xv[tt + 1], nxt = hf ? (float)xv[18 + tt] : (float)xv[tt + 2];
            const float sv = cur + mp * (prev - cur) + mn * (nxt - cur);
            dst[(hf * 16 + tt) * 384] = (h16)(sv + ((float)vfv[tt] - sv) * sigmoidf_(ga[tt]));
          }
        }
      }
    }
    {
      const int w = __builtin_amdgcn_readfirstlane(tid >> 6), lane = tid & 63, lq = tid & 31, hh = lane >> 5;
      const int dir = w & 1, chalf = w >> 1;
      half8 xin[2][4];
#pragma unroll
      for (int kind = 0; kind < 2; ++kind)
#pragma unroll
        for (int ks = 0; ks < 4; ++ks) xin[kind][ks] = *(const half8*)(inh + lq * 264 + kind * 128 + dir * 64 + 16 * ks + 8 * hh);
      h16* ost = (h16*)(smem + 32 * 264 * 2 + 4096) + w * (32 * 72);
      h16* fbase = p.F + (size_t)(rowbase + t0) * 1536 + dir * 768 + chalf * 384;
#pragma unroll 1
      for (int np = 0; np < 6; ++np) {
        const int c0 = chalf * 192 + np * 32;
        f32x16 acc[2];
#pragma unroll
        for (int kind = 0; kind < 2; ++kind) {
          const float* bias = (kind == 0 ? p.w0 : p.a0) + (l * 2 + dir) * 384 + c0;
          const h16* wl = p.wl_t + (size_t)((l * 4 + kind * 2 + dir) * 384 + c0) * 64;
#pragma unroll
          for (int g = 0; g < 4; ++g) { const f32x4 bv = *(const f32x4*)(bias + 8 * g + 4 * hh); acc[kind][4 * g] = bv[0]; acc[kind][4 * g + 1] = bv[1]; acc[kind][4 * g + 2] = bv[2]; acc[kind][4 * g + 3] = bv[3]; }
#pragma unroll
          for (int ks = 0; ks < 4; ++ks) {
            const half8 wf = *(const half8*)(wl + (size_t)lq * 64 + 16 * ks + 8 * hh);
            acc[kind] = __builtin_amdgcn_mfma_f32_32x32x16_f16(wf, xin[kind][ks], acc[kind], 0, 0, 0);
          }
        }
#pragma unroll
        for (int g = 0; g < 4; ++g) {
          half8 o;
#pragma unroll
          for (int j = 0; j < 4; ++j) { o[2 * j] = (h16)(1.f - __expf(-0.6065306597126334f * sigmoidf_(acc[0][4 * g + j]))); o[2 * j + 1] = (h16)sigmoidf_(acc[1][4 * g + j]); }
          *(half8*)(ost + lq * 72 + 16 * g + 8 * hh) = o;
        }
        asm volatile("s_waitcnt lgkmcnt(0)" ::: "memory");
#pragma unroll
        for (int q = 0; q < 4; ++q) {
          const int id = lane + q * 64; const int rr = id >> 3, ch = id & 7;
          *(u32x4*)(fbase + (size_t)rr * 1536 + np * 64 + ch * 8) = *(const u32x4*)(ost + rr * 72 + ch * 8);
        }
        asm volatile("s_waitcnt lgkmcnt(0)" ::: "memory");
      }
    }
    {
      const int head = tid >> 5, pr = tid & 31, half = pr >> 4, i = pr & 15;
      const int colbase = head < 6 ? 3072 + head * 64 : 3456 + (head - 6) * 64;
      const int d1 = half * 32 + i;
      const float qs = (head < 6 && !dry) ? 0.125f : 1.f;
      h16* pp = p.P + (size_t)(rowbase + t0) * PC + colbase + d1;
      h16 x1[32], x2[32];
#pragma unroll
      for (int u = 0; u < 32; ++u) { x1[u] = pp[(size_t)u * PC]; x2[u] = pp[(size_t)u * PC + 16]; }
#pragma unroll
      for (int u = 0; u < 32; ++u) {
        const int t = t0 + u;
        float cs = 1.f, sn = 0.f;
        if (!isctx && !dry) { const int pos = half == 0 ? (t >> 6) : (t & 63); const f32x2 r2 = *(const f32x2*)&p.rope[(pos * 16 + i) * 2]; cs = r2[0]; sn = r2[1]; }
        const float a = (float)x1[u], bq = (float)x2[u];
        pp[(size_t)u * PC] = (h16)((a * cs - bq * sn) * qs);
        pp[(size_t)u * PC + 16] = (h16)((a * sn + bq * cs) * qs);
      }
    }
    if (tid < 128) {
      const int g = tid >> 6, d = tid & 63;
      const h16* base = p.P + (size_t)(rowbase + t0) * PC + 3584 + tid;
      h16* dst = p.VT + (size_t)((b * 2 + g) * 64 + d) * VTS + (isctx ? 4096 + t0 : t0);
      half8 v[4];
#pragma unroll
      for (int q = 0; q < 4; ++q)
#pragma unroll
        for (int j = 0; j < 8; ++j) v[q][j] = base[(size_t)(q * 8 + j) * PC];
#pragma unroll
      for (int q = 0; q < 4; ++q) *(half8*)(dst + q * 8) = v[q];
    }
    __syncthreads();
  }
}

__device__ __forceinline__ float ulo(unsigned u) { return (float)__builtin_bit_cast(h16, (unsigned short)(u & 0xffffu)); }
__device__ __forceinline__ float uhi(unsigned u) { return (float)__builtin_bit_cast(h16, (unsigned short)(u >> 16)); }
__device__ __forceinline__ float red16(float x) {
  x += dpp_mov<0xB1>(x);
  x += dpp_mov<0x4E>(x);
  x += dpp_mov<0x141>(x);
  x += dpp_mov<0x140>(x);
  return x;
}
#define LDS_BARRIER() do { asm volatile("s_waitcnt lgkmcnt(0)" ::: "memory"); __builtin_amdgcn_s_barrier(); asm volatile("" ::: "memory"); } while (0)
constexpr int RREC = 336;
struct RwkvPf { unsigned rk[6]; h16 v[4]; unsigned ea[4]; };

__device__ __forceinline__ void rwkv_chain(const Params& p, int l, int item, char* smem) {
  const int tid0 = tid_opaque();
  const int tid = (item >= 256) ? (tid0 ^ 128) : tid0;
  const int lane = tid & 63, w = __builtin_amdgcn_readfirstlane(tid >> 6);
  const int chain = item >> 2, vq = item & 3;
  const int dir = chain / 48, b = (chain % 48) / 6, h = chain % 6;
  float* opb = (float*)smem;
  float* ybuf = opb + 2 * 8 * RREC;
  constexpr int NCH = 544;
  if (w < 2) {
    const int rl = tid >> 3, kq = tid & 7;
    float S[8];
#pragma unroll
    for (int j = 0; j < 8; ++j) S[j] = 0.f;
    __builtin_amdgcn_s_setprio(3);
    LDS_BARRIER();
#pragma unroll 1
    for (int ci = 0; ci < NCH; ++ci) {
      const float* op = opb + (ci & 1) * 8 * RREC;
      float* yb = ybuf + (ci & 1) * 1024;
      f32x4 aA = *(const f32x4*)(op + 8 * kq + 64), aB = *(const f32x4*)(op + 8 * kq + 68);
#pragma unroll
      for (int step = 0; step < 8; ++step) {
        const float* o = op + step * RREC + 8 * kq;
        const f32x4 wA = *(const f32x4*)(o), wB = *(const f32x4*)(o + 4);
        const f32x4 bA = *(const f32x4*)(o + 128), bB = *(const f32x4*)(o + 132);
        const f32x4 kA = *(const f32x4*)(o + 192), kB = *(const f32x4*)(o + 196);
        const f32x4 rA = *(const f32x4*)(o + 256), rB = *(const f32x4*)(o + 260);
        const float vv = op[step * RREC + 320 + rl];
        f32x4 naA = aA, naB = aB;
        if (step + 1 < 8) { naA = *(const f32x4*)(o + RREC + 64); naB = *(const f32x4*)(o + RREC + 68); }
        const float d0 = S[0] * aA[0] + S[1] * aA[1] + S[2] * aA[2] + S[3] * aA[3];
        const float d1 = S[4] * aB[0] + S[5] * aB[1] + S[6] * aB[2] + S[7] * aB[3];
        const float sa = red8(d0 + d1);
#pragma unroll
        for (int j = 0; j < 4; ++j) {
          S[j] = S[j] * wA[j] + sa * bA[j] + vv * kA[j];
          S[4 + j] = S[4 + j] * wB[j] + sa * bB[j] + vv * kB[j];
        }
        const float y0 = S[0] * rA[0] + S[1] * rA[1] + S[2] * rA[2] + S[3] * rA[3];
        const float y1 = S[4] * rB[0] + S[5] * rB[1] + S[6] * rB[2] + S[7] * rB[3];
        yb[step * 128 + tid] = y0 + y1;
        aA = naA; aB = naB;
      }
      LDS_BARRIER();
    }
    __builtin_amdgcn_s_setprio(0);
  } else {
    const int lw = w - 2, lt = tid - 128;
    const int hc = h * 64 + lane;
    const float mpr = p.mu_prev[l * 1792 + hc], mnr = p.mu_next[l * 1792 + hc];
    const float mpk = p.mu_prev[l * 1792 + 384 + hc], mnk = p.mu_next[l * 1792 + 384 + hc];
    const float kkw = p.k_k[l * 384 + hc], kaw = p.k_a[l * 384 + hc];
    const float cAr = dir ? mnr : mpr, cBr = dir ? mpr : mnr, cAk = dir ? mnk : mpk, cBk = dir ? mpk : mnk;
    const unsigned* zrow = p.bar + XCD_BAR_WORDS;
    RwkvPf pfA, pfB;
#define RWKV_ISSUE(ci_, PF) { const int seg_ = (ci_) >= 32; const int Tn_ = seg_ ? 4096 : 256; const int rb_ = seg_ ? b * 4096 : NLAT + b * 256; const int s0_ = (seg_ ? (ci_) - 32 : (ci_)) * 8 + 4 * lw; \
    _Pragma("unroll") for (int q = 0; q < 6; ++q) { const int t_ = dir == 0 ? s0_ - 1 + q : Tn_ - s0_ - q; \
      const unsigned* src_ = ((unsigned)t_ < (unsigned)Tn_) ? (const unsigned*)(p.P + (size_t)(rb_ + t_) * PC + h * 128) : zrow; \
      PF.rk[q] = src_[lane]; } \
    _Pragma("unroll") for (int i = 0; i < 4; ++i) { const int t_ = dir == 0 ? s0_ + i : Tn_ - 1 - (s0_ + i); const size_t row = (size_t)rb_ + t_; \
      PF.v[i] = p.VB[row * 384 + hc]; PF.ea[i] = ((const unsigned*)(p.F + row * 1536 + dir * 768))[hc]; } }
#define RWKV_STAGE(ci_, PF) { float* op_ = opb + ((ci_) & 1) * 8 * RREC; \
    const int seg = (ci_) >= 32; const int Tn = seg ? 4096 : 256; const int c0 = (seg ? (ci_) - 32 : (ci_)) * 8; \
    _Pragma("unroll") for (int i = 0; i < 4; ++i) { \
      const int step = lw * 4 + i; const int t = dir == 0 ? c0 + step : Tn - 1 - (c0 + step); \
      const float rlo = ulo(PF.rk[i]), r0 = ulo(PF.rk[i + 1]), rhi = ulo(PF.rk[i + 2]); \
      const float klo = uhi(PF.rk[i]), k0 = uhi(PF.rk[i + 1]), khi = uhi(PF.rk[i + 2]); \
      const float vv = (float)PF.v[i], e = ulo(PF.ea[i]), al = uhi(PF.ea[i]); \
      const float rs = r0 + cAr * (rlo - r0) + cBr * (rhi - r0); \
      const float ks = k0 + cAk * (klo - k0) + cBk * (khi - k0); \
      const float kkr = ks * kkw; \
      const float n2 = wave_sum_dpp(kkr * kkr); \
      const float kk = kkr * rsqrtf(fmaxf(n2, 1e-24f)); \
      float* o = op_ + step * RREC + lane; \
      o[0] = 1.f - e; o[64] = -kk; o[128] = kk * al; o[192] = ks * (1.f + (al - 1.f) * kaw); o[256] = rs; \
      if ((lane >> 4) == vq) op_[step * RREC + 320 + (lane & 15)] = vv; } }
#define RWKV_WRITE(cj_) { const int seg = (cj_) >= 32; const int Tn = seg ? 4096 : 256; const int rowbase = seg ? b * 4096 : NLAT + b * 256; const int c0 = (seg ? (cj_) - 32 : (cj_)) * 8; \
    if (seg == 1 || l == 0) { const float* yb = ybuf + ((cj_) & 1) * 1024; \
      const int step = lt >> 4, ch = lt & 15; \
      const int t = dir == 0 ? c0 + step : Tn - 1 - (c0 + step); \
      const f32x4 y0 = *(const f32x4*)(yb + step * 128 + ch * 8), y1 = *(const f32x4*)(yb + step * 128 + ch * 8 + 4); \
      const f32x4 ys = y0 + y1; const h16 yv = (h16)((ys[0] + ys[1]) + (ys[2] + ys[3])); \
      if (dir == 0) p.P[(size_t)(rowbase + t) * PC + 768 + h * 64 + 16 * vq + ch] = yv; \
      else p.hy[(size_t)(rowbase + t) * 1024 + h * 64 + 16 * vq + ch] = yv; } }
    RWKV_ISSUE(0, pfA)
    RWKV_STAGE(0, pfA)
    RWKV_ISSUE(1, pfB)
    RWKV_ISSUE(2, pfA)
    LDS_BARRIER();
#pragma unroll 1
    for (int ci = 0; ci < NCH; ci += 2) {
      if (ci + 1 < NCH) RWKV_STAGE(ci + 1, pfB)
      if (ci + 3 < NCH) RWKV_ISSUE(ci + 3, pfB)
      if (ci >= 1) RWKV_WRITE(ci - 1)
      LDS_BARRIER();
      if (ci + 2 < NCH) RWKV_STAGE(ci + 2, pfA)
      if (ci + 4 < NCH) RWKV_ISSUE(ci + 4, pfA)
      RWKV_WRITE(ci)
      LDS_BARRIER();
    }
    RWKV_WRITE(NCH - 1)
  }
}

constexpr int HREC = 224;
struct HgrnPf { h16 f[4], q[4], iv[4]; };
__device__ __forceinline__ void hgrn_chain(const Params& p, int l, int item, char* smem) {
  const int tid = tid_opaque(), lane = tid & 63, w = __builtin_amdgcn_readfirstlane(tid >> 6);
  const int chain = item >> 1, vh = item & 1;
  const int dir = chain / 32, b = (chain % 32) / 4, h = chain % 4;
  float* op = (float*)smem;
  float* ybuf = op + 16 * HREC;
  const int hc = h * 64 + lane;
  float lb = 0.f;
  if (l == 1) lb = sigmoidf_(p.lb_logits[(dir * 2 + 1) * 256 + hc] - p.lb_logits[(dir * 2 + 0) * 256 + hc]);
  const int fcol = 1792 + 256 * (1 + dir) + hc;
  const int vc = tid >> 3, kq = tid & 7;
  float S[8];
#pragma unroll
  for (int j = 0; j < 8; ++j) S[j] = 0.f;
  HgrnPf pfA, pfB;
#define HGRN_ISSUE(ci_, PF) { const int seg_ = (ci_) >= 16; const int Tn_ = seg_ ? 4096 : 256; const int rb_ = seg_ ? b * 4096 : NLAT + b * 256; const int c0_ = (seg_ ? (ci_) - 16 : (ci_)) * 16; \
    _Pragma("unroll") for (int i = 0; i < 4; ++i) { const int step = w * 4 + i; const int t = dir == 0 ? c0_ + step : Tn_ - 1 - (c0_ + step); const h16* pr = p.P + ((size_t)rb_ + t) * PC; \
      PF.f[i] = pr[fcol]; PF.q[i] = pr[1792 + hc]; PF.iv[i] = pr[1792 + 768 + hc]; } }
#define HGRN_CHUNK(ci_, PF) { \
    const int seg = (ci_) >= 16; const int Tn = seg ? 4096 : 256; const int rowbase = seg ? b * 4096 : NLAT + b * 256; const int c0 = (seg ? (ci_) - 16 : (ci_)) * 16; \
    _Pragma("unroll") for (int i = 0; i < 4; ++i) { \
      const int step = w * 4 + i; \
      float* o = op + step * HREC + lane; \
      const float f = lb + (1.f - lb) * sigmoidf_((float)PF.f[i]); \
      o[0] = f; o[128] = (float)PF.q[i]; \
      if ((lane >> 5) == vh) op[step * HREC + 192 + (lane & 31)] = (float)PF.iv[i]; } \
    LDS_BARRIER(); \
    if ((ci_) + 2 < 272) HGRN_ISSUE((ci_) + 2, PF) \
    _Pragma("unroll") for (int step = 0; step < 16; ++step) { \
      const float* o = op + step * HREC + 8 * kq; \
      const f32x4 fA = *(const f32x4*)(o), fB = *(const f32x4*)(o + 4); \
      const f32x4 qA = *(const f32x4*)(o + 128), qB = *(const f32x4*)(o + 132); \
      const float iv = op[step * HREC + 192 + vc]; \
      const float f[8] = {fA[0], fA[1], fA[2], fA[3], fB[0], fB[1], fB[2], fB[3]}; \
      const float q[8] = {qA[0], qA[1], qA[2], qA[3], qB[0], qB[1], qB[2], qB[3]}; \
      float acc = 0.f; \
      _Pragma("unroll") for (int j = 0; j < 8; ++j) { S[j] = f[j] * (S[j] - iv) + iv; acc += S[j] * q[j]; } \
      ybuf[step * 256 + tid] = acc; } \
    LDS_BARRIER(); \
    if (seg == 1 || l == 0) { \
      _Pragma("unroll") for (int i = 0; i < 2; ++i) { \
        const int idx = tid + i * 256; const int step = idx >> 5, ch = idx & 31; \
        const int t = dir == 0 ? c0 + step : Tn - 1 - (c0 + step); \
        const float* yb = ybuf + step * 256 + ch * 8; \
        const f32x4 y0 = *(const f32x4*)(yb), y1 = *(const f32x4*)(yb + 4); \
        const f32x4 ys = y0 + y1; \
        const h16 ov = (h16)((ys[0] + ys[1]) + (ys[2] + ys[3])); \
        if (dir == 0) p.P[(size_t)(rowbase + t) * PC + 1152 + h * 64 + 32 * vh + ch] = ov; \
        else p.hy[(size_t)(rowbase + t) * 1024 + 384 + h * 64 + 32 * vh + ch] = ov; } } }
  HGRN_ISSUE(0, pfA)
  HGRN_ISSUE(1, pfB)
  __builtin_amdgcn_s_setprio(2);
#pragma unroll 1
  for (int ci = 0; ci < 272; ci += 2) {
    HGRN_CHUNK(ci, pfA)
    HGRN_CHUNK(ci + 1, pfB)
  }
  __builtin_amdgcn_s_setprio(0);
}

__device__ __forceinline__ void attn_unit(const Params& p, int l, int u) {
  const int tid = tid_opaque(), lane = tid & 63, w = __builtin_amdgcn_readfirstlane(tid >> 6), lq = lane & 31, hh = lane >> 5;
  int b, head, qrow_base, qpos0; bool isctx;
  if (u < 1536) { b = u / 192; int rem = u % 192; int blk = rem / 6; head = rem % 6; qpos0 = blk * 128 + w * 32; qrow_base = b * 4096; isctx = false; }
  else { int j = u - 1536; b = j / 12; int rem = j % 12; int qb = rem / 6; head = rem % 6; qpos0 = qb * 128 + w * 32; qrow_base = NLAT + b * 256; isctx = true; }
  const int g = head / 3;
  const size_t qrow = (size_t)qrow_base + qpos0 + lq;
  half8 qf[4];
#pragma unroll
  for (int s = 0; s < 4; ++s) qf[s] = *(const half8*)(p.P + qrow * PC + 3072 + head * 64 + 16 * s + 8 * hh);
  const float sinkv = p.sink[l * 6 + head];
  float m = sinkv, lsum = hh == 0 ? 1.f : 0.f;
  f32x16 O[2];
#pragma unroll
  for (int r = 0; r < 16; ++r) { O[0][r] = 0.f; O[1][r] = 0.f; }
  const h16* vt = p.VT + (size_t)((b * 2 + g) * 64) * VTS;
  int nband = 0, kstart = 0;
  if (!isctx) { kstart = max(0, qpos0 - 128); const int kend = min(4096, qpos0 + 160); nband = (kend - kstart) >> 5; }
  const int ntiles = nband + 8;
  for (int ti = 0; ti < ntiles; ++ti) {
    const bool band = ti < nband;
    const int kt = band ? kstart + ti * 32 : (ti - nband) * 32;
    const size_t krow = band ? (size_t)b * 4096 + kt + lq : (size_t)NLAT + b * 256 + kt + lq;
    const int vidx = band ? kt : 4096 + kt;
    const h16* kp = p.P + krow * PC + 3456 + g * 64 + 8 * hh;
    f32x16 sacc;
#pragma unroll
    for (int r = 0; r < 16; ++r) sacc[r] = 0.f;
#pragma unroll
    for (int s = 0; s < 4; ++s) { half8 kf = *(const half8*)(kp + 16 * s); sacc = __builtin_amdgcn_mfma_f32_32x32x16_f16(kf, qf[s], sacc, 0, 0, 0); }
    float mx = -INFINITY;
#pragma unroll
    for (int r = 0; r < 16; ++r) {
      float sv = sacc[r];
      if (band) { const int dlt = kt + (r & 3) + 8 * (r >> 2) + 4 * hh - (qpos0 + lq); if (dlt > 128 || dlt < -128) sv = -INFINITY; }
      sacc[r] = sv; mx = fmaxf(mx, sv);
    }
    mx = fmaxf(mx, __shfl_xor(mx, 32));
    const float mn = fmaxf(m, mx); const float corr = __expf(m - mn); m = mn;
    float ps = 0.f; half8 pb[2];
#pragma unroll
    for (int r = 0; r < 16; ++r) { const float pv = __expf(sacc[r] - mn); ps += pv; pb[r >> 3][r & 7] = (h16)pv; }
    lsum = lsum * corr + ps;
#pragma unroll
    for (int r = 0; r < 16; ++r) { O[0][r] *= corr; O[1][r] *= corr; }
#pragma unroll
    for (int s2 = 0; s2 < 2; ++s2)
#pragma unroll
      for (int dt = 0; dt < 2; ++dt) {
        const h16* vp = vt + (size_t)(dt * 32 + lq) * VTS + vidx + 16 * s2 + 4 * hh;
        const half4 lo = *(const half4*)vp, hi = *(const half4*)(vp + 8);
        const half8 vf = {lo[0], lo[1], lo[2], lo[3], hi[0], hi[1], hi[2], hi[3]};
        O[dt] = __builtin_amdgcn_mfma_f32_32x32x16_f16(vf, pb[s2], O[dt], 0, 0, 0);
      }
  }
  lsum += __shfl_xor(lsum, 32);
  const float inv = 1.f / lsum;
#pragma unroll
  for (int dt = 0; dt < 2; ++dt)
#pragma unroll
    for (int g4 = 0; g4 < 4; ++g4) {
      const int d0 = dt * 32 + 8 * g4 + 4 * hh;
      const half4 ga = *(const half4*)(p.P + qrow * PC + 3712 + head * 64 + d0);
      half4 o;
#pragma unroll
      for (int j = 0; j < 4; ++j) { const float gv = (float)ga[j]; o[j] = (h16)(O[dt][g4 * 4 + j] * inv * siluf_(gv)); }
      *(half4*)(p.hy + qrow * 1024 + 640 + head * 64 + d0) = o;
    }
}

__device__ __forceinline__ void phase_mix(const Params& p, int l, int bid, int nb, char* smem, int sub) {
  const int nunits = l == 0 ? 1536 + 96 : 1536;
  if (nb >= 640) {
    if (bid < 384) { if (sub & 1) rwkv_chain(p, l, bid, smem); }
    else if (bid < 512) { if (sub & 2) hgrn_chain(p, l, bid - 384, smem); }
    else if (sub & 4) for (int u = bid - 512; u < nunits; u += nb - 512) attn_unit(p, l, u);
  } else {
    for (int it = bid; it < 512 + nunits; it += nb) {
      if (it < 384) rwkv_chain(p, l, it, smem);
      else if (it < 512) hgrn_chain(p, l, it - 384, smem);
      else attn_unit(p, l, it - 512);
      __syncthreads();
    }
  }
}

__device__ __forceinline__ float sum4(const f32x4 v) { return (v[0] + v[1]) + (v[2] + v[3]); }
__device__ __forceinline__ f32x4 h4f(const half4 h) { return (f32x4){(float)h[0], (float)h[1], (float)h[2], (float)h[3]}; }
__device__ __forceinline__ half8 zero_h8() { half8 z;
#pragma unroll
  for (int j = 0; j < 8; ++j) z[j] = (h16)0.f; return z; }
__device__ __forceinline__ half4 zero_h4() { half4 z; z[0] = z[1] = z[2] = z[3] = (h16)0.f; return z; }
__device__ __forceinline__ void phase_readout(const Params& p, int l, int bid, int nb, bool dummy) {
  const int tid = tid_opaque(), lane = tid & 63, w = __builtin_amdgcn_readfirstlane(tid >> 6);
  const int nrows = l == 1 ? NLAT : NTOK;
  const int hl = lane >> 4, c4 = (lane & 15) * 4;
  const int gw = bid * 4 + w, nper = (nb * 4) / 3;
  const int q = gw % 3, ridx = gw / 3;
  if (ridx >= nper) return;
  const int rpw = (nrows + nper - 1) / nper;
  const int r0 = ridx * rpw, r1 = min(nrows, r0 + rpw);
  if (r0 >= r1) return;
  if (q < 2) {
    const int head = q * 4 + hl; const bool valid = head < 6; const int hcl = valid ? head : 5; const int c = hcl * 64 + c4;
    const f32x4 mpr = *(const f32x4*)(p.mu_prev + l * 1792 + c), mnr = *(const f32x4*)(p.mu_next + l * 1792 + c);
    const f32x4 mpk = *(const f32x4*)(p.mu_prev + l * 1792 + 384 + c), mnk = *(const f32x4*)(p.mu_next + l * 1792 + 384 + c);
    const f32x4 mpg = *(const f32x4*)(p.mu_prev + l * 1792 + 1408 + c), mng = *(const f32x4*)(p.mu_next + l * 1792 + 1408 + c);
    const f32x4 gwt = *(const f32x4*)(p.gn_w + l * 384 + c), gbs = *(const f32x4*)(p.gn_b + l * 384 + c), rkw = *(const f32x4*)(p.r_k + l * 384 + c);
    const h16* prk = p.P + hcl * 128 + 2 * c4;
    const h16* pg = p.P + 1408 + c;
    half8 rk_prev = r0 > 0 ? *(const half8*)(prk + (size_t)(r0 - 1) * PC) : zero_h8();
    half4 g_prev = r0 > 0 ? *(const half4*)(pg + (size_t)(r0 - 1) * PC) : zero_h4();
    half8 rk_cur = *(const half8*)(prk + (size_t)r0 * PC);
    half4 g_cur = *(const half4*)(pg + (size_t)r0 * PC);
    half8 rk_next = r0 + 1 < NTOK ? *(const half8*)(prk + (size_t)(r0 + 1) * PC) : zero_h8();
    half4 g_next = r0 + 1 < NTOK ? *(const half4*)(pg + (size_t)(r0 + 1) * PC) : zero_h4();
    half4 yf_c = *(const half4*)(p.P + (size_t)r0 * PC + 768 + c), yb_c = *(const half4*)(p.hy + (size_t)r0 * 1024 + c), v_c = *(const half4*)(p.VB + (size_t)r0 * 384 + c);
#pragma unroll 1
    for (int row = r0; row < r1; ++row) {
      const bool more = row + 1 < r1;
      const half8 rk_nn = row + 2 < NTOK ? *(const half8*)(prk + (size_t)(row + 2) * PC) : zero_h8();
      const half4 g_nn = row + 2 < NTOK ? *(const half4*)(pg + (size_t)(row + 2) * PC) : zero_h4();
      half4 yf_n = yf_c, yb_n = yb_c, v_n = v_c;
      if (more) { yf_n = *(const half4*)(p.P + (size_t)(row + 1) * PC + 768 + c); yb_n = *(const half4*)(p.hy + (size_t)(row + 1) * 1024 + c); v_n = *(const half4*)(p.VB + (size_t)(row + 1) * 384 + c); }
      int t, Tn;
      if (row < NLAT) { t = row & 4095; Tn = 4096; } else { t = (row - NLAT) & 255; Tn = 256; }
      const bool hp = t > 0, hn = t + 1 < Tn;
      f32x4 sh[3];
#pragma unroll
      for (int k = 0; k < 2; ++k) {
        const f32x4 cur = {(float)rk_cur[k], (float)rk_cur[2 + k], (float)rk_cur[4 + k], (float)rk_cur[6 + k]};
        f32x4 prv = {(float)rk_prev[k], (float)rk_prev[2 + k], (float)rk_prev[4 + k], (float)rk_prev[6 + k]};
        f32x4 nxt = {(float)rk_next[k], (float)rk_next[2 + k], (float)rk_next[4 + k], (float)rk_next[6 + k]};
        if (!hp) prv = (f32x4){0.f, 0.f, 0.f, 0.f};
        if (!hn) nxt = (f32x4){0.f, 0.f, 0.f, 0.f};
        sh[k] = cur + (k == 0 ? mpr : mpk) * (prv - cur) + (k == 0 ? mnr : mnk) * (nxt - cur);
      }
      {
        const f32x4 cur = h4f(g_cur);
        f32x4 prv = h4f(g_prev), nxt = h4f(g_next);
        if (!hp) prv = (f32x4){0.f, 0.f, 0.f, 0.f};
        if (!hn) nxt = (f32x4){0.f, 0.f, 0.f, 0.f};
        sh[2] = cur + mpg * (prv - cur) + mng * (nxt - cur);
      }
      const f32x4 y = h4f(yf_c) + h4f(yb_c);
      const f32x4 v = h4f(v_c);
      const float mean = red16(sum4(y)) * (1.f / 64.f);
      const f32x4 yc = y - mean;
      const float var = red16(sum4(yc * yc)) * (1.f / 64.f);
      const float rs = rsqrtf(var + 64e-5f);
      const float bs = red16(sum4(sh[0] * sh[1] * rkw));
      half4 o;
#pragma unroll
      for (int j = 0; j < 4; ++j) o[j] = (h16)((yc[j] * rs * gwt[j] + gbs[j] + bs * v[j]) * siluf_(sh[2][j]));
      h16* yw = dummy ? p.F + (size_t)row * 1536 : p.hy + (size_t)row * 1024;
      if (valid) *(half4*)(yw + c) = o;
      rk_prev = rk_cur; rk_cur = rk_next; rk_next = rk_nn;
      g_prev = g_cur; g_cur = g_next; g_next = g_nn;
      yf_c = yf_n; yb_c = yb_n; v_c = v_n;
    }
  } else {
    const int c = hl * 64 + c4;
    const f32x4 nw = *(const f32x4*)(p.hg_norm_w + l * 256 + c);
    half4 of_c = *(const half4*)(p.P + (size_t)r0 * PC + 1152 + c), ob_c = *(const half4*)(p.hy + (size_t)r0 * 1024 + 384 + c), g_c = *(const half4*)(p.P + (size_t)r0 * PC + 2816 + c);
#pragma unroll 1
    for (int row = r0; row < r1; ++row) {
      half4 of_n = of_c, ob_n = ob_c, g_n = g_c;
      if (row + 1 < r1) { of_n = *(const half4*)(p.P + (size_t)(row + 1) * PC + 1152 + c); ob_n = *(const half4*)(p.hy + (size_t)(row + 1) * 1024 + 384 + c); g_n = *(const half4*)(p.P + (size_t)(row + 1) * PC + 2816 + c); }
      const f32x4 o = h4f(of_c) + h4f(ob_c);
      const f32x4 g = h4f(g_c);
      const float ms = red16(sum4(o * o)) * (1.f / 64.f);
      const float rs = rsqrtf(ms + 1e-6f);
      half4 ov;
#pragma unroll
      for (int j = 0; j < 4; ++j) ov[j] = (h16)(o[j] * rs * nw[j] * siluf_(g[j]));
      h16* yw = dummy ? p.F + (size_t)row * 1536 : p.hy + (size_t)row * 1024;
      *(half4*)(yw + 384 + c) = ov;
      of_c = of_n; ob_c = ob_n; g_c = g_n;
    }
  }
}

__device__ __forceinline__ void phase_final(const Params& p, int bid, int nb) {
  const int tid = tid_opaque(), lane = tid & 63, w = __builtin_amdgcn_readfirstlane(tid >> 6);
  for (int row = bid * 4 + w; row < NLAT; row += nb * 4) {
    float* src = p.out + (size_t)row * 1024;
    f32x4 v[4]; float ss = 0.f;
#pragma unroll
    for (int i = 0; i < 4; ++i) { v[i] = *(const f32x4*)(src + i * 256 + lane * 4); ss += v[i][0] * v[i][0] + v[i][1] * v[i][1] + v[i][2] * v[i][2] + v[i][3] * v[i][3]; }
    ss = wave_sum_dpp(ss);
    const float rs = rsqrtf(ss * (1.f / 1024.f) + 1e-6f);
#pragma unroll
    for (int i = 0; i < 4; ++i) {
      const int col = i * 256 + lane * 4;
      const f32x4 nwv = *(const f32x4*)(p.final_w + col);
      f32x4 o;
#pragma unroll
      for (int j = 0; j < 4; ++j) o[j] = v[i][j] * rs * nwv[j];
      *(f32x4*)(src + col) = o;
    }
  }
}

__global__ void __launch_bounds__(256, 3) __attribute__((target("no-packed-fp32-ops"))) mega(Params p, int ph_lo, int ph_hi, int coop) {
  __shared__ __attribute__((aligned(16))) char smem[SMEM_BYTES];
  __shared__ uint4 xb_words;
  XcdBarrier xb; xb.bar = p.bar; xb.x = 0; xb.st = (volatile LAS unsigned*)&xb_words;
  if (coop) { if (threadIdx.x == 0) xb_words = make_uint4(0u, 0u, 0u, 0u); __syncthreads(); xb = xcd_barrier_post(p.bar, (volatile LAS unsigned*)&xb_words); }
  if (coop) for (int i = 0; i < EXTRA_SYNCS; ++i) { xcd_barrier(xb); }
  if (coop == 2) cg::this_grid().sync();
  for (int ph = ph_lo; ph < ph_hi; ++ph) {
    for (int rep = 0; rep < (((PROBE_MASK >> ph) & 1) ? 2 : 1); ++rep) {
      int bid = blockIdx.x, nb = gridDim.x;
      asm volatile("" : "+s"(bid), "+s"(nb));
      if (ph == 0) phase_prep(p, bid, nb, smem);
      else if (ph == 13) phase_final(p, bid, nb);
      else {
        const int l = (ph - 1) / 6, s = (ph - 1) % 6;
        if (s == 0) phase_norm(p, l, bid, nb);
        else if (s == 1) phase_gemm<0>(p, l, bid, nb, smem);
        else if (s == 2) phase_feat(p, l, bid, nb, smem, PROBE_MASK && ((PROBE_MASK >> ph) & 1) && rep == 0);
        else if (s == 3) phase_mix(p, l, bid, nb, smem, rep ? PROBE_SUB : 7);
        else if (s == 4) phase_readout(p, l, bid, nb, PROBE_MASK && ((PROBE_MASK >> ph) & 1) && rep == 0);
        else phase_gemm<1>(p, l, bid, nb, smem);
      }
      if (PROBE_MASK && rep == 0 && ((PROBE_MASK >> ph) & 1)) { xcd_barrier(xb); }
    }
    if (coop && ph + 1 < ph_hi) { xcd_barrier(xb); }
  }
}

extern "C" void kernel_launch(void* const* d_in, const int* in_sizes, int n_in, void* d_out, int out_size, void* d_ws, size_t ws_size, hipStream_t stream) {
  static int grid_blocks = 0;
  if (!grid_blocks) {
    int dev = 0, cus = 0, per_cu = 0;
    hipGetDevice(&dev);
    hipDeviceGetAttribute(&cus, hipDeviceAttributeMultiprocessorCount, dev);
    hipOccupancyMaxActiveBlocksPerMultiprocessor(&per_cu, mega, 256, 0);
    if (per_cu < 1) per_cu = 1;
    grid_blocks = cus * per_cu;
  }
  Params p{};
  const float* const* in = (const float* const*)d_in;
  p.x = in[0]; p.c = in[1]; p.ctx = in[2]; p.c_ctx = in[3]; p.mod_w = in[4]; p.mod_b = in[5]; p.norm_w = in[6]; p.w_in = in[7]; p.w_out = in[8];
  p.mu_prev = in[9]; p.mu_next = in[10]; p.w0 = in[11]; p.w2 = in[12]; p.a0 = in[13]; p.a2 = in[14]; p.k_k = in[15]; p.k_a = in[16]; p.r_k = in[17];
  p.gn_w = in[18]; p.gn_b = in[19]; p.vw1 = in[20]; p.vw2 = in[21]; p.vb = in[22]; p.lb_logits = in[23]; p.hg_norm_w = in[24]; p.sink = in[25]; p.final_w = in[26];
  p.out = (float*)d_out;
  char* ws = (char*)d_ws; size_t off = 0;
  auto take = [&](size_t bytes) { char* r = ws + off; off += (bytes + 255) & ~(size_t)255; return r; };
  p.win_t = (h16*)take((size_t)2 * NPAD * 1024 * 2);
  p.wout_t = (h16*)take((size_t)2 * 1024 * 1024 * 2);
  p.wl_t = (h16*)take((size_t)2 * 4 * 384 * 64 * 2);
  p.mod = (float*)take((size_t)2 * 9 * 3072 * 4);
  p.rope = (float*)take((size_t)64 * 16 * 2 * 4);
  p.hy = (h16*)take((size_t)NTOK * 1024 * 2);
  p.P = (h16*)take((size_t)NTOK * PC * 2);
  p.F = (h16*)take((size_t)NTOK * 1536 * 2);
  p.VB = (h16*)take((size_t)NTOK * 384 * 2);
  p.VT = (h16*)take((size_t)16 * 64 * VTS * 2);
  p.xc1 = (float*)take((size_t)2048 * 1024 * 4);
  p.bar = (unsigned*)take(16384);
  if (off > ws_size) fprintf(stderr, "workspace too small: need %zu have %zu\n", off, ws_size);
#if SINGLE_LAUNCH
  hipMemsetAsync(p.bar, 0, 16384, stream);
  int lo = 0, hi = 14, coop = 1;
  void* args[] = {&p, &lo, &hi, &coop};
  hipError_t e = hipLaunchCooperativeKernel((void*)mega, dim3(grid_blocks), dim3(256), args, 0, stream);
  if (e != hipSuccess) fprintf(stderr, "cooperative launch failed: %s (grid %d)\n", hipGetErrorString(e), grid_blocks);
#else
  for (int ph = 0; ph < 14; ++ph) mega<<<grid_blocks, 256, 0, stream>>>(p, ph, ph + 1, 0);
#endif
}
```

```cpp
#include <hip/hip_runtime.h>
#include <hip/hip_cooperative_groups.h>
#include <cstdio>
#include <cstdint>
namespace cg = cooperative_groups;

typedef _Float16 h16;
typedef _Float16 half8 __attribute__((ext_vector_type(8)));
typedef _Float16 half4 __attribute__((ext_vector_type(4)));
typedef float f32x16 __attribute__((ext_vector_type(16)));
typedef float f32x4 __attribute__((ext_vector_type(4)));
typedef float f32x2 __attribute__((ext_vector_type(2)));
typedef unsigned u32x4 __attribute__((ext_vector_type(4)));
typedef _Float16 half2v __attribute__((ext_vector_type(2)));

constexpr int NLAT = 32768, NTOK = 34816;
constexpr int PC = 4160;
constexpr int NPAD = 4224;
constexpr int VTS = 4352;
constexpr int SMEM_BYTES = 49152;

#ifndef EXTRA_SYNCS
#define EXTRA_SYNCS 0
#endif
#ifndef PROBE_SUB
#define PROBE_SUB 7
#endif
#ifndef PROBE_MASK
#define PROBE_MASK 0
#endif
#ifndef SINGLE_LAUNCH
#define SINGLE_LAUNCH 1
#endif

struct Params {
  const float *x, *c, *ctx, *c_ctx, *mod_w, *mod_b, *norm_w, *w_in, *w_out;
  const float *mu_prev, *mu_next, *w0, *w2, *a0, *a2, *k_k, *k_a, *r_k, *gn_w, *gn_b;
  const float *vw1, *vw2, *vb, *lb_logits, *hg_norm_w, *sink, *final_w;
  float* out;
  h16 *win_t, *wout_t, *wl_t;
  float* mod;
  h16 *hy, *P, *F, *VB;
  h16* VT;
  float* xc1;
  float* rope;
  unsigned* bar;
};

__device__ __forceinline__ int tid_opaque() { int t = threadIdx.x; asm volatile("" : "+v"(t)); return t; }
__device__ __forceinline__ float wave_sum(float v) {
#pragma unroll
  for (int o = 32; o > 0; o >>= 1) v += __shfl_xor(v, o);
  return v;
}
__device__ __forceinline__ float sigmoidf_(float x) { return __builtin_amdgcn_rcpf(1.f + __expf(-x)); }
__device__ __forceinline__ float siluf_(float x) { return x * __builtin_amdgcn_rcpf(1.f + __expf(-x)); }
template <int CTRL> __device__ __forceinline__ float dpp_mov(float x) {
  return __int_as_float(__builtin_amdgcn_update_dpp(0, __float_as_int(x), CTRL, 0xf, 0xf, true));
}
__device__ __forceinline__ float wave_sum_dpp(float x) {
  x += dpp_mov<0xB1>(x);
  x += dpp_mov<0x4E>(x);
  x += dpp_mov<0x141>(x);
  x += dpp_mov<0x140>(x);
  const int xi = __float_as_int(x);
  return __int_as_float(__builtin_amdgcn_readlane(xi, 0)) + __int_as_float(__builtin_amdgcn_readlane(xi, 16)) +
         __int_as_float(__builtin_amdgcn_readlane(xi, 32)) + __int_as_float(__builtin_amdgcn_readlane(xi, 48));
}
__device__ __forceinline__ float red8(float x) {
  x += dpp_mov<0xB1>(x);
  x += dpp_mov<0x4E>(x);
  x += dpp_mov<0x141>(x);
  return x;
}

#define XB_TMO      128
#define XB_XCNT(j)  (256  + 64 * (j))
#define XB_XSUB(j)  (1280 + 64 * (j))
#define XB_XGEN(j)  (2304 + 64 * (j))
#define XB_TOP      3328
#define XB_TOPGEN   3392
#define XCD_BAR_WORDS 3456
#define XB_SPIN_CAP (1u << 18)
#define LAS __attribute__((address_space(3)))
__device__ __forceinline__ unsigned xb_ld(unsigned* p)              { return __hip_atomic_load(p, __ATOMIC_RELAXED, __HIP_MEMORY_SCOPE_AGENT); }
__device__ __forceinline__ unsigned xb_add(unsigned* p, unsigned v) { return __hip_atomic_fetch_add(p, v, __ATOMIC_RELAXED, __HIP_MEMORY_SCOPE_AGENT); }
__device__ __forceinline__ unsigned xb_xcc_id() { return (unsigned)__builtin_amdgcn_s_getreg((3 << 11) | 20) & 0xFu; }
#define XB_SPIN(cond, bar) do { unsigned _sp = 0; while (cond) { __builtin_amdgcn_s_sleep(1); \
    if ((++_sp & 255u) == 0u) { if (xb_ld(&(bar)[XB_TMO])) break; if (_sp > XB_SPIN_CAP) { atomicAdd(&(bar)[XB_TMO], 1u); break; } } } } while (0)
struct XcdBarrier { unsigned* bar; unsigned x; volatile LAS unsigned* st; };
__device__ __forceinline__ XcdBarrier xcd_barrier_post(unsigned* bar, volatile LAS unsigned* st) {
  XcdBarrier b; b.bar = bar; b.x = xb_xcc_id(); b.st = st;
  if (threadIdx.x == 0) (void)xb_add(&bar[XB_XCNT(b.x)], 1u);
  return b;
}
__device__ __forceinline__ void xcd_barrier_complete(unsigned* bar, unsigned x, unsigned& nloc, unsigned& nx) {
  const unsigned G = gridDim.x * gridDim.y * gridDim.z;
  unsigned sum, cnt, mine, sp = 0u;
  for (;;) {
    sum = 0u; cnt = 0u; mine = 0u;
#pragma unroll
    for (unsigned j = 0; j < 16; ++j) { const unsigned c = xb_ld(&bar[XB_XCNT(j)]); sum += c; cnt += (c > 0u) ? 1u : 0u; mine = (j == x) ? c : mine; }
    if (sum == G) break;
    __builtin_amdgcn_s_sleep(1);
    if ((++sp & 255u) == 0u) { if (xb_ld(&bar[XB_TMO])) break; if (sp > XB_SPIN_CAP) { atomicAdd(&bar[XB_TMO], 1u); break; } }
  }
  nloc = mine > 0u ? mine : 1u; nx = cnt > 0u ? cnt : 1u;
}
__device__ __forceinline__ void xcd_barrier(const XcdBarrier& b) {
  asm volatile("s_waitcnt vmcnt(0)" ::: "memory");
  __syncthreads();
  if (threadIdx.x == 0) {
    unsigned* bar = b.bar;
    __builtin_amdgcn_s_waitcnt(0);
    unsigned nloc = b.st[0], nx = b.st[1];
    if (nloc == 0u) { xcd_barrier_complete(bar, b.x, nloc, nx); b.st[0] = nloc; b.st[1] = nx; }
    const unsigned old = xb_add(&bar[XB_XSUB(b.x)], 1u);
    const unsigned gen = old / nloc;
    if (old + 1u == (gen + 1u) * nloc) {
      __builtin_amdgcn_fence(__ATOMIC_RELEASE, "agent");
      asm volatile("s_waitcnt vmcnt(0)" ::: "memory");
      const unsigned og = xb_add(&bar[XB_TOP], 1u);
      const unsigned tg = og / nx;
      if (og + 1u == (tg + 1u) * nx) xb_add(&bar[XB_TOPGEN], 1u);
      else XB_SPIN(xb_ld(&bar[XB_TOPGEN]) == tg, bar);
      __builtin_amdgcn_fence(__ATOMIC_ACQUIRE, "agent");
      xb_add(&bar[XB_XGEN(b.x)], 1u);
      asm volatile("s_waitcnt vmcnt(0)" ::: "memory");
    } else {
      XB_SPIN(xb_ld(&bar[XB_XGEN(b.x)]) == gen, bar);
      __builtin_amdgcn_fence(__ATOMIC_ACQUIRE, "agent");
      asm volatile("s_waitcnt vmcnt(0)" ::: "memory");
    }
  }
  __syncthreads();
}

__device__ __forceinline__ void phase_prep(const Params& p, int bid, int nb, char* smem) {
  const int tid = tid_opaque();
  float* sf = (float*)smem;
  constexpr int N_WIN = 2048, N_WOUT = 512, N_MOD = 192, N_PADI = 1024, N_WL = 768;
  constexpr int total = N_WIN + N_WOUT + N_MOD + N_PADI + N_WL + 1;
  for (int it = bid; it < total; it += nb) {
    if (it < N_WIN + N_WOUT) {
      const float* src; h16* dst; int ncols, kt, ntile;
      if (it < N_WIN) { int l = it >> 10, r = it & 1023; kt = r >> 6; ntile = r & 63; src = p.w_in + (size_t)l * 1024 * 4096; dst = p.win_t + (size_t)l * NPAD * 1024; ncols = 4096; }
      else { int j = it - N_WIN; int l = j >> 8, r = j & 255; kt = r >> 4; ntile = r & 15; src = p.w_out + (size_t)l * 1024 * 1024; dst = p.wout_t + (size_t)l * 1024 * 1024; ncols = 1024; }
      for (int i = tid; i < 4096; i += 256) { int kk = i >> 6, nn = i & 63; sf[kk * 65 + nn] = src[(size_t)(kt * 64 + kk) * ncols + ntile * 64 + nn]; }
      __syncthreads();
      const bool rkperm = it < N_WIN && ntile < 12;
      for (int i = tid; i < 4096; i += 256) {
        int nn = i >> 6, kk = i & 63;
        const int nrow = rkperm ? ((ntile % 6) * 128 + 2 * nn + ntile / 6) : (ntile * 64 + nn);
        dst[(size_t)nrow * 1024 + kt * 64 + kk] = (h16)sf[kk * 65 + nn];
      }
      __syncthreads();
    } else if (it < N_WIN + N_WOUT + N_MOD) {
      const int j = it - N_WIN - N_WOUT; const int l = j / 96; const int cl = tid & 31, ks = tid >> 5; const int col = (j % 96) * 32 + cl;
      for (int i = tid; i < 9 * 1024; i += 256) { int r = i >> 10, k = i & 1023; float v = r < 8 ? p.c[r * 1024 + k] : p.c_ctx[k]; sf[i] = siluf_(v); }
      __syncthreads();
      float acc[9];
#pragma unroll
      for (int r = 0; r < 9; ++r) acc[r] = 0.f;
      const float* mw = p.mod_w + (size_t)l * 1024 * 3072 + (size_t)(ks * 128) * 3072 + col;
#pragma unroll 2
      for (int k = 0; k < 128; k += 4) {
        const float w0 = mw[(size_t)k * 3072], w1 = mw[(size_t)(k + 1) * 3072], w2 = mw[(size_t)(k + 2) * 3072], w3 = mw[(size_t)(k + 3) * 3072];
#pragma unroll
        for (int r = 0; r < 9; ++r) { const f32x4 sv = *(const f32x4*)&sf[r * 1024 + ks * 128 + k]; acc[r] += sv[0] * w0 + sv[1] * w1 + sv[2] * w2 + sv[3] * w3; }
      }
#pragma unroll
      for (int r = 0; r < 9; ++r) acc[r] += __shfl_xor(acc[r], 32);
      __syncthreads();
      if ((tid & 63) < 32) {
#pragma unroll
        for (int r = 0; r < 9; ++r) sf[((tid >> 6) * 9 + r) * 32 + cl] = acc[r];
      }
      __syncthreads();
      for (int i = tid; i < 288; i += 256) {
        const int r = i >> 5, c2 = i & 31;
        const float v = sf[(0 * 9 + r) * 32 + c2] + sf[(1 * 9 + r) * 32 + c2] + sf[(2 * 9 + r) * 32 + c2] + sf[(3 * 9 + r) * 32 + c2];
        const int cc = (j % 96) * 32 + c2;
        p.mod[(size_t)(l * 9 + r) * 3072 + cc] = v + p.mod_b[l * 3072 + cc];
      }
      __syncthreads();
    } else if (it < N_WIN + N_WOUT + N_MOD + N_PADI) {
      int j = it - (N_WIN + N_WOUT + N_MOD); int idx = j * 256 + tid;
      int l = idx >> 17; int rem = idx & 131071; int m = rem >> 10, k = rem & 1023;
      float v = (l == 1 && m < 32) ? p.vw1[k * 32 + m] : 0.f;
      p.win_t[(size_t)l * NPAD * 1024 + (size_t)(4096 + m) * 1024 + k] = (h16)v;
    } else if (it < N_WIN + N_WOUT + N_MOD + N_PADI + N_WL) {
      const int idx = (it - (N_WIN + N_WOUT + N_MOD + N_PADI)) * 256 + tid;
      const int r = idx & 63, c = (idx >> 6) % 384, ls = idx / (384 * 64); const int l = ls >> 2, slot = ls & 3, dir = slot & 1, kind = slot >> 1;
      const float v = (kind == 0 ? p.w2 : p.a2)[((size_t)(l * 2 + dir) * 64 + r) * 384 + c];
      p.wl_t[idx] = (h16)v;
    } else {
      if (tid < 16) {
        double inv = 1.0; for (int i = 0; i < tid; ++i) inv *= 0.5623413251903491;
        double x2 = inv * inv, ts = inv, tc = 1.0, s1 = inv, c1 = 1.0;
        for (int n = 1; n <= 10; ++n) { tc *= -x2 / ((2.0 * n - 1.0) * (2.0 * n)); c1 += tc; ts *= -x2 / ((2.0 * n) * (2.0 * n + 1.0)); s1 += ts; }
        double cc = 1.0, ss = 0.0;
        for (int pos = 0; pos < 64; ++pos) {
          p.rope[(pos * 16 + tid) * 2] = (float)cc; p.rope[(pos * 16 + tid) * 2 + 1] = (float)ss;
          double nc = cc * c1 - ss * s1, ns = ss * c1 + cc * s1; cc = nc; ss = ns;
        }
      }
    }
  }
}

__device__ __forceinline__ void phase_norm(const Params& p, int l, int bid, int nb) {
  const int tid = tid_opaque(), lane = tid & 63, w = __builtin_amdgcn_readfirstlane(tid >> 6);
  for (int row = bid * 4 + w; row < NTOK; row += nb * 4) {
    const float* src = (l == 0) ? (row < NLAT ? p.x + (size_t)row * 1024 : p.ctx + (size_t)(row - NLAT) * 1024)
                                : (row < NLAT ? p.out + (size_t)row * 1024 : p.xc1 + (size_t)(row - NLAT) * 1024);
    const int mr = row < NLAT ? (row >> 12) : 8;
    const float* md = p.mod + (size_t)(l * 9 + mr) * 3072;
    const float* nw = p.norm_w + l * 1024;
    f32x4 v[4]; float ss = 0.f;
#pragma unroll
    for (int i = 0; i < 4; ++i) { v[i] = *(const f32x4*)(src + i * 256 + lane * 4); ss += v[i][0] * v[i][0] + v[i][1] * v[i][1] + v[i][2] * v[i][2] + v[i][3] * v[i][3]; }
    ss = wave_sum_dpp(ss);
    const float rs = rsqrtf(ss * (1.f / 1024.f) + 1e-6f);
#pragma unroll
    for (int i = 0; i < 4; ++i) {
      const int col = i * 256 + lane * 4;
      f32x4 nwv = *(const f32x4*)(nw + col), sc = *(const f32x4*)(md + 1024 + col), sh = *(const f32x4*)(md + col);
      half4 o;
#pragma unroll
      for (int j = 0; j < 4; ++j) o[j] = (h16)(v[i][j] * rs * nwv[j] * (1.f + sc[j]) + sh[j]);
      *(half4*)(p.hy + (size_t)row * 1024 + col) = o;
    }
  }
}

template <int MODE>
__device__ __forceinline__ void phase_gemm(const Params& p, int l, int bid, int nb, char* smem) {
  const h16* A = p.hy;
  const h16* Bt = MODE == 0 ? p.win_t + (size_t)l * NPAD * 1024 : p.wout_t + (size_t)l * 1024 * 1024;
  const int ntn = MODE == 0 ? (l == 1 ? 33 : 32) : 8;
  const int ntm = (MODE == 1 && l == 1) ? 256 : 272;
  const int tid = tid_opaque(), lane = tid & 63, w = __builtin_amdgcn_readfirstlane(tid >> 6), wr = w >> 1, wc = w & 1, lq = lane & 31, hh = lane >> 5;
  h16* As = (h16*)smem; h16* Bs = As + 128 * 72;
  const int ldrow = tid >> 3, ldch = (tid & 7) * 8;
  for (int tile = bid; tile < ntm * ntn; tile += nb) {
    int tm, tn;
    {
      const int mper = ntm >> 3;
      const int nmain = MODE == 0 ? 32 : 8;
      if (tile < ntm * nmain) {
        const int x = tile & 7, sq = tile >> 3;
        const int strip = sq / (mper * 8), rem = sq - strip * (mper * 8);
        tm = x * mper + (rem >> 3); tn = strip * 8 + (rem & 7);
      } else { tm = tile - ntm * nmain; tn = nmain; }
    }
    const h16* Ag = A + (size_t)(tm * 128 + ldrow) * 1024 + ldch; const h16* Bg = Bt + (size_t)(tn * 128 + ldrow) * 1024 + ldch;
    f32x16 acc[2][2];
#pragma unroll
    for (int i = 0; i < 2; ++i)
#pragma unroll
      for (int j = 0; j < 2; ++j)
#pragma unroll
        for (int r = 0; r < 16; ++r) acc[i][j][r] = 0.f;
    u32x4 ra[4], rb[4];
#pragma unroll
    for (int i = 0; i < 4; ++i) { ra[i] = *(const u32x4*)(Ag + (size_t)i * 32 * 1024); rb[i] = *(const u32x4*)(Bg + (size_t)i * 32 * 1024); }
#pragma unroll 2
    for (int kt = 0; kt < 16; ++kt) {
      __syncthreads();
#pragma unroll
      for (int i = 0; i < 4; ++i) { *(u32x4*)(As + (ldrow + i * 32) * 72 + ldch) = ra[i]; *(u32x4*)(Bs + (ldrow + i * 32) * 72 + ldch) = rb[i]; }
      __syncthreads();
      if (kt + 1 < 16) {
#pragma unroll
        for (int i = 0; i < 4; ++i) { ra[i] = *(const u32x4*)(Ag + (size_t)i * 32 * 1024 + (kt + 1) * 64); rb[i] = *(const u32x4*)(Bg + (size_t)i * 32 * 1024 + (kt + 1) * 64); }
      }
#pragma unroll
      for (int s = 0; s < 4; ++s) {
        half8 a[2], b[2];
#pragma unroll
        for (int i = 0; i < 2; ++i) { a[i] = *(const half8*)(As + (64 * wr + 32 * i + lq) * 72 + 16 * s + 8 * hh); b[i] = *(const half8*)(Bs + (64 * wc + 32 * i + lq) * 72 + 16 * s + 8 * hh); }
#pragma unroll
        for (int i = 0; i < 2; ++i)
#pragma unroll
          for (int j = 0; j < 2; ++j) {
            if (MODE == 0) acc[i][j] = __builtin_amdgcn_mfma_f32_32x32x16_f16(b[j], a[i], acc[i][j], 0, 0, 0);
            else acc[i][j] = __builtin_amdgcn_mfma_f32_32x32x16_f16(a[i], b[j], acc[i][j], 0, 0, 0);
          }
      }
    }
    if (MODE == 0) {
      if (tn < 32) {
        __syncthreads();
        h16* Cs = (h16*)smem;
#pragma unroll
        for (int i = 0; i < 2; ++i)
#pragma unroll
          for (int j = 0; j < 2; ++j)
#pragma unroll
            for (int g = 0; g < 4; ++g) {
              half4 o;
#pragma unroll
              for (int q = 0; q < 4; ++q) o[q] = (h16)acc[i][j][4 * g + q];
              *(half4*)(Cs + (64 * wr + 32 * i + lq) * 136 + 64 * wc + 32 * j + 8 * g + 4 * hh) = o;
            }
        __syncthreads();
#pragma unroll
        for (int q = 0; q < 8; ++q) {
          const int id = tid + q * 256; const int row = id >> 4, ch = id & 15;
          *(u32x4*)(p.P + (size_t)(tm * 128 + row) * PC + tn * 128 + ch * 8) = *(const u32x4*)(Cs + row * 136 + ch * 8);
        }
      } else if (wc == 0) {
#pragma unroll
        for (int i = 0; i < 2; ++i)
#pragma unroll
          for (int r = 0; r < 16; ++r) ((float*)(p.F + (size_t)(tm * 128 + 64 * wr + 32 * i + lq) * 1536))[(r & 3) + 8 * (r >> 2) + 4 * hh] = acc[i][0][r];
      }
    } else {
      const int row0 = tm * 128;
      const int mr = row0 < NLAT ? (row0 >> 12) : 8;
      const int col = tn * 128 + 64 * wc + lq;
      const float* gp = p.mod + (size_t)(l * 9 + mr) * 3072 + 2048 + col;
      const float g0 = gp[0], g1 = gp[32];
      const float* xs0; float* xd0;
      if (l == 0) { if (row0 < NLAT) { xs0 = p.x + (size_t)row0 * 1024; xd0 = p.out + (size_t)row0 * 1024; } else { xs0 = p.ctx + (size_t)(row0 - NLAT) * 1024; xd0 = p.xc1 + (size_t)(row0 - NLAT) * 1024; } }
      else { xs0 = p.out + (size_t)row0 * 1024; xd0 = p.out + (size_t)row0 * 1024; }
      const float* __restrict__ xsrc = xs0 + (size_t)(64 * wr + 4 * hh) * 1024 + col;
      float* __restrict__ xdst = xd0 + (size_t)(64 * wr + 4 * hh) * 1024 + col;
#pragma unroll
      for (int i = 0; i < 2; ++i)
#pragma unroll
        for (int r = 0; r < 16; ++r) {
          const int ro = (32 * i + (r & 3) + 8 * (r >> 2)) * 1024;
          xdst[ro] = xsrc[ro] + g0 * acc[i][0][r];
          xdst[ro + 32] = xsrc[ro + 32] + g1 * acc[i][1][r];
        }
    }
  }
}

#define LOAD_COL34(arr, base, t0, Tn) \
  _Pragma("unroll") for (int q_ = 0; q_ < 34; ++q_) { const int t_ = (t0) - 1 + q_; arr[q_] = (t_ >= 0 && t_ < (Tn)) ? (base)[(long)t_ * PC] : (h16)0.f; }

__device__ __forceinline__ void phase_feat(const Params& p, int l, int bid, int nb, char* smem, bool dry) {
  const int tid = tid_opaque();
  h16* inh = (h16*)smem;
  float* zt = (float*)(smem + 32 * 264 * 2);
  for (int item = bid; item < 1088; item += nb) {
    int b, t0, Tn, rowbase; bool isctx;
    if (item < 1024) { b = item >> 7; t0 = (item & 127) * 32; Tn = 4096; rowbase = b * 4096; isctx = false; }
    else { int j = item - 1024; b = j >> 3; t0 = (j & 7) * 32; Tn = 256; rowbase = NLAT + b * 256; isctx = true; }
    {
      const int col = 1152 + tid;
      const float mp = p.mu_prev[l * 1792 + col], mn = p.mu_next[l * 1792 + col];
      const h16* base = p.P + (size_t)rowbase * PC + col;
      h16 xv[34];
      LOAD_COL34(xv, base, t0, Tn)
#pragma unroll
      for (int tt = 0; tt < 32; ++tt) {
        const float prev = (float)xv[tt], cur = (float)xv[tt + 1], nxt = (float)xv[tt + 2];
        float sv = cur + mp * (prev - cur) + mn * (nxt - cur);
        if (tid < 128) { const float e2 = __expf(2.f * sv); sv = 1.f - 2.f / (e2 + 1.f); }
        inh[tt * 264 + tid] = (h16)sv;
      }
      if (l == 1) {
#pragma unroll
        for (int i = 0; i < 4; ++i) { int id = tid + i * 256; zt[id] = ((const float*)(p.F + (size_t)(rowbase + t0 + (id >> 5)) * 1536))[id & 31]; }
      }
    }
    __syncthreads();
#pragma unroll 1
    for (int c = tid; c < 384; c += 256) {
      const int col = 768 + c;
      const float mp = p.mu_prev[l * 1792 + col], mn = p.mu_next[l * 1792 + col];
      const h16* base = p.P + (size_t)rowbase * PC + col;
      h16 xv[34];
      LOAD_COL34(xv, base, t0, Tn)
      h16* dst = p.VB + (size_t)(rowbase + t0) * 384 + c;
      if (l == 0) {
#pragma unroll
        for (int tt = 0; tt < 32; ++tt) {
          const float prev = (float)xv[tt], cur = (float)xv[tt + 1], nxt = (float)xv[tt + 2];
          dst[tt * 384] = (h16)(cur + mp * (prev - cur) + mn * (nxt - cur));
        }
      } else {
        const float vbv = p.vb[c];
#pragma unroll 1
        for (int hf = 0; hf < 2; ++hf) {
          h16 vfv[16]; float ga[16];
#pragma unroll
          for (int tt = 0; tt < 16; ++tt) { vfv[tt] = dst[(hf * 16 + tt) * 384]; ga[tt] = vbv; }
#pragma unroll 1
          for (int m = 0; m < 32; m += 4) {
            const float w0 = p.vw2[m * 384 + c], w1 = p.vw2[(m + 1) * 384 + c], w2 = p.vw2[(m + 2) * 384 + c], w3 = p.vw2[(m + 3) * 384 + c];
#pragma unroll
            for (int tt = 0; tt < 16; ++tt) { const f32x4 z = *(const f32x4*)&zt[(hf * 16 + tt) * 32 + m]; ga[tt] += z[0] * w0 + z[1] * w1 + z[2] * w2 + z[3] * w3; }
          }
#pragma unroll
          for (int tt = 0; tt < 16; ++tt) {
            const float prev = hf ? (float)xv[16 + tt] : (float)xv[tt], cur = hf ? (float)xv[17 + tt] : (float)xv[tt + 1], nxt = hf ? (float)xv[18 + tt] : (float)xv[tt + 2];
            const float sv = cur + mp * (prev - cur) + mn * (nxt - cur);
            dst[(hf * 16 + tt) * 384] = (h16)(sv + ((float)vfv[tt] - sv) * sigmoidf_(ga[tt]));
          }
        }
      }
    }
    {
      const int w = __builtin_amdgcn_readfirstlane(tid >> 6), lane = tid & 63, lq = tid & 31, hh = lane >> 5;
      const int dir = w & 1, chalf = w >> 1;
      half8 xin[2][4];
#pragma unroll
      for (int kind = 0; kind < 2; ++kind)
#pragma unroll
        for (int ks = 0; ks < 4; ++ks) xin[kind][ks] = *(const half8*)(inh + lq * 264 + kind * 128 + dir * 64 + 16 * ks + 8 * hh);
      h16* ost = (h16*)(smem + 32 * 264 * 2 + 4096) + w * (32 * 72);
      h16* fbase = p.F + (size_t)(rowbase + t0) * 1536 + dir * 768 + chalf * 384;
#pragma unroll 1
      for (int np = 0; np < 6; ++np) {
        const int c0 = chalf * 192 + np * 32;
        f32x16 acc[2];
#pragma unroll
        for (int kind = 0; kind < 2; ++kind) {
          const float* bias = (kind == 0 ? p.w0 : p.a0) + (l * 2 + dir) * 384 + c0;
          const h16* wl = p.wl_t + (size_t)((l * 4 + kind * 2 + dir) * 384 + c0) * 64;
#pragma unroll
          for (int g = 0; g < 4; ++g) { const f32x4 bv = *(const f32x4*)(bias + 8 * g + 4 * hh); acc[kind][4 * g] = bv[0]; acc[kind][4 * g + 1] = bv[1]; acc[kind][4 * g + 2] = bv[2]; acc[kind][4 * g + 3] = bv[3]; }
#pragma unroll
          for (int ks = 0; ks < 4; ++ks) {
            const half8 wf = *(const half8*)(wl + (size_t)lq * 64 + 16 * ks + 8 * hh);
            acc[kind] = __builtin_amdgcn_mfma_f32_32x32x16_f16(wf, xin[kind][ks], acc[kind], 0, 0, 0);
          }
        }
#pragma unroll
        for (int g = 0; g < 4; ++g) {
          half8 o;
#pragma unroll
          for (int j = 0; j < 4; ++j) { o[2 * j] = (h16)(1.f - __expf(-0.6065306597126334f * sigmoidf_(acc[0][4 * g + j]))); o[2 * j + 1] = (h16)sigmoidf_(acc[1][4 * g + j]); }
          *(half8*)(ost + lq * 72 + 16 * g + 8 * hh) = o;
        }
        asm volatile("s_waitcnt lgkmcnt(0)" ::: "memory");
#pragma unroll
        for (int q = 0; q < 4; ++q) {
          const int id = lane + q * 64; const int rr = id >> 3, ch = id & 7;
          *(u32x4*)(fbase + (size_t)rr * 1536 + np * 64 + ch * 8) = *(const u32x4*)(ost + rr * 72 + ch * 8);
        }
        asm volatile("s_waitcnt lgkmcnt(0)" ::: "memory");
      }
    }
    {
      const int head = tid >> 5, pr = tid & 31, half = pr >> 4, i = pr & 15;
      const int colbase = head < 6 ? 3072 + head * 64 : 3456 + (head - 6) * 64;
      const int d1 = half * 32 + i;
      const float qs = (head < 6 && !dry) ? 0.125f : 1.f;
      h16* pp = p.P + (size_t)(rowbase + t0) * PC + colbase + d1;
      h16 x1[32], x2[32];
#pragma unroll
      for (int u = 0; u < 32; ++u) { x1[u] = pp[(size_t)u * PC]; x2[u] = pp[(size_t)u * PC + 16]; }
#pragma unroll
      for (int u = 0; u < 32; ++u) {
        const int t = t0 + u;
        float cs = 1.f, sn = 0.f;
        if (!isctx && !dry) { const int pos = half == 0 ? (t >> 6) : (t & 63); const f32x2 r2 = *(const f32x2*)&p.rope[(pos * 16 + i) * 2]; cs = r2[0]; sn = r2[1]; }
        const float a = (float)x1[u], bq = (float)x2[u];
        pp[(size_t)u * PC] = (h16)((a * cs - bq * sn) * qs);
        pp[(size_t)u * PC + 16] = (h16)((a * sn + bq * cs) * qs);
      }
    }
    if (tid < 128) {
      const int g = tid >> 6, d = tid & 63;
      const h16* base = p.P + (size_t)(rowbase + t0) * PC + 3584 + tid;
      h16* dst = p.VT + (size_t)((b * 2 + g) * 64 + d) * VTS + (isctx ? 4096 + t0 : t0);
      half8 v[4];
#pragma unroll
      for (int q = 0; q < 4; ++q)
#pragma unroll
        for (int j = 0; j < 8; ++j) v[q][j] = base[(size_t)(q * 8 + j) * PC];
#pragma unroll
      for (int q = 0; q < 4; ++q) *(half8*)(dst + q * 8) = v[q];
    }
    __syncthreads();
  }
}

__device__ __forceinline__ float ulo(unsigned u) { return (float)__builtin_bit_cast(h16, (unsigned short)(u & 0xffffu)); }
__device__ __forceinline__ float uhi(unsigned u) { return (float)__builtin_bit_cast(h16, (unsigned short)(u >> 16)); }
__device__ __forceinline__ float red16(float x) {
  x += dpp_mov<0xB1>(x);
  x += dpp_mov<0x4E>(x);
  x += dpp_mov<0x141>(x);
  x += dpp_mov<0x140>(x);
  return x;
}
#define LDS_BARRIER() do { asm volatile("s_waitcnt lgkmcnt(0)" ::: "memory"); __builtin_amdgcn_s_barrier(); asm volatile("" ::: "memory"); } while (0)
constexpr int RREC = 336;
struct RwkvPf { unsigned rk[6]; h16 v[4]; unsigned ea[4]; };

__device__ __forceinline__ void rwkv_chain(const Params& p, int l, int item, char* smem) {
  const int tid0 = tid_opaque();
  const int tid = (item >= 256) ? (tid0 ^ 128) : tid0;
  const int lane = tid & 63, w = __builtin_amdgcn_readfirstlane(tid >> 6);
  const int chain = item >> 2, vq = item & 3;
  const int dir = chain / 48, b = (chain % 48) / 6, h = chain % 6;
  float* opb = (float*)smem;
  float* ybuf = opb + 2 * 8 * RREC;
  constexpr int NCH = 544;
  if (w < 2) {
    const int rl = tid >> 3, kq = tid & 7;
    float S[8];
#pragma unroll
    for (int j = 0; j < 8; ++j) S[j] = 0.f;
    __builtin_amdgcn_s_setprio(3);
    LDS_BARRIER();
#pragma unroll 1
    for (int ci = 0; ci < NCH; ++ci) {
      const float* op = opb + (ci & 1) * 8 * RREC;
      float* yb = ybuf + (ci & 1) * 1024;
      f32x4 aA = *(const f32x4*)(op + 8 * kq + 64), aB = *(const f32x4*)(op + 8 * kq + 68);
#pragma unroll
      for (int step = 0; step < 8; ++step) {
        const float* o = op + step * RREC + 8 * kq;
        const f32x4 wA = *(const f32x4*)(o), wB = *(const f32x4*)(o + 4);
        const f32x4 bA = *(const f32x4*)(o + 128), bB = *(const f32x4*)(o + 132);
        const f32x4 kA = *(const f32x4*)(o + 192), kB = *(const f32x4*)(o + 196);
        const f32x4 rA = *(const f32x4*)(o + 256), rB = *(const f32x4*)(o + 260);
        const float vv = op[step * RREC + 320 + rl];
        f32x4 naA = aA, naB = aB;
        if (step + 1 < 8) { naA = *(const f32x4*)(o + RREC + 64); naB = *(const f32x4*)(o + RREC + 68); }
        const float d0 = S[0] * aA[0] + S[1] * aA[1] + S[2] * aA[2] + S[3] * aA[3];
        const float d1 = S[4] * aB[0] + S[5] * aB[1] + S[6] * aB[2] + S[7] * aB[3];
        const float sa = red8(d0 + d1);
#pragma unroll
        for (int j = 0; j < 4; ++j) {
          S[j] = S[j] * wA[j] + sa * bA[j] + vv * kA[j];
          S[4 + j] = S[4 + j] * wB[j] + sa * bB[j] + vv * kB[j];
        }
        const float y0 = S[0] * rA[0] + S[1] * rA[1] + S[2] * rA[2] + S[3] * rA[3];
        const float y1 = S[4] * rB[0] + S[5] * rB[1] + S[6] * rB[2] + S[7] * rB[3];
        yb[step * 128 + tid] = y0 + y1;
        aA = naA; aB = naB;
      }
      LDS_BARRIER();
    }
    __builtin_amdgcn_s_setprio(0);
  } else {
    const int lw = w - 2, lt = tid - 128;
    const int hc = h * 64 + lane;
    const float mpr = p.mu_prev[l * 1792 + hc], mnr = p.mu_next[l * 1792 + hc];
    const float mpk = p.mu_prev[l * 1792 + 384 + hc], mnk = p.mu_next[l * 1792 + 384 + hc];
    const float kkw = p.k_k[l * 384 + hc], kaw = p.k_a[l * 384 + hc];
    const float cAr = dir ? mnr : mpr, cBr = dir ? mpr : mnr, cAk = dir ? mnk : mpk, cBk = dir ? mpk : mnk;
    const unsigned* zrow = p.bar + XCD_BAR_WORDS;
    RwkvPf pfA, pfB, pfC, pfD;
#define RWKV_ISSUE(ci_, PF) { const int seg_ = (ci_) >= 32; const int Tn_ = seg_ ? 4096 : 256; const int rb_ = seg_ ? b * 4096 : NLAT + b * 256; const int s0_ = (seg_ ? (ci_) - 32 : (ci_)) * 8 + 4 * lw; \
    _Pragma("unroll") for (int q = 0; q < 6; ++q) { const int t_ = dir == 0 ? s0_ - 1 + q : Tn_ - s0_ - q; \
      const unsigned* src_ = ((unsigned)t_ < (unsigned)Tn_) ? (const unsigned*)(p.P + (size_t)(rb_ + t_) * PC + h * 128) : zrow; \
      PF.rk[q] = src_[lane]; } \
    _Pragma("unroll") for (int i = 0; i < 4; ++i) { const int t_ = dir == 0 ? s0_ + i : Tn_ - 1 - (s0_ + i); const size_t row = (size_t)rb_ + t_; \
      PF.v[i] = p.VB[row * 384 + hc]; PF.ea[i] = ((const unsigned*)(p.F + row * 1536 + dir * 768))[hc]; } }
#define RWKV_STAGE(ci_, PF) { float* op_ = opb + ((ci_) & 1) * 8 * RREC; \
    const int seg = (ci_) >= 32; const int Tn = seg ? 4096 : 256; const int c0 = (seg ? (ci_) - 32 : (ci_)) * 8; \
    _Pragma("unroll") for (int i = 0; i < 4; ++i) { \
      const int step = lw * 4 + i; const int t = dir == 0 ? c0 + step : Tn - 1 - (c0 + step); \
      const float rlo = ulo(PF.rk[i]), r0 = ulo(PF.rk[i + 1]), rhi = ulo(PF.rk[i + 2]); \
      const float klo = uhi(PF.rk[i]), k0 = uhi(PF.rk[i + 1]), khi = uhi(PF.rk[i + 2]); \
      const float vv = (float)PF.v[i], e = ulo(PF.ea[i]), al = uhi(PF.ea[i]); \
      const float rs = r0 + cAr * (rlo - r0) + cBr * (rhi - r0); \
      const float ks = k0 + cAk * (klo - k0) + cBk * (khi - k0); \
      const float kkr = ks * kkw; \
      const float n2 = wave_sum_dpp(kkr * kkr); \
      const float kk = kkr * rsqrtf(fmaxf(n2, 1e-24f)); \
      float* o = op_ + step * RREC + lane; \
      o[0] = 1.f - e; o[64] = -kk; o[128] = kk * al; o[192] = ks * (1.f + (al - 1.f) * kaw); o[256] = rs; \
      if ((lane >> 4) == vq) op_[step * RREC + 320 + (lane & 15)] = vv; } }
#define RWKV_WRITE(cj_) { const int seg = (cj_) >= 32; const int Tn = seg ? 4096 : 256; const int rowbase = seg ? b * 4096 : NLAT + b * 256; const int c0 = (seg ? (cj_) - 32 : (cj_)) * 8; \
    if (seg == 1 || l == 0) { const float* yb = ybuf + ((cj_) & 1) * 1024; \
      const int step = lt >> 4, ch = lt & 15; \
      const int t = dir == 0 ? c0 + step : Tn - 1 - (c0 + step); \
      const f32x4 y0 = *(const f32x4*)(yb + step * 128 + ch * 8), y1 = *(const f32x4*)(yb + step * 128 + ch * 8 + 4); \
      const f32x4 ys = y0 + y1; const h16 yv = (h16)((ys[0] + ys[1]) + (ys[2] + ys[3])); \
      if (dir == 0) p.P[(size_t)(rowbase + t) * PC + 768 + h * 64 + 16 * vq + ch] = yv; \
      else p.hy[(size_t)(rowbase + t) * 1024 + h * 64 + 16 * vq + ch] = yv; } }
    RWKV_ISSUE(0, pfA)
    RWKV_STAGE(0, pfA)
    RWKV_ISSUE(1, pfB)
    RWKV_ISSUE(2, pfC)
    RWKV_ISSUE(3, pfD)
    RWKV_ISSUE(4, pfA)
    LDS_BARRIER();
#pragma unroll 1
    for (int ci = 0; ci < NCH; ci += 4) {
      if (ci + 1 < NCH) RWKV_STAGE(ci + 1, pfB)
      if (ci + 5 < NCH) RWKV_ISSUE(ci + 5, pfB)
      if (ci >= 1) RWKV_WRITE(ci - 1)
      LDS_BARRIER();
      if (ci + 2 < NCH) RWKV_STAGE(ci + 2, pfC)
      if (ci + 6 < NCH) RWKV_ISSUE(ci + 6, pfC)
      RWKV_WRITE(ci)
      LDS_BARRIER();
      if (ci + 3 < NCH) RWKV_STAGE(ci + 3, pfD)
      if (ci + 7 < NCH) RWKV_ISSUE(ci + 7, pfD)
      RWKV_WRITE(ci + 1)
      LDS_BARRIER();
      if (ci + 4 < NCH) RWKV_STAGE(ci + 4, pfA)
      if (ci + 8 < NCH) RWKV_ISSUE(ci + 8, pfA)
      RWKV_WRITE(ci + 2)
      LDS_BARRIER();
    }
    RWKV_WRITE(NCH - 1)
  }
}

constexpr int HREC = 224;
struct HgrnPf { h16 f[4], q[4], iv[4]; };
__device__ __forceinline__ void hgrn_chain(const Params& p, int l, int item, char* smem) {
  const int tid = tid_opaque(), lane = tid & 63, w = __builtin_amdgcn_readfirstlane(tid >> 6);
  const int chain = item >> 1, vh = item & 1;
  const int dir = chain / 32, b = (chain % 32) / 4, h = chain % 4;
  float* op = (float*)smem;
  float* ybuf = op + 16 * HREC;
  const int hc = h * 64 + lane;
  float lb = 0.f;
  if (l == 1) lb = sigmoidf_(p.lb_logits[(dir * 2 + 1) * 256 + hc] - p.lb_logits[(dir * 2 + 0) * 256 + hc]);
  const int fcol = 1792 + 256 * (1 + dir) + hc;
  const int vc = tid >> 3, kq = tid & 7;
  float S[8];
#pragma unroll
  for (int j = 0; j < 8; ++j) S[j] = 0.f;
  HgrnPf pfA, pfB;
#define HGRN_ISSUE(ci_, PF) { const int seg_ = (ci_) >= 16; const int Tn_ = seg_ ? 4096 : 256; const int rb_ = seg_ ? b * 4096 : NLAT + b * 256; const int c0_ = (seg_ ? (ci_) - 16 : (ci_)) * 16; \
    _Pragma("unroll") for (int i = 0; i < 4; ++i) { const int step = w * 4 + i; const int t = dir == 0 ? c0_ + step : Tn_ - 1 - (c0_ + step); const h16* pr = p.P + ((size_t)rb_ + t) * PC; \
      PF.f[i] = pr[fcol]; PF.q[i] = pr[1792 + hc]; PF.iv[i] = pr[1792 + 768 + hc]; } }
#define HGRN_CHUNK(ci_, PF) { \
    const int seg = (ci_) >= 16; const int Tn = seg ? 4096 : 256; const int rowbase = seg ? b * 4096 : NLAT + b * 256; const int c0 = (seg ? (ci_) - 16 : (ci_)) * 16; \
    _Pragma("unroll") for (int i = 0; i < 4; ++i) { \
      const int step = w * 4 + i; \
      float* o = op + step * HREC + lane; \
      const float f = lb + (1.f - lb) * sigmoidf_((float)PF.f[i]); \
      o[0] = f; o[128] = (float)PF.q[i]; \
      if ((lane >> 5) == vh) op[step * HREC + 192 + (lane & 31)] = (float)PF.iv[i]; } \
    LDS_BARRIER(); \
    if ((ci_) + 2 < 272) HGRN_ISSUE((ci_) + 2, PF) \
    _Pragma("unroll") for (int step = 0; step < 16; ++step) { \
      const float* o = op + step * HREC + 8 * kq; \
      const f32x4 fA = *(const f32x4*)(o), fB = *(const f32x4*)(o + 4); \
      const f32x4 qA = *(const f32x4*)(o + 128), qB = *(const f32x4*)(o + 132); \
      const float iv = op[step * HREC + 192 + vc]; \
      const float f[8] = {fA[0], fA[1], fA[2], fA[3], fB[0], fB[1], fB[2], fB[3]}; \
      const float q[8] = {qA[0], qA[1], qA[2], qA[3], qB[0], qB[1], qB[2], qB[3]}; \
      float acc = 0.f; \
      _Pragma("unroll") for (int j = 0; j < 8; ++j) { S[j] = f[j] * (S[j] - iv) + iv; acc += S[j] * q[j]; } \
      ybuf[step * 256 + tid] = acc; } \
    LDS_BARRIER(); \
    if (seg == 1 || l == 0) { \
      _Pragma("unroll") for (int i = 0; i < 2; ++i) { \
        const int idx = tid + i * 256; const int step = idx >> 5, ch = idx & 31; \
        const int t = dir == 0 ? c0 + step : Tn - 1 - (c0 + step); \
        const float* yb = ybuf + step * 256 + ch * 8; \
        const f32x4 y0 = *(const f32x4*)(yb), y1 = *(const f32x4*)(yb + 4); \
        const f32x4 ys = y0 + y1; \
        const h16 ov = (h16)((ys[0] + ys[1]) + (ys[2] + ys[3])); \
        if (dir == 0) p.P[(size_t)(rowbase + t) * PC + 1152 + h * 64 + 32 * vh + ch] = ov; \
        else p.hy[(size_t)(rowbase + t) * 1024 + 384 + h * 64 + 32 * vh + ch] = ov; } } }
  HGRN_ISSUE(0, pfA)
  HGRN_ISSUE(1, pfB)
  __builtin_amdgcn_s_setprio(2);
#pragma unroll 1
  for (int ci = 0; ci < 272; ci += 2) {
    HGRN_CHUNK(ci, pfA)
    HGRN_CHUNK(ci + 1, pfB)
  }
  __builtin_amdgcn_s_setprio(0);
}

__device__ __forceinline__ void attn_unit(const Params& p, int l, int u) {
  const int tid = tid_opaque(), lane = tid & 63, w = __builtin_amdgcn_readfirstlane(tid >> 6), lq = lane & 31, hh = lane >> 5;
  int b, head, qrow_base, qpos0; bool isctx;
  if (u < 1536) { b = u / 192; int rem = u % 192; int blk = rem / 6; head = rem % 6; qpos0 = blk * 128 + w * 32; qrow_base = b * 4096; isctx = false; }
  else { int j = u - 1536; b = j / 12; int rem = j % 12; int qb = rem / 6; head = rem % 6; qpos0 = qb * 128 + w * 32; qrow_base = NLAT + b * 256; isctx = true; }
  const int g = head / 3;
  const size_t qrow = (size_t)qrow_base + qpos0 + lq;
  half8 qf[4];
#pragma unroll
  for (int s = 0; s < 4; ++s) qf[s] = *(const half8*)(p.P + qrow * PC + 3072 + head * 64 + 16 * s + 8 * hh);
  const float sinkv = p.sink[l * 6 + head];
  float m = sinkv, lsum = hh == 0 ? 1.f : 0.f;
  f32x16 O[2];
#pragma unroll
  for (int r = 0; r < 16; ++r) { O[0][r] = 0.f; O[1][r] = 0.f; }
  const h16* vt = p.VT + (size_t)((b * 2 + g) * 64) * VTS;
  int nband = 0, kstart = 0;
  if (!isctx) { kstart = max(0, qpos0 - 128); const int kend = min(4096, qpos0 + 160); nband = (kend - kstart) >> 5; }
  const int ntiles = nband + 8;
  for (int ti = 0; ti < ntiles; ++ti) {
    const bool band = ti < nband;
    const int kt = band ? kstart + ti * 32 : (ti - nband) * 32;
    const size_t krow = band ? (size_t)b * 4096 + kt + lq : (size_t)NLAT + b * 256 + kt + lq;
    const int vidx = band ? kt : 4096 + kt;
    const h16* kp = p.P + krow * PC + 3456 + g * 64 + 8 * hh;
    f32x16 sacc;
#pragma unroll
    for (int r = 0; r < 16; ++r) sacc[r] = 0.f;
#pragma unroll
    for (int s = 0; s < 4; ++s) { half8 kf = *(const half8*)(kp + 16 * s); sacc = __builtin_amdgcn_mfma_f32_32x32x16_f16(kf, qf[s], sacc, 0, 0, 0); }
    float mx = -INFINITY;
#pragma unroll
    for (int r = 0; r < 16; ++r) {
      float sv = sacc[r];
      if (band) { const int dlt = kt + (r & 3) + 8 * (r >> 2) + 4 * hh - (qpos0 + lq); if (dlt > 128 || dlt < -128) sv = -INFINITY; }
      sacc[r] = sv; mx = fmaxf(mx, sv);
    }
    mx = fmaxf(mx, __shfl_xor(mx, 32));
    const float mn = fmaxf(m, mx); const float corr = __expf(m - mn); m = mn;
    float ps = 0.f; half8 pb[2];
#pragma unroll
    for (int r = 0; r < 16; ++r) { const float pv = __expf(sacc[r] - mn); ps += pv; pb[r >> 3][r & 7] = (h16)pv; }
    lsum = lsum * corr + ps;
#pragma unroll
    for (int r = 0; r < 16; ++r) { O[0][r] *= corr; O[1][r] *= corr; }
#pragma unroll
    for (int s2 = 0; s2 < 2; ++s2)
#pragma unroll
      for (int dt = 0; dt < 2; ++dt) {
        const h16* vp = vt + (size_t)(dt * 32 + lq) * VTS + vidx + 16 * s2 + 4 * hh;
        const half4 lo = *(const half4*)vp, hi = *(const half4*)(vp + 8);
        const half8 vf = {lo[0], lo[1], lo[2], lo[3], hi[0], hi[1], hi[2], hi[3]};
        O[dt] = __builtin_amdgcn_mfma_f32_32x32x16_f16(vf, pb[s2], O[dt], 0, 0, 0);
      }
  }
  lsum += __shfl_xor(lsum, 32);
  const float inv = 1.f / lsum;
#pragma unroll
  for (int dt = 0; dt < 2; ++dt)
#pragma unroll
    for (int g4 = 0; g4 < 4; ++g4) {
      const int d0 = dt * 32 + 8 * g4 + 4 * hh;
      const half4 ga = *(const half4*)(p.P + qrow * PC + 3712 + head * 64 + d0);
      half4 o;
#pragma unroll
      for (int j = 0; j < 4; ++j) { const float gv = (float)ga[j]; o[j] = (h16)(O[dt][g4 * 4 + j] * inv * siluf_(gv)); }
      *(half4*)(p.hy + qrow * 1024 + 640 + head * 64 + d0) = o;
    }
}

__device__ __forceinline__ void phase_mix(const Params& p, int l, int bid, int nb, char* smem, int sub) {
  const int nunits = l == 0 ? 1536 + 96 : 1536;
  if (nb >= 640) {
    if (bid < 384) { if (sub & 1) rwkv_chain(p, l, bid, smem); }
    else if (bid < 512) { if (sub & 2) hgrn_chain(p, l, bid - 384, smem); }
    else if (sub & 4) for (int u = bid - 512; u < nunits; u += nb - 512) attn_unit(p, l, u);
  } else {
    for (int it = bid; it < 512 + nunits; it += nb) {
      if (it < 384) rwkv_chain(p, l, it, smem);
      else if (it < 512) hgrn_chain(p, l, it - 384, smem);
      else attn_unit(p, l, it - 512);
      __syncthreads();
    }
  }
}

__device__ __forceinline__ float sum4(const f32x4 v) { return (v[0] + v[1]) + (v[2] + v[3]); }
__device__ __forceinline__ f32x4 h4f(const half4 h) { return (f32x4){(float)h[0], (float)h[1], (float)h[2], (float)h[3]}; }
__device__ __forceinline__ half8 zero_h8() { half8 z;
#pragma unroll
  for (int j = 0; j < 8; ++j) z[j] = (h16)0.f; return z; }
__device__ __forceinline__ half4 zero_h4() { half4 z; z[0] = z[1] = z[2] = z[3] = (h16)0.f; return z; }
__device__ __forceinline__ void phase_readout(const Params& p, int l, int bid, int nb, bool dummy) {
  const int tid = tid_opaque(), lane = tid & 63, w = __builtin_amdgcn_readfirstlane(tid >> 6);
  const int nrows = l == 1 ? NLAT : NTOK;
  const int hl = lane >> 4, c4 = (lane & 15) * 4;
  const int gw = bid * 4 + w, nper = (nb * 4) / 3;
  const int q = gw % 3, ridx = gw / 3;
  if (ridx >= nper) return;
  const int rpw = (nrows + nper - 1) / nper;
  const int r0 = ridx * rpw, r1 = min(nrows, r0 + rpw);
  if (r0 >= r1) return;
  if (q < 2) {
    const int head = q * 4 + hl; const bool valid = head < 6; const int hcl = valid ? head : 5; const int c = hcl * 64 + c4;
    const f32x4 mpr = *(const f32x4*)(p.mu_prev + l * 1792 + c), mnr = *(const f32x4*)(p.mu_next + l * 1792 + c);
    const f32x4 mpk = *(const f32x4*)(p.mu_prev + l * 1792 + 384 + c), mnk = *(const f32x4*)(p.mu_next + l * 1792 + 384 + c);
    const f32x4 mpg = *(const f32x4*)(p.mu_prev + l * 1792 + 1408 + c), mng = *(const f32x4*)(p.mu_next + l * 1792 + 1408 + c);
    const f32x4 gwt = *(const f32x4*)(p.gn_w + l * 384 + c), gbs = *(const f32x4*)(p.gn_b + l * 384 + c), rkw = *(const f32x4*)(p.r_k + l * 384 + c);
    const h16* prk = p.P + hcl * 128 + 2 * c4;
    const h16* pg = p.P + 1408 + c;
    half8 rk_prev = r0 > 0 ? *(const half8*)(prk + (size_t)(r0 - 1) * PC) : zero_h8();
    half4 g_prev = r0 > 0 ? *(const half4*)(pg + (size_t)(r0 - 1) * PC) : zero_h4();
    half8 rk_cur = *(const half8*)(prk + (size_t)r0 * PC);
    half4 g_cur = *(const half4*)(pg + (size_t)r0 * PC);
    half8 rk_next = r0 + 1 < NTOK ? *(const half8*)(prk + (size_t)(r0 + 1) * PC) : zero_h8();
    half4 g_next = r0 + 1 < NTOK ? *(const half4*)(pg + (size_t)(r0 + 1) * PC) : zero_h4();
    half4 yf_c = *(const half4*)(p.P + (size_t)r0 * PC + 768 + c), yb_c = *(const half4*)(p.hy + (size_t)r0 * 1024 + c), v_c = *(const half4*)(p.VB + (size_t)r0 * 384 + c);
#pragma unroll 1
    for (int row = r0; row < r1; ++row) {
      const bool more = row + 1 < r1;
      const half8 rk_nn = row + 2 < NTOK ? *(const half8*)(prk + (size_t)(row + 2) * PC) : zero_h8();
      const half4 g_nn = row + 2 < NTOK ? *(const half4*)(pg + (size_t)(row + 2) * PC) : zero_h4();
      half4 yf_n = yf_c, yb_n = yb_c, v_n = v_c;
      if (more) { yf_n = *(const half4*)(p.P + (size_t)(row + 1) * PC + 768 + c); yb_n = *(const half4*)(p.hy + (size_t)(row + 1) * 1024 + c); v_n = *(const half4*)(p.VB + (size_t)(row + 1) * 384 + c); }
      int t, Tn;
      if (row < NLAT) { t = row & 4095; Tn = 4096; } else { t = (row - NLAT) & 255; Tn = 256; }
      const bool hp = t > 0, hn = t + 1 < Tn;
      f32x4 sh[3];
#pragma unroll
      for (int k = 0; k < 2; ++k) {
        const f32x4 cur = {(float)rk_cur[k], (float)rk_cur[2 + k], (float)rk_cur[4 + k], (float)rk_cur[6 + k]};
        f32x4 prv = {(float)rk_prev[k], (float)rk_prev[2 + k], (float)rk_prev[4 + k], (float)rk_prev[6 + k]};
        f32x4 nxt = {(float)rk_next[k], (float)rk_next[2 + k], (float)rk_next[4 + k], (float)rk_next[6 + k]};
        if (!hp) prv = (f32x4){0.f, 0.f, 0.f, 0.f};
        if (!hn) nxt = (f32x4){0.f, 0.f, 0.f, 0.f};
        sh[k] = cur + (k == 0 ? mpr : mpk) * (prv - cur) + (k == 0 ? mnr : mnk) * (nxt - cur);
      }
      {
        const f32x4 cur = h4f(g_cur);
        f32x4 prv = h4f(g_prev), nxt = h4f(g_next);
        if (!hp) prv = (f32x4){0.f, 0.f, 0.f, 0.f};
        if (!hn) nxt = (f32x4){0.f, 0.f, 0.f, 0.f};
        sh[2] = cur + mpg * (prv - cur) + mng * (nxt - cur);
      }
      const f32x4 y = h4f(yf_c) + h4f(yb_c);
      const f32x4 v = h4f(v_c);
      const float mean = red16(sum4(y)) * (1.f / 64.f);
      const f32x4 yc = y - mean;
      const float var = red16(sum4(yc * yc)) * (1.f / 64.f);
      const float rs = rsqrtf(var + 64e-5f);
      const float bs = red16(sum4(sh[0] * sh[1] * rkw));
      half4 o;
#pragma unroll
      for (int j = 0; j < 4; ++j) o[j] = (h16)((yc[j] * rs * gwt[j] + gbs[j] + bs * v[j]) * siluf_(sh[2][j]));
      h16* yw = dummy ? p.F + (size_t)row * 1536 : p.hy + (size_t)row * 1024;
      if (valid) *(half4*)(yw + c) = o;
      rk_prev = rk_cur; rk_cur = rk_next; rk_next = rk_nn;
      g_prev = g_cur; g_cur = g_next; g_next = g_nn;
      yf_c = yf_n; yb_c = yb_n; v_c = v_n;
    }
  } else {
    const int c = hl * 64 + c4;
    const f32x4 nw = *(const f32x4*)(p.hg_norm_w + l * 256 + c);
    half4 of_c = *(const half4*)(p.P + (size_t)r0 * PC + 1152 + c), ob_c = *(const half4*)(p.hy + (size_t)r0 * 1024 + 384 + c), g_c = *(const half4*)(p.P + (size_t)r0 * PC + 2816 + c);
#pragma unroll 1
    for (int row = r0; row < r1; ++row) {
      half4 of_n = of_c, ob_n = ob_c, g_n = g_c;
      if (row + 1 < r1) { of_n = *(const half4*)(p.P + (size_t)(row + 1) * PC + 1152 + c); ob_n = *(const half4*)(p.hy + (size_t)(row + 1) * 1024 + 384 + c); g_n = *(const half4*)(p.P + (size_t)(row + 1) * PC + 2816 + c); }
      const f32x4 o = h4f(of_c) + h4f(ob_c);
      const f32x4 g = h4f(g_c);
      const float ms = red16(sum4(o * o)) * (1.f / 64.f);
      const float rs = rsqrtf(ms + 1e-6f);
      half4 ov;
#pragma unroll
      for (int j = 0; j < 4; ++j) ov[j] = (h16)(o[j] * rs * nw[j] * siluf_(g[j]));
      h16* yw = dummy ? p.F + (size_t)row * 1536 : p.hy + (size_t)row * 1024;
      *(half4*)(yw + 384 + c) = ov;
      of_c = of_n; ob_c = ob_n; g_c = g_n;
    }
  }
}

__device__ __forceinline__ void phase_final(const Params& p, int bid, int nb) {
  const int tid = tid_opaque(), lane = tid & 63, w = __builtin_amdgcn_readfirstlane(tid >> 6);
  for (int row = bid * 4 + w; row < NLAT; row += nb * 4) {
    float* src = p.out + (size_t)row * 1024;
    f32x4 v[4]; float ss = 0.f;
#pragma unroll
    for (int i = 0; i < 4; ++i) { v[i] = *(const f32x4*)(src + i * 256 + lane * 4); ss += v[i][0] * v[i][0] + v[i][1] * v[i][1] + v[i][2] * v[i][2] + v[i][3] * v[i][3]; }
    ss = wave_sum_dpp(ss);
    const float rs = rsqrtf(ss * (1.f / 1024.f) + 1e-6f);
#pragma unroll
    for (int i = 0; i < 4; ++i) {
      const int col = i * 256 + lane * 4;
      const f32x4 nwv = *(const f32x4*)(p.final_w + col);
      f32x4 o;
#pragma unroll
      for (int j = 0; j < 4; ++j) o[j] = v[i][j] * rs * nwv[j];
      *(f32x4*)(src + col) = o;
    }
  }
}

__global__ void __launch_bounds__(256, 3) __attribute__((target("no-packed-fp32-ops"))) mega(Params p, int ph_lo, int ph_hi, int coop) {
  __shared__ __attribute__((aligned(16))) char smem[SMEM_BYTES];
  __shared__ uint4 xb_words;
  XcdBarrier xb; xb.bar = p.bar; xb.x = 0; xb.st = (volatile LAS unsigned*)&xb_words;
  if (coop) { if (threadIdx.x == 0) xb_words = make_uint4(0u, 0u, 0u, 0u); __syncthreads(); xb = xcd_barrier_post(p.bar, (volatile LAS unsigned*)&xb_words); }
  if (coop) for (int i = 0; i < EXTRA_SYNCS; ++i) { xcd_barrier(xb); }
  if (coop == 2) cg::this_grid().sync();
  for (int ph = ph_lo; ph < ph_hi; ++ph) {
    for (int rep = 0; rep < (((PROBE_MASK >> ph) & 1) ? 2 : 1); ++rep) {
      int bid = blockIdx.x, nb = gridDim.x;
      asm volatile("" : "+s"(bid), "+s"(nb));
      if (ph == 0) phase_prep(p, bid, nb, smem);
      else if (ph == 13) phase_final(p, bid, nb);
      else {
        const int l = (ph - 1) / 6, s = (ph - 1) % 6;
        if (s == 0) phase_norm(p, l, bid, nb);
        else if (s == 1) phase_gemm<0>(p, l, bid, nb, smem);
        else if (s == 2) phase_feat(p, l, bid, nb, smem, PROBE_MASK && ((PROBE_MASK >> ph) & 1) && rep == 0);
        else if (s == 3) phase_mix(p, l, bid, nb, smem, rep ? PROBE_SUB : 7);
        else if (s == 4) phase_readout(p, l, bid, nb, PROBE_MASK && ((PROBE_MASK >> ph) & 1) && rep == 0);
        else phase_gemm<1>(p, l, bid, nb, smem);
      }
      if (PROBE_MASK && rep == 0 && ((PROBE_MASK >> ph) & 1)) { xcd_barrier(xb); }
    }
    if (coop && ph + 1 < ph_hi) { xcd_barrier(xb); }
  }
}

extern "C" void kernel_launch(void* const* d_in, const int* in_sizes, int n_in, void* d_out, int out_size, void* d_ws, size_t ws_size, hipStream_t stream) {
  static int grid_blocks = 0;
  if (!grid_blocks) {
    int dev = 0, cus = 0, per_cu = 0;
    hipGetDevice(&dev);
    hipDeviceGetAttribute(&cus, hipDeviceAttributeMultiprocessorCount, dev);
    hipOccupancyMaxActiveBlocksPerMultiprocessor(&per_cu, mega, 256, 0);
    if (per_cu < 1) per_cu = 1;
    grid_blocks = cus * per_cu;
  }
  Params p{};
  const float* const* in = (const float* const*)d_in;
  p.x = in[0]; p.c = in[1]; p.ctx = in[2]; p.c_ctx = in[3]; p.mod_w = in[4]; p.mod_b = in[5]; p.norm_w = in[6]; p.w_in = in[7]; p.w_out = in[8];
  p.mu_prev = in[9]; p.mu_next = in[10]; p.w0 = in[11]; p.w2 = in[12]; p.a0 = in[13]; p.a2 = in[14]; p.k_k = in[15]; p.k_a = in[16]; p.r_k = in[17];
  p.gn_w = in[18]; p.gn_b = in[19]; p.vw1 = in[20]; p.vw2 = in[21]; p.vb = in[22]; p.lb_logits = in[23]; p.hg_norm_w = in[24]; p.sink = in[25]; p.final_w = in[26];
  p.out = (float*)d_out;
  char* ws = (char*)d_ws; size_t off = 0;
  auto take = [&](size_t bytes) { char* r = ws + off; off += (bytes + 255) & ~(size_t)255; return r; };
  p.win_t = (h16*)take((size_t)2 * NPAD * 1024 * 2);
  p.wout_t = (h16*)take((size_t)2 * 1024 * 1024 * 2);
  p.wl_t = (h16*)take((size_t)2 * 4 * 384 * 64 * 2);
  p.mod = (float*)take((size_t)2 * 9 * 3072 * 4);
  p.rope = (float*)take((size_t)64 * 16 * 2 * 4);
  p.hy = (h16*)take((size_t)NTOK * 1024 * 2);
  p.P = (h16*)take((size_t)NTOK * PC * 2);
  p.F = (h16*)take((size_t)NTOK * 1536 * 2);
  p.VB = (h16*)take((size_t)NTOK * 384 * 2);
  p.VT = (h16*)take((size_t)16 * 64 * VTS * 2);
  p.xc1 = (float*)take((size_t)2048 * 1024 * 4);
  p.bar = (unsigned*)take(16384);
  if (off > ws_size) fprintf(stderr, "workspace too small: need %zu have %zu\n", off, ws_size);
#if SINGLE_LAUNCH
  hipMemsetAsync(p.bar, 0, 16384, stream);
  int lo = 0, hi = 14, coop = 1;
  void* args[] = {&p, &lo, &hi, &coop};
  hipError_t e = hipLaunchCooperativeKernel((void*)mega, dim3(grid_blocks), dim3(256), args, 0, stream);
  if (e != hipSuccess) fprintf(stderr, "cooperative launch failed: %s (grid %d)\n", hipGetErrorString(e), grid_blocks);
#else
  for (int ph = 0; ph < 14; ++ph) mega<<<grid_blocks, 256, 0, stream>>>(p, ph, ph + 1, 0);
#endif
}
```

```cpp
#include <hip/hip_runtime.h>
#include <hip/hip_cooperative_groups.h>
#include <cstdio>
#include <cstdint>
namespace cg = cooperative_groups;

typedef _Float16 h16;
typedef _Float16 half8 __attribute__((ext_vector_type(8)));
typedef _Float16 half4 __attribute__((ext_vector_type(4)));
typedef float f32x16 __attribute__((ext_vector_type(16)));
typedef float f32x4 __attribute__((ext_vector_type(4)));
typedef float f32x2 __attribute__((ext_vector_type(2)));
typedef unsigned u32x4 __attribute__((ext_vector_type(4)));
typedef _Float16 half2v __attribute__((ext_vector_type(2)));

constexpr int NLAT = 32768, NTOK = 34816;
constexpr int PC = 4160;
constexpr int NPAD = 4224;
constexpr int VTS = 4352;
constexpr int SMEM_BYTES = 49152;

#ifndef EXTRA_SYNCS
#define EXTRA_SYNCS 0
#endif
#ifndef PROBE_SUB
#define PROBE_SUB 7
#endif
#ifndef PROBE_MASK
#define PROBE_MASK 0
#endif
#ifndef SINGLE_LAUNCH
#define SINGLE_LAUNCH 1
#endif

struct Params {
  const float *x, *c, *ctx, *c_ctx, *mod_w, *mod_b, *norm_w, *w_in, *w_out;
  const float *mu_prev, *mu_next, *w0, *w2, *a0, *a2, *k_k, *k_a, *r_k, *gn_w, *gn_b;
  const float *vw1, *vw2, *vb, *lb_logits, *hg_norm_w, *sink, *final_w;
  float* out;
  h16 *win_t, *wout_t, *wl_t;
  float* mod;
  h16 *hy, *P, *F, *VB;
  h16* VT;
  float* xc1;
  float* rope;
  unsigned* bar;
};

__device__ __forceinline__ int tid_opaque() { int t = threadIdx.x; asm volatile("" : "+v"(t)); return t; }
__device__ __forceinline__ float wave_sum(float v) {
#pragma unroll
  for (int o = 32; o > 0; o >>= 1) v += __shfl_xor(v, o);
  return v;
}
__device__ __forceinline__ float sigmoidf_(float x) { return __builtin_amdgcn_rcpf(1.f + __expf(-x)); }
__device__ __forceinline__ float siluf_(float x) { return x * __builtin_amdgcn_rcpf(1.f + __expf(-x)); }
template <int CTRL> __device__ __forceinline__ float dpp_mov(float x) {
  return __int_as_float(__builtin_amdgcn_update_dpp(0, __float_as_int(x), CTRL, 0xf, 0xf, true));
}
__device__ __forceinline__ float wave_sum_dpp(float x) {
  x += dpp_mov<0xB1>(x);
  x += dpp_mov<0x4E>(x);
  x += dpp_mov<0x141>(x);
  x += dpp_mov<0x140>(x);
  const int xi = __float_as_int(x);
  return __int_as_float(__builtin_amdgcn_readlane(xi, 0)) + __int_as_float(__builtin_amdgcn_readlane(xi, 16)) +
         __int_as_float(__builtin_amdgcn_readlane(xi, 32)) + __int_as_float(__builtin_amdgcn_readlane(xi, 48));
}
__device__ __forceinline__ float red8(float x) {
  x += dpp_mov<0xB1>(x);
  x += dpp_mov<0x4E>(x);
  x += dpp_mov<0x141>(x);
  return x;
}

#define XB_TMO      128
#define XB_XCNT(j)  (256  + 64 * (j))
#define XB_XSUB(j)  (1280 + 64 * (j))
#define XB_XGEN(j)  (2304 + 64 * (j))
#define XB_TOP      3328
#define XB_TOPGEN   3392
#define XCD_BAR_WORDS 3456
#define XB_SPIN_CAP (1u << 18)
#define LAS __attribute__((address_space(3)))
__device__ __forceinline__ unsigned xb_ld(unsigned* p)              { return __hip_atomic_load(p, __ATOMIC_RELAXED, __HIP_MEMORY_SCOPE_AGENT); }
__device__ __forceinline__ unsigned xb_add(unsigned* p, unsigned v) { return __hip_atomic_fetch_add(p, v, __ATOMIC_RELAXED, __HIP_MEMORY_SCOPE_AGENT); }
__device__ __forceinline__ unsigned xb_xcc_id() { return (unsigned)__builtin_amdgcn_s_getreg((3 << 11) | 20) & 0xFu; }
#define XB_SPIN(cond, bar) do { unsigned _sp = 0; while (cond) { __builtin_amdgcn_s_sleep(1); \
    if ((++_sp & 255u) == 0u) { if (xb_ld(&(bar)[XB_TMO])) break; if (_sp > XB_SPIN_CAP) { atomicAdd(&(bar)[XB_TMO], 1u); break; } } } } while (0)
struct XcdBarrier { unsigned* bar; unsigned x; volatile LAS unsigned* st; };
__device__ __forceinline__ XcdBarrier xcd_barrier_post(unsigned* bar, volatile LAS unsigned* st) {
  XcdBarrier b; b.bar = bar; b.x = xb_xcc_id(); b.st = st;
  if (threadIdx.x == 0) (void)xb_add(&bar[XB_XCNT(b.x)], 1u);
  return b;
}
__device__ __forceinline__ void xcd_barrier_complete(unsigned* bar, unsigned x, unsigned& nloc, unsigned& nx) {
  const unsigned G = gridDim.x * gridDim.y * gridDim.z;
  unsigned sum, cnt, mine, sp = 0u;
  for (;;) {
    sum = 0u; cnt = 0u; mine = 0u;
#pragma unroll
    for (unsigned j = 0; j < 16; ++j) { const unsigned c = xb_ld(&bar[XB_XCNT(j)]); sum += c; cnt += (c > 0u) ? 1u : 0u; mine = (j == x) ? c : mine; }
    if (sum == G) break;
    __builtin_amdgcn_s_sleep(1);
    if ((++sp & 255u) == 0u) { if (xb_ld(&bar[XB_TMO])) break; if (sp > XB_SPIN_CAP) { atomicAdd(&bar[XB_TMO], 1u); break; } }
  }
  nloc = mine > 0u ? mine : 1u; nx = cnt > 0u ? cnt : 1u;
}
__device__ __forceinline__ void xcd_barrier(const XcdBarrier& b) {
  asm volatile("s_waitcnt vmcnt(0)" ::: "memory");
  __syncthreads();
  if (threadIdx.x == 0) {
    unsigned* bar = b.bar;
    __builtin_amdgcn_s_waitcnt(0);
    unsigned nloc = b.st[0], nx = b.st[1];
    if (nloc == 0u) { xcd_barrier_complete(bar, b.x, nloc, nx); b.st[0] = nloc; b.st[1] = nx; }
    const unsigned old = xb_add(&bar[XB_XSUB(b.x)], 1u);
    const unsigned gen = old / nloc;
    if (old + 1u == (gen + 1u) * nloc) {
      __builtin_amdgcn_fence(__ATOMIC_RELEASE, "agent");
      asm volatile("s_waitcnt vmcnt(0)" ::: "memory");
      const unsigned og = xb_add(&bar[XB_TOP], 1u);
      const unsigned tg = og / nx;
      if (og + 1u == (tg + 1u) * nx) xb_add(&bar[XB_TOPGEN], 1u);
      else XB_SPIN(xb_ld(&bar[XB_TOPGEN]) == tg, bar);
      __builtin_amdgcn_fence(__ATOMIC_ACQUIRE, "agent");
      xb_add(&bar[XB_XGEN(b.x)], 1u);
      asm volatile("s_waitcnt vmcnt(0)" ::: "memory");
    } else {
      XB_SPIN(xb_ld(&bar[XB_XGEN(b.x)]) == gen, bar);
      __builtin_amdgcn_fence(__ATOMIC_ACQUIRE, "agent");
      asm volatile("s_waitcnt vmcnt(0)" ::: "memory");
    }
  }
  __syncthreads();
}

__device__ __forceinline__ void phase_prep(const Params& p, int bid, int nb, char* smem) {
  const int tid = tid_opaque();
  float* sf = (float*)smem;
  constexpr int N_WIN = 2048, N_WOUT = 512, N_MOD = 192, N_PADI = 1024, N_WL = 768;
  constexpr int total = N_WIN + N_WOUT + N_MOD + N_PADI + N_WL + 1;
  for (int it = bid; it < total; it += nb) {
    if (it < N_WIN + N_WOUT) {
      const float* src; h16* dst; int ncols, kt, ntile;
      if (it < N_WIN) { int l = it >> 10, r = it & 1023; kt = r >> 6; ntile = r & 63; src = p.w_in + (size_t)l * 1024 * 4096; dst = p.win_t + (size_t)l * NPAD * 1024; ncols = 4096; }
      else { int j = it - N_WIN; int l = j >> 8, r = j & 255; kt = r >> 4; ntile = r & 15; src = p.w_out + (size_t)l * 1024 * 1024; dst = p.wout_t + (size_t)l * 1024 * 1024; ncols = 1024; }
      for (int i = tid; i < 4096; i += 256) { int kk = i >> 6, nn = i & 63; sf[kk * 65 + nn] = src[(size_t)(kt * 64 + kk) * ncols + ntile * 64 + nn]; }
      __syncthreads();
      const bool rkperm = it < N_WIN && ntile < 12;
      for (int i = tid; i < 4096; i += 256) {
        int nn = i >> 6, kk = i & 63;
        const int nrow = rkperm ? ((ntile % 6) * 128 + 2 * nn + ntile / 6) : (ntile * 64 + nn);
        dst[(size_t)nrow * 1024 + kt * 64 + kk] = (h16)sf[kk * 65 + nn];
      }
      __syncthreads();
    } else if (it < N_WIN + N_WOUT + N_MOD) {
      const int j = it - N_WIN - N_WOUT; const int l = j / 96; const int cl = tid & 31, ks = tid >> 5; const int col = (j % 96) * 32 + cl;
      for (int i = tid; i < 9 * 1024; i += 256) { int r = i >> 10, k = i & 1023; float v = r < 8 ? p.c[r * 1024 + k] : p.c_ctx[k]; sf[i] = siluf_(v); }
      __syncthreads();
      float acc[9];
#pragma unroll
      for (int r = 0; r < 9; ++r) acc[r] = 0.f;
      const float* mw = p.mod_w + (size_t)l * 1024 * 3072 + (size_t)(ks * 128) * 3072 + col;
#pragma unroll 2
      for (int k = 0; k < 128; k += 4) {
        const float w0 = mw[(size_t)k * 3072], w1 = mw[(size_t)(k + 1) * 3072], w2 = mw[(size_t)(k + 2) * 3072], w3 = mw[(size_t)(k + 3) * 3072];
#pragma unroll
        for (int r = 0; r < 9; ++r) { const f32x4 sv = *(const f32x4*)&sf[r * 1024 + ks * 128 + k]; acc[r] += sv[0] * w0 + sv[1] * w1 + sv[2] * w2 + sv[3] * w3; }
      }
#pragma unroll
      for (int r = 0; r < 9; ++r) acc[r] += __shfl_xor(acc[r], 32);
      __syncthreads();
      if ((tid & 63) < 32) {
#pragma unroll
        for (int r = 0; r < 9; ++r) sf[((tid >> 6) * 9 + r) * 32 + cl] = acc[r];
      }
      __syncthreads();
      for (int i = tid; i < 288; i += 256) {
        const int r = i >> 5, c2 = i & 31;
        const float v = sf[(0 * 9 + r) * 32 + c2] + sf[(1 * 9 + r) * 32 + c2] + sf[(2 * 9 + r) * 32 + c2] + sf[(3 * 9 + r) * 32 + c2];
        const int cc = (j % 96) * 32 + c2;
        p.mod[(size_t)(l * 9 + r) * 3072 + cc] = v + p.mod_b[l * 3072 + cc];
      }
      __syncthreads();
    } else if (it < N_WIN + N_WOUT + N_MOD + N_PADI) {
      int j = it - (N_WIN + N_WOUT + N_MOD); int idx = j * 256 + tid;
      int l = idx >> 17; int rem = idx & 131071; int m = rem >> 10, k = rem & 1023;
      float v = (l == 1 && m < 32) ? p.vw1[k * 32 + m] : 0.f;
      p.win_t[(size_t)l * NPAD * 1024 + (size_t)(4096 + m) * 1024 + k] = (h16)v;
    } else if (it < N_WIN + N_WOUT + N_MOD + N_PADI + N_WL) {
      const int idx = (it - (N_WIN + N_WOUT + N_MOD + N_PADI)) * 256 + tid;
      const int r = idx & 63, c = (idx >> 6) % 384, ls = idx / (384 * 64); const int l = ls >> 2, slot = ls & 3, dir = slot & 1, kind = slot >> 1;
      const float v = (kind == 0 ? p.w2 : p.a2)[((size_t)(l * 2 + dir) * 64 + r) * 384 + c];
      p.wl_t[idx] = (h16)v;
    } else {
      if (tid < 16) {
        double inv = 1.0; for (int i = 0; i < tid; ++i) inv *= 0.5623413251903491;
        double x2 = inv * inv, ts = inv, tc = 1.0, s1 = inv, c1 = 1.0;
        for (int n = 1; n <= 10; ++n) { tc *= -x2 / ((2.0 * n - 1.0) * (2.0 * n)); c1 += tc; ts *= -x2 / ((2.0 * n) * (2.0 * n + 1.0)); s1 += ts; }
        double cc = 1.0, ss = 0.0;
        for (int pos = 0; pos < 64; ++pos) {
          p.rope[(pos * 16 + tid) * 2] = (float)cc; p.rope[(pos * 16 + tid) * 2 + 1] = (float)ss;
          double nc = cc * c1 - ss * s1, ns = ss * c1 + cc * s1; cc = nc; ss = ns;
        }
      }
    }
  }
}

__device__ __forceinline__ void phase_norm(const Params& p, int l, int bid, int nb) {
  const int tid = tid_opaque(), lane = tid & 63, w = __builtin_amdgcn_readfirstlane(tid >> 6);
  for (int row = bid * 4 + w; row < NTOK; row += nb * 4) {
    const float* src = (l == 0) ? (row < NLAT ? p.x + (size_t)row * 1024 : p.ctx + (size_t)(row - NLAT) * 1024)
                                : (row < NLAT ? p.out + (size_t)row * 1024 : p.xc1 + (size_t)(row - NLAT) * 1024);
    const int mr = row < NLAT ? (row >> 12) : 8;
    const float* md = p.mod + (size_t)(l * 9 + mr) * 3072;
    const float* nw = p.norm_w + l * 1024;
    f32x4 v[4]; float ss = 0.f;
#pragma unroll
    for (int i = 0; i < 4; ++i) { v[i] = *(const f32x4*)(src + i * 256 + lane * 4); ss += v[i][0] * v[i][0] + v[i][1] * v[i][1] + v[i][2] * v[i][2] + v[i][3] * v[i][3]; }
    ss = wave_sum_dpp(ss);
    const float rs = rsqrtf(ss * (1.f / 1024.f) + 1e-6f);
#pragma unroll
    for (int i = 0; i < 4; ++i) {
      const int col = i * 256 + lane * 4;
      f32x4 nwv = *(const f32x4*)(nw + col), sc = *(const f32x4*)(md + 1024 + col), sh = *(const f32x4*)(md + col);
      half4 o;
#pragma unroll
      for (int j = 0; j < 4; ++j) o[j] = (h16)(v[i][j] * rs * nwv[j] * (1.f + sc[j]) + sh[j]);
      *(half4*)(p.hy + (size_t)row * 1024 + col) = o;
    }
  }
}

template <int MODE>
__device__ __forceinline__ void phase_gemm(const Params& p, int l, int bid, int nb, char* smem) {
  const h16* A = p.hy;
  const h16* Bt = MODE == 0 ? p.win_t + (size_t)l * NPAD * 1024 : p.wout_t + (size_t)l * 1024 * 1024;
  const int ntn = MODE == 0 ? (l == 1 ? 33 : 32) : 8;
  const int ntm = (MODE == 1 && l == 1) ? 256 : 272;
  const int tid = tid_opaque(), lane = tid & 63, w = __builtin_amdgcn_readfirstlane(tid >> 6), wr = w >> 1, wc = w & 1, lq = lane & 31, hh = lane >> 5;
  h16* As = (h16*)smem; h16* Bs = As + 128 * 72;
  const int ldrow = tid >> 3, ldch = (tid & 7) * 8;
  for (int tile = bid; tile < ntm * ntn; tile += nb) {
    int tm, tn;
    {
      const int mper = ntm >> 3;
      const int nmain = MODE == 0 ? 32 : 8;
      if (tile < ntm * nmain) {
        const int x = tile & 7, sq = tile >> 3;
        const int strip = sq / (mper * 8), rem = sq - strip * (mper * 8);
        tm = x * mper + (rem >> 3); tn = strip * 8 + (rem & 7);
      } else { tm = tile - ntm * nmain; tn = nmain; }
    }
    const h16* Ag = A + (size_t)(tm * 128 + ldrow) * 1024 + ldch; const h16* Bg = Bt + (size_t)(tn * 128 + ldrow) * 1024 + ldch;
    f32x16 acc[2][2];
#pragma unroll
    for (int i = 0; i < 2; ++i)
#pragma unroll
      for (int j = 0; j < 2; ++j)
#pragma unroll
        for (int r = 0; r < 16; ++r) acc[i][j][r] = 0.f;
    u32x4 ra[4], rb[4];
#pragma unroll
    for (int i = 0; i < 4; ++i) { ra[i] = *(const u32x4*)(Ag + (size_t)i * 32 * 1024); rb[i] = *(const u32x4*)(Bg + (size_t)i * 32 * 1024); }
#pragma unroll 2
    for (int kt = 0; kt < 16; ++kt) {
      __syncthreads();
#pragma unroll
      for (int i = 0; i < 4; ++i) { *(u32x4*)(As + (ldrow + i * 32) * 72 + ldch) = ra[i]; *(u32x4*)(Bs + (ldrow + i * 32) * 72 + ldch) = rb[i]; }
      __syncthreads();
      if (kt + 1 < 16) {
#pragma unroll
        for (int i = 0; i < 4; ++i) { ra[i] = *(const u32x4*)(Ag + (size_t)i * 32 * 1024 + (kt + 1) * 64); rb[i] = *(const u32x4*)(Bg + (size_t)i * 32 * 1024 + (kt + 1) * 64); }
      }
#pragma unroll
      for (int s = 0; s < 4; ++s) {
        half8 a[2], b[2];
#pragma unroll
        for (int i = 0; i < 2; ++i) { a[i] = *(const half8*)(As + (64 * wr + 32 * i + lq) * 72 + 16 * s + 8 * hh); b[i] = *(const half8*)(Bs + (64 * wc + 32 * i + lq) * 72 + 16 * s + 8 * hh); }
#pragma unroll
        for (int i = 0; i < 2; ++i)
#pragma unroll
          for (int j = 0; j < 2; ++j) {
            if (MODE == 0) acc[i][j] = __builtin_amdgcn_mfma_f32_32x32x16_f16(b[j], a[i], acc[i][j], 0, 0, 0);
            else acc[i][j] = __builtin_amdgcn_mfma_f32_32x32x16_f16(a[i], b[j], acc[i][j], 0, 0, 0);
          }
      }
    }
    if (MODE == 0) {
      if (tn < 32) {
        __syncthreads();
        h16* Cs = (h16*)smem;
#pragma unroll
        for (int i = 0; i < 2; ++i)
#pragma unroll
          for (int j = 0; j < 2; ++j)
#pragma unroll
            for (int g = 0; g < 4; ++g) {
              half4 o;
#pragma unroll
              for (int q = 0; q < 4; ++q) o[q] = (h16)acc[i][j][4 * g + q];
              *(half4*)(Cs + (64 * wr + 32 * i + lq) * 136 + 64 * wc + 32 * j + 8 * g + 4 * hh) = o;
            }
        __syncthreads();
#pragma unroll
        for (int q = 0; q < 8; ++q) {
          const int id = tid + q * 256; const int row = id >> 4, ch = id & 15;
          *(u32x4*)(p.P + (size_t)(tm * 128 + row) * PC + tn * 128 + ch * 8) = *(const u32x4*)(Cs + row * 136 + ch * 8);
        }
      } else if (wc == 0) {
#pragma unroll
        for (int i = 0; i < 2; ++i)
#pragma unroll
          for (int r = 0; r < 16; ++r) ((float*)(p.F + (size_t)(tm * 128 + 64 * wr + 32 * i + lq) * 1536))[(r & 3) + 8 * (r >> 2) + 4 * hh] = acc[i][0][r];
      }
    } else {
      const int row0 = tm * 128;
      const int mr = row0 < NLAT ? (row0 >> 12) : 8;
      const int col = tn * 128 + 64 * wc + lq;
      const float* gp = p.mod + (size_t)(l * 9 + mr) * 3072 + 2048 + col;
      const float g0 = gp[0], g1 = gp[32];
      const float* xs0; float* xd0;
      if (l == 0) { if (row0 < NLAT) { xs0 = p.x + (size_t)row0 * 1024; xd0 = p.out + (size_t)row0 * 1024; } else { xs0 = p.ctx + (size_t)(row0 - NLAT) * 1024; xd0 = p.xc1 + (size_t)(row0 - NLAT) * 1024; } }
      else { xs0 = p.out + (size_t)row0 * 1024; xd0 = p.out + (size_t)row0 * 1024; }
      const float* __restrict__ xsrc = xs0 + (size_t)(64 * wr + 4 * hh) * 1024 + col;
      float* __restrict__ xdst = xd0 + (size_t)(64 * wr + 4 * hh) * 1024 + col;
#pragma unroll
      for (int i = 0; i < 2; ++i)
#pragma unroll
        for (int r = 0; r < 16; ++r) {
          const int ro = (32 * i + (r & 3) + 8 * (r >> 2)) * 1024;
          xdst[ro] = xsrc[ro] + g0 * acc[i][0][r];
          xdst[ro + 32] = xsrc[ro + 32] + g1 * acc[i][1][r];
        }
    }
  }
}

#define LOAD_COL34(arr, base, t0, Tn) \
  _Pragma("unroll") for (int q_ = 0; q_ < 34; ++q_) { const int t_ = (t0) - 1 + q_; arr[q_] = (t_ >= 0 && t_ < (Tn)) ? (base)[(long)t_ * PC] : (h16)0.f; }

__device__ __forceinline__ void phase_feat(const Params& p, int l, int bid, int nb, char* smem, bool dry) {
  const int tid = tid_opaque();
  h16* inh = (h16*)smem;
  float* zt = (float*)(smem + 32 * 264 * 2);
  for (int item = bid; item < 1088; item += nb) {
    int b, t0, Tn, rowbase; bool isctx;
    if (item < 1024) { b = item >> 7; t0 = (item & 127) * 32; Tn = 4096; rowbase = b * 4096; isctx = false; }
    else { int j = item - 1024; b = j >> 3; t0 = (j & 7) * 32; Tn = 256; rowbase = NLAT + b * 256; isctx = true; }
    {
      const int col = 1152 + tid;
      const float mp = p.mu_prev[l * 1792 + col], mn = p.mu_next[l * 1792 + col];
      const h16* base = p.P + (size_t)rowbase * PC + col;
      h16 xv[34];
      LOAD_COL34(xv, base, t0, Tn)
#pragma unroll
      for (int tt = 0; tt < 32; ++tt) {
        const float prev = (float)xv[tt], cur = (float)xv[tt + 1], nxt = (float)xv[tt + 2];
        float sv = cur + mp * (prev - cur) + mn * (nxt - cur);
        if (tid < 128) { const float e2 = __expf(2.f * sv); sv = 1.f - 2.f / (e2 + 1.f); }
        inh[tt * 264 + tid] = (h16)sv;
      }
      if (l == 1) {
#pragma unroll
        for (int i = 0; i < 4; ++i) { int id = tid + i * 256; zt[id] = ((const float*)(p.F + (size_t)(rowbase + t0 + (id >> 5)) * 1536))[id & 31]; }
      }
    }
    __syncthreads();
#pragma unroll 1
    for (int c = tid; c < 384; c += 256) {
      const int col = 768 + c;
      const float mp = p.mu_prev[l * 1792 + col], mn = p.mu_next[l * 1792 + col];
      const h16* base = p.P + (size_t)rowbase * PC + col;
      h16 xv[34];
      LOAD_COL34(xv, base, t0, Tn)
      h16* dst = p.VB + (size_t)(rowbase + t0) * 384 + c;
      if (l == 0) {
#pragma unroll
        for (int tt = 0; tt < 32; ++tt) {
          const float prev = (float)xv[tt], cur = (float)xv[tt + 1], nxt = (float)xv[tt + 2];
          dst[tt * 384] = (h16)(cur + mp * (prev - cur) + mn * (nxt - cur));
        }
      } else {
        const float vbv = p.vb[c];
#pragma unroll 1
        for (int hf = 0; hf < 2; ++hf) {
          h16 vfv[16]; float ga[16];
#pragma unroll
          for (int tt = 0; tt < 16; ++tt) { vfv[tt] = dst[(hf * 16 + tt) * 384]; ga[tt] = vbv; }
#pragma unroll 1
          for (int m = 0; m < 32; m += 4) {
            const float w0 = p.vw2[m * 384 + c], w1 = p.vw2[(m + 1) * 384 + c], w2 = p.vw2[(m + 2) * 384 + c], w3 = p.vw2[(m + 3) * 384 + c];
#pragma unroll
            for (int tt = 0; tt < 16; ++tt) { const f32x4 z = *(const f32x4*)&zt[(hf * 16 + tt) * 32 + m]; ga[tt] += z[0] * w0 + z[1] * w1 + z[2] * w2 + z[3] * w3; }
          }
#pragma unroll
          for (int tt = 0; tt < 16; ++tt) {
            const float prev = hf ? (float)xv[16 + tt] : (float)xv[tt], cur = hf ? (float)xv[17 + tt] : (float)xv[tt + 1], nxt = hf ? (float)xv[18 + tt] : (float)xv[tt + 2];
            const float sv = cur + mp * (prev - cur) + mn * (nxt - cur);
            dst[(hf * 16 + tt) * 384] = (h16)(sv + ((float)vfv[tt] - sv) * sigmoidf_(ga[tt]));
          }
        }
      }
    }
    {
      const int w = __builtin_amdgcn_readfirstlane(tid >> 6), lane = tid & 63, lq = tid & 31, hh = lane >> 5;
      const int dir = w & 1, chalf = w >> 1;
      half8 xin[2][4];
#pragma unroll
      for (int kind = 0; kind < 2; ++kind)
#pragma unroll
        for (int ks = 0; ks < 4; ++ks) xin[kind][ks] = *(const half8*)(inh + lq * 264 + kind * 128 + dir * 64 + 16 * ks + 8 * hh);
      h16* ost = (h16*)(smem + 32 * 264 * 2 + 4096) + w * (32 * 72);
      h16* fbase = p.F + (size_t)(rowbase + t0) * 1536 + dir * 768 + chalf * 384;
#pragma unroll 1
      for (int np = 0; np < 6; ++np) {
        const int c0 = chalf * 192 + np * 32;
        f32x16 acc[2];
#pragma unroll
        for (int kind = 0; kind < 2; ++kind) {
          const float* bias = (kind == 0 ? p.w0 : p.a0) + (l * 2 + dir) * 384 + c0;
          const h16* wl = p.wl_t + (size_t)((l * 4 + kind * 2 + dir) * 384 + c0) * 64;
#pragma unroll
          for (int g = 0; g < 4; ++g) { const f32x4 bv = *(const f32x4*)(bias + 8 * g + 4 * hh); acc[kind][4 * g] = bv[0]; acc[kind][4 * g + 1] = bv[1]; acc[kind][4 * g + 2] = bv[2]; acc[kind][4 * g + 3] = bv[3]; }
#pragma unroll
          for (int ks = 0; ks < 4; ++ks) {
            const half8 wf = *(const half8*)(wl + (size_t)lq * 64 + 16 * ks + 8 * hh);
            acc[kind] = __builtin_amdgcn_mfma_f32_32x32x16_f16(wf, xin[kind][ks], acc[kind], 0, 0, 0);
          }
        }
#pragma unroll
        for (int g = 0; g < 4; ++g) {
          half8 o;
#pragma unroll
          for (int j = 0; j < 4; ++j) { o[2 * j] = (h16)(1.f - __expf(-0.6065306597126334f * sigmoidf_(acc[0][4 * g + j]))); o[2 * j + 1] = (h16)sigmoidf_(acc[1][4 * g + j]); }
          *(half8*)(ost + lq * 72 + 16 * g + 8 * hh) = o;
        }
        asm volatile("s_waitcnt lgkmcnt(0)" ::: "memory");
#pragma unroll
        for (int q = 0; q < 4; ++q) {
          const int id = lane + q * 64; const int rr = id >> 3, ch = id & 7;
          *(u32x4*)(fbase + (size_t)rr * 1536 + np * 64 + ch * 8) = *(const u32x4*)(ost + rr * 72 + ch * 8);
        }
        asm volatile("s_waitcnt lgkmcnt(0)" ::: "memory");
      }
    }
    {
      const int head = tid >> 5, pr = tid & 31, half = pr >> 4, i = pr & 15;
      const int colbase = head < 6 ? 3072 + head * 64 : 3456 + (head - 6) * 64;
      const int d1 = half * 32 + i;
      const float qs = (head < 6 && !dry) ? 0.125f : 1.f;
      h16* pp = p.P + (size_t)(rowbase + t0) * PC + colbase + d1;
      h16 x1[32], x2[32];
#pragma unroll
      for (int u = 0; u < 32; ++u) { x1[u] = pp[(size_t)u * PC]; x2[u] = pp[(size_t)u * PC + 16]; }
#pragma unroll
      for (int u = 0; u < 32; ++u) {
        const int t = t0 + u;
        float cs = 1.f, sn = 0.f;
        if (!isctx && !dry) { const int pos = half == 0 ? (t >> 6) : (t & 63); const f32x2 r2 = *(const f32x2*)&p.rope[(pos * 16 + i) * 2]; cs = r2[0]; sn = r2[1]; }
        const float a = (float)x1[u], bq = (float)x2[u];
        pp[(size_t)u * PC] = (h16)((a * cs - bq * sn) * qs);
        pp[(size_t)u * PC + 16] = (h16)((a * sn + bq * cs) * qs);
      }
    }
    if (tid < 128) {
      const int g = tid >> 6, d = tid & 63;
      const h16* base = p.P + (size_t)(rowbase + t0) * PC + 3584 + tid;
      h16* dst = p.VT + (size_t)((b * 2 + g) * 64 + d) * VTS + (isctx ? 4096 + t0 : t0);
      half8 v[4];
#pragma unroll
      for (int q = 0; q < 4; ++q)
#pragma unroll
        for (int j = 0; j < 8; ++j) v[q][j] = base[(size_t)(q * 8 + j) * PC];
#pragma unroll
      for (int q = 0; q < 4; ++q) *(half8*)(dst + q * 8) = v[q];
    }
    __syncthreads();
  }
}

__device__ __forceinline__ float ulo(unsigned u) { return (float)__builtin_bit_cast(h16, (unsigned short)(u & 0xffffu)); }
__device__ __forceinline__ float uhi(unsigned u) { return (float)__builtin_bit_cast(h16, (unsigned short)(u >> 16)); }
__device__ __forceinline__ float red16(float x) {
  x += dpp_mov<0xB1>(x);
  x += dpp_mov<0x4E>(x);
  x += dpp_mov<0x141>(x);
  x += dpp_mov<0x140>(x);
  return x;
}
#define LDS_BARRIER() do { asm volatile("s_waitcnt lgkmcnt(0)" ::: "memory"); __builtin_amdgcn_s_barrier(); asm volatile("" ::: "memory"); } while (0)
constexpr int RREC = 336;
struct RwkvPf { unsigned rk[6]; h16 v[4]; unsigned ea[4]; };

__device__ __forceinline__ void rwkv_chain(const Params& p, int l, int item, char* smem, bool swap_roles) {
  const int tid0 = tid_opaque();
  const int tid = swap_roles ? (tid0 ^ 128) : tid0;
  const int lane = tid & 63, w = __builtin_amdgcn_readfirstlane(tid >> 6);
  const int chain = item >> 2, vq = item & 3;
  const int dir = chain / 48, b = (chain % 48) / 6, h = chain % 6;
  float* opb = (float*)smem;
  float* ybuf = opb + 2 * 8 * RREC;
  constexpr int NCH = 544;
  if (w < 2) {
    const int rl = tid >> 3, kq = tid & 7;
    float S[8];
#pragma unroll
    for (int j = 0; j < 8; ++j) S[j] = 0.f;
    __builtin_amdgcn_s_setprio(3);
    LDS_BARRIER();
#pragma unroll 1
    for (int ci = 0; ci < NCH; ++ci) {
      const float* op = opb + (ci & 1) * 8 * RREC;
      float* yb = ybuf + (ci & 1) * 1024;
      f32x4 aA = *(const f32x4*)(op + 8 * kq + 64), aB = *(const f32x4*)(op + 8 * kq + 68);
#pragma unroll
      for (int step = 0; step < 8; ++step) {
        const float* o = op + step * RREC + 8 * kq;
        const f32x4 wA = *(const f32x4*)(o), wB = *(const f32x4*)(o + 4);
        const f32x4 bA = *(const f32x4*)(o + 128), bB = *(const f32x4*)(o + 132);
        const f32x4 kA = *(const f32x4*)(o + 192), kB = *(const f32x4*)(o + 196);
        const f32x4 rA = *(const f32x4*)(o + 256), rB = *(const f32x4*)(o + 260);
        const float vv = op[step * RREC + 320 + rl];
        f32x4 naA = aA, naB = aB;
        if (step + 1 < 8) { naA = *(const f32x4*)(o + RREC + 64); naB = *(const f32x4*)(o + RREC + 68); }
        const float d0 = S[0] * aA[0] + S[1] * aA[1] + S[2] * aA[2] + S[3] * aA[3];
        const float d1 = S[4] * aB[0] + S[5] * aB[1] + S[6] * aB[2] + S[7] * aB[3];
        const float sa = red8(d0 + d1);
#pragma unroll
        for (int j = 0; j < 4; ++j) {
          S[j] = S[j] * wA[j] + sa * bA[j] + vv * kA[j];
          S[4 + j] = S[4 + j] * wB[j] + sa * bB[j] + vv * kB[j];
        }
        const float y0 = S[0] * rA[0] + S[1] * rA[1] + S[2] * rA[2] + S[3] * rA[3];
        const float y1 = S[4] * rB[0] + S[5] * rB[1] + S[6] * rB[2] + S[7] * rB[3];
        yb[step * 128 + tid] = y0 + y1;
        aA = naA; aB = naB;
      }
      LDS_BARRIER();
    }
    __builtin_amdgcn_s_setprio(0);
  } else {
    const int lw = w - 2, lt = tid - 128;
    const int hc = h * 64 + lane;
    const float mpr = p.mu_prev[l * 1792 + hc], mnr = p.mu_next[l * 1792 + hc];
    const float mpk = p.mu_prev[l * 1792 + 384 + hc], mnk = p.mu_next[l * 1792 + 384 + hc];
    const float kkw = p.k_k[l * 384 + hc], kaw = p.k_a[l * 384 + hc];
    const float cAr = dir ? mnr : mpr, cBr = dir ? mpr : mnr, cAk = dir ? mnk : mpk, cBk = dir ? mpk : mnk;
    const unsigned* zrow = p.bar + XCD_BAR_WORDS;
    RwkvPf pfA, pfB, pfC, pfD;
#define RWKV_ISSUE(ci_, PF) { const int seg_ = (ci_) >= 32; const int Tn_ = seg_ ? 4096 : 256; const int rb_ = seg_ ? b * 4096 : NLAT + b * 256; const int s0_ = (seg_ ? (ci_) - 32 : (ci_)) * 8 + 4 * lw; \
    _Pragma("unroll") for (int q = 0; q < 6; ++q) { const int t_ = dir == 0 ? s0_ - 1 + q : Tn_ - s0_ - q; \
      const unsigned* src_ = ((unsigned)t_ < (unsigned)Tn_) ? (const unsigned*)(p.P + (size_t)(rb_ + t_) * PC + h * 128) : zrow; \
      PF.rk[q] = src_[lane]; } \
    _Pragma("unroll") for (int i = 0; i < 4; ++i) { const int t_ = dir == 0 ? s0_ + i : Tn_ - 1 - (s0_ + i); const size_t row = (size_t)rb_ + t_; \
      PF.v[i] = p.VB[row * 384 + hc]; PF.ea[i] = ((const unsigned*)(p.F + row * 1536 + dir * 768))[hc]; } }
#define RWKV_STAGE(ci_, PF) { float* op_ = opb + ((ci_) & 1) * 8 * RREC; \
    const int seg = (ci_) >= 32; const int Tn = seg ? 4096 : 256; const int c0 = (seg ? (ci_) - 32 : (ci_)) * 8; \
    _Pragma("unroll") for (int i = 0; i < 4; ++i) { \
      const int step = lw * 4 + i; const int t = dir == 0 ? c0 + step : Tn - 1 - (c0 + step); \
      const float rlo = ulo(PF.rk[i]), r0 = ulo(PF.rk[i + 1]), rhi = ulo(PF.rk[i + 2]); \
      const float klo = uhi(PF.rk[i]), k0 = uhi(PF.rk[i + 1]), khi = uhi(PF.rk[i + 2]); \
      const float vv = (float)PF.v[i], e = ulo(PF.ea[i]), al = uhi(PF.ea[i]); \
      const float rs = r0 + cAr * (rlo - r0) + cBr * (rhi - r0); \
      const float ks = k0 + cAk * (klo - k0) + cBk * (khi - k0); \
      const float kkr = ks * kkw; \
      const float n2 = wave_sum_dpp(kkr * kkr); \
      const float kk = kkr * rsqrtf(fmaxf(n2, 1e-24f)); \
      float* o = op_ + step * RREC + lane; \
      o[0] = 1.f - e; o[64] = -kk; o[128] = kk * al; o[192] = ks * (1.f + (al - 1.f) * kaw); o[256] = rs; \
      if ((lane >> 4) == vq) op_[step * RREC + 320 + (lane & 15)] = vv; } }
#define RWKV_WRITE(cj_) { const int seg = (cj_) >= 32; const int Tn = seg ? 4096 : 256; const int rowbase = seg ? b * 4096 : NLAT + b * 256; const int c0 = (seg ? (cj_) - 32 : (cj_)) * 8; \
    if (seg == 1 || l == 0) { const float* yb = ybuf + ((cj_) & 1) * 1024; \
      const int step = lt >> 4, ch = lt & 15; \
      const int t = dir == 0 ? c0 + step : Tn - 1 - (c0 + step); \
      const f32x4 y0 = *(const f32x4*)(yb + step * 128 + ch * 8), y1 = *(const f32x4*)(yb + step * 128 + ch * 8 + 4); \
      const f32x4 ys = y0 + y1; const h16 yv = (h16)((ys[0] + ys[1]) + (ys[2] + ys[3])); \
      if (dir == 0) p.P[(size_t)(rowbase + t) * PC + 768 + h * 64 + 16 * vq + ch] = yv; \
      else p.hy[(size_t)(rowbase + t) * 1024 + h * 64 + 16 * vq + ch] = yv; } }
    RWKV_ISSUE(0, pfA)
    RWKV_STAGE(0, pfA)
    RWKV_ISSUE(1, pfB)
    RWKV_ISSUE(2, pfC)
    RWKV_ISSUE(3, pfD)
    RWKV_ISSUE(4, pfA)
    LDS_BARRIER();
#pragma unroll 1
    for (int ci = 0; ci < NCH; ci += 4) {
      if (ci + 1 < NCH) RWKV_STAGE(ci + 1, pfB)
      if (ci + 5 < NCH) RWKV_ISSUE(ci + 5, pfB)
      if (ci >= 1) RWKV_WRITE(ci - 1)
      LDS_BARRIER();
      if (ci + 2 < NCH) RWKV_STAGE(ci + 2, pfC)
      if (ci + 6 < NCH) RWKV_ISSUE(ci + 6, pfC)
      RWKV_WRITE(ci)
      LDS_BARRIER();
      if (ci + 3 < NCH) RWKV_STAGE(ci + 3, pfD)
      if (ci + 7 < NCH) RWKV_ISSUE(ci + 7, pfD)
      RWKV_WRITE(ci + 1)
      LDS_BARRIER();
      if (ci + 4 < NCH) RWKV_STAGE(ci + 4, pfA)
      if (ci + 8 < NCH) RWKV_ISSUE(ci + 8, pfA)
      RWKV_WRITE(ci + 2)
      LDS_BARRIER();
    }
    RWKV_WRITE(NCH - 1)
  }
}

constexpr int HREC = 224;
struct HgrnPf { h16 f[4], q[4], iv[4]; };
__device__ __forceinline__ void hgrn_chain(const Params& p, int l, int item, char* smem) {
  const int tid = tid_opaque(), lane = tid & 63, w = __builtin_amdgcn_readfirstlane(tid >> 6);
  const int chain = item >> 1, vh = item & 1;
  const int dir = chain / 32, b = (chain % 32) / 4, h = chain % 4;
  float* op = (float*)smem;
  float* ybuf = op + 16 * HREC;
  const int hc = h * 64 + lane;
  float lb = 0.f;
  if (l == 1) lb = sigmoidf_(p.lb_logits[(dir * 2 + 1) * 256 + hc] - p.lb_logits[(dir * 2 + 0) * 256 + hc]);
  const int fcol = 1792 + 256 * (1 + dir) + hc;
  const int vc = tid >> 3, kq = tid & 7;
  float S[8];
#pragma unroll
  for (int j = 0; j < 8; ++j) S[j] = 0.f;
  HgrnPf pfA, pfB;
#define HGRN_ISSUE(ci_, PF) { const int seg_ = (ci_) >= 16; const int Tn_ = seg_ ? 4096 : 256; const int rb_ = seg_ ? b * 4096 : NLAT + b * 256; const int c0_ = (seg_ ? (ci_) - 16 : (ci_)) * 16; \
    _Pragma("unroll") for (int i = 0; i < 4; ++i) { const int step = w * 4 + i; const int t = dir == 0 ? c0_ + step : Tn_ - 1 - (c0_ + step); const h16* pr = p.P + ((size_t)rb_ + t) * PC; \
      PF.f[i] = pr[fcol]; PF.q[i] = pr[1792 + hc]; PF.iv[i] = pr[1792 + 768 + hc]; } }
#define HGRN_CHUNK(ci_, PF) { \
    const int seg = (ci_) >= 16; const int Tn = seg ? 4096 : 256; const int rowbase = seg ? b * 4096 : NLAT + b * 256; const int c0 = (seg ? (ci_) - 16 : (ci_)) * 16; \
    _Pragma("unroll") for (int i = 0; i < 4; ++i) { \
      const int step = w * 4 + i; \
      float* o = op + step * HREC + lane; \
      const float f = lb + (1.f - lb) * sigmoidf_((float)PF.f[i]); \
      o[0] = f; o[128] = (float)PF.q[i]; \
      if ((lane >> 5) == vh) op[step * HREC + 192 + (lane & 31)] = (float)PF.iv[i]; } \
    LDS_BARRIER(); \
    if ((ci_) + 2 < 272) HGRN_ISSUE((ci_) + 2, PF) \
    _Pragma("unroll") for (int step = 0; step < 16; ++step) { \
      const float* o = op + step * HREC + 8 * kq; \
      const f32x4 fA = *(const f32x4*)(o), fB = *(const f32x4*)(o + 4); \
      const f32x4 qA = *(const f32x4*)(o + 128), qB = *(const f32x4*)(o + 132); \
      const float iv = op[step * HREC + 192 + vc]; \
      const float f[8] = {fA[0], fA[1], fA[2], fA[3], fB[0], fB[1], fB[2], fB[3]}; \
      const float q[8] = {qA[0], qA[1], qA[2], qA[3], qB[0], qB[1], qB[2], qB[3]}; \
      float acc = 0.f; \
      _Pragma("unroll") for (int j = 0; j < 8; ++j) { S[j] = f[j] * (S[j] - iv) + iv; acc += S[j] * q[j]; } \
      ybuf[step * 256 + tid] = acc; } \
    LDS_BARRIER(); \
    if (seg == 1 || l == 0) { \
      _Pragma("unroll") for (int i = 0; i < 2; ++i) { \
        const int idx = tid + i * 256; const int step = idx >> 5, ch = idx & 31; \
        const int t = dir == 0 ? c0 + step : Tn - 1 - (c0 + step); \
        const float* yb = ybuf + step * 256 + ch * 8; \
        const f32x4 y0 = *(const f32x4*)(yb), y1 = *(const f32x4*)(yb + 4); \
        const f32x4 ys = y0 + y1; \
        const h16 ov = (h16)((ys[0] + ys[1]) + (ys[2] + ys[3])); \
        if (dir == 0) p.P[(size_t)(rowbase + t) * PC + 1152 + h * 64 + 32 * vh + ch] = ov; \
        else p.hy[(size_t)(rowbase + t) * 1024 + 384 + h * 64 + 32 * vh + ch] = ov; } } }
  HGRN_ISSUE(0, pfA)
  HGRN_ISSUE(1, pfB)
  __builtin_amdgcn_s_setprio(2);
#pragma unroll 1
  for (int ci = 0; ci < 272; ci += 2) {
    HGRN_CHUNK(ci, pfA)
    HGRN_CHUNK(ci + 1, pfB)
  }
  __builtin_amdgcn_s_setprio(0);
}

__device__ __forceinline__ void attn_unit(const Params& p, int l, int u) {
  const int tid = tid_opaque(), lane = tid & 63, w = __builtin_amdgcn_readfirstlane(tid >> 6), lq = lane & 31, hh = lane >> 5;
  int b, head, qrow_base, qpos0; bool isctx;
  if (u < 1536) { b = u / 192; int rem = u % 192; int blk = rem / 6; head = rem % 6; qpos0 = blk * 128 + w * 32; qrow_base = b * 4096; isctx = false; }
  else { int j = u - 1536; b = j / 12; int rem = j % 12; int qb = rem / 6; head = rem % 6; qpos0 = qb * 128 + w * 32; qrow_base = NLAT + b * 256; isctx = true; }
  const int g = head / 3;
  const size_t qrow = (size_t)qrow_base + qpos0 + lq;
  half8 qf[4];
#pragma unroll
  for (int s = 0; s < 4; ++s) qf[s] = *(const half8*)(p.P + qrow * PC + 3072 + head * 64 + 16 * s + 8 * hh);
  const float sinkv = p.sink[l * 6 + head];
  float m = sinkv, lsum = hh == 0 ? 1.f : 0.f;
  f32x16 O[2];
#pragma unroll
  for (int r = 0; r < 16; ++r) { O[0][r] = 0.f; O[1][r] = 0.f; }
  const h16* vt = p.VT + (size_t)((b * 2 + g) * 64) * VTS;
  int nband = 0, kstart = 0;
  if (!isctx) { kstart = max(0, qpos0 - 128); const int kend = min(4096, qpos0 + 160); nband = (kend - kstart) >> 5; }
  const int ntiles = nband + 8;
  for (int ti = 0; ti < ntiles; ++ti) {
    const bool band = ti < nband;
    const int kt = band ? kstart + ti * 32 : (ti - nband) * 32;
    const size_t krow = band ? (size_t)b * 4096 + kt + lq : (size_t)NLAT + b * 256 + kt + lq;
    const int vidx = band ? kt : 4096 + kt;
    const h16* kp = p.P + krow * PC + 3456 + g * 64 + 8 * hh;
    f32x16 sacc;
#pragma unroll
    for (int r = 0; r < 16; ++r) sacc[r] = 0.f;
#pragma unroll
    for (int s = 0; s < 4; ++s) { half8 kf = *(const half8*)(kp + 16 * s); sacc = __builtin_amdgcn_mfma_f32_32x32x16_f16(kf, qf[s], sacc, 0, 0, 0); }
    float mx = -INFINITY;
#pragma unroll
    for (int r = 0; r < 16; ++r) {
      float sv = sacc[r];
      if (band) { const int dlt = kt + (r & 3) + 8 * (r >> 2) + 4 * hh - (qpos0 + lq); if (dlt > 128 || dlt < -128) sv = -INFINITY; }
      sacc[r] = sv; mx = fmaxf(mx, sv);
    }
    mx = fmaxf(mx, __shfl_xor(mx, 32));
    const float mn = fmaxf(m, mx); const float corr = __expf(m - mn); m = mn;
    float ps = 0.f; half8 pb[2];
#pragma unroll
    for (int r = 0; r < 16; ++r) { const float pv = __expf(sacc[r] - mn); ps += pv; pb[r >> 3][r & 7] = (h16)pv; }
    lsum = lsum * corr + ps;
#pragma unroll
    for (int r = 0; r < 16; ++r) { O[0][r] *= corr; O[1][r] *= corr; }
#pragma unroll
    for (int s2 = 0; s2 < 2; ++s2)
#pragma unroll
      for (int dt = 0; dt < 2; ++dt) {
        const h16* vp = vt + (size_t)(dt * 32 + lq) * VTS + vidx + 16 * s2 + 4 * hh;
        const half4 lo = *(const half4*)vp, hi = *(const half4*)(vp + 8);
        const half8 vf = {lo[0], lo[1], lo[2], lo[3], hi[0], hi[1], hi[2], hi[3]};
        O[dt] = __builtin_amdgcn_mfma_f32_32x32x16_f16(vf, pb[s2], O[dt], 0, 0, 0);
      }
  }
  lsum += __shfl_xor(lsum, 32);
  const float inv = 1.f / lsum;
#pragma unroll
  for (int dt = 0; dt < 2; ++dt)
#pragma unroll
    for (int g4 = 0; g4 < 4; ++g4) {
      const int d0 = dt * 32 + 8 * g4 + 4 * hh;
      const half4 ga = *(const half4*)(p.P + qrow * PC + 3712 + head * 64 + d0);
      half4 o;
#pragma unroll
      for (int j = 0; j < 4; ++j) { const float gv = (float)ga[j]; o[j] = (h16)(O[dt][g4 * 4 + j] * inv * siluf_(gv)); }
      *(half4*)(p.hy + qrow * 1024 + 640 + head * 64 + d0) = o;
    }
}

__device__ __forceinline__ void phase_mix(const Params& p, int l, int bid, int nb, char* smem, int sub) {
  const int nunits = l == 0 ? 1536 + 96 : 1536;
  if (nb >= 640) {
    if (bid < 384) { if (sub & 1) { const int x = bid & 7, j = bid >> 3; rwkv_chain(p, l, (((j >> 2) * 8 + x) << 2) | (j & 3), smem, bid >= 256); } }
    else if (bid < 512) { if (sub & 2) { const int hb = bid - 384, x = hb & 7, j = hb >> 3; hgrn_chain(p, l, (((j >> 1) * 8 + x) << 1) | (j & 1), smem); } }
    else if (sub & 4) for (int u = bid - 512; u < nunits; u += nb - 512) attn_unit(p, l, u);
  } else {
    for (int it = bid; it < 512 + nunits; it += nb) {
      if (it < 384) rwkv_chain(p, l, it, smem, false);
      else if (it < 512) hgrn_chain(p, l, it - 384, smem);
      else attn_unit(p, l, it - 512);
      __syncthreads();
    }
  }
}

__device__ __forceinline__ float sum4(const f32x4 v) { return (v[0] + v[1]) + (v[2] + v[3]); }
__device__ __forceinline__ f32x4 h4f(const half4 h) { return (f32x4){(float)h[0], (float)h[1], (float)h[2], (float)h[3]}; }
__device__ __forceinline__ half8 zero_h8() { half8 z;
#pragma unroll
  for (int j = 0; j < 8; ++j) z[j] = (h16)0.f; return z; }
__device__ __forceinline__ half4 zero_h4() { half4 z; z[0] = z[1] = z[2] = z[3] = (h16)0.f; return z; }
__device__ __forceinline__ void phase_readout(const Params& p, int l, int bid, int nb, bool dummy) {
  const int tid = tid_opaque(), lane = tid & 63, w = __builtin_amdgcn_readfirstlane(tid >> 6);
  const int nrows = l == 1 ? NLAT : NTOK;
  const int hl = lane >> 4, c4 = (lane & 15) * 4;
  const int gw = bid * 4 + w, nper = (nb * 4) / 3;
  const int q = gw % 3, ridx = gw / 3;
  if (ridx >= nper) return;
  const int rpw = (nrows + nper - 1) / nper;
  const int r0 = ridx * rpw, r1 = min(nrows, r0 + rpw);
  if (r0 >= r1) return;
  if (q < 2) {
    const int head = q * 4 + hl; const bool valid = head < 6; const int hcl = valid ? head : 5; const int c = hcl * 64 + c4;
    const f32x4 mpr = *(const f32x4*)(p.mu_prev + l * 1792 + c), mnr = *(const f32x4*)(p.mu_next + l * 1792 + c);
    const f32x4 mpk = *(const f32x4*)(p.mu_prev + l * 1792 + 384 + c), mnk = *(const f32x4*)(p.mu_next + l * 1792 + 384 + c);
    const f32x4 mpg = *(const f32x4*)(p.mu_prev + l * 1792 + 1408 + c), mng = *(const f32x4*)(p.mu_next + l * 1792 + 1408 + c);
    const f32x4 gwt = *(const f32x4*)(p.gn_w + l * 384 + c), gbs = *(const f32x4*)(p.gn_b + l * 384 + c), rkw = *(const f32x4*)(p.r_k + l * 384 + c);
    const h16* prk = p.P + hcl * 128 + 2 * c4;
    const h16* pg = p.P + 1408 + c;
    half8 rk_prev = r0 > 0 ? *(const half8*)(prk + (size_t)(r0 - 1) * PC) : zero_h8();
    half4 g_prev = r0 > 0 ? *(const half4*)(pg + (size_t)(r0 - 1) * PC) : zero_h4();
    half8 rk_cur = *(const half8*)(prk + (size_t)r0 * PC);
    half4 g_cur = *(const half4*)(pg + (size_t)r0 * PC);
    half8 rk_next = r0 + 1 < NTOK ? *(const half8*)(prk + (size_t)(r0 + 1) * PC) : zero_h8();
    half4 g_next = r0 + 1 < NTOK ? *(const half4*)(pg + (size_t)(r0 + 1) * PC) : zero_h4();
    half4 yf_c = *(const half4*)(p.P + (size_t)r0 * PC + 768 + c), yb_c = *(const half4*)(p.hy + (size_t)r0 * 1024 + c), v_c = *(const half4*)(p.VB + (size_t)r0 * 384 + c);
#pragma unroll 1
    for (int row = r0; row < r1; ++row) {
      const bool more = row + 1 < r1;
      const half8 rk_nn = row + 2 < NTOK ? *(const half8*)(prk + (size_t)(row + 2) * PC) : zero_h8();
      const half4 g_nn = row + 2 < NTOK ? *(const half4*)(pg + (size_t)(row + 2) * PC) : zero_h4();
      half4 yf_n = yf_c, yb_n = yb_c, v_n = v_c;
      if (more) { yf_n = *(const half4*)(p.P + (size_t)(row + 1) * PC + 768 + c); yb_n = *(const half4*)(p.hy + (size_t)(row + 1) * 1024 + c); v_n = *(const half4*)(p.VB + (size_t)(row + 1) * 384 + c); }
      int t, Tn;
      if (row < NLAT) { t = row & 4095; Tn = 4096; } else { t = (row - NLAT) & 255; Tn = 256; }
      const bool hp = t > 0, hn = t + 1 < Tn;
      f32x4 sh[3];
#pragma unroll
      for (int k = 0; k < 2; ++k) {
        const f32x4 cur = {(float)rk_cur[k], (float)rk_cur[2 + k], (float)rk_cur[4 + k], (float)rk_cur[6 + k]};
        f32x4 prv = {(float)rk_prev[k], (float)rk_prev[2 + k], (float)rk_prev[4 + k], (float)rk_prev[6 + k]};
        f32x4 nxt = {(float)rk_next[k], (float)rk_next[2 + k], (float)rk_next[4 + k], (float)rk_next[6 + k]};
        if (!hp) prv = (f32x4){0.f, 0.f, 0.f, 0.f};
        if (!hn) nxt = (f32x4){0.f, 0.f, 0.f, 0.f};
        sh[k] = cur + (k == 0 ? mpr : mpk) * (prv - cur) + (k == 0 ? mnr : mnk) * (nxt - cur);
      }
      {
        const f32x4 cur = h4f(g_cur);
        f32x4 prv = h4f(g_prev), nxt = h4f(g_next);
        if (!hp) prv = (f32x4){0.f, 0.f, 0.f, 0.f};
        if (!hn) nxt = (f32x4){0.f, 0.f, 0.f, 0.f};
        sh[2] = cur + mpg * (prv - cur) + mng * (nxt - cur);
      }
      const f32x4 y = h4f(yf_c) + h4f(yb_c);
      const f32x4 v = h4f(v_c);
      const float mean = red16(sum4(y)) * (1.f / 64.f);
      const f32x4 yc = y - mean;
      const float var = red16(sum4(yc * yc)) * (1.f / 64.f);
      const float rs = rsqrtf(var + 64e-5f);
      const float bs = red16(sum4(sh[0] * sh[1] * rkw));
      half4 o;
#pragma unroll
      for (int j = 0; j < 4; ++j) o[j] = (h16)((yc[j] * rs * gwt[j] + gbs[j] + bs * v[j]) * siluf_(sh[2][j]));
      h16* yw = dummy ? p.F + (size_t)row * 1536 : p.hy + (size_t)row * 1024;
      if (valid) *(half4*)(yw + c) = o;
      rk_prev = rk_cur; rk_cur = rk_next; rk_next = rk_nn;
      g_prev = g_cur; g_cur = g_next; g_next = g_nn;
      yf_c = yf_n; yb_c = yb_n; v_c = v_n;
    }
  } else {
    const int c = hl * 64 + c4;
    const f32x4 nw = *(const f32x4*)(p.hg_norm_w + l * 256 + c);
    half4 of_c = *(const half4*)(p.P + (size_t)r0 * PC + 1152 + c), ob_c = *(const half4*)(p.hy + (size_t)r0 * 1024 + 384 + c), g_c = *(const half4*)(p.P + (size_t)r0 * PC + 2816 + c);
#pragma unroll 1
    for (int row = r0; row < r1; ++row) {
      half4 of_n = of_c, ob_n = ob_c, g_n = g_c;
      if (row + 1 < r1) { of_n = *(const half4*)(p.P + (size_t)(row + 1) * PC + 1152 + c); ob_n = *(const half4*)(p.hy + (size_t)(row + 1) * 1024 + 384 + c); g_n = *(const half4*)(p.P + (size_t)(row + 1) * PC + 2816 + c); }
      const f32x4 o = h4f(of_c) + h4f(ob_c);
      const f32x4 g = h4f(g_c);
      const float ms = red16(sum4(o * o)) * (1.f / 64.f);
      const float rs = rsqrtf(ms + 1e-6f);
      half4 ov;
#pragma unroll
      for (int j = 0; j < 4; ++j) ov[j] = (h16)(o[j] * rs * nw[j] * siluf_(g[j]));
      h16* yw = dummy ? p.F + (size_t)row * 1536 : p.hy + (size_t)row * 1024;
      *(half4*)(yw + 384 + c) = ov;
      of_c = of_n; ob_c = ob_n; g_c = g_n;
    }
  }
}

__device__ __forceinline__ void phase_final(const Params& p, int bid, int nb) {
  const int tid = tid_opaque(), lane = tid & 63, w = __builtin_amdgcn_readfirstlane(tid >> 6);
  for (int row = bid * 4 + w; row < NLAT; row += nb * 4) {
    float* src = p.out + (size_t)row * 1024;
    f32x4 v[4]; float ss = 0.f;
#pragma unroll
    for (int i = 0; i < 4; ++i) { v[i] = *(const f32x4*)(src + i * 256 + lane * 4); ss += v[i][0] * v[i][0] + v[i][1] * v[i][1] + v[i][2] * v[i][2] + v[i][3] * v[i][3]; }
    ss = wave_sum_dpp(ss);
    const float rs = rsqrtf(ss * (1.f / 1024.f) + 1e-6f);
#pragma unroll
    for (int i = 0; i < 4; ++i) {
      const int col = i * 256 + lane * 4;
      const f32x4 nwv = *(const f32x4*)(p.final_w + col);
      f32x4 o;
#pragma unroll
      for (int j = 0; j < 4; ++j) o[j] = v[i][j] * rs * nwv[j];
      *(f32x4*)(src + col) = o;
    }
  }
}

__global__ void __launch_bounds__(256, 3) __attribute__((target("no-packed-fp32-ops"))) mega(Params p, int ph_lo, int ph_hi, int coop) {
  __shared__ __attribute__((aligned(16))) char smem[SMEM_BYTES];
  __shared__ uint4 xb_words;
  XcdBarrier xb; xb.bar = p.bar; xb.x = 0; xb.st = (volatile LAS unsigned*)&xb_words;
  if (coop) { if (threadIdx.x == 0) xb_words = make_uint4(0u, 0u, 0u, 0u); __syncthreads(); xb = xcd_barrier_post(p.bar, (volatile LAS unsigned*)&xb_words); }
  if (coop) for (int i = 0; i < EXTRA_SYNCS; ++i) { xcd_barrier(xb); }
  if (coop == 2) cg::this_grid().sync();
  for (int ph = ph_lo; ph < ph_hi; ++ph) {
    for (int rep = 0; rep < (((PROBE_MASK >> ph) & 1) ? 2 : 1); ++rep) {
      int bid = blockIdx.x, nb = gridDim.x;
      asm volatile("" : "+s"(bid), "+s"(nb));
      if (ph == 0) phase_prep(p, bid, nb, smem);
      else if (ph == 13) phase_final(p, bid, nb);
      else {
        const int l = (ph - 1) / 6, s = (ph - 1) % 6;
        if (s == 0) phase_norm(p, l, bid, nb);
        else if (s == 1) phase_gemm<0>(p, l, bid, nb, smem);
        else if (s == 2) phase_feat(p, l, bid, nb, smem, PROBE_MASK && ((PROBE_MASK >> ph) & 1) && rep == 0);
        else if (s == 3) phase_mix(p, l, bid, nb, smem, rep ? PROBE_SUB : 7);
        else if (s == 4) phase_readout(p, l, bid, nb, PROBE_MASK && ((PROBE_MASK >> ph) & 1) && rep == 0);
        else phase_gemm<1>(p, l, bid, nb, smem);
      }
      if (PROBE_MASK && rep == 0 && ((PROBE_MASK >> ph) & 1)) { xcd_barrier(xb); }
    }
    if (coop && ph + 1 < ph_hi) { xcd_barrier(xb); }
  }
}

extern "C" void kernel_launch(void* const* d_in, const int* in_sizes, int n_in, void* d_out, int out_size, void* d_ws, size_t ws_size, hipStream_t stream) {
  static int grid_blocks = 0;
  if (!grid_blocks) {
    int dev = 0, cus = 0, per_cu = 0;
    hipGetDevice(&dev);
    hipDeviceGetAttribute(&cus, hipDeviceAttributeMultiprocessorCount, dev);
    hipOccupancyMaxActiveBlocksPerMultiprocessor(&per_cu, mega, 256, 0);
    if (per_cu < 1) per_cu = 1;
    grid_blocks = cus * per_cu;
  }
  Params p{};
  const float* const* in = (const float* const*)d_in;
  p.x = in[0]; p.c = in[1]; p.ctx = in[2]; p.c_ctx = in[3]; p.mod_w = in[4]; p.mod_b = in[5]; p.norm_w = in[6]; p.w_in = in[7]; p.w_out = in[8];
  p.mu_prev = in[9]; p.mu_next = in[10]; p.w0 = in[11]; p.w2 = in[12]; p.a0 = in[13]; p.a2 = in[14]; p.k_k = in[15]; p.k_a = in[16]; p.r_k = in[17];
  p.gn_w = in[18]; p.gn_b = in[19]; p.vw1 = in[20]; p.vw2 = in[21]; p.vb = in[22]; p.lb_logits = in[23]; p.hg_norm_w = in[24]; p.sink = in[25]; p.final_w = in[26];
  p.out = (float*)d_out;
  char* ws = (char*)d_ws; size_t off = 0;
  auto take = [&](size_t bytes) { char* r = ws + off; off += (bytes + 255) & ~(size_t)255; return r; };
  p.win_t = (h16*)take((size_t)2 * NPAD * 1024 * 2);
  p.wout_t = (h16*)take((size_t)2 * 1024 * 1024 * 2);
  p.wl_t = (h16*)take((size_t)2 * 4 * 384 * 64 * 2);
  p.mod = (float*)take((size_t)2 * 9 * 3072 * 4);
  p.rope = (float*)take((size_t)64 * 16 * 2 * 4);
  p.hy = (h16*)take((size_t)NTOK * 1024 * 2);
  p.P = (h16*)take((size_t)NTOK * PC * 2);
  p.F = (h16*)take((size_t)NTOK * 1536 * 2);
  p.VB = (h16*)take((size_t)NTOK * 384 * 2);
  p.VT = (h16*)take((size_t)16 * 64 * VTS * 2);
  p.xc1 = (float*)take((size_t)2048 * 1024 * 4);
  p.bar = (unsigned*)take(16384);
  if (off > ws_size) fprintf(stderr, "workspace too small: need %zu have %zu\n", off, ws_size);
#if SINGLE_LAUNCH
  hipMemsetAsync(p.bar, 0, 16384, stream);
  int lo = 0, hi = 14, coop = 1;
  void* args[] = {&p, &lo, &hi, &coop};
  hipError_t e = hipLaunchCooperativeKernel((void*)mega, dim3(grid_blocks), dim3(256), args, 0, stream);
  if (e != hipSuccess) fprintf(stderr, "cooperative launch failed: %s (grid %d)\n", hipGetErrorString(e), grid_blocks);
#else
  for (int ph = 0; ph < 14; ++ph) mega<<<grid_blocks, 256, 0, stream>>>(p, ph, ph + 1, 0);
#endif
}
```

```cpp
#include <hip/hip_runtime.h>
#include <hip/hip_cooperative_groups.h>
#include <cstdio>
#include <cstdint>
namespace cg = cooperative_groups;

typedef _Float16 h16;
typedef _Float16 half8 __attribute__((ext_vector_type(8)));
typedef _Float16 half4 __attribute__((ext_vector_type(4)));
typedef float f32x16 __attribute__((ext_vector_type(16)));
typedef float f32x4 __attribute__((ext_vector_type(4)));
typedef float f32x2 __attribute__((ext_vector_type(2)));
typedef unsigned u32x4 __attribute__((ext_vector_type(4)));
typedef _Float16 half2v __attribute__((ext_vector_type(2)));

constexpr int NLAT = 32768, NTOK = 34816;
constexpr int PC = 4160;
constexpr int NPAD = 4224;
constexpr int VTS = 4352;
constexpr int SMEM_BYTES = 49152;

#ifndef EXTRA_SYNCS
#define EXTRA_SYNCS 0
#endif
#ifndef PROBE_SUB
#define PROBE_SUB 7
#endif
#ifndef PROBE_MASK
#define PROBE_MASK 0
#endif
#ifndef SINGLE_LAUNCH
#define SINGLE_LAUNCH 1
#endif

struct Params {
  const float *x, *c, *ctx, *c_ctx, *mod_w, *mod_b, *norm_w, *w_in, *w_out;
  const float *mu_prev, *mu_next, *w0, *w2, *a0, *a2, *k_k, *k_a, *r_k, *gn_w, *gn_b;
  const float *vw1, *vw2, *vb, *lb_logits, *hg_norm_w, *sink, *final_w;
  float* out;
  h16 *win_t, *wout_t, *wl_t;
  float* mod;
  h16 *hy, *P, *F, *VB;
  h16* VT;
  float* xc1;
  float* rope;
  unsigned* bar;
};

__device__ __forceinline__ int tid_opaque() { int t = threadIdx.x; asm volatile("" : "+v"(t)); return t; }
__device__ __forceinline__ float wave_sum(float v) {
#pragma unroll
  for (int o = 32; o > 0; o >>= 1) v += __shfl_xor(v, o);
  return v;
}
__device__ __forceinline__ float sigmoidf_(float x) { return __builtin_amdgcn_rcpf(1.f + __expf(-x)); }
__device__ __forceinline__ float siluf_(float x) { return x * __builtin_amdgcn_rcpf(1.f + __expf(-x)); }
template <int CTRL> __device__ __forceinline__ float dpp_mov(float x) {
  return __int_as_float(__builtin_amdgcn_update_dpp(0, __float_as_int(x), CTRL, 0xf, 0xf, true));
}
__device__ __forceinline__ float wave_sum_dpp(float x) {
  x += dpp_mov<0xB1>(x);
  x += dpp_mov<0x4E>(x);
  x += dpp_mov<0x141>(x);
  x += dpp_mov<0x140>(x);
  const int xi = __float_as_int(x);
  return __int_as_float(__builtin_amdgcn_readlane(xi, 0)) + __int_as_float(__builtin_amdgcn_readlane(xi, 16)) +
         __int_as_float(__builtin_amdgcn_readlane(xi, 32)) + __int_as_float(__builtin_amdgcn_readlane(xi, 48));
}
__device__ __forceinline__ float red8(float x) {
  x += dpp_mov<0xB1>(x);
  x += dpp_mov<0x4E>(x);
  x += dpp_mov<0x141>(x);
  return x;
}

#define XB_TMO      128
#define XB_XCNT(j)  (256  + 64 * (j))
#define XB_XSUB(j)  (1280 + 64 * (j))
#define XB_XGEN(j)  (2304 + 64 * (j))
#define XB_TOP      3328
#define XB_TOPGEN   3392
#define XCD_BAR_WORDS 3456
#define XB_SPIN_CAP (1u << 18)
#define LAS __attribute__((address_space(3)))
__device__ __forceinline__ unsigned xb_ld(unsigned* p)              { return __hip_atomic_load(p, __ATOMIC_RELAXED, __HIP_MEMORY_SCOPE_AGENT); }
__device__ __forceinline__ unsigned xb_add(unsigned* p, unsigned v) { return __hip_atomic_fetch_add(p, v, __ATOMIC_RELAXED, __HIP_MEMORY_SCOPE_AGENT); }
__device__ __forceinline__ unsigned xb_xcc_id() { return (unsigned)__builtin_amdgcn_s_getreg((3 << 11) | 20) & 0xFu; }
#define XB_SPIN(cond, bar) do { unsigned _sp = 0; while (cond) { __builtin_amdgcn_s_sleep(1); \
    if ((++_sp & 255u) == 0u) { if (xb_ld(&(bar)[XB_TMO])) break; if (_sp > XB_SPIN_CAP) { atomicAdd(&(bar)[XB_TMO], 1u); break; } } } } while (0)
struct XcdBarrier { unsigned* bar; unsigned x; volatile LAS unsigned* st; };
__device__ __forceinline__ XcdBarrier xcd_barrier_post(unsigned* bar, volatile LAS unsigned* st) {
  XcdBarrier b; b.bar = bar; b.x = xb_xcc_id(); b.st = st;
  if (threadIdx.x == 0) (void)xb_add(&bar[XB_XCNT(b.x)], 1u);
  return b;
}
__device__ __forceinline__ void xcd_barrier_complete(unsigned* bar, unsigned x, unsigned& nloc, unsigned& nx) {
  const unsigned G = gridDim.x * gridDim.y * gridDim.z;
  unsigned sum, cnt, mine, sp = 0u;
  for (;;) {
    sum = 0u; cnt = 0u; mine = 0u;
#pragma unroll
    for (unsigned j = 0; j < 16; ++j) { const unsigned c = xb_ld(&bar[XB_XCNT(j)]); sum += c; cnt += (c > 0u) ? 1u : 0u; mine = (j == x) ? c : mine; }
    if (sum == G) break;
    __builtin_amdgcn_s_sleep(1);
    if ((++sp & 255u) == 0u) { if (xb_ld(&bar[XB_TMO])) break; if (sp > XB_SPIN_CAP) { atomicAdd(&bar[XB_TMO], 1u); break; } }
  }
  nloc = mine > 0u ? mine : 1u; nx = cnt > 0u ? cnt : 1u;
}
__device__ __forceinline__ void xcd_barrier(const XcdBarrier& b) {
  asm volatile("s_waitcnt vmcnt(0)" ::: "memory");
  __syncthreads();
  if (threadIdx.x == 0) {
    unsigned* bar = b.bar;
    __builtin_amdgcn_s_waitcnt(0);
    unsigned nloc = b.st[0], nx = b.st[1];
    if (nloc == 0u) { xcd_barrier_complete(bar, b.x, nloc, nx); b.st[0] = nloc; b.st[1] = nx; }
    const unsigned old = xb_add(&bar[XB_XSUB(b.x)], 1u);
    const unsigned gen = old / nloc;
    if (old + 1u == (gen + 1u) * nloc) {
      __builtin_amdgcn_fence(__ATOMIC_RELEASE, "agent");
      asm volatile("s_waitcnt vmcnt(0)" ::: "memory");
      const unsigned og = xb_add(&bar[XB_TOP], 1u);
      const unsigned tg = og / nx;
      if (og + 1u == (tg + 1u) * nx) xb_add(&bar[XB_TOPGEN], 1u);
      else XB_SPIN(xb_ld(&bar[XB_TOPGEN]) == tg, bar);
      __builtin_amdgcn_fence(__ATOMIC_ACQUIRE, "agent");
      xb_add(&bar[XB_XGEN(b.x)], 1u);
      asm volatile("s_waitcnt vmcnt(0)" ::: "memory");
    } else {
      XB_SPIN(xb_ld(&bar[XB_XGEN(b.x)]) == gen, bar);
      __builtin_amdgcn_fence(__ATOMIC_ACQUIRE, "agent");
      asm volatile("s_waitcnt vmcnt(0)" ::: "memory");
    }
  }
  __syncthreads();
}

__device__ __forceinline__ void phase_prep(const Params& p, int bid, int nb, char* smem) {
  const int tid = tid_opaque();
  float* sf = (float*)smem;
  constexpr int N_WIN = 2048, N_WOUT = 512, N_MOD = 192, N_PADI = 1024, N_WL = 768;
  constexpr int total = N_WIN + N_WOUT + N_MOD + N_PADI + N_WL + 1;
  for (int it = bid; it < total; it += nb) {
    if (it < N_WIN + N_WOUT) {
      const float* src; h16* dst; int ncols, kt, ntile;
      if (it < N_WIN) { int l = it >> 10, r = it & 1023; kt = r >> 6; ntile = r & 63; src = p.w_in + (size_t)l * 1024 * 4096; dst = p.win_t + (size_t)l * NPAD * 1024; ncols = 4096; }
      else { int j = it - N_WIN; int l = j >> 8, r = j & 255; kt = r >> 4; ntile = r & 15; src = p.w_out + (size_t)l * 1024 * 1024; dst = p.wout_t + (size_t)l * 1024 * 1024; ncols = 1024; }
      for (int i = tid; i < 4096; i += 256) { int kk = i >> 6, nn = i & 63; sf[kk * 65 + nn] = src[(size_t)(kt * 64 + kk) * ncols + ntile * 64 + nn]; }
      __syncthreads();
      const bool rkperm = it < N_WIN && ntile < 12;
      for (int i = tid; i < 4096; i += 256) {
        int nn = i >> 6, kk = i & 63;
        int nrow = rkperm ? ((ntile % 6) * 128 + 2 * nn + ntile / 6) : (ntile * 64 + nn);
        if (it < N_WIN && ntile >= 28 && ntile < 44) {
          const int kind = (ntile - 28) >> 2, hh4 = (ntile - 28) & 3;
          const int slot = kind == 0 ? 0 : (kind == 3 ? 1 : kind + 1);
          nrow = 1792 + (hh4 * 64 + nn) * 4 + slot;
        }
        dst[(size_t)nrow * 1024 + kt * 64 + kk] = (h16)sf[kk * 65 + nn];
      }
      __syncthreads();
    } else if (it < N_WIN + N_WOUT + N_MOD) {
      const int j = it - N_WIN - N_WOUT; const int l = j / 96; const int cl = tid & 31, ks = tid >> 5; const int col = (j % 96) * 32 + cl;
      for (int i = tid; i < 9 * 1024; i += 256) { int r = i >> 10, k = i & 1023; float v = r < 8 ? p.c[r * 1024 + k] : p.c_ctx[k]; sf[i] = siluf_(v); }
      __syncthreads();
      float acc[9];
#pragma unroll
      for (int r = 0; r < 9; ++r) acc[r] = 0.f;
      const float* mw = p.mod_w + (size_t)l * 1024 * 3072 + (size_t)(ks * 128) * 3072 + col;
#pragma unroll 2
      for (int k = 0; k < 128; k += 4) {
        const float w0 = mw[(size_t)k * 3072], w1 = mw[(size_t)(k + 1) * 3072], w2 = mw[(size_t)(k + 2) * 3072], w3 = mw[(size_t)(k + 3) * 3072];
#pragma unroll
        for (int r = 0; r < 9; ++r) { const f32x4 sv = *(const f32x4*)&sf[r * 1024 + ks * 128 + k]; acc[r] += sv[0] * w0 + sv[1] * w1 + sv[2] * w2 + sv[3] * w3; }
      }
#pragma unroll
      for (int r = 0; r < 9; ++r) acc[r] += __shfl_xor(acc[r], 32);
      __syncthreads();
      if ((tid & 63) < 32) {
#pragma unroll
        for (int r = 0; r < 9; ++r) sf[((tid >> 6) * 9 + r) * 32 + cl] = acc[r];
      }
      __syncthreads();
      for (int i = tid; i < 288; i += 256) {
        const int r = i >> 5, c2 = i & 31;
        const float v = sf[(0 * 9 + r) * 32 + c2] + sf[(1 * 9 + r) * 32 + c2] + sf[(2 * 9 + r) * 32 + c2] + sf[(3 * 9 + r) * 32 + c2];
        const int cc = (j % 96) * 32 + c2;
        p.mod[(size_t)(l * 9 + r) * 3072 + cc] = v + p.mod_b[l * 3072 + cc];
      }
      __syncthreads();
    } else if (it < N_WIN + N_WOUT + N_MOD + N_PADI) {
      int j = it - (N_WIN + N_WOUT + N_MOD); int idx = j * 256 + tid;
      int l = idx >> 17; int rem = idx & 131071; int m = rem >> 10, k = rem & 1023;
      float v = (l == 1 && m < 32) ? p.vw1[k * 32 + m] : 0.f;
      p.win_t[(size_t)l * NPAD * 1024 + (size_t)(4096 + m) * 1024 + k] = (h16)v;
    } else if (it < N_WIN + N_WOUT + N_MOD + N_PADI + N_WL) {
      const int idx = (it - (N_WIN + N_WOUT + N_MOD + N_PADI)) * 256 + tid;
      const int r = idx & 63, c = (idx >> 6) % 384, ls = idx / (384 * 64); const int l = ls >> 2, slot = ls & 3, dir = slot & 1, kind = slot >> 1;
      const float v = (kind == 0 ? p.w2 : p.a2)[((size_t)(l * 2 + dir) * 64 + r) * 384 + c];
      p.wl_t[idx] = (h16)v;
    } else {
      if (tid < 16) {
        double inv = 1.0; for (int i = 0; i < tid; ++i) inv *= 0.5623413251903491;
        double x2 = inv * inv, ts = inv, tc = 1.0, s1 = inv, c1 = 1.0;
        for (int n = 1; n <= 10; ++n) { tc *= -x2 / ((2.0 * n - 1.0) * (2.0 * n)); c1 += tc; ts *= -x2 / ((2.0 * n) * (2.0 * n + 1.0)); s1 += ts; }
        double cc = 1.0, ss = 0.0;
        for (int pos = 0; pos < 64; ++pos) {
          p.rope[(pos * 16 + tid) * 2] = (float)cc; p.rope[(pos * 16 + tid) * 2 + 1] = (float)ss;
          double nc = cc * c1 - ss * s1, ns = ss * c1 + cc * s1; cc = nc; ss = ns;
        }
      }
    }
  }
}

__device__ __forceinline__ void phase_norm(const Params& p, int l, int bid, int nb) {
  const int tid = tid_opaque(), lane = tid & 63, w = __builtin_amdgcn_readfirstlane(tid >> 6);
  for (int row = bid * 4 + w; row < NTOK; row += nb * 4) {
    const float* src = (l == 0) ? (row < NLAT ? p.x + (size_t)row * 1024 : p.ctx + (size_t)(row - NLAT) * 1024)
                                : (row < NLAT ? p.out + (size_t)row * 1024 : p.xc1 + (size_t)(row - NLAT) * 1024);
    const int mr = row < NLAT ? (row >> 12) : 8;
    const float* md = p.mod + (size_t)(l * 9 + mr) * 3072;
    const float* nw = p.norm_w + l * 1024;
    f32x4 v[4]; float ss = 0.f;
#pragma unroll
    for (int i = 0; i < 4; ++i) { v[i] = *(const f32x4*)(src + i * 256 + lane * 4); ss += v[i][0] * v[i][0] + v[i][1] * v[i][1] + v[i][2] * v[i][2] + v[i][3] * v[i][3]; }
    ss = wave_sum_dpp(ss);
    const float rs = rsqrtf(ss * (1.f / 1024.f) + 1e-6f);
#pragma unroll
    for (int i = 0; i < 4; ++i) {
      const int col = i * 256 + lane * 4;
      f32x4 nwv = *(const f32x4*)(nw + col), sc = *(const f32x4*)(md + 1024 + col), sh = *(const f32x4*)(md + col);
      half4 o;
#pragma unroll
      for (int j = 0; j < 4; ++j) o[j] = (h16)(v[i][j] * rs * nwv[j] * (1.f + sc[j]) + sh[j]);
      *(half4*)(p.hy + (size_t)row * 1024 + col) = o;
    }
  }
}

template <int MODE>
__device__ __forceinline__ void phase_gemm(const Params& p, int l, int bid, int nb, char* smem) {
  const h16* A = p.hy;
  const h16* Bt = MODE == 0 ? p.win_t + (size_t)l * NPAD * 1024 : p.wout_t + (size_t)l * 1024 * 1024;
  const int ntn = MODE == 0 ? (l == 1 ? 33 : 32) : 8;
  const int ntm = (MODE == 1 && l == 1) ? 256 : 272;
  const int tid = tid_opaque(), lane = tid & 63, w = __builtin_amdgcn_readfirstlane(tid >> 6), wr = w >> 1, wc = w & 1, lq = lane & 31, hh = lane >> 5;
  h16* As = (h16*)smem; h16* Bs = As + 128 * 72;
  const int ldrow = tid >> 3, ldch = (tid & 7) * 8;
  for (int tile = bid; tile < ntm * ntn; tile += nb) {
    int tm, tn;
    {
      const int mper = ntm >> 3;
      const int nmain = MODE == 0 ? 32 : 8;
      if (tile < ntm * nmain) {
        const int x = tile & 7, sq = tile >> 3;
        const int strip = sq / (mper * 8), rem = sq - strip * (mper * 8);
        tm = x * mper + (rem >> 3); tn = strip * 8 + (rem & 7);
      } else { tm = tile - ntm * nmain; tn = nmain; }
    }
    const h16* Ag = A + (size_t)(tm * 128 + ldrow) * 1024 + ldch; const h16* Bg = Bt + (size_t)(tn * 128 + ldrow) * 1024 + ldch;
    f32x16 acc[2][2];
#pragma unroll
    for (int i = 0; i < 2; ++i)
#pragma unroll
      for (int j = 0; j < 2; ++j)
#pragma unroll
        for (int r = 0; r < 16; ++r) acc[i][j][r] = 0.f;
    u32x4 ra[4], rb[4];
#pragma unroll
    for (int i = 0; i < 4; ++i) { ra[i] = *(const u32x4*)(Ag + (size_t)i * 32 * 1024); rb[i] = *(const u32x4*)(Bg + (size_t)i * 32 * 1024); }
#pragma unroll 2
    for (int kt = 0; kt < 16; ++kt) {
      __syncthreads();
#pragma unroll
      for (int i = 0; i < 4; ++i) { *(u32x4*)(As + (ldrow + i * 32) * 72 + ldch) = ra[i]; *(u32x4*)(Bs + (ldrow + i * 32) * 72 + ldch) = rb[i]; }
      __syncthreads();
      if (kt + 1 < 16) {
#pragma unroll
        for (int i = 0; i < 4; ++i) { ra[i] = *(const u32x4*)(Ag + (size_t)i * 32 * 1024 + (kt + 1) * 64); rb[i] = *(const u32x4*)(Bg + (size_t)i * 32 * 1024 + (kt + 1) * 64); }
      }
#pragma unroll
      for (int s = 0; s < 4; ++s) {
        half8 a[2], b[2];
#pragma unroll
        for (int i = 0; i < 2; ++i) { a[i] = *(const half8*)(As + (64 * wr + 32 * i + lq) * 72 + 16 * s + 8 * hh); b[i] = *(const half8*)(Bs + (64 * wc + 32 * i + lq) * 72 + 16 * s + 8 * hh); }
#pragma unroll
        for (int i = 0; i < 2; ++i)
#pragma unroll
          for (int j = 0; j < 2; ++j) {
            if (MODE == 0) acc[i][j] = __builtin_amdgcn_mfma_f32_32x32x16_f16(b[j], a[i], acc[i][j], 0, 0, 0);
            else acc[i][j] = __builtin_amdgcn_mfma_f32_32x32x16_f16(a[i], b[j], acc[i][j], 0, 0, 0);
          }
      }
    }
    if (MODE == 0) {
      if (tn < 32) {
        __syncthreads();
        h16* Cs = (h16*)smem;
#pragma unroll
        for (int i = 0; i < 2; ++i)
#pragma unroll
          for (int j = 0; j < 2; ++j)
#pragma unroll
            for (int g = 0; g < 4; ++g) {
              half4 o;
#pragma unroll
              for (int q = 0; q < 4; ++q) o[q] = (h16)acc[i][j][4 * g + q];
              *(half4*)(Cs + (64 * wr + 32 * i + lq) * 136 + 64 * wc + 32 * j + 8 * g + 4 * hh) = o;
            }
        __syncthreads();
#pragma unroll
        for (int q = 0; q < 8; ++q) {
          const int id = tid + q * 256; const int row = id >> 4, ch = id & 15;
          *(u32x4*)(p.P + (size_t)(tm * 128 + row) * PC + tn * 128 + ch * 8) = *(const u32x4*)(Cs + row * 136 + ch * 8);
        }
      } else if (wc == 0) {
#pragma unroll
        for (int i = 0; i < 2; ++i)
#pragma unroll
          for (int r = 0; r < 16; ++r) ((float*)(p.F + (size_t)(tm * 128 + 64 * wr + 32 * i + lq) * 1536))[(r & 3) + 8 * (r >> 2) + 4 * hh] = acc[i][0][r];
      }
    } else {
      const int row0 = tm * 128;
      const int mr = row0 < NLAT ? (row0 >> 12) : 8;
      const int col = tn * 128 + 64 * wc + lq;
      const float* gp = p.mod + (size_t)(l * 9 + mr) * 3072 + 2048 + col;
      const float g0 = gp[0], g1 = gp[32];
      const float* xs0; float* xd0;
      if (l == 0) { if (row0 < NLAT) { xs0 = p.x + (size_t)row0 * 1024; xd0 = p.out + (size_t)row0 * 1024; } else { xs0 = p.ctx + (size_t)(row0 - NLAT) * 1024; xd0 = p.xc1 + (size_t)(row0 - NLAT) * 1024; } }
      else { xs0 = p.out + (size_t)row0 * 1024; xd0 = p.out + (size_t)row0 * 1024; }
      const float* __restrict__ xsrc = xs0 + (size_t)(64 * wr + 4 * hh) * 1024 + col;
      float* __restrict__ xdst = xd0 + (size_t)(64 * wr + 4 * hh) * 1024 + col;
#pragma unroll
      for (int i = 0; i < 2; ++i)
#pragma unroll
        for (int r = 0; r < 16; ++r) {
          const int ro = (32 * i + (r & 3) + 8 * (r >> 2)) * 1024;
          xdst[ro] = xsrc[ro] + g0 * acc[i][0][r];
          xdst[ro + 32] = xsrc[ro + 32] + g1 * acc[i][1][r];
        }
    }
  }
}

#define LOAD_COL34(arr, base, t0, Tn) \
  _Pragma("unroll") for (int q_ = 0; q_ < 34; ++q_) { const int t_ = (t0) - 1 + q_; arr[q_] = (t_ >= 0 && t_ < (Tn)) ? (base)[(long)t_ * PC] : (h16)0.f; }

__device__ __forceinline__ void phase_feat(const Params& p, int l, int bid, int nb, char* smem, bool dry) {
  const int tid = tid_opaque();
  h16* inh = (h16*)smem;
  float* zt = (float*)(smem + 32 * 264 * 2);
  for (int item = bid; item < 1088; item += nb) {
    int b, t0, Tn, rowbase; bool isctx;
    if (item < 1024) { b = item >> 7; t0 = (item & 127) * 32; Tn = 4096; rowbase = b * 4096; isctx = false; }
    else { int j = item - 1024; b = j >> 3; t0 = (j & 7) * 32; Tn = 256; rowbase = NLAT + b * 256; isctx = true; }
    {
      const int col = 1152 + tid;
      const float mp = p.mu_prev[l * 1792 + col], mn = p.mu_next[l * 1792 + col];
      const h16* base = p.P + (size_t)rowbase * PC + col;
      h16 xv[34];
      LOAD_COL34(xv, base, t0, Tn)
#pragma unroll
      for (int tt = 0; tt < 32; ++tt) {
        const float prev = (float)xv[tt], cur = (float)xv[tt + 1], nxt = (float)xv[tt + 2];
        float sv = cur + mp * (prev - cur) + mn * (nxt - cur);
        if (tid < 128) { const float e2 = __expf(2.f * sv); sv = 1.f - 2.f / (e2 + 1.f); }
        inh[tt * 264 + tid] = (h16)sv;
      }
      if (l == 1) {
#pragma unroll
        for (int i = 0; i < 4; ++i) { int id = tid + i * 256; zt[id] = ((const float*)(p.F + (size_t)(rowbase + t0 + (id >> 5)) * 1536))[id & 31]; }
      }
    }
    __syncthreads();
#pragma unroll 1
    for (int c = tid; c < 384; c += 256) {
      const int col = 768 + c;
      const float mp = p.mu_prev[l * 1792 + col], mn = p.mu_next[l * 1792 + col];
      const h16* base = p.P + (size_t)rowbase * PC + col;
      h16 xv[34];
      LOAD_COL34(xv, base, t0, Tn)
      h16* dst = p.VB + (size_t)(rowbase + t0) * 384 + c;
      if (l == 0) {
#pragma unroll
        for (int tt = 0; tt < 32; ++tt) {
          const float prev = (float)xv[tt], cur = (float)xv[tt + 1], nxt = (float)xv[tt + 2];
          dst[tt * 384] = (h16)(cur + mp * (prev - cur) + mn * (nxt - cur));
        }
      } else {
        const float vbv = p.vb[c];
#pragma unroll 1
        for (int hf = 0; hf < 2; ++hf) {
          h16 vfv[16]; float ga[16];
#pragma unroll
          for (int tt = 0; tt < 16; ++tt) { vfv[tt] = dst[(hf * 16 + tt) * 384]; ga[tt] = vbv; }
#pragma unroll 1
          for (int m = 0; m < 32; m += 4) {
            const float w0 = p.vw2[m * 384 + c], w1 = p.vw2[(m + 1) * 384 + c], w2 = p.vw2[(m + 2) * 384 + c], w3 = p.vw2[(m + 3) * 384 + c];
#pragma unroll
            for (int tt = 0; tt < 16; ++tt) { const f32x4 z = *(const f32x4*)&zt[(hf * 16 + tt) * 32 + m]; ga[tt] += z[0] * w0 + z[1] * w1 + z[2] * w2 + z[3] * w3; }
          }
#pragma unroll
          for (int tt = 0; tt < 16; ++tt) {
            const float prev = hf ? (float)xv[16 + tt] : (float)xv[tt], cur = hf ? (float)xv[17 + tt] : (float)xv[tt + 1], nxt = hf ? (float)xv[18 + tt] : (float)xv[tt + 2];
            const float sv = cur + mp * (prev - cur) + mn * (nxt - cur);
            dst[(hf * 16 + tt) * 384] = (h16)(sv + ((float)vfv[tt] - sv) * sigmoidf_(ga[tt]));
          }
        }
      }
    }
    {
      const int w = __builtin_amdgcn_readfirstlane(tid >> 6), lane = tid & 63, lq = tid & 31, hh = lane >> 5;
      const int dir = w & 1, chalf = w >> 1;
      half8 xin[2][4];
#pragma unroll
      for (int kind = 0; kind < 2; ++kind)
#pragma unroll
        for (int ks = 0; ks < 4; ++ks) xin[kind][ks] = *(const half8*)(inh + lq * 264 + kind * 128 + dir * 64 + 16 * ks + 8 * hh);
      h16* ost = (h16*)(smem + 32 * 264 * 2 + 4096) + w * (32 * 72);
      h16* fbase = p.F + (size_t)(rowbase + t0) * 1536 + dir * 768 + chalf * 384;
#pragma unroll 1
      for (int np = 0; np < 6; ++np) {
        const int c0 = chalf * 192 + np * 32;
        f32x16 acc[2];
#pragma unroll
        for (int kind = 0; kind < 2; ++kind) {
          const float* bias = (kind == 0 ? p.w0 : p.a0) + (l * 2 + dir) * 384 + c0;
          const h16* wl = p.wl_t + (size_t)((l * 4 + kind * 2 + dir) * 384 + c0) * 64;
#pragma unroll
          for (int g = 0; g < 4; ++g) { const f32x4 bv = *(const f32x4*)(bias + 8 * g + 4 * hh); acc[kind][4 * g] = bv[0]; acc[kind][4 * g + 1] = bv[1]; acc[kind][4 * g + 2] = bv[2]; acc[kind][4 * g + 3] = bv[3]; }
#pragma unroll
          for (int ks = 0; ks < 4; ++ks) {
            const half8 wf = *(const half8*)(wl + (size_t)lq * 64 + 16 * ks + 8 * hh);
            acc[kind] = __builtin_amdgcn_mfma_f32_32x32x16_f16(wf, xin[kind][ks], acc[kind], 0, 0, 0);
          }
        }
#pragma unroll
        for (int g = 0; g < 4; ++g) {
          half8 o;
#pragma unroll
          for (int j = 0; j < 4; ++j) { o[2 * j] = (h16)(1.f - __expf(-0.6065306597126334f * sigmoidf_(acc[0][4 * g + j]))); o[2 * j + 1] = (h16)sigmoidf_(acc[1][4 * g + j]); }
          *(half8*)(ost + lq * 72 + 16 * g + 8 * hh) = o;
        }
        asm volatile("s_waitcnt lgkmcnt(0)" ::: "memory");
#pragma unroll
        for (int q = 0; q < 4; ++q) {
          const int id = lane + q * 64; const int rr = id >> 3, ch = id & 7;
          *(u32x4*)(fbase + (size_t)rr * 1536 + np * 64 + ch * 8) = *(const u32x4*)(ost + rr * 72 + ch * 8);
        }
        asm volatile("s_waitcnt lgkmcnt(0)" ::: "memory");
      }
    }
    {
      const int head = tid >> 5, pr = tid & 31, half = pr >> 4, i = pr & 15;
      const int colbase = head < 6 ? 3072 + head * 64 : 3456 + (head - 6) * 64;
      const int d1 = half * 32 + i;
      const float qs = (head < 6 && !dry) ? 0.125f : 1.f;
      h16* pp = p.P + (size_t)(rowbase + t0) * PC + colbase + d1;
      h16 x1[32], x2[32];
#pragma unroll
      for (int u = 0; u < 32; ++u) { x1[u] = pp[(size_t)u * PC]; x2[u] = pp[(size_t)u * PC + 16]; }
#pragma unroll
      for (int u = 0; u < 32; ++u) {
        const int t = t0 + u;
        float cs = 1.f, sn = 0.f;
        if (!isctx && !dry) { const int pos = half == 0 ? (t >> 6) : (t & 63); const f32x2 r2 = *(const f32x2*)&p.rope[(pos * 16 + i) * 2]; cs = r2[0]; sn = r2[1]; }
        const float a = (float)x1[u], bq = (float)x2[u];
        pp[(size_t)u * PC] = (h16)((a * cs - bq * sn) * qs);
        pp[(size_t)u * PC + 16] = (h16)((a * sn + bq * cs) * qs);
      }
    }
    if (tid < 128) {
      const int g = tid >> 6, d = tid & 63;
      const h16* base = p.P + (size_t)(rowbase + t0) * PC + 3584 + tid;
      h16* dst = p.VT + (size_t)((b * 2 + g) * 64 + d) * VTS + (isctx ? 4096 + t0 : t0);
      half8 v[4];
#pragma unroll
      for (int q = 0; q < 4; ++q)
#pragma unroll
        for (int j = 0; j < 8; ++j) v[q][j] = base[(size_t)(q * 8 + j) * PC];
#pragma unroll
      for (int q = 0; q < 4; ++q) *(half8*)(dst + q * 8) = v[q];
    }
    __syncthreads();
  }
}

__device__ __forceinline__ float ulo(unsigned u) { return (float)__builtin_bit_cast(h16, (unsigned short)(u & 0xffffu)); }
__device__ __forceinline__ float uhi(unsigned u) { return (float)__builtin_bit_cast(h16, (unsigned short)(u >> 16)); }
__device__ __forceinline__ float red16(float x) {
  x += dpp_mov<0xB1>(x);
  x += dpp_mov<0x4E>(x);
  x += dpp_mov<0x141>(x);
  x += dpp_mov<0x140>(x);
  return x;
}
#define LDS_BARRIER() do { asm volatile("s_waitcnt lgkmcnt(0)" ::: "memory"); __builtin_amdgcn_s_barrier(); asm volatile("" ::: "memory"); } while (0)
constexpr int RREC = 336;
struct RwkvPf { unsigned rk[6]; h16 v[4]; unsigned ea[4]; };

__device__ __forceinline__ void rwkv_chain(const Params& p, int l, int item, char* smem, bool swap_roles) {
  const int tid0 = tid_opaque();
  const int tid = swap_roles ? (tid0 ^ 128) : tid0;
  const int lane = tid & 63, w = __builtin_amdgcn_readfirstlane(tid >> 6);
  const int chain = item >> 2, vq = item & 3;
  const int dir = chain / 48, b = (chain % 48) / 6, h = chain % 6;
  float* opb = (float*)smem;
  float* ybuf = opb + 2 * 8 * RREC;
  constexpr int NCH = 544;
  if (w < 2) {
    const int rl = tid >> 3, kq = tid & 7;
    float S[8];
#pragma unroll
    for (int j = 0; j < 8; ++j) S[j] = 0.f;
    __builtin_amdgcn_s_setprio(3);
    LDS_BARRIER();
#pragma unroll 1
    for (int ci = 0; ci < NCH; ++ci) {
      const float* op = opb + (ci & 1) * 8 * RREC;
      float* yb = ybuf + (ci & 1) * 1024;
      f32x4 aA = *(const f32x4*)(op + 8 * kq + 64), aB = *(const f32x4*)(op + 8 * kq + 68);
#pragma unroll
      for (int step = 0; step < 8; ++step) {
        const float* o = op + step * RREC + 8 * kq;
        const f32x4 wA = *(const f32x4*)(o), wB = *(const f32x4*)(o + 4);
        const f32x4 bA = *(const f32x4*)(o + 128), bB = *(const f32x4*)(o + 132);
        const f32x4 kA = *(const f32x4*)(o + 192), kB = *(const f32x4*)(o + 196);
        const f32x4 rA = *(const f32x4*)(o + 256), rB = *(const f32x4*)(o + 260);
        const float vv = op[step * RREC + 320 + rl];
        f32x4 naA = aA, naB = aB;
        if (step + 1 < 8) { naA = *(const f32x4*)(o + RREC + 64); naB = *(const f32x4*)(o + RREC + 68); }
        const float d0 = S[0] * aA[0] + S[1] * aA[1] + S[2] * aA[2] + S[3] * aA[3];
        const float d1 = S[4] * aB[0] + S[5] * aB[1] + S[6] * aB[2] + S[7] * aB[3];
        const float sa = red8(d0 + d1);
#pragma unroll
        for (int j = 0; j < 4; ++j) {
          S[j] = S[j] * wA[j] + sa * bA[j] + vv * kA[j];
          S[4 + j] = S[4 + j] * wB[j] + sa * bB[j] + vv * kB[j];
        }
        const float y0 = S[0] * rA[0] + S[1] * rA[1] + S[2] * rA[2] + S[3] * rA[3];
        const float y1 = S[4] * rB[0] + S[5] * rB[1] + S[6] * rB[2] + S[7] * rB[3];
        yb[step * 128 + tid] = y0 + y1;
        aA = naA; aB = naB;
      }
      LDS_BARRIER();
    }
    __builtin_amdgcn_s_setprio(0);
  } else {
    const int lw = w - 2, lt = tid - 128;
    const int hc = h * 64 + lane;
    const float mpr = p.mu_prev[l * 1792 + hc], mnr = p.mu_next[l * 1792 + hc];
    const float mpk = p.mu_prev[l * 1792 + 384 + hc], mnk = p.mu_next[l * 1792 + 384 + hc];
    const float kkw = p.k_k[l * 384 + hc], kaw = p.k_a[l * 384 + hc];
    const float cAr = dir ? mnr : mpr, cBr = dir ? mpr : mnr, cAk = dir ? mnk : mpk, cBk = dir ? mpk : mnk;
    const unsigned* zrow = p.bar + XCD_BAR_WORDS;
    RwkvPf pfA, pfB, pfC, pfD;
#define RWKV_ISSUE(ci_, PF) { const int seg_ = (ci_) >= 32; const int Tn_ = seg_ ? 4096 : 256; const int rb_ = seg_ ? b * 4096 : NLAT + b * 256; const int s0_ = (seg_ ? (ci_) - 32 : (ci_)) * 8 + 4 * lw; \
    _Pragma("unroll") for (int q = 0; q < 6; ++q) { const int t_ = dir == 0 ? s0_ - 1 + q : Tn_ - s0_ - q; \
      const unsigned* src_ = ((unsigned)t_ < (unsigned)Tn_) ? (const unsigned*)(p.P + (size_t)(rb_ + t_) * PC + h * 128) : zrow; \
      PF.rk[q] = src_[lane]; } \
    _Pragma("unroll") for (int i = 0; i < 4; ++i) { const int t_ = dir == 0 ? s0_ + i : Tn_ - 1 - (s0_ + i); const size_t row = (size_t)rb_ + t_; \
      PF.v[i] = p.VB[row * 384 + hc]; PF.ea[i] = ((const unsigned*)(p.F + row * 1536 + dir * 768))[hc]; } }
#define RWKV_STAGE(ci_, PF) { float* op_ = opb + ((ci_) & 1) * 8 * RREC; \
    const int seg = (ci_) >= 32; const int Tn = seg ? 4096 : 256; const int c0 = (seg ? (ci_) - 32 : (ci_)) * 8; \
    _Pragma("unroll") for (int i = 0; i < 4; ++i) { \
      const int step = lw * 4 + i; const int t = dir == 0 ? c0 + step : Tn - 1 - (c0 + step); \
      const float rlo = ulo(PF.rk[i]), r0 = ulo(PF.rk[i + 1]), rhi = ulo(PF.rk[i + 2]); \
      const float klo = uhi(PF.rk[i]), k0 = uhi(PF.rk[i + 1]), khi = uhi(PF.rk[i + 2]); \
      const float vv = (float)PF.v[i], e = ulo(PF.ea[i]), al = uhi(PF.ea[i]); \
      const float rs = r0 + cAr * (rlo - r0) + cBr * (rhi - r0); \
      const float ks = k0 + cAk * (klo - k0) + cBk * (khi - k0); \
      const float kkr = ks * kkw; \
      const float n2 = wave_sum_dpp(kkr * kkr); \
      const float kk = kkr * rsqrtf(fmaxf(n2, 1e-24f)); \
      float* o = op_ + step * RREC + lane; \
      o[0] = 1.f - e; o[64] = -kk; o[128] = kk * al; o[192] = ks * (1.f + (al - 1.f) * kaw); o[256] = rs; \
      if ((lane >> 4) == vq) op_[step * RREC + 320 + (lane & 15)] = vv; } }
#define RWKV_WRITE(cj_) { const int seg = (cj_) >= 32; const int Tn = seg ? 4096 : 256; const int rowbase = seg ? b * 4096 : NLAT + b * 256; const int c0 = (seg ? (cj_) - 32 : (cj_)) * 8; \
    if (seg == 1 || l == 0) { const float* yb = ybuf + ((cj_) & 1) * 1024; \
      const int step = lt >> 4, ch = lt & 15; \
      const int t = dir == 0 ? c0 + step : Tn - 1 - (c0 + step); \
      const f32x4 y0 = *(const f32x4*)(yb + step * 128 + ch * 8), y1 = *(const f32x4*)(yb + step * 128 + ch * 8 + 4); \
      const f32x4 ys = y0 + y1; const h16 yv = (h16)((ys[0] + ys[1]) + (ys[2] + ys[3])); \
      if (dir == 0) p.P[(size_t)(rowbase + t) * PC + 768 + h * 64 + 16 * vq + ch] = yv; \
      else p.hy[(size_t)(rowbase + t) * 1024 + h * 64 + 16 * vq + ch] = yv; } }
    RWKV_ISSUE(0, pfA)
    RWKV_STAGE(0, pfA)
    RWKV_ISSUE(1, pfB)
    RWKV_ISSUE(2, pfC)
    RWKV_ISSUE(3, pfD)
    RWKV_ISSUE(4, pfA)
    LDS_BARRIER();
#pragma unroll 1
    for (int ci = 0; ci < NCH; ci += 4) {
      if (ci + 1 < NCH) RWKV_STAGE(ci + 1, pfB)
      if (ci + 5 < NCH) RWKV_ISSUE(ci + 5, pfB)
      if (ci >= 1) RWKV_WRITE(ci - 1)
      LDS_BARRIER();
      if (ci + 2 < NCH) RWKV_STAGE(ci + 2, pfC)
      if (ci + 6 < NCH) RWKV_ISSUE(ci + 6, pfC)
      RWKV_WRITE(ci)
      LDS_BARRIER();
      if (ci + 3 < NCH) RWKV_STAGE(ci + 3, pfD)
      if (ci + 7 < NCH) RWKV_ISSUE(ci + 7, pfD)
      RWKV_WRITE(ci + 1)
      LDS_BARRIER();
      if (ci + 4 < NCH) RWKV_STAGE(ci + 4, pfA)
      if (ci + 8 < NCH) RWKV_ISSUE(ci + 8, pfA)
      RWKV_WRITE(ci + 2)
      LDS_BARRIER();
    }
    RWKV_WRITE(NCH - 1)
  }
}

constexpr int HREC = 224;
typedef unsigned u32x2 __attribute__((ext_vector_type(2)));
struct HgrnPf { u32x2 qi_ff[4]; };
__device__ __forceinline__ void hgrn_chain(const Params& p, int l, int item, char* smem) {
  const int tid = tid_opaque(), lane = tid & 63, w = __builtin_amdgcn_readfirstlane(tid >> 6);
  const int chain = item >> 1, vh = item & 1;
  const int dir = chain / 32, b = (chain % 32) / 4, h = chain % 4;
  float* op = (float*)smem;
  float* ybuf = op + 16 * HREC;
  const int hc = h * 64 + lane;
  float lb = 0.f;
  if (l == 1) lb = sigmoidf_(p.lb_logits[(dir * 2 + 1) * 256 + hc] - p.lb_logits[(dir * 2 + 0) * 256 + hc]);
  const int vc = tid >> 3, kq = tid & 7;
  float S[8];
#pragma unroll
  for (int j = 0; j < 8; ++j) S[j] = 0.f;
  HgrnPf pfA, pfB;
#define HGRN_ISSUE(ci_, PF) { const int seg_ = (ci_) >= 16; const int Tn_ = seg_ ? 4096 : 256; const int rb_ = seg_ ? b * 4096 : NLAT + b * 256; const int c0_ = (seg_ ? (ci_) - 16 : (ci_)) * 16; \
    _Pragma("unroll") for (int i = 0; i < 4; ++i) { const int step = w * 4 + i; const int t = dir == 0 ? c0_ + step : Tn_ - 1 - (c0_ + step); \
      PF.qi_ff[i] = ((const u32x2*)(p.P + ((size_t)rb_ + t) * PC + 1792))[hc]; } }
#define HGRN_CHUNK(ci_, PF) { \
    const int seg = (ci_) >= 16; const int Tn = seg ? 4096 : 256; const int rowbase = seg ? b * 4096 : NLAT + b * 256; const int c0 = (seg ? (ci_) - 16 : (ci_)) * 16; \
    _Pragma("unroll") for (int i = 0; i < 4; ++i) { \
      const int step = w * 4 + i; \
      float* o = op + step * HREC + lane; \
      const float f = lb + (1.f - lb) * sigmoidf_(dir ? uhi(PF.qi_ff[i][1]) : ulo(PF.qi_ff[i][1])); \
      o[0] = f; o[128] = ulo(PF.qi_ff[i][0]); \
      if ((lane >> 5) == vh) op[step * HREC + 192 + (lane & 31)] = uhi(PF.qi_ff[i][0]); } \
    LDS_BARRIER(); \
    if ((ci_) + 2 < 272) HGRN_ISSUE((ci_) + 2, PF) \
    _Pragma("unroll") for (int step = 0; step < 16; ++step) { \
      const float* o = op + step * HREC + 8 * kq; \
      const f32x4 fA = *(const f32x4*)(o), fB = *(const f32x4*)(o + 4); \
      const f32x4 qA = *(const f32x4*)(o + 128), qB = *(const f32x4*)(o + 132); \
      const float iv = op[step * HREC + 192 + vc]; \
      const float f[8] = {fA[0], fA[1], fA[2], fA[3], fB[0], fB[1], fB[2], fB[3]}; \
      const float q[8] = {qA[0], qA[1], qA[2], qA[3], qB[0], qB[1], qB[2], qB[3]}; \
      float acc = 0.f; \
      _Pragma("unroll") for (int j = 0; j < 8; ++j) { S[j] = f[j] * (S[j] - iv) + iv; acc += S[j] * q[j]; } \
      ybuf[step * 256 + tid] = acc; } \
    LDS_BARRIER(); \
    if (seg == 1 || l == 0) { \
      _Pragma("unroll") for (int i = 0; i < 2; ++i) { \
        const int idx = tid + i * 256; const int step = idx >> 5, ch = idx & 31; \
        const int t = dir == 0 ? c0 + step : Tn - 1 - (c0 + step); \
        const float* yb = ybuf + step * 256 + ch * 8; \
        const f32x4 y0 = *(const f32x4*)(yb), y1 = *(const f32x4*)(yb + 4); \
        const f32x4 ys = y0 + y1; \
        const h16 ov = (h16)((ys[0] + ys[1]) + (ys[2] + ys[3])); \
        if (dir == 0) p.P[(size_t)(rowbase + t) * PC + 1152 + h * 64 + 32 * vh + ch] = ov; \
        else p.hy[(size_t)(rowbase + t) * 1024 + 384 + h * 64 + 32 * vh + ch] = ov; } } }
  HGRN_ISSUE(0, pfA)
  HGRN_ISSUE(1, pfB)
  __builtin_amdgcn_s_setprio(2);
#pragma unroll 1
  for (int ci = 0; ci < 272; ci += 2) {
    HGRN_CHUNK(ci, pfA)
    HGRN_CHUNK(ci + 1, pfB)
  }
  __builtin_amdgcn_s_setprio(0);
}

__device__ __forceinline__ void attn_unit(const Params& p, int l, int u) {
  const int tid = tid_opaque(), lane = tid & 63, w = __builtin_amdgcn_readfirstlane(tid >> 6), lq = lane & 31, hh = lane >> 5;
  int b, head, qrow_base, qpos0; bool isctx;
  if (u < 1536) { b = u / 192; int rem = u % 192; int blk = rem / 6; head = rem % 6; qpos0 = blk * 128 + w * 32; qrow_base = b * 4096; isctx = false; }
  else { int j = u - 1536; b = j / 12; int rem = j % 12; int qb = rem / 6; head = rem % 6; qpos0 = qb * 128 + w * 32; qrow_base = NLAT + b * 256; isctx = true; }
  const int g = head / 3;
  const size_t qrow = (size_t)qrow_base + qpos0 + lq;
  half8 qf[4];
#pragma unroll
  for (int s = 0; s < 4; ++s) qf[s] = *(const half8*)(p.P + qrow * PC + 3072 + head * 64 + 16 * s + 8 * hh);
  const float sinkv = p.sink[l * 6 + head];
  float m = sinkv, lsum = hh == 0 ? 1.f : 0.f;
  f32x16 O[2];
#pragma unroll
  for (int r = 0; r < 16; ++r) { O[0][r] = 0.f; O[1][r] = 0.f; }
  const h16* vt = p.VT + (size_t)((b * 2 + g) * 64) * VTS;
  int nband = 0, kstart = 0;
  if (!isctx) { kstart = max(0, qpos0 - 128); const int kend = min(4096, qpos0 + 160); nband = (kend - kstart) >> 5; }
  const int ntiles = nband + 8;
  for (int ti = 0; ti < ntiles; ++ti) {
    const bool band = ti < nband;
    const int kt = band ? kstart + ti * 32 : (ti - nband) * 32;
    const size_t krow = band ? (size_t)b * 4096 + kt + lq : (size_t)NLAT + b * 256 + kt + lq;
    const int vidx = band ? kt : 4096 + kt;
    const h16* kp = p.P + krow * PC + 3456 + g * 64 + 8 * hh;
    f32x16 sacc;
#pragma unroll
    for (int r = 0; r < 16; ++r) sacc[r] = 0.f;
#pragma unroll
    for (int s = 0; s < 4; ++s) { half8 kf = *(const half8*)(kp + 16 * s); sacc = __builtin_amdgcn_mfma_f32_32x32x16_f16(kf, qf[s], sacc, 0, 0, 0); }
    float mx = -INFINITY;
#pragma unroll
    for (int r = 0; r < 16; ++r) {
      float sv = sacc[r];
      if (band) { const int dlt = kt + (r & 3) + 8 * (r >> 2) + 4 * hh - (qpos0 + lq); if (dlt > 128 || dlt < -128) sv = -INFINITY; }
      sacc[r] = sv; mx = fmaxf(mx, sv);
    }
    mx = fmaxf(mx, __shfl_xor(mx, 32));
    const float mn = fmaxf(m, mx); const float corr = __expf(m - mn); m = mn;
    float ps = 0.f; half8 pb[2];
#pragma unroll
    for (int r = 0; r < 16; ++r) { const float pv = __expf(sacc[r] - mn); ps += pv; pb[r >> 3][r & 7] = (h16)pv; }
    lsum = lsum * corr + ps;
#pragma unroll
    for (int r = 0; r < 16; ++r) { O[0][r] *= corr; O[1][r] *= corr; }
#pragma unroll
    for (int s2 = 0; s2 < 2; ++s2)
#pragma unroll
      for (int dt = 0; dt < 2; ++dt) {
        const h16* vp = vt + (size_t)(dt * 32 + lq) * VTS + vidx + 16 * s2 + 4 * hh;
        const half4 lo = *(const half4*)vp, hi = *(const half4*)(vp + 8);
        const half8 vf = {lo[0], lo[1], lo[2], lo[3], hi[0], hi[1], hi[2], hi[3]};
        O[dt] = __builtin_amdgcn_mfma_f32_32x32x16_f16(vf, pb[s2], O[dt], 0, 0, 0);
      }
  }
  lsum += __shfl_xor(lsum, 32);
  const float inv = 1.f / lsum;
#pragma unroll
  for (int dt = 0; dt < 2; ++dt)
#pragma unroll
    for (int g4 = 0; g4 < 4; ++g4) {
      const int d0 = dt * 32 + 8 * g4 + 4 * hh;
      const half4 ga = *(const half4*)(p.P + qrow * PC + 3712 + head * 64 + d0);
      half4 o;
#pragma unroll
      for (int j = 0; j < 4; ++j) { const float gv = (float)ga[j]; o[j] = (h16)(O[dt][g4 * 4 + j] * inv * siluf_(gv)); }
      *(half4*)(p.hy + qrow * 1024 + 640 + head * 64 + d0) = o;
    }
}

__device__ __forceinline__ void phase_mix(const Params& p, int l, int bid, int nb, char* smem, int sub) {
  const int nunits = l == 0 ? 1536 + 96 : 1536;
  if (nb >= 640) {
    if (bid < 384) { if (sub & 1) { const int x = bid & 7, j = bid >> 3; rwkv_chain(p, l, (((j >> 2) * 8 + x) << 2) | (j & 3), smem, bid >= 256); } }
    else if (bid < 512) { if (sub & 2) { const int hb = bid - 384, x = hb & 7, j = hb >> 3; hgrn_chain(p, l, (((j >> 1) * 8 + x) << 1) | (j & 1), smem); } }
    else if (sub & 4) for (int u = bid - 512; u < nunits; u += nb - 512) attn_unit(p, l, u);
  } else {
    for (int it = bid; it < 512 + nunits; it += nb) {
      if (it < 384) rwkv_chain(p, l, it, smem, false);
      else if (it < 512) hgrn_chain(p, l, it - 384, smem);
      else attn_unit(p, l, it - 512);
      __syncthreads();
    }
  }
}

__device__ __forceinline__ float sum4(const f32x4 v) { return (v[0] + v[1]) + (v[2] + v[3]); }
__device__ __forceinline__ f32x4 h4f(const half4 h) { return (f32x4){(float)h[0], (float)h[1], (float)h[2], (float)h[3]}; }
__device__ __forceinline__ half8 zero_h8() { half8 z;
#pragma unroll
  for (int j = 0; j < 8; ++j) z[j] = (h16)0.f; return z; }
__device__ __forceinline__ half4 zero_h4() { half4 z; z[0] = z[1] = z[2] = z[3] = (h16)0.f; return z; }
__device__ __forceinline__ void phase_readout(const Params& p, int l, int bid, int nb, bool dummy) {
  const int tid = tid_opaque(), lane = tid & 63, w = __builtin_amdgcn_readfirstlane(tid >> 6);
  const int nrows = l == 1 ? NLAT : NTOK;
  const int hl = lane >> 4, c4 = (lane & 15) * 4;
  const int gw = bid * 4 + w, nper = (nb * 4) / 3;
  const int q = gw % 3, ridx = gw / 3;
  if (ridx >= nper) return;
  const int rpw = (nrows + nper - 1) / nper;
  const int r0 = ridx * rpw, r1 = min(nrows, r0 + rpw);
  if (r0 >= r1) return;
  if (q < 2) {
    const int head = q * 4 + hl; const bool valid = head < 6; const int hcl = valid ? head : 5; const int c = hcl * 64 + c4;
    const f32x4 mpr = *(const f32x4*)(p.mu_prev + l * 1792 + c), mnr = *(const f32x4*)(p.mu_next + l * 1792 + c);
    const f32x4 mpk = *(const f32x4*)(p.mu_prev + l * 1792 + 384 + c), mnk = *(const f32x4*)(p.mu_next + l * 1792 + 384 + c);
    const f32x4 mpg = *(const f32x4*)(p.mu_prev + l * 1792 + 1408 + c), mng = *(const f32x4*)(p.mu_next + l * 1792 + 1408 + c);
    const f32x4 gwt = *(const f32x4*)(p.gn_w + l * 384 + c), gbs = *(const f32x4*)(p.gn_b + l * 384 + c), rkw = *(const f32x4*)(p.r_k + l * 384 + c);
    const h16* prk = p.P + hcl * 128 + 2 * c4;
    const h16* pg = p.P + 1408 + c;
    half8 rk_prev = r0 > 0 ? *(const half8*)(prk + (size_t)(r0 - 1) * PC) : zero_h8();
    half4 g_prev = r0 > 0 ? *(const half4*)(pg + (size_t)(r0 - 1) * PC) : zero_h4();
    half8 rk_cur = *(const half8*)(prk + (size_t)r0 * PC);
    half4 g_cur = *(const half4*)(pg + (size_t)r0 * PC);
    half8 rk_next = r0 + 1 < NTOK ? *(const half8*)(prk + (size_t)(r0 + 1) * PC) : zero_h8();
    half4 g_next = r0 + 1 < NTOK ? *(const half4*)(pg + (size_t)(r0 + 1) * PC) : zero_h4();
    half4 yf_c = *(const half4*)(p.P + (size_t)r0 * PC + 768 + c), yb_c = *(const half4*)(p.hy + (size_t)r0 * 1024 + c), v_c = *(const half4*)(p.VB + (size_t)r0 * 384 + c);
#pragma unroll 1
    for (int row = r0; row < r1; ++row) {
      const bool more = row + 1 < r1;
      const half8 rk_nn = row + 2 < NTOK ? *(const half8*)(prk + (size_t)(row + 2) * PC) : zero_h8();
      const half4 g_nn = row + 2 < NTOK ? *(const half4*)(pg + (size_t)(row + 2) * PC) : zero_h4();
      half4 yf_n = yf_c, yb_n = yb_c, v_n = v_c;
      if (more) { yf_n = *(const half4*)(p.P + (size_t)(row + 1) * PC + 768 + c); yb_n = *(const half4*)(p.hy + (size_t)(row + 1) * 1024 + c); v_n = *(const half4*)(p.VB + (size_t)(row + 1) * 384 + c); }
      int t, Tn;
      if (row < NLAT) { t = row & 4095; Tn = 4096; } else { t = (row - NLAT) & 255; Tn = 256; }
      const bool hp = t > 0, hn = t + 1 < Tn;
      f32x4 sh[3];
#pragma unroll
      for (int k = 0; k < 2; ++k) {
        const f32x4 cur = {(float)rk_cur[k], (float)rk_cur[2 + k], (float)rk_cur[4 + k], (float)rk_cur[6 + k]};
        f32x4 prv = {(float)rk_prev[k], (float)rk_prev[2 + k], (float)rk_prev[4 + k], (float)rk_prev[6 + k]};
        f32x4 nxt = {(float)rk_next[k], (float)rk_next[2 + k], (float)rk_next[4 + k], (float)rk_next[6 + k]};
        if (!hp) prv = (f32x4){0.f, 0.f, 0.f, 0.f};
        if (!hn) nxt = (f32x4){0.f, 0.f, 0.f, 0.f};
        sh[k] = cur + (k == 0 ? mpr : mpk) * (prv - cur) + (k == 0 ? mnr : mnk) * (nxt - cur);
      }
      {
        const f32x4 cur = h4f(g_cur);
        f32x4 prv = h4f(g_prev), nxt = h4f(g_next);
        if (!hp) prv = (f32x4){0.f, 0.f, 0.f, 0.f};
        if (!hn) nxt = (f32x4){0.f, 0.f, 0.f, 0.f};
        sh[2] = cur + mpg * (prv - cur) + mng * (nxt - cur);
      }
      const f32x4 y = h4f(yf_c) + h4f(yb_c);
      const f32x4 v = h4f(v_c);
      const float mean = red16(sum4(y)) * (1.f / 64.f);
      const f32x4 yc = y - mean;
      const float var = red16(sum4(yc * yc)) * (1.f / 64.f);
      const float rs = rsqrtf(var + 64e-5f);
      const float bs = red16(sum4(sh[0] * sh[1] * rkw));
      half4 o;
#pragma unroll
      for (int j = 0; j < 4; ++j) o[j] = (h16)((yc[j] * rs * gwt[j] + gbs[j] + bs * v[j]) * siluf_(sh[2][j]));
      h16* yw = dummy ? p.F + (size_t)row * 1536 : p.hy + (size_t)row * 1024;
      if (valid) *(half4*)(yw + c) = o;
      rk_prev = rk_cur; rk_cur = rk_next; rk_next = rk_nn;
      g_prev = g_cur; g_cur = g_next; g_next = g_nn;
      yf_c = yf_n; yb_c = yb_n; v_c = v_n;
    }
  } else {
    const int c = hl * 64 + c4;
    const f32x4 nw = *(const f32x4*)(p.hg_norm_w + l * 256 + c);
    half4 of_c = *(const half4*)(p.P + (size_t)r0 * PC + 1152 + c), ob_c = *(const half4*)(p.hy + (size_t)r0 * 1024 + 384 + c), g_c = *(const half4*)(p.P + (size_t)r0 * PC + 2816 + c);
#pragma unroll 1
    for (int row = r0; row < r1; ++row) {
      half4 of_n = of_c, ob_n = ob_c, g_n = g_c;
      if (row + 1 < r1) { of_n = *(const half4*)(p.P + (size_t)(row + 1) * PC + 1152 + c); ob_n = *(const half4*)(p.hy + (size_t)(row + 1) * 1024 + 384 + c); g_n = *(const half4*)(p.P + (size_t)(row + 1) * PC + 2816 + c); }
      const f32x4 o = h4f(of_c) + h4f(ob_c);
      const f32x4 g = h4f(g_c);
      const float ms = red16(sum4(o * o)) * (1.f / 64.f);
      const float rs = rsqrtf(ms + 1e-6f);
      half4 ov;
#pragma unroll
      for (int j = 0; j < 4; ++j) ov[j] = (h16)(o[j] * rs * nw[j] * siluf_(g[j]));
      h16* yw = dummy ? p.F + (size_t)row * 1536 : p.hy + (size_t)row * 1024;
      *(half4*)(yw + 384 + c) = ov;
      of_c = of_n; ob_c = ob_n; g_c = g_n;
    }
  }
}

__device__ __forceinline__ void phase_final(const Params& p, int bid, int nb) {
  const int tid = tid_opaque(), lane = tid & 63, w = __builtin_amdgcn_readfirstlane(tid >> 6);
  for (int row = bid * 4 + w; row < NLAT; row += nb * 4) {
    float* src = p.out + (size_t)row * 1024;
    f32x4 v[4]; float ss = 0.f;
#pragma unroll
    for (int i = 0; i < 4; ++i) { v[i] = *(const f32x4*)(src + i * 256 + lane * 4); ss += v[i][0] * v[i][0] + v[i][1] * v[i][1] + v[i][2] * v[i][2] + v[i][3] * v[i][3]; }
    ss = wave_sum_dpp(ss);
    const float rs = rsqrtf(ss * (1.f / 1024.f) + 1e-6f);
#pragma unroll
    for (int i = 0; i < 4; ++i) {
      const int col = i * 256 + lane * 4;
      const f32x4 nwv = *(const f32x4*)(p.final_w + col);
      f32x4 o;
#pragma unroll
      for (int j = 0; j < 4; ++j) o[j] = v[i][j] * rs * nwv[j];
      *(f32x4*)(src + col) = o;
    }
  }
}

__global__ void __launch_bounds__(256, 3) __attribute__((target("no-packed-fp32-ops"))) mega(Params p, int ph_lo, int ph_hi, int coop) {
  __shared__ __attribute__((aligned(16))) char smem[SMEM_BYTES];
  __shared__ uint4 xb_words;
  XcdBarrier xb; xb.bar = p.bar; xb.x = 0; xb.st = (volatile LAS unsigned*)&xb_words;
  if (coop) { if (threadIdx.x == 0) xb_words = make_uint4(0u, 0u, 0u, 0u); __syncthreads(); xb = xcd_barrier_post(p.bar, (volatile LAS unsigned*)&xb_words); }
  if (coop) for (int i = 0; i < EXTRA_SYNCS; ++i) { xcd_barrier(xb); }
  if (coop == 2) cg::this_grid().sync();
  for (int ph = ph_lo; ph < ph_hi; ++ph) {
    for (int rep = 0; rep < (((PROBE_MASK >> ph) & 1) ? 2 : 1); ++rep) {
      int bid = blockIdx.x, nb = gridDim.x;
      asm volatile("" : "+s"(bid), "+s"(nb));
      if (ph == 0) phase_prep(p, bid, nb, smem);
      else if (ph == 13) phase_final(p, bid, nb);
      else {
        const int l = (ph - 1) / 6, s = (ph - 1) % 6;
        if (s == 0) phase_norm(p, l, bid, nb);
        else if (s == 1) phase_gemm<0>(p, l, bid, nb, smem);
        else if (s == 2) phase_feat(p, l, bid, nb, smem, PROBE_MASK && ((PROBE_MASK >> ph) & 1) && rep == 0);
        else if (s == 3) phase_mix(p, l, bid, nb, smem, rep ? PROBE_SUB : 7);
        else if (s == 4) phase_readout(p, l, bid, nb, PROBE_MASK && ((PROBE_MASK >> ph) & 1) && rep == 0);
        else phase_gemm<1>(p, l, bid, nb, smem);
      }
      if (PROBE_MASK && rep == 0 && ((PROBE_MASK >> ph) & 1)) { xcd_barrier(xb); }
    }
    if (coop && ph + 1 < ph_hi) { xcd_barrier(xb); }
  }
}

extern "C" void kernel_launch(void* const* d_in, const int* in_sizes, int n_in, void* d_out, int out_size, void* d_ws, size_t ws_size, hipStream_t stream) {
  static int grid_blocks = 0;
  if (!grid_blocks) {
    int dev = 0, cus = 0, per_cu = 0;
    hipGetDevice(&dev);
    hipDeviceGetAttribute(&cus, hipDeviceAttributeMultiprocessorCount, dev);
    hipOccupancyMaxActiveBlocksPerMultiprocessor(&per_cu, mega, 256, 0);
    if (per_cu < 1) per_cu = 1;
    grid_blocks = cus * per_cu;
  }
  Params p{};
  const float* const* in = (const float* const*)d_in;
  p.x = in[0]; p.c = in[1]; p.ctx = in[2]; p.c_ctx = in[3]; p.mod_w = in[4]; p.mod_b = in[5]; p.norm_w = in[6]; p.w_in = in[7]; p.w_out = in[8];
  p.mu_prev = in[9]; p.mu_next = in[10]; p.w0 = in[11]; p.w2 = in[12]; p.a0 = in[13]; p.a2 = in[14]; p.k_k = in[15]; p.k_a = in[16]; p.r_k = in[17];
  p.gn_w = in[18]; p.gn_b = in[19]; p.vw1 = in[20]; p.vw2 = in[21]; p.vb = in[22]; p.lb_logits = in[23]; p.hg_norm_w = in[24]; p.sink = in[25]; p.final_w = in[26];
  p.out = (float*)d_out;
  char* ws = (char*)d_ws; size_t off = 0;
  auto take = [&](size_t bytes) { char* r = ws + off; off += (bytes + 255) & ~(size_t)255; return r; };
  p.win_t = (h16*)take((size_t)2 * NPAD * 1024 * 2);
  p.wout_t = (h16*)take((size_t)2 * 1024 * 1024 * 2);
  p.wl_t = (h16*)take((size_t)2 * 4 * 384 * 64 * 2);
  p.mod = (float*)take((size_t)2 * 9 * 3072 * 4);
  p.rope = (float*)take((size_t)64 * 16 * 2 * 4);
  p.hy = (h16*)take((size_t)NTOK * 1024 * 2);
  p.P = (h16*)take((size_t)NTOK * PC * 2);
  p.F = (h16*)take((size_t)NTOK * 1536 * 2);
  p.VB = (h16*)take((size_t)NTOK * 384 * 2);
  p.VT = (h16*)take((size_t)16 * 64 * VTS * 2);
  p.xc1 = (float*)take((size_t)2048 * 1024 * 4);
  p.bar = (unsigned*)take(16384);
  if (off > ws_size) fprintf(stderr, "workspace too small: need %zu have %zu\n", off, ws_size);
#if SINGLE_LAUNCH
  hipMemsetAsync(p.bar, 0, 16384, stream);
  int lo = 0, hi = 14, coop = 1;
  void* args[] = {&p, &lo, &hi, &coop};
  hipError_t e = hipLaunchCooperativeKernel((void*)mega, dim3(grid_blocks), dim3(256), args, 0, stream);
  if (e != hipSuccess) fprintf(stderr, "cooperative launch failed: %s (grid %d)\n", hipGetErrorString(e), grid_blocks);
#else
  for (int ph = 0; ph < 14; ++ph) mega<<<grid_blocks, 256, 0, stream>>>(p, ph, ph + 1, 0);
#endif
}
```

```cpp
#include <hip/hip_runtime.h>
#include <hip/hip_cooperative_groups.h>
#include <cstdio>
#include <cstdint>
namespace cg = cooperative_groups;

typedef _Float16 h16;
typedef _Float16 half8 __attribute__((ext_vector_type(8)));
typedef _Float16 half4 __attribute__((ext_vector_type(4)));
typedef float f32x16 __attribute__((ext_vector_type(16)));
typedef float f32x4 __attribute__((ext_vector_type(4)));
typedef float f32x2 __attribute__((ext_vector_type(2)));
typedef unsigned u32x4 __attribute__((ext_vector_type(4)));
typedef _Float16 half2v __attribute__((ext_vector_type(2)));

constexpr int NLAT = 32768, NTOK = 34816;
constexpr int PC = 4160;
constexpr int NPAD = 4224;
constexpr int VTS = 4352;
constexpr int SMEM_BYTES = 49152;

#ifndef EXTRA_SYNCS
#define EXTRA_SYNCS 0
#endif
#ifndef PROBE_SUB
#define PROBE_SUB 7
#endif
#ifndef PROBE_MASK
#define PROBE_MASK 0
#endif
#ifndef SINGLE_LAUNCH
#define SINGLE_LAUNCH 1
#endif

struct Params {
  const float *x, *c, *ctx, *c_ctx, *mod_w, *mod_b, *norm_w, *w_in, *w_out;
  const float *mu_prev, *mu_next, *w0, *w2, *a0, *a2, *k_k, *k_a, *r_k, *gn_w, *gn_b;
  const float *vw1, *vw2, *vb, *lb_logits, *hg_norm_w, *sink, *final_w;
  float* out;
  h16 *win_t, *wout_t, *wl_t;
  float* mod;
  h16 *hy, *P, *F, *VB;
  h16* VT;
  float* xc1;
  float* rope;
  unsigned* bar;
};

__device__ __forceinline__ int tid_opaque() { int t = threadIdx.x; asm volatile("" : "+v"(t)); return t; }
__device__ __forceinline__ float wave_sum(float v) {
#pragma unroll
  for (int o = 32; o > 0; o >>= 1) v += __shfl_xor(v, o);
  return v;
}
__device__ __forceinline__ float sigmoidf_(float x) { return __builtin_amdgcn_rcpf(1.f + __expf(-x)); }
__device__ __forceinline__ float siluf_(float x) { return x * __builtin_amdgcn_rcpf(1.f + __expf(-x)); }
template <int CTRL> __device__ __forceinline__ float dpp_mov(float x) {
  return __int_as_float(__builtin_amdgcn_update_dpp(0, __float_as_int(x), CTRL, 0xf, 0xf, true));
}
__device__ __forceinline__ float wave_sum_dpp(float x) {
  x += dpp_mov<0xB1>(x);
  x += dpp_mov<0x4E>(x);
  x += dpp_mov<0x141>(x);
  x += dpp_mov<0x140>(x);
  const int xi = __float_as_int(x);
  return __int_as_float(__builtin_amdgcn_readlane(xi, 0)) + __int_as_float(__builtin_amdgcn_readlane(xi, 16)) +
         __int_as_float(__builtin_amdgcn_readlane(xi, 32)) + __int_as_float(__builtin_amdgcn_readlane(xi, 48));
}
__device__ __forceinline__ float red8(float x) {
  x += dpp_mov<0xB1>(x);
  x += dpp_mov<0x4E>(x);
  x += dpp_mov<0x141>(x);
  return x;
}

#define XB_TMO      128
#define XB_XCNT(j)  (256  + 64 * (j))
#define XB_XSUB(j)  (1280 + 64 * (j))
#define XB_XGEN(j)  (2304 + 64 * (j))
#define XB_TOP      3328
#define XB_TOPGEN   3392
#define XCD_BAR_WORDS 3456
#define XB_SPIN_CAP (1u << 18)
#define LAS __attribute__((address_space(3)))
__device__ __forceinline__ unsigned xb_ld(unsigned* p)              { return __hip_atomic_load(p, __ATOMIC_RELAXED, __HIP_MEMORY_SCOPE_AGENT); }
__device__ __forceinline__ unsigned xb_add(unsigned* p, unsigned v) { return __hip_atomic_fetch_add(p, v, __ATOMIC_RELAXED, __HIP_MEMORY_SCOPE_AGENT); }
__device__ __forceinline__ unsigned xb_xcc_id() { return (unsigned)__builtin_amdgcn_s_getreg((3 << 11) | 20) & 0xFu; }
#define XB_SPIN(cond, bar) do { unsigned _sp = 0; while (cond) { __builtin_amdgcn_s_sleep(1); \
    if ((++_sp & 255u) == 0u) { if (xb_ld(&(bar)[XB_TMO])) break; if (_sp > XB_SPIN_CAP) { atomicAdd(&(bar)[XB_TMO], 1u); break; } } } } while (0)
struct XcdBarrier { unsigned* bar; unsigned x; volatile LAS unsigned* st; };
__device__ __forceinline__ XcdBarrier xcd_barrier_post(unsigned* bar, volatile LAS unsigned* st) {
  XcdBarrier b; b.bar = bar; b.x = xb_xcc_id(); b.st = st;
  if (threadIdx.x == 0) (void)xb_add(&bar[XB_XCNT(b.x)], 1u);
  return b;
}
__device__ __forceinline__ void xcd_barrier_complete(unsigned* bar, unsigned x, unsigned& nloc, unsigned& nx) {
  const unsigned G = gridDim.x * gridDim.y * gridDim.z;
  unsigned sum, cnt, mine, sp = 0u;
  for (;;) {
    sum = 0u; cnt = 0u; mine = 0u;
#pragma unroll
    for (unsigned j = 0; j < 16; ++j) { const unsigned c = xb_ld(&bar[XB_XCNT(j)]); sum += c; cnt += (c > 0u) ? 1u : 0u; mine = (j == x) ? c : mine; }
    if (sum == G) break;
    __builtin_amdgcn_s_sleep(1);
    if ((++sp & 255u) == 0u) { if (xb_ld(&bar[XB_TMO])) break; if (sp > XB_SPIN_CAP) { atomicAdd(&bar[XB_TMO], 1u); break; } }
  }
  nloc = mine > 0u ? mine : 1u; nx = cnt > 0u ? cnt : 1u;
}
__device__ __forceinline__ void xcd_barrier(const XcdBarrier& b) {
  asm volatile("s_waitcnt vmcnt(0)" ::: "memory");
  __syncthreads();
  if (threadIdx.x == 0) {
    unsigned* bar = b.bar;
    __builtin_amdgcn_s_waitcnt(0);
    unsigned nloc = b.st[0], nx = b.st[1];
    if (nloc == 0u) { xcd_barrier_complete(bar, b.x, nloc, nx); b.st[0] = nloc; b.st[1] = nx; }
    const unsigned old = xb_add(&bar[XB_XSUB(b.x)], 1u);
    const unsigned gen = old / nloc;
    if (old + 1u == (gen + 1u) * nloc) {
      __builtin_amdgcn_fence(__ATOMIC_RELEASE, "agent");
      asm volatile("s_waitcnt vmcnt(0)" ::: "memory");
      const unsigned og = xb_add(&bar[XB_TOP], 1u);
      const unsigned tg = og / nx;
      if (og + 1u == (tg + 1u) * nx) xb_add(&bar[XB_TOPGEN], 1u);
      else XB_SPIN(xb_ld(&bar[XB_TOPGEN]) == tg, bar);
      __builtin_amdgcn_fence(__ATOMIC_ACQUIRE, "agent");
      xb_add(&bar[XB_XGEN(b.x)], 1u);
      asm volatile("s_waitcnt vmcnt(0)" ::: "memory");
    } else {
      XB_SPIN(xb_ld(&bar[XB_XGEN(b.x)]) == gen, bar);
      __builtin_amdgcn_fence(__ATOMIC_ACQUIRE, "agent");
      asm volatile("s_waitcnt vmcnt(0)" ::: "memory");
    }
  }
  __syncthreads();
}

__device__ __forceinline__ void phase_prep(const Params& p, int bid, int nb, char* smem) {
  const int tid = tid_opaque();
  float* sf = (float*)smem;
  constexpr int N_WIN = 2048, N_WOUT = 512, N_MOD = 192, N_PADI = 1024, N_WL = 768;
  constexpr int total = N_WIN + N_WOUT + N_MOD + N_PADI + N_WL + 1;
  for (int it = bid; it < total; it += nb) {
    if (it < N_WIN + N_WOUT) {
      const float* src; h16* dst; int ncols, kt, ntile;
      if (it < N_WIN) { int l = it >> 10, r = it & 1023; kt = r >> 6; ntile = r & 63; src = p.w_in + (size_t)l * 1024 * 4096; dst = p.win_t + (size_t)l * NPAD * 1024; ncols = 4096; }
      else { int j = it - N_WIN; int l = j >> 8, r = j & 255; kt = r >> 4; ntile = r & 15; src = p.w_out + (size_t)l * 1024 * 1024; dst = p.wout_t + (size_t)l * 1024 * 1024; ncols = 1024; }
      for (int i = tid; i < 4096; i += 256) { int kk = i >> 6, nn = i & 63; sf[kk * 65 + nn] = src[(size_t)(kt * 64 + kk) * ncols + ntile * 64 + nn]; }
      __syncthreads();
      const bool rkperm = it < N_WIN && ntile < 12;
      for (int i = tid; i < 4096; i += 256) {
        int nn = i >> 6, kk = i & 63;
        int nrow = rkperm ? ((ntile % 6) * 128 + 2 * nn + ntile / 6) : (ntile * 64 + nn);
        if (it < N_WIN && ntile >= 28 && ntile < 44) {
          const int kind = (ntile - 28) >> 2, hh4 = (ntile - 28) & 3;
          const int slot = kind == 0 ? 0 : (kind == 3 ? 1 : kind + 1);
          nrow = 1792 + (hh4 * 64 + nn) * 4 + slot;
        }
        dst[(size_t)nrow * 1024 + kt * 64 + kk] = (h16)sf[kk * 65 + nn];
      }
      __syncthreads();
    } else if (it < N_WIN + N_WOUT + N_MOD) {
      const int j = it - N_WIN - N_WOUT; const int l = j / 96; const int cl = tid & 31, ks = tid >> 5; const int col = (j % 96) * 32 + cl;
      for (int i = tid; i < 9 * 1024; i += 256) { int r = i >> 10, k = i & 1023; float v = r < 8 ? p.c[r * 1024 + k] : p.c_ctx[k]; sf[i] = siluf_(v); }
      __syncthreads();
      float acc[9];
#pragma unroll
      for (int r = 0; r < 9; ++r) acc[r] = 0.f;
      const float* mw = p.mod_w + (size_t)l * 1024 * 3072 + (size_t)(ks * 128) * 3072 + col;
#pragma unroll 2
      for (int k = 0; k < 128; k += 4) {
        const float w0 = mw[(size_t)k * 3072], w1 = mw[(size_t)(k + 1) * 3072], w2 = mw[(size_t)(k + 2) * 3072], w3 = mw[(size_t)(k + 3) * 3072];
#pragma unroll
        for (int r = 0; r < 9; ++r) { const f32x4 sv = *(const f32x4*)&sf[r * 1024 + ks * 128 + k]; acc[r] += sv[0] * w0 + sv[1] * w1 + sv[2] * w2 + sv[3] * w3; }
      }
#pragma unroll
      for (int r = 0; r < 9; ++r) acc[r] += __shfl_xor(acc[r], 32);
      __syncthreads();
      if ((tid & 63) < 32) {
#pragma unroll
        for (int r = 0; r < 9; ++r) sf[((tid >> 6) * 9 + r) * 32 + cl] = acc[r];
      }
      __syncthreads();
      for (int i = tid; i < 288; i += 256) {
        const int r = i >> 5, c2 = i & 31;
        const float v = sf[(0 * 9 + r) * 32 + c2] + sf[(1 * 9 + r) * 32 + c2] + sf[(2 * 9 + r) * 32 + c2] + sf[(3 * 9 + r) * 32 + c2];
        const int cc = (j % 96) * 32 + c2;
        p.mod[(size_t)(l * 9 + r) * 3072 + cc] = v + p.mod_b[l * 3072 + cc];
      }
      __syncthreads();
    } else if (it < N_WIN + N_WOUT + N_MOD + N_PADI) {
      int j = it - (N_WIN + N_WOUT + N_MOD); int idx = j * 256 + tid;
      int l = idx >> 17; int rem = idx & 131071; int m = rem >> 10, k = rem & 1023;
      float v = (l == 1 && m < 32) ? p.vw1[k * 32 + m] : 0.f;
      p.win_t[(size_t)l * NPAD * 1024 + (size_t)(4096 + m) * 1024 + k] = (h16)v;
    } else if (it < N_WIN + N_WOUT + N_MOD + N_PADI + N_WL) {
      const int idx = (it - (N_WIN + N_WOUT + N_MOD + N_PADI)) * 256 + tid;
      const int r = idx & 63, c = (idx >> 6) % 384, ls = idx / (384 * 64); const int l = ls >> 2, slot = ls & 3, dir = slot & 1, kind = slot >> 1;
      const float v = (kind == 0 ? p.w2 : p.a2)[((size_t)(l * 2 + dir) * 64 + r) * 384 + c];
      p.wl_t[idx] = (h16)v;
    } else {
      if (tid < 16) {
        double inv = 1.0; for (int i = 0; i < tid; ++i) inv *= 0.5623413251903491;
        double x2 = inv * inv, ts = inv, tc = 1.0, s1 = inv, c1 = 1.0;
        for (int n = 1; n <= 10; ++n) { tc *= -x2 / ((2.0 * n - 1.0) * (2.0 * n)); c1 += tc; ts *= -x2 / ((2.0 * n) * (2.0 * n + 1.0)); s1 += ts; }
        double cc = 1.0, ss = 0.0;
        for (int pos = 0; pos < 64; ++pos) {
          p.rope[(pos * 16 + tid) * 2] = (float)cc; p.rope[(pos * 16 + tid) * 2 + 1] = (float)ss;
          double nc = cc * c1 - ss * s1, ns = ss * c1 + cc * s1; cc = nc; ss = ns;
        }
      }
    }
  }
}

__device__ __forceinline__ void phase_norm(const Params& p, int l, int bid, int nb) {
  const int tid = tid_opaque(), lane = tid & 63, w = __builtin_amdgcn_readfirstlane(tid >> 6);
  for (int row = bid * 4 + w; row < NTOK; row += nb * 4) {
    const float* src = (l == 0) ? (row < NLAT ? p.x + (size_t)row * 1024 : p.ctx + (size_t)(row - NLAT) * 1024)
                                : (row < NLAT ? p.out + (size_t)row * 1024 : p.xc1 + (size_t)(row - NLAT) * 1024);
    const int mr = row < NLAT ? (row >> 12) : 8;
    const float* md = p.mod + (size_t)(l * 9 + mr) * 3072;
    const float* nw = p.norm_w + l * 1024;
    f32x4 v[4]; float ss = 0.f;
#pragma unroll
    for (int i = 0; i < 4; ++i) { v[i] = *(const f32x4*)(src + i * 256 + lane * 4); ss += v[i][0] * v[i][0] + v[i][1] * v[i][1] + v[i][2] * v[i][2] + v[i][3] * v[i][3]; }
    ss = wave_sum_dpp(ss);
    const float rs = rsqrtf(ss * (1.f / 1024.f) + 1e-6f);
#pragma unroll
    for (int i = 0; i < 4; ++i) {
      const int col = i * 256 + lane * 4;
      f32x4 nwv = *(const f32x4*)(nw + col), sc = *(const f32x4*)(md + 1024 + col), sh = *(const f32x4*)(md + col);
      half4 o;
#pragma unroll
      for (int j = 0; j < 4; ++j) o[j] = (h16)(v[i][j] * rs * nwv[j] * (1.f + sc[j]) + sh[j]);
      *(half4*)(p.hy + (size_t)row * 1024 + col) = o;
    }
  }
}

template <int MODE>
__device__ __forceinline__ void phase_gemm(const Params& p, int l, int bid, int nb, char* smem) {
  const h16* A = p.hy;
  const h16* Bt = MODE == 0 ? p.win_t + (size_t)l * NPAD * 1024 : p.wout_t + (size_t)l * 1024 * 1024;
  const int ntn = MODE == 0 ? (l == 1 ? 33 : 32) : 8;
  const int ntm = (MODE == 1 && l == 1) ? 256 : 272;
  const int tid = tid_opaque(), lane = tid & 63, w = __builtin_amdgcn_readfirstlane(tid >> 6), wr = w >> 1, wc = w & 1, lq = lane & 31, hh = lane >> 5;
  h16* As = (h16*)smem; h16* Bs = As + 128 * 72;
  const int ldrow = tid >> 3, ldch = (tid & 7) * 8;
  for (int tile = bid; tile < ntm * ntn; tile += nb) {
    int tm, tn;
    {
      const int mper = ntm >> 3;
      const int nmain = MODE == 0 ? 32 : 8;
      if (tile < ntm * nmain) {
        const int x = tile & 7, sq = tile >> 3;
        const int strip = sq / (mper * 8), rem = sq - strip * (mper * 8);
        tm = x * mper + (rem >> 3); tn = strip * 8 + (rem & 7);
      } else { tm = tile - ntm * nmain; tn = nmain; }
    }
    const h16* Ag = A + (size_t)(tm * 128 + ldrow) * 1024 + ldch; const h16* Bg = Bt + (size_t)(tn * 128 + ldrow) * 1024 + ldch;
    f32x16 acc[2][2];
#pragma unroll
    for (int i = 0; i < 2; ++i)
#pragma unroll
      for (int j = 0; j < 2; ++j)
#pragma unroll
        for (int r = 0; r < 16; ++r) acc[i][j][r] = 0.f;
    u32x4 ra[4], rb[4];
#pragma unroll
    for (int i = 0; i < 4; ++i) { ra[i] = *(const u32x4*)(Ag + (size_t)i * 32 * 1024); rb[i] = *(const u32x4*)(Bg + (size_t)i * 32 * 1024); }
#pragma unroll 2
    for (int kt = 0; kt < 16; ++kt) {
      __syncthreads();
#pragma unroll
      for (int i = 0; i < 4; ++i) { *(u32x4*)(As + (ldrow + i * 32) * 72 + ldch) = ra[i]; *(u32x4*)(Bs + (ldrow + i * 32) * 72 + ldch) = rb[i]; }
      __syncthreads();
      if (kt + 1 < 16) {
#pragma unroll
        for (int i = 0; i < 4; ++i) { ra[i] = *(const u32x4*)(Ag + (size_t)i * 32 * 1024 + (kt + 1) * 64); rb[i] = *(const u32x4*)(Bg + (size_t)i * 32 * 1024 + (kt + 1) * 64); }
      }
#pragma unroll
      for (int s = 0; s < 4; ++s) {
        half8 a[2], b[2];
#pragma unroll
        for (int i = 0; i < 2; ++i) { a[i] = *(const half8*)(As + (64 * wr + 32 * i + lq) * 72 + 16 * s + 8 * hh); b[i] = *(const half8*)(Bs + (64 * wc + 32 * i + lq) * 72 + 16 * s + 8 * hh); }
#pragma unroll
        for (int i = 0; i < 2; ++i)
#pragma unroll
          for (int j = 0; j < 2; ++j) {
            if (MODE == 0) acc[i][j] = __builtin_amdgcn_mfma_f32_32x32x16_f16(b[j], a[i], acc[i][j], 0, 0, 0);
            else acc[i][j] = __builtin_amdgcn_mfma_f32_32x32x16_f16(a[i], b[j], acc[i][j], 0, 0, 0);
          }
      }
    }
    if (MODE == 0) {
      if (tn < 32) {
        __syncthreads();
        h16* Cs = (h16*)smem;
#pragma unroll
        for (int i = 0; i < 2; ++i)
#pragma unroll
          for (int j = 0; j < 2; ++j)
#pragma unroll
            for (int g = 0; g < 4; ++g) {
              half4 o;
#pragma unroll
              for (int q = 0; q < 4; ++q) o[q] = (h16)acc[i][j][4 * g + q];
              *(half4*)(Cs + (64 * wr + 32 * i + lq) * 136 + 64 * wc + 32 * j + 8 * g + 4 * hh) = o;
            }
        __syncthreads();
#pragma unroll
        for (int q = 0; q < 8; ++q) {
          const int id = tid + q * 256; const int row = id >> 4, ch = id & 15;
          *(u32x4*)(p.P + (size_t)(tm * 128 + row) * PC + tn * 128 + ch * 8) = *(const u32x4*)(Cs + row * 136 + ch * 8);
        }
      } else if (wc == 0) {
#pragma unroll
        for (int i = 0; i < 2; ++i)
#pragma unroll
          for (int r = 0; r < 16; ++r) ((float*)(p.F + (size_t)(tm * 128 + 64 * wr + 32 * i + lq) * 1536))[(r & 3) + 8 * (r >> 2) + 4 * hh] = acc[i][0][r];
      }
    } else {
      const int row0 = tm * 128;
      const int mr = row0 < NLAT ? (row0 >> 12) : 8;
      const int col = tn * 128 + 64 * wc + lq;
      const float* gp = p.mod + (size_t)(l * 9 + mr) * 3072 + 2048 + col;
      const float g0 = gp[0], g1 = gp[32];
      const float* xs0; float* xd0;
      if (l == 0) { if (row0 < NLAT) { xs0 = p.x + (size_t)row0 * 1024; xd0 = p.out + (size_t)row0 * 1024; } else { xs0 = p.ctx + (size_t)(row0 - NLAT) * 1024; xd0 = p.xc1 + (size_t)(row0 - NLAT) * 1024; } }
      else { xs0 = p.out + (size_t)row0 * 1024; xd0 = p.out + (size_t)row0 * 1024; }
      const float* __restrict__ xsrc = xs0 + (size_t)(64 * wr + 4 * hh) * 1024 + col;
      float* __restrict__ xdst = xd0 + (size_t)(64 * wr + 4 * hh) * 1024 + col;
#pragma unroll
      for (int i = 0; i < 2; ++i)
#pragma unroll
        for (int r = 0; r < 16; ++r) {
          const int ro = (32 * i + (r & 3) + 8 * (r >> 2)) * 1024;
          xdst[ro] = xsrc[ro] + g0 * acc[i][0][r];
          xdst[ro + 32] = xsrc[ro + 32] + g1 * acc[i][1][r];
        }
    }
  }
}

#define LOAD_COL34(arr, base, t0, Tn) \
  _Pragma("unroll") for (int q_ = 0; q_ < 34; ++q_) { const int t_ = (t0) - 1 + q_; arr[q_] = (t_ >= 0 && t_ < (Tn)) ? (base)[(long)t_ * PC] : (h16)0.f; }

__device__ __forceinline__ void phase_feat(const Params& p, int l, int bid, int nb, char* smem, bool dry) {
  const int tid = tid_opaque();
  h16* inh = (h16*)smem;
  float* zt = (float*)(smem + 32 * 264 * 2);
  for (int item = bid; item < 1088; item += nb) {
    int b, t0, Tn, rowbase; bool isctx;
    if (item < 1024) { b = item >> 7; t0 = (item & 127) * 32; Tn = 4096; rowbase = b * 4096; isctx = false; }
    else { int j = item - 1024; b = j >> 3; t0 = (j & 7) * 32; Tn = 256; rowbase = NLAT + b * 256; isctx = true; }
    {
      const int col = 1152 + tid;
      const float mp = p.mu_prev[l * 1792 + col], mn = p.mu_next[l * 1792 + col];
      const h16* base = p.P + (size_t)rowbase * PC + col;
      h16 xv[34];
      LOAD_COL34(xv, base, t0, Tn)
#pragma unroll
      for (int tt = 0; tt < 32; ++tt) {
        const float prev = (float)xv[tt], cur = (float)xv[tt + 1], nxt = (float)xv[tt + 2];
        float sv = cur + mp * (prev - cur) + mn * (nxt - cur);
        if (tid < 128) { const float e2 = __expf(2.f * sv); sv = 1.f - 2.f / (e2 + 1.f); }
        inh[tt * 264 + tid] = (h16)sv;
      }
      if (l == 1) {
#pragma unroll
        for (int i = 0; i < 4; ++i) { int id = tid + i * 256; zt[id] = ((const float*)(p.F + (size_t)(rowbase + t0 + (id >> 5)) * 1536))[id & 31]; }
      }
    }
    __syncthreads();
#pragma unroll 1
    for (int c = tid; c < 384; c += 256) {
      const int col = 768 + c;
      const float mp = p.mu_prev[l * 1792 + col], mn = p.mu_next[l * 1792 + col];
      const h16* base = p.P + (size_t)rowbase * PC + col;
      h16 xv[34];
      LOAD_COL34(xv, base, t0, Tn)
      h16* dst = p.VB + (size_t)(rowbase + t0) * 384 + c;
      if (l == 0) {
#pragma unroll
        for (int tt = 0; tt < 32; ++tt) {
          const float prev = (float)xv[tt], cur = (float)xv[tt + 1], nxt = (float)xv[tt + 2];
          dst[tt * 384] = (h16)(cur + mp * (prev - cur) + mn * (nxt - cur));
        }
      } else {
        const float vbv = p.vb[c];
#pragma unroll 1
        for (int hf = 0; hf < 2; ++hf) {
          h16 vfv[16]; float ga[16];
#pragma unroll
          for (int tt = 0; tt < 16; ++tt) { vfv[tt] = dst[(hf * 16 + tt) * 384]; ga[tt] = vbv; }
#pragma unroll 1
          for (int m = 0; m < 32; m += 4) {
            const float w0 = p.vw2[m * 384 + c], w1 = p.vw2[(m + 1) * 384 + c], w2 = p.vw2[(m + 2) * 384 + c], w3 = p.vw2[(m + 3) * 384 + c];
#pragma unroll
            for (int tt = 0; tt < 16; ++tt) { const f32x4 z = *(const f32x4*)&zt[(hf * 16 + tt) * 32 + m]; ga[tt] += z[0] * w0 + z[1] * w1 + z[2] * w2 + z[3] * w3; }
          }
#pragma unroll
          for (int tt = 0; tt < 16; ++tt) {
            const float prev = hf ? (float)xv[16 + tt] : (float)xv[tt], cur = hf ? (float)xv[17 + tt] : (float)xv[tt + 1], nxt = hf ? (float)xv[18 + tt] : (float)xv[tt + 2];
            const float sv = cur + mp * (prev - cur) + mn * (nxt - cur);
            dst[(hf * 16 + tt) * 384] = (h16)(sv + ((float)vfv[tt] - sv) * sigmoidf_(ga[tt]));
          }
        }
      }
    }
    {
      const int w = __builtin_amdgcn_readfirstlane(tid >> 6), lane = tid & 63, lq = tid & 31, hh = lane >> 5;
      const int dir = w & 1, chalf = w >> 1;
      half8 xin[2][4];
#pragma unroll
      for (int kind = 0; kind < 2; ++kind)
#pragma unroll
        for (int ks = 0; ks < 4; ++ks) xin[kind][ks] = *(const half8*)(inh + lq * 264 + kind * 128 + dir * 64 + 16 * ks + 8 * hh);
      h16* ost = (h16*)(smem + 32 * 264 * 2 + 4096) + w * (32 * 72);
      h16* fbase = p.F + (size_t)(rowbase + t0) * 1536 + dir * 768 + chalf * 384;
#pragma unroll 1
      for (int np = 0; np < 6; ++np) {
        const int c0 = chalf * 192 + np * 32;
        f32x16 acc[2];
#pragma unroll
        for (int kind = 0; kind < 2; ++kind) {
          const float* bias = (kind == 0 ? p.w0 : p.a0) + (l * 2 + dir) * 384 + c0;
          const h16* wl = p.wl_t + (size_t)((l * 4 + kind * 2 + dir) * 384 + c0) * 64;
#pragma unroll
          for (int g = 0; g < 4; ++g) { const f32x4 bv = *(const f32x4*)(bias + 8 * g + 4 * hh); acc[kind][4 * g] = bv[0]; acc[kind][4 * g + 1] = bv[1]; acc[kind][4 * g + 2] = bv[2]; acc[kind][4 * g + 3] = bv[3]; }
#pragma unroll
          for (int ks = 0; ks < 4; ++ks) {
            const half8 wf = *(const half8*)(wl + (size_t)lq * 64 + 16 * ks + 8 * hh);
            acc[kind] = __builtin_amdgcn_mfma_f32_32x32x16_f16(wf, xin[kind][ks], acc[kind], 0, 0, 0);
          }
        }
#pragma unroll
        for (int g = 0; g < 4; ++g) {
          half8 o;
#pragma unroll
          for (int j = 0; j < 4; ++j) { o[2 * j] = (h16)(1.f - __expf(-0.6065306597126334f * sigmoidf_(acc[0][4 * g + j]))); o[2 * j + 1] = (h16)sigmoidf_(acc[1][4 * g + j]); }
          *(half8*)(ost + lq * 72 + 16 * g + 8 * hh) = o;
        }
        asm volatile("s_waitcnt lgkmcnt(0)" ::: "memory");
#pragma unroll
        for (int q = 0; q < 4; ++q) {
          const int id = lane + q * 64; const int rr = id >> 3, ch = id & 7;
          *(u32x4*)(fbase + (size_t)rr * 1536 + np * 64 + ch * 8) = *(const u32x4*)(ost + rr * 72 + ch * 8);
        }
        asm volatile("s_waitcnt lgkmcnt(0)" ::: "memory");
      }
    }
    {
      const int head = tid >> 5, pr = tid & 31, half = pr >> 4, i = pr & 15;
      const int colbase = head < 6 ? 3072 + head * 64 : 3456 + (head - 6) * 64;
      const int d1 = half * 32 + i;
      const float qs = (head < 6 && !dry) ? 0.125f : 1.f;
      h16* pp = p.P + (size_t)(rowbase + t0) * PC + colbase + d1;
      h16 x1[32], x2[32];
#pragma unroll
      for (int u = 0; u < 32; ++u) { x1[u] = pp[(size_t)u * PC]; x2[u] = pp[(size_t)u * PC + 16]; }
#pragma unroll
      for (int u = 0; u < 32; ++u) {
        const int t = t0 + u;
        float cs = 1.f, sn = 0.f;
        if (!isctx && !dry) { const int pos = half == 0 ? (t >> 6) : (t & 63); const f32x2 r2 = *(const f32x2*)&p.rope[(pos * 16 + i) * 2]; cs = r2[0]; sn = r2[1]; }
        const float a = (float)x1[u], bq = (float)x2[u];
        pp[(size_t)u * PC] = (h16)((a * cs - bq * sn) * qs);
        pp[(size_t)u * PC + 16] = (h16)((a * sn + bq * cs) * qs);
      }
    }
    if (tid < 128) {
      const int g = tid >> 6, d = tid & 63;
      const h16* base = p.P + (size_t)(rowbase + t0) * PC + 3584 + tid;
      h16* dst = p.VT + (size_t)((b * 2 + g) * 64 + d) * VTS + (isctx ? 4096 + t0 : t0);
      half8 v[4];
#pragma unroll
      for (int q = 0; q < 4; ++q)
#pragma unroll
        for (int j = 0; j < 8; ++j) v[q][j] = base[(size_t)(q * 8 + j) * PC];
#pragma unroll
      for (int q = 0; q < 4; ++q) *(half8*)(dst + q * 8) = v[q];
    }
    __syncthreads();
  }
}

__device__ __forceinline__ float ulo(unsigned u) { return (float)__builtin_bit_cast(h16, (unsigned short)(u & 0xffffu)); }
__device__ __forceinline__ float uhi(unsigned u) { return (float)__builtin_bit_cast(h16, (unsigned short)(u >> 16)); }
__device__ __forceinline__ float red16(float x) {
  x += dpp_mov<0xB1>(x);
  x += dpp_mov<0x4E>(x);
  x += dpp_mov<0x141>(x);
  x += dpp_mov<0x140>(x);
  return x;
}
#define LDS_BARRIER() do { asm volatile("s_waitcnt lgkmcnt(0)" ::: "memory"); __builtin_amdgcn_s_barrier(); asm volatile("" ::: "memory"); } while (0)
constexpr int RREC = 336;
struct RwkvPf { unsigned rk[6]; h16 v[4]; unsigned ea[4]; };

__device__ __forceinline__ void rwkv_chain(const Params& p, int l, int item, char* smem, bool swap_roles) {
  const int tid0 = tid_opaque();
  const int tid = swap_roles ? (tid0 ^ 128) : tid0;
  const int lane = tid & 63, w = __builtin_amdgcn_readfirstlane(tid >> 6);
  const int chain = item >> 2, vq = item & 3;
  const int dir = chain / 48, b = (chain % 48) / 6, h = chain % 6;
  float* opb = (float*)smem;
  float* ybuf = opb + 2 * 8 * RREC;
  constexpr int NCH = 544;
  if (w < 2) {
    const int rl = tid >> 3, kq = tid & 7;
    float S[8];
#pragma unroll
    for (int j = 0; j < 8; ++j) S[j] = 0.f;
    __builtin_amdgcn_s_setprio(3);
    LDS_BARRIER();
#pragma unroll 1
    for (int ci = 0; ci < NCH; ++ci) {
      const float* op = opb + (ci & 1) * 8 * RREC;
      float* yb = ybuf + (ci & 1) * 1024;
      f32x4 aA = *(const f32x4*)(op + 8 * kq + 64), aB = *(const f32x4*)(op + 8 * kq + 68);
#pragma unroll
      for (int step = 0; step < 8; ++step) {
        const float* o = op + step * RREC + 8 * kq;
        const f32x4 wA = *(const f32x4*)(o), wB = *(const f32x4*)(o + 4);
        const f32x4 bA = *(const f32x4*)(o + 128), bB = *(const f32x4*)(o + 132);
        const f32x4 kA = *(const f32x4*)(o + 192), kB = *(const f32x4*)(o + 196);
        const f32x4 rA = *(const f32x4*)(o + 256), rB = *(const f32x4*)(o + 260);
        const float vv = op[step * RREC + 320 + rl];
        f32x4 naA = aA, naB = aB;
        if (step + 1 < 8) { naA = *(const f32x4*)(o + RREC + 64); naB = *(const f32x4*)(o + RREC + 68); }
        const float d0 = S[0] * aA[0] + S[1] * aA[1] + S[2] * aA[2] + S[3] * aA[3];
        const float d1 = S[4] * aB[0] + S[5] * aB[1] + S[6] * aB[2] + S[7] * aB[3];
        const float sa = red8(d0 + d1);
#pragma unroll
        for (int j = 0; j < 4; ++j) {
          S[j] = S[j] * wA[j] + sa * bA[j] + vv * kA[j];
          S[4 + j] = S[4 + j] * wB[j] + sa * bB[j] + vv * kB[j];
        }
        const float y0 = S[0] * rA[0] + S[1] * rA[1] + S[2] * rA[2] + S[3] * rA[3];
        const float y1 = S[4] * rB[0] + S[5] * rB[1] + S[6] * rB[2] + S[7] * rB[3];
        yb[step * 128 + tid] = y0 + y1;
        aA = naA; aB = naB;
      }
      LDS_BARRIER();
    }
    __builtin_amdgcn_s_setprio(0);
  } else {
    const int lw = w - 2, lt = tid - 128;
    const int hc = h * 64 + lane;
    const float mpr = p.mu_prev[l * 1792 + hc], mnr = p.mu_next[l * 1792 + hc];
    const float mpk = p.mu_prev[l * 1792 + 384 + hc], mnk = p.mu_next[l * 1792 + 384 + hc];
    const float kkw = p.k_k[l * 384 + hc], kaw = p.k_a[l * 384 + hc];
    const float cAr = dir ? mnr : mpr, cBr = dir ? mpr : mnr, cAk = dir ? mnk : mpk, cBk = dir ? mpk : mnk;
    const unsigned* zrow = p.bar + XCD_BAR_WORDS;
    RwkvPf pfA, pfB, pfC, pfD;
#define RWKV_ISSUE(ci_, PF) { const int seg_ = (ci_) >= 32; const int Tn_ = seg_ ? 4096 : 256; const int rb_ = seg_ ? b * 4096 : NLAT + b * 256; const int s0_ = (seg_ ? (ci_) - 32 : (ci_)) * 8 + 4 * lw; \
    _Pragma("unroll") for (int q = 0; q < 6; ++q) { const int t_ = dir == 0 ? s0_ - 1 + q : Tn_ - s0_ - q; \
      const unsigned* src_ = ((unsigned)t_ < (unsigned)Tn_) ? (const unsigned*)(p.P + (size_t)(rb_ + t_) * PC + h * 128) : zrow; \
      PF.rk[q] = src_[lane]; } \
    _Pragma("unroll") for (int i = 0; i < 4; ++i) { const int t_ = dir == 0 ? s0_ + i : Tn_ - 1 - (s0_ + i); const size_t row = (size_t)rb_ + t_; \
      PF.v[i] = p.VB[row * 384 + hc]; PF.ea[i] = ((const unsigned*)(p.F + row * 1536 + dir * 768))[hc]; } }
#define RWKV_STAGE(ci_, PF) { float* op_ = opb + ((ci_) & 1) * 8 * RREC; \
    const int seg = (ci_) >= 32; const int Tn = seg ? 4096 : 256; const int c0 = (seg ? (ci_) - 32 : (ci_)) * 8; \
    _Pragma("unroll") for (int i = 0; i < 4; ++i) { \
      const int step = lw * 4 + i; const int t = dir == 0 ? c0 + step : Tn - 1 - (c0 + step); \
      const float rlo = ulo(PF.rk[i]), r0 = ulo(PF.rk[i + 1]), rhi = ulo(PF.rk[i + 2]); \
      const float klo = uhi(PF.rk[i]), k0 = uhi(PF.rk[i + 1]), khi = uhi(PF.rk[i + 2]); \
      const float vv = (float)PF.v[i], e = ulo(PF.ea[i]), al = uhi(PF.ea[i]); \
      const float rs = r0 + cAr * (rlo - r0) + cBr * (rhi - r0); \
      const float ks = k0 + cAk * (klo - k0) + cBk * (khi - k0); \
      const float kkr = ks * kkw; \
      const float n2 = wave_sum_dpp(kkr * kkr); \
      const float kk = kkr * rsqrtf(fmaxf(n2, 1e-24f)); \
      float* o = op_ + step * RREC + lane; \
      o[0] = 1.f - e; o[64] = -kk; o[128] = kk * al; o[192] = ks * (1.f + (al - 1.f) * kaw); o[256] = rs; \
      if ((lane >> 4) == vq) op_[step * RREC + 320 + (lane & 15)] = vv; } }
#define RWKV_WRITE(cj_) { const int seg = (cj_) >= 32; const int Tn = seg ? 4096 : 256; const int rowbase = seg ? b * 4096 : NLAT + b * 256; const int c0 = (seg ? (cj_) - 32 : (cj_)) * 8; \
    if (seg == 1 || l == 0) { const float* yb = ybuf + ((cj_) & 1) * 1024; \
      const int step = lt >> 4, ch = lt & 15; \
      const int t = dir == 0 ? c0 + step : Tn - 1 - (c0 + step); \
      const f32x4 y0 = *(const f32x4*)(yb + step * 128 + ch * 8), y1 = *(const f32x4*)(yb + step * 128 + ch * 8 + 4); \
      const f32x4 ys = y0 + y1; const h16 yv = (h16)((ys[0] + ys[1]) + (ys[2] + ys[3])); \
      if (dir == 0) p.P[(size_t)(rowbase + t) * PC + 768 + h * 64 + 16 * vq + ch] = yv; \
      else p.hy[(size_t)(rowbase + t) * 1024 + h * 64 + 16 * vq + ch] = yv; } }
    RWKV_ISSUE(0, pfA)
    RWKV_STAGE(0, pfA)
    RWKV_ISSUE(1, pfB)
    RWKV_ISSUE(2, pfC)
    RWKV_ISSUE(3, pfD)
    RWKV_ISSUE(4, pfA)
    LDS_BARRIER();
#pragma unroll 1
    for (int ci = 0; ci < NCH; ci += 4) {
      if (ci + 1 < NCH) RWKV_STAGE(ci + 1, pfB)
      if (ci + 5 < NCH) RWKV_ISSUE(ci + 5, pfB)
      if (ci >= 1) RWKV_WRITE(ci - 1)
      LDS_BARRIER();
      if (ci + 2 < NCH) RWKV_STAGE(ci + 2, pfC)
      if (ci + 6 < NCH) RWKV_ISSUE(ci + 6, pfC)
      RWKV_WRITE(ci)
      LDS_BARRIER();
      if (ci + 3 < NCH) RWKV_STAGE(ci + 3, pfD)
      if (ci + 7 < NCH) RWKV_ISSUE(ci + 7, pfD)
      RWKV_WRITE(ci + 1)
      LDS_BARRIER();
      if (ci + 4 < NCH) RWKV_STAGE(ci + 4, pfA)
      if (ci + 8 < NCH) RWKV_ISSUE(ci + 8, pfA)
      RWKV_WRITE(ci + 2)
      LDS_BARRIER();
    }
    RWKV_WRITE(NCH - 1)
  }
}

constexpr int HREC = 224;
typedef unsigned u32x2 __attribute__((ext_vector_type(2)));
struct HgrnPf { u32x2 qi_ff[4]; };
__device__ __forceinline__ void hgrn_chain(const Params& p, int l, int item, char* smem) {
  const int tid = tid_opaque(), lane = tid & 63, w = __builtin_amdgcn_readfirstlane(tid >> 6);
  const int chain = item >> 1, vh = item & 1;
  const int dir = chain / 32, b = (chain % 32) / 4, h = chain % 4;
  float* op = (float*)smem;
  float* ybuf = op + 16 * HREC;
  const int hc = h * 64 + lane;
  float lb = 0.f;
  if (l == 1) lb = sigmoidf_(p.lb_logits[(dir * 2 + 1) * 256 + hc] - p.lb_logits[(dir * 2 + 0) * 256 + hc]);
  const int vc = tid >> 3, kq = tid & 7;
  float S[8];
#pragma unroll
  for (int j = 0; j < 8; ++j) S[j] = 0.f;
  HgrnPf pfA, pfB;
#define HGRN_ISSUE(ci_, PF) { const int seg_ = (ci_) >= 16; const int Tn_ = seg_ ? 4096 : 256; const int rb_ = seg_ ? b * 4096 : NLAT + b * 256; const int c0_ = (seg_ ? (ci_) - 16 : (ci_)) * 16; \
    _Pragma("unroll") for (int i = 0; i < 4; ++i) { const int step = w * 4 + i; const int t = dir == 0 ? c0_ + step : Tn_ - 1 - (c0_ + step); \
      PF.qi_ff[i] = ((const u32x2*)(p.P + ((size_t)rb_ + t) * PC + 1792))[hc]; } }
#define HGRN_CHUNK(ci_, PF) { \
    const int seg = (ci_) >= 16; const int Tn = seg ? 4096 : 256; const int rowbase = seg ? b * 4096 : NLAT + b * 256; const int c0 = (seg ? (ci_) - 16 : (ci_)) * 16; \
    _Pragma("unroll") for (int i = 0; i < 4; ++i) { \
      const int step = w * 4 + i; \
      float* o = op + step * HREC + lane; \
      const float f = lb + (1.f - lb) * sigmoidf_(dir ? uhi(PF.qi_ff[i][1]) : ulo(PF.qi_ff[i][1])); \
      o[0] = f; o[128] = ulo(PF.qi_ff[i][0]); \
      if ((lane >> 5) == vh) op[step * HREC + 192 + (lane & 31)] = uhi(PF.qi_ff[i][0]); } \
    LDS_BARRIER(); \
    if ((ci_) + 2 < 272) HGRN_ISSUE((ci_) + 2, PF) \
    _Pragma("unroll") for (int step = 0; step < 16; ++step) { \
      const float* o = op + step * HREC + 8 * kq; \
      const f32x4 fA = *(const f32x4*)(o), fB = *(const f32x4*)(o + 4); \
      const f32x4 qA = *(const f32x4*)(o + 128), qB = *(const f32x4*)(o + 132); \
      const float iv = op[step * HREC + 192 + vc]; \
      const float f[8] = {fA[0], fA[1], fA[2], fA[3], fB[0], fB[1], fB[2], fB[3]}; \
      const float q[8] = {qA[0], qA[1], qA[2], qA[3], qB[0], qB[1], qB[2], qB[3]}; \
      float acc = 0.f; \
      _Pragma("unroll") for (int j = 0; j < 8; ++j) { S[j] = f[j] * (S[j] - iv) + iv; acc += S[j] * q[j]; } \
      ybuf[step * 256 + tid] = acc; } \
    LDS_BARRIER(); \
    if (seg == 1 || l == 0) { \
      _Pragma("unroll") for (int i = 0; i < 2; ++i) { \
        const int idx = tid + i * 256; const int step = idx >> 5, ch = idx & 31; \
        const int t = dir == 0 ? c0 + step : Tn - 1 - (c0 + step); \
        const float* yb = ybuf + step * 256 + ch * 8; \
        const f32x4 y0 = *(const f32x4*)(yb), y1 = *(const f32x4*)(yb + 4); \
        const f32x4 ys = y0 + y1; \
        const h16 ov = (h16)((ys[0] + ys[1]) + (ys[2] + ys[3])); \
        if (dir == 0) p.P[(size_t)(rowbase + t) * PC + 1152 + h * 64 + 32 * vh + ch] = ov; \
        else p.hy[(size_t)(rowbase + t) * 1024 + 384 + h * 64 + 32 * vh + ch] = ov; } } }
  HGRN_ISSUE(0, pfA)
  HGRN_ISSUE(1, pfB)
  __builtin_amdgcn_s_setprio(2);
#pragma unroll 1
  for (int ci = 0; ci < 272; ci += 2) {
    HGRN_CHUNK(ci, pfA)
    HGRN_CHUNK(ci + 1, pfB)
  }
  __builtin_amdgcn_s_setprio(0);
}

__device__ __forceinline__ void attn_unit(const Params& p, int l, int u) {
  const int tid = tid_opaque(), lane = tid & 63, w = __builtin_amdgcn_readfirstlane(tid >> 6), lq = lane & 31, hh = lane >> 5;
  int b, head, qrow_base, qpos0; bool isctx;
  if (u < 1536) { b = u / 192; int rem = u % 192; int blk = rem / 6; head = rem % 6; qpos0 = blk * 128 + w * 32; qrow_base = b * 4096; isctx = false; }
  else { int j = u - 1536; b = j / 12; int rem = j % 12; int qb = rem / 6; head = rem % 6; qpos0 = qb * 128 + w * 32; qrow_base = NLAT + b * 256; isctx = true; }
  const int g = head / 3;
  const size_t qrow = (size_t)qrow_base + qpos0 + lq;
  half8 qf[4];
#pragma unroll
  for (int s = 0; s < 4; ++s) qf[s] = *(const half8*)(p.P + qrow * PC + 3072 + head * 64 + 16 * s + 8 * hh);
  const float sinkv = p.sink[l * 6 + head];
  float m = sinkv, lsum = hh == 0 ? 1.f : 0.f;
  f32x16 O[2];
#pragma unroll
  for (int r = 0; r < 16; ++r) { O[0][r] = 0.f; O[1][r] = 0.f; }
  const h16* vt = p.VT + (size_t)((b * 2 + g) * 64) * VTS;
  int nband = 0, kstart = 0;
  if (!isctx) { kstart = max(0, qpos0 - 128); const int kend = min(4096, qpos0 + 160); nband = (kend - kstart) >> 5; }
  const int ntiles = nband + 8;
  for (int ti = 0; ti < ntiles; ++ti) {
    const bool band = ti < nband;
    const int kt = band ? kstart + ti * 32 : (ti - nband) * 32;
    const size_t krow = band ? (size_t)b * 4096 + kt + lq : (size_t)NLAT + b * 256 + kt + lq;
    const int vidx = band ? kt : 4096 + kt;
    const h16* kp = p.P + krow * PC + 3456 + g * 64 + 8 * hh;
    f32x16 sacc;
#pragma unroll
    for (int r = 0; r < 16; ++r) sacc[r] = 0.f;
#pragma unroll
    for (int s = 0; s < 4; ++s) { half8 kf = *(const half8*)(kp + 16 * s); sacc = __builtin_amdgcn_mfma_f32_32x32x16_f16(kf, qf[s], sacc, 0, 0, 0); }
    float mx = -INFINITY;
#pragma unroll
    for (int r = 0; r < 16; ++r) {
      float sv = sacc[r];
      if (band) { const int dlt = kt + (r & 3) + 8 * (r >> 2) + 4 * hh - (qpos0 + lq); if (dlt > 128 || dlt < -128) sv = -INFINITY; }
      sacc[r] = sv; mx = fmaxf(mx, sv);
    }
    mx = fmaxf(mx, __shfl_xor(mx, 32));
    const float mn = fmaxf(m, mx); const float corr = __expf(m - mn); m = mn;
    float ps = 0.f; half8 pb[2];
#pragma unroll
    for (int r = 0; r < 16; ++r) { const float pv = __expf(sacc[r] - mn); ps += pv; pb[r >> 3][r & 7] = (h16)pv; }
    lsum = lsum * corr + ps;
#pragma unroll
    for (int r = 0; r < 16; ++r) { O[0][r] *= corr; O[1][r] *= corr; }
#pragma unroll
    for (int s2 = 0; s2 < 2; ++s2)
#pragma unroll
      for (int dt = 0; dt < 2; ++dt) {
        const h16* vp = vt + (size_t)(dt * 32 + lq) * VTS + vidx + 16 * s2 + 4 * hh;
        const half4 lo = *(const half4*)vp, hi = *(const half4*)(vp + 8);
        const half8 vf = {lo[0], lo[1], lo[2], lo[3], hi[0], hi[1], hi[2], hi[3]};
        O[dt] = __builtin_amdgcn_mfma_f32_32x32x16_f16(vf, pb[s2], O[dt], 0, 0, 0);
      }
  }
  lsum += __shfl_xor(lsum, 32);
  const float inv = 1.f / lsum;
#pragma unroll
  for (int dt = 0; dt < 2; ++dt)
#pragma unroll
    for (int g4 = 0; g4 < 4; ++g4) {
      const int d0 = dt * 32 + 8 * g4 + 4 * hh;
      const half4 ga = *(const half4*)(p.P + qrow * PC + 3712 + head * 64 + d0);
      half4 o;
#pragma unroll
      for (int j = 0; j < 4; ++j) { const float gv = (float)ga[j]; o[j] = (h16)(O[dt][g4 * 4 + j] * inv * siluf_(gv)); }
      *(half4*)(p.hy + qrow * 1024 + 640 + head * 64 + d0) = o;
    }
}

__device__ __forceinline__ void phase_mix(const Params& p, int l, int bid, int nb, char* smem, int sub) {
  const int nunits = l == 0 ? 1536 + 96 : 1536;
  if (nb >= 640) {
    if (bid < 384) { if (sub & 1) { const int x = bid & 7, j = bid >> 3; rwkv_chain(p, l, (((j >> 2) * 8 + x) << 2) | (j & 3), smem, bid >= 256); } }
    else if (bid < 512) { if (sub & 2) { const int hb = bid - 384, x = hb & 7, j = hb >> 3; hgrn_chain(p, l, (((j >> 1) * 8 + x) << 1) | (j & 1), smem); } }
    else if (sub & 4) {
      if (nb == 768) {
        const int ab = bid - 512;
        if (ab < 128) { for (int u = ab; u < nunits; u += 384) attn_unit(p, l, u); }
        else { for (int u = 128 + 2 * (ab - 128); u < nunits; u += 384) attn_unit(p, l, u);
               for (int u = 129 + 2 * (ab - 128); u < nunits; u += 384) attn_unit(p, l, u); }
      } else for (int u = bid - 512; u < nunits; u += nb - 512) attn_unit(p, l, u);
    }
  } else {
    for (int it = bid; it < 512 + nunits; it += nb) {
      if (it < 384) rwkv_chain(p, l, it, smem, false);
      else if (it < 512) hgrn_chain(p, l, it - 384, smem);
      else attn_unit(p, l, it - 512);
      __syncthreads();
    }
  }
}

__device__ __forceinline__ float sum4(const f32x4 v) { return (v[0] + v[1]) + (v[2] + v[3]); }
__device__ __forceinline__ f32x4 h4f(const half4 h) { return (f32x4){(float)h[0], (float)h[1], (float)h[2], (float)h[3]}; }
__device__ __forceinline__ half8 zero_h8() { half8 z;
#pragma unroll
  for (int j = 0; j < 8; ++j) z[j] = (h16)0.f; return z; }
__device__ __forceinline__ half4 zero_h4() { half4 z; z[0] = z[1] = z[2] = z[3] = (h16)0.f; return z; }
__device__ __forceinline__ void phase_readout(const Params& p, int l, int bid, int nb, bool dummy) {
  const int tid = tid_opaque(), lane = tid & 63, w = __builtin_amdgcn_readfirstlane(tid >> 6);
  const int nrows = l == 1 ? NLAT : NTOK;
  const int hl = lane >> 4, c4 = (lane & 15) * 4;
  const int gw = bid * 4 + w, nper = (nb * 4) / 3;
  const int q = gw % 3, ridx = gw / 3;
  if (ridx >= nper) return;
  const int rpw = (nrows + nper - 1) / nper;
  const int r0 = ridx * rpw, r1 = min(nrows, r0 + rpw);
  if (r0 >= r1) return;
  if (q < 2) {
    const int head = q * 4 + hl; const bool valid = head < 6; const int hcl = valid ? head : 5; const int c = hcl * 64 + c4;
    const f32x4 mpr = *(const f32x4*)(p.mu_prev + l * 1792 + c), mnr = *(const f32x4*)(p.mu_next + l * 1792 + c);
    const f32x4 mpk = *(const f32x4*)(p.mu_prev + l * 1792 + 384 + c), mnk = *(const f32x4*)(p.mu_next + l * 1792 + 384 + c);
    const f32x4 mpg = *(const f32x4*)(p.mu_prev + l * 1792 + 1408 + c), mng = *(const f32x4*)(p.mu_next + l * 1792 + 1408 + c);
    const f32x4 gwt = *(const f32x4*)(p.gn_w + l * 384 + c), gbs = *(const f32x4*)(p.gn_b + l * 384 + c), rkw = *(const f32x4*)(p.r_k + l * 384 + c);
    const h16* prk = p.P + hcl * 128 + 2 * c4;
    const h16* pg = p.P + 1408 + c;
    half8 rk_prev = r0 > 0 ? *(const half8*)(prk + (size_t)(r0 - 1) * PC) : zero_h8();
    half4 g_prev = r0 > 0 ? *(const half4*)(pg + (size_t)(r0 - 1) * PC) : zero_h4();
    half8 rk_cur = *(const half8*)(prk + (size_t)r0 * PC);
    half4 g_cur = *(const half4*)(pg + (size_t)r0 * PC);
    half8 rk_next = r0 + 1 < NTOK ? *(const half8*)(prk + (size_t)(r0 + 1) * PC) : zero_h8();
    half4 g_next = r0 + 1 < NTOK ? *(const half4*)(pg + (size_t)(r0 + 1) * PC) : zero_h4();
    half4 yf_c = *(const half4*)(p.P + (size_t)r0 * PC + 768 + c), yb_c = *(const half4*)(p.hy + (size_t)r0 * 1024 + c), v_c = *(const half4*)(p.VB + (size_t)r0 * 384 + c);
#pragma unroll 1
    for (int row = r0; row < r1; ++row) {
      const bool more = row + 1 < r1;
      const half8 rk_nn = row + 2 < NTOK ? *(const half8*)(prk + (size_t)(row + 2) * PC) : zero_h8();
      const half4 g_nn = row + 2 < NTOK ? *(const half4*)(pg + (size_t)(row + 2) * PC) : zero_h4();
      half4 yf_n = yf_c, yb_n = yb_c, v_n = v_c;
      if (more) { yf_n = *(const half4*)(p.P + (size_t)(row + 1) * PC + 768 + c); yb_n = *(const half4*)(p.hy + (size_t)(row + 1) * 1024 + c); v_n = *(const half4*)(p.VB + (size_t)(row + 1) * 384 + c); }
      int t, Tn;
      if (row < NLAT) { t = row & 4095; Tn = 4096; } else { t = (row - NLAT) & 255; Tn = 256; }
      const bool hp = t > 0, hn = t + 1 < Tn;
      f32x4 sh[3];
#pragma unroll
      for (int k = 0; k < 2; ++k) {
        const f32x4 cur = {(float)rk_cur[k], (float)rk_cur[2 + k], (float)rk_cur[4 + k], (float)rk_cur[6 + k]};
        f32x4 prv = {(float)rk_prev[k], (float)rk_prev[2 + k], (float)rk_prev[4 + k], (float)rk_prev[6 + k]};
        f32x4 nxt = {(float)rk_next[k], (float)rk_next[2 + k], (float)rk_next[4 + k], (float)rk_next[6 + k]};
        if (!hp) prv = (f32x4){0.f, 0.f, 0.f, 0.f};
        if (!hn) nxt = (f32x4){0.f, 0.f, 0.f, 0.f};
        sh[k] = cur + (k == 0 ? mpr : mpk) * (prv - cur) + (k == 0 ? mnr : mnk) * (nxt - cur);
      }
      {
        const f32x4 cur = h4f(g_cur);
        f32x4 prv = h4f(g_prev), nxt = h4f(g_next);
        if (!hp) prv = (f32x4){0.f, 0.f, 0.f, 0.f};
        if (!hn) nxt = (f32x4){0.f, 0.f, 0.f, 0.f};
        sh[2] = cur + mpg * (prv - cur) + mng * (nxt - cur);
      }
      const f32x4 y = h4f(yf_c) + h4f(yb_c);
      const f32x4 v = h4f(v_c);
      const float mean = red16(sum4(y)) * (1.f / 64.f);
      const f32x4 yc = y - mean;
      const float var = red16(sum4(yc * yc)) * (1.f / 64.f);
      const float rs = rsqrtf(var + 64e-5f);
      const float bs = red16(sum4(sh[0] * sh[1] * rkw));
      half4 o;
#pragma unroll
      for (int j = 0; j < 4; ++j) o[j] = (h16)((yc[j] * rs * gwt[j] + gbs[j] + bs * v[j]) * siluf_(sh[2][j]));
      h16* yw = dummy ? p.F + (size_t)row * 1536 : p.hy + (size_t)row * 1024;
      if (valid) *(half4*)(yw + c) = o;
      rk_prev = rk_cur; rk_cur = rk_next; rk_next = rk_nn;
      g_prev = g_cur; g_cur = g_next; g_next = g_nn;
      yf_c = yf_n; yb_c = yb_n; v_c = v_n;
    }
  } else {
    const int c = hl * 64 + c4;
    const f32x4 nw = *(const f32x4*)(p.hg_norm_w + l * 256 + c);
    half4 of_c = *(const half4*)(p.P + (size_t)r0 * PC + 1152 + c), ob_c = *(const half4*)(p.hy + (size_t)r0 * 1024 + 384 + c), g_c = *(const half4*)(p.P + (size_t)r0 * PC + 2816 + c);
#pragma unroll 1
    for (int row = r0; row < r1; ++row) {
      half4 of_n = of_c, ob_n = ob_c, g_n = g_c;
      if (row + 1 < r1) { of_n = *(const half4*)(p.P + (size_t)(row + 1) * PC + 1152 + c); ob_n = *(const half4*)(p.hy + (size_t)(row + 1) * 1024 + 384 + c); g_n = *(const half4*)(p.P + (size_t)(row + 1) * PC + 2816 + c); }
      const f32x4 o = h4f(of_c) + h4f(ob_c);
      const f32x4 g = h4f(g_c);
      const float ms = red16(sum4(o * o)) * (1.f / 64.f);
      const float rs = rsqrtf(ms + 1e-6f);
      half4 ov;
#pragma unroll
      for (int j = 0; j < 4; ++j) ov[j] = (h16)(o[j] * rs * nw[j] * siluf_(g[j]));
      h16* yw = dummy ? p.F + (size_t)row * 1536 : p.hy + (size_t)row * 1024;
      *(half4*)(yw + 384 + c) = ov;
      of_c = of_n; ob_c = ob_n; g_c = g_n;
    }
  }
}

__device__ __forceinline__ void phase_final(const Params& p, int bid, int nb) {
  const int tid = tid_opaque(), lane = tid & 63, w = __builtin_amdgcn_readfirstlane(tid >> 6);
  for (int row = bid * 4 + w; row < NLAT; row += nb * 4) {
    float* src = p.out + (size_t)row * 1024;
    f32x4 v[4]; float ss = 0.f;
#pragma unroll
    for (int i = 0; i < 4; ++i) { v[i] = *(const f32x4*)(src + i * 256 + lane * 4); ss += v[i][0] * v[i][0] + v[i][1] * v[i][1] + v[i][2] * v[i][2] + v[i][3] * v[i][3]; }
    ss = wave_sum_dpp(ss);
    const float rs = rsqrtf(ss * (1.f / 1024.f) + 1e-6f);
#pragma unroll
    for (int i = 0; i < 4; ++i) {
      const int col = i * 256 + lane * 4;
      const f32x4 nwv = *(const f32x4*)(p.final_w + col);
      f32x4 o;
#pragma unroll
      for (int j = 0; j < 4; ++j) o[j] = v[i][j] * rs * nwv[j];
      *(f32x4*)(src + col) = o;
    }
  }
}

__global__ void __launch_bounds__(256, 3) __attribute__((target("no-packed-fp32-ops"))) mega(Params p, int ph_lo, int ph_hi, int coop) {
  __shared__ __attribute__((aligned(16))) char smem[SMEM_BYTES];
  __shared__ uint4 xb_words;
  XcdBarrier xb; xb.bar = p.bar; xb.x = 0; xb.st = (volatile LAS unsigned*)&xb_words;
  if (coop) { if (threadIdx.x == 0) xb_words = make_uint4(0u, 0u, 0u, 0u); __syncthreads(); xb = xcd_barrier_post(p.bar, (volatile LAS unsigned*)&xb_words); }
  if (coop) for (int i = 0; i < EXTRA_SYNCS; ++i) { xcd_barrier(xb); }
  if (coop == 2) cg::this_grid().sync();
  for (int ph = ph_lo; ph < ph_hi; ++ph) {
    for (int rep = 0; rep < (((PROBE_MASK >> ph) & 1) ? 2 : 1); ++rep) {
      int bid = blockIdx.x, nb = gridDim.x;
      asm volatile("" : "+s"(bid), "+s"(nb));
      if (ph == 0) phase_prep(p, bid, nb, smem);
      else if (ph == 13) phase_final(p, bid, nb);
      else {
        const int l = (ph - 1) / 6, s = (ph - 1) % 6;
        if (s == 0) phase_norm(p, l, bid, nb);
        else if (s == 1) phase_gemm<0>(p, l, bid, nb, smem);
        else if (s == 2) phase_feat(p, l, bid, nb, smem, PROBE_MASK && ((PROBE_MASK >> ph) & 1) && rep == 0);
        else if (s == 3) phase_mix(p, l, bid, nb, smem, rep ? PROBE_SUB : 7);
        else if (s == 4) phase_readout(p, l, bid, nb, PROBE_MASK && ((PROBE_MASK >> ph) & 1) && rep == 0);
        else phase_gemm<1>(p, l, bid, nb, smem);
      }
      if (PROBE_MASK && rep == 0 && ((PROBE_MASK >> ph) & 1)) { xcd_barrier(xb); }
    }
    if (coop && ph + 1 < ph_hi) { xcd_barrier(xb); }
  }
}

extern "C" void kernel_launch(void* const* d_in, const int* in_sizes, int n_in, void* d_out, int out_size, void* d_ws, size_t ws_size, hipStream_t stream) {
  static int grid_blocks = 0;
  if (!grid_blocks) {
    int dev = 0, cus = 0, per_cu = 0;
    hipGetDevice(&dev);
    hipDeviceGetAttribute(&cus, hipDeviceAttributeMultiprocessorCount, dev);
    hipOccupancyMaxActiveBlocksPerMultiprocessor(&per_cu, mega, 256, 0);
    if (per_cu < 1) per_cu = 1;
    grid_blocks = cus * per_cu;
  }
  Params p{};
  const float* const* in = (const float* const*)d_in;
  p.x = in[0]; p.c = in[1]; p.ctx = in[2]; p.c_ctx = in[3]; p.mod_w = in[4]; p.mod_b = in[5]; p.norm_w = in[6]; p.w_in = in[7]; p.w_out = in[8];
  p.mu_prev = in[9]; p.mu_next = in[10]; p.w0 = in[11]; p.w2 = in[12]; p.a0 = in[13]; p.a2 = in[14]; p.k_k = in[15]; p.k_a = in[16]; p.r_k = in[17];
  p.gn_w = in[18]; p.gn_b = in[19]; p.vw1 = in[20]; p.vw2 = in[21]; p.vb = in[22]; p.lb_logits = in[23]; p.hg_norm_w = in[24]; p.sink = in[25]; p.final_w = in[26];
  p.out = (float*)d_out;
  char* ws = (char*)d_ws; size_t off = 0;
  auto take = [&](size_t bytes) { char* r = ws + off; off += (bytes + 255) & ~(size_t)255; return r; };
  p.win_t = (h16*)take((size_t)2 * NPAD * 1024 * 2);
  p.wout_t = (h16*)take((size_t)2 * 1024 * 1024 * 2);
  p.wl_t = (h16*)take((size_t)2 * 4 * 384 * 64 * 2);
  p.mod = (float*)take((size_t)2 * 9 * 3072 * 4);
  p.rope = (float*)take((size_t)64 * 16 * 2 * 4);
  p.hy = (h16*)take((size_t)NTOK * 1024 * 2);
  p.P = (h16*)take((size_t)NTOK * PC * 2);
  p.F = (h16*)take((size_t)NTOK * 1536 * 2);
  p.VB = (h16*)take((size_t)NTOK * 384 * 2);
  p.VT = (h16*)take((size_t)16 * 64 * VTS * 2);
  p.xc1 = (float*)take((size_t)2048 * 1024 * 4);
  p.bar = (unsigned*)take(16384);
  if (off > ws_size) fprintf(stderr, "workspace too small: need %zu have %zu\n", off, ws_size);
#if SINGLE_LAUNCH
  hipMemsetAsync(p.bar, 0, 16384, stream);
  int lo = 0, hi = 14, coop = 1;
  void* args[] = {&p, &lo, &hi, &coop};
  hipError_t e = hipLaunchCooperativeKernel((void*)mega, dim3(grid_blocks), dim3(256), args, 0, stream);
  if (e != hipSuccess) fprintf(stderr, "cooperative launch failed: %s (grid %d)\n", hipGetErrorString(e), grid_blocks);
#else
  for (int ph = 0; ph < 14; ++ph) mega<<<grid_blocks, 256, 0, stream>>>(p, ph, ph + 1, 0);
#endif
}
```
